# Optimizing an MI355X kernel written in HIP

```python
import jax, jax.numpy as jnp
from jax import lax
import numpy as np

D_MODEL = 1024
BATCH = 16
SEQ = 256
DEPTH = 2
DEC_BATCH = 8
DEC_SEQ = 1024
PAST_LEN = 512

GRID_W = 64
N_HEADS = 16
HEAD_DIM = D_MODEL // N_HEADS
ATTN_SCALE = HEAD_DIM ** -0.5
WIN_ROWS = 8
WIN_COLS = 16
Q_BLOCK = 128
D_LRU = D_MODEL
LRU_BLOCKS = 8
LRU_BLOCK_W = D_LRU // LRU_BLOCKS
CONV_W = 4
LRU_C = 8.0
D_FF = -(-(8 * D_MODEL) // (3 * 256)) * 256
N_MOD = 6
N_ATTN = (DEPTH + 1) // 2
N_LRU = DEPTH // 2
RMS_EPS = 1e-6
NEG_INF = -1e30

kernel_name = 'hybrid_na_rglru_flow_step'


def _rms_norm(x, g):
    xf = x.astype(jnp.float32)
    y = xf * lax.rsqrt(jnp.mean(xf * xf, axis=-1, keepdims=True) + RMS_EPS)
    return (y * g.astype(jnp.float32)).astype(x.dtype)


def _adaln(cond, w_mod, b_mod):
    m = jax.nn.silu(cond) @ w_mod + b_mod
    return jnp.split(m, N_MOD, axis=-1)


def _modulate(x, g, shift, scale):
    return _rms_norm(x, g) * (1 + scale[:, None, :]) + shift[:, None, :]


def _swiglu(x, w_gu, w_down):
    gate, up = jnp.split(x @ w_gu, 2, axis=-1)
    return (jax.nn.silu(gate) * up) @ w_down


def _qkv(xm, w_qkv):
    B, T, _ = xm.shape
    q, k, v = jnp.split(xm @ w_qkv, 3, axis=-1)
    shp = (B, T, N_HEADS, HEAD_DIM)
    return q.reshape(shp), k.reshape(shp), v.reshape(shp)


def _context_self_attention(q, k, v):
    B, L, H, hd = q.shape
    nb = L // Q_BLOCK
    qb = jnp.moveaxis(q.reshape(B, nb, Q_BLOCK, H, hd), 1, 0)

    def block(qblk):
        s = jnp.einsum('bqhd,bkhd->bhqk', qblk * ATTN_SCALE, k).astype(jnp.float32)
        p = jax.nn.softmax(s, axis=-1).astype(v.dtype)
        return jnp.einsum('bhqk,bkhd->bqhd', p, v)

    o = lax.map(block, qb)
    return jnp.moveaxis(o, 0, 1).reshape(B, L, H * hd)


def _neighbourhood_attention(q, k, v, ck, cv, rpb):
    B, T, H, hd = q.shape
    rows = T // GRID_W
    kh = min(WIN_ROWS, rows)
    r = jnp.arange(rows)
    row_start = jnp.clip(r - kh // 2, 0, rows - kh)
    row_idx = row_start[:, None] + jnp.arange(kh)[None, :]
    col = jnp.arange(GRID_W)
    col_start = jnp.clip(col - WIN_COLS // 2, 0, GRID_W - WIN_COLS)
    in_win = (col[None, :] >= col_start[:, None]) & (col[None, :] < col_start[:, None] + WIN_COLS)
    dr = row_idx - r[:, None] + (WIN_ROWS - 1)
    dc = jnp.clip(col[None, :] - col[:, None], -(WIN_COLS - 1), WIN_COLS - 1) + (WIN_COLS - 1)
    bias = rpb.astype(jnp.float32)[:, dr[:, None, :, None], dc[None, :, None, :]]
    bias = jnp.where(in_win[None, None, :, None, :], bias, NEG_INF)
    qg = q.reshape(B, rows, GRID_W, H, hd) * ATTN_SCALE
    kg = k.reshape(B, rows, GRID_W, H, hd)[:, row_idx]
    vg = v.reshape(B, rows, GRID_W, H, hd)[:, row_idx]
    s_lat = jnp.einsum('brqhd,brjkhd->bhrqjk', qg, kg).astype(jnp.float32) + bias[None]
    s_ctx = jnp.einsum('brqhd,bchd->bhrqc', qg, ck).astype(jnp.float32)
    n_lat = kh * GRID_W
    s = jnp.concatenate([s_lat.reshape(B, H, rows, GRID_W, n_lat), s_ctx], axis=-1)
    p = jax.nn.softmax(s, axis=-1).astype(v.dtype)
    p_lat = p[..., :n_lat].reshape(B, H, rows, GRID_W, kh, GRID_W)
    p_ctx = p[..., n_lat:]
    o = (jnp.einsum('bhrqjk,brjkhd->brqhd', p_lat, vg)
         + jnp.einsum('bhrqc,bchd->brqhd', p_ctx, cv))
    return o.reshape(B, T, H * hd)


def _centred_depthwise_conv(x, w, b):
    T = x.shape[1]
    left = CONV_W // 2
    xp = jnp.pad(x, ((0, 0), (left, CONV_W - 1 - left), (0, 0)))
    y = b
    for j in range(CONV_W):
        y = y + xp[:, j:j + T] * w[j]
    return y


def _rglru_coeffs(xc, w_a, b_a, w_i, b_i, lam):
    B, T, D = xc.shape
    xb = xc.reshape(B, T, LRU_BLOCKS, LRU_BLOCK_W)
    r = jax.nn.sigmoid(jnp.einsum('btnk,nkj->btnj', xb, w_a).reshape(B, T, D) + b_a)
    i = jax.nn.sigmoid(jnp.einsum('btnk,nkj->btnj', xb, w_i).reshape(B, T, D) + b_i)
    log_a = -LRU_C * r * jax.nn.softplus(-lam.astype(jnp.float32))
    a = jnp.exp(log_a)
    b = jnp.sqrt(-jnp.expm1(2.0 * log_a)) * (i * xc)
    return a.astype(jnp.float32), b.astype(jnp.float32)


def _linear_scan(a, b, h0, reverse):
    def step(h, ab):
        a_t, b_t = ab
        h = a_t * h + b_t
        return h, h

    h_last, hs = lax.scan(step, h0, (jnp.swapaxes(a, 0, 1), jnp.swapaxes(b, 0, 1)), reverse=reverse)
    return jnp.swapaxes(hs, 0, 1), h_last


def _lru_mixer(xm, h0, w_in, conv_w, conv_b, w_a, b_a, w_i, b_i, lam, w_out):
    gate, xr = jnp.split(xm @ w_in, 2, axis=-1)
    xc = _centred_depthwise_conv(xr, conv_w, conv_b).astype(jnp.float32)
    h0 = h0.astype(jnp.float32)
    a_f, b_f = _rglru_coeffs(xc, w_a[0], b_a[0], w_i[0], b_i[0], lam[0])
    a_b, b_b = _rglru_coeffs(xc, w_a[1], b_a[1], w_i[1], b_i[1], lam[1])
    hs_f, hT_f = _linear_scan(a_f, b_f, h0[:, 0], reverse=False)
    hs_b, hT_b = _linear_scan(a_b, b_b, h0[:, 1], reverse=True)
    y = (hs_f + hs_b).astype(xm.dtype) * jax.nn.gelu(gate)
    return y @ w_out, jnp.stack([hT_f, hT_b], axis=1)


def setup_inputs(seed: int = 0) -> dict:
    key = jax.random.key(seed)
    ks = jax.random.split(key, 32)
    f32 = jnp.float32

    def nrm(k, shape, scale):
        return jax.random.normal(k, shape, f32) * scale

    D = D_MODEL
    u = jax.random.uniform(ks[20], (N_LRU, 2, D_LRU), f32, 0.9, 0.999)
    a0 = u ** (1.0 / LRU_C)
    return {
        'x_prompt': nrm(ks[0], (BATCH, SEQ, D), 1.0),
        'x_sample': nrm(ks[1], (DEC_BATCH, DEC_SEQ, D), 1.0),
        'c': nrm(ks[2], (DEC_BATCH, D), 1.0),
        'cache_k': nrm(ks[3], (DEC_BATCH, N_ATTN, PAST_LEN, N_HEADS, HEAD_DIM), 1.0),
        'cache_v': nrm(ks[4], (DEC_BATCH, N_ATTN, PAST_LEN, N_HEADS, HEAD_DIM), 1.0),
        'state_h': nrm(ks[5], (DEC_BATCH, N_LRU, 2, D_LRU), 0.5),
        'c_ctx': nrm(ks[6], (D,), 1.0),
        'norm_g': 1.0 + nrm(ks[7], (DEPTH, 2, D), 0.02),
        'w_mod': nrm(ks[8], (DEPTH, D, N_MOD * D), 0.5 * D ** -0.5),
        'b_mod': nrm(ks[9], (DEPTH, N_MOD * D), 0.02),
        'attn_w_qkv': nrm(ks[10], (N_ATTN, D, 3 * D), D ** -0.5),
        'attn_w_o': nrm(ks[11], (N_ATTN, D, D), D ** -0.5),
        'attn_rpb': nrm(ks[12], (N_ATTN, N_HEADS, 2 * WIN_ROWS - 1, 2 * WIN_COLS - 1), 0.1),
        'lru_w_in': nrm(ks[13], (N_LRU, D, 2 * D_LRU), D ** -0.5),
        'lru_conv_w': nrm(ks[14], (N_LRU, CONV_W, D_LRU), CONV_W ** -0.5),
        'lru_conv_b': nrm(ks[15], (N_LRU, D_LRU), 0.02),
        'lru_w_a': nrm(ks[16], (N_LRU, 2, LRU_BLOCKS, LRU_BLOCK_W, LRU_BLOCK_W), LRU_BLOCK_W ** -0.5),
        'lru_b_a': nrm(ks[17], (N_LRU, 2, D_LRU), 0.02),
        'lru_w_i': nrm(ks[18], (N_LRU, 2, LRU_BLOCKS, LRU_BLOCK_W, LRU_BLOCK_W), LRU_BLOCK_W ** -0.5),
        'lru_b_i': nrm(ks[19], (N_LRU, 2, D_LRU), 0.02),
        'lru_lam': jnp.log(a0) - jnp.log1p(-a0),
        'lru_w_out': nrm(ks[21], (N_LRU, D_LRU, D), D_LRU ** -0.5),
        'ffn_w_gu': nrm(ks[22], (DEPTH, D, 2 * D_FF), D ** -0.5),
        'ffn_w_down': nrm(ks[23], (DEPTH, D_FF, D), D_FF ** -0.5),
        'final_g': 1.0 + nrm(ks[24], (D,), 0.02),
    }


def reference(x_prompt, x_sample, c, cache_k, cache_v, state_h, c_ctx, norm_g, w_mod, b_mod,
              attn_w_qkv, attn_w_o, attn_rpb, lru_w_in, lru_conv_w, lru_conv_b, lru_w_a, lru_b_a,
              lru_w_i, lru_b_i, lru_lam, lru_w_out, ffn_w_gu, ffn_w_down, final_g):
    ctx = x_prompt
    lat = x_sample
    new_k, new_v, new_h = [], [], []
    for i in range(DEPTH):
        j = i // 2
        sh1_c, sc1_c, g1_c, sh2_c, sc2_c, g2_c = _adaln(c_ctx[None, :], w_mod[i], b_mod[i])
        sh1_l, sc1_l, g1_l, sh2_l, sc2_l, g2_l = _adaln(c, w_mod[i], b_mod[i])
        xm_c = _modulate(ctx, norm_g[i, 0], sh1_c, sc1_c)
        xm_l = _modulate(lat, norm_g[i, 0], sh1_l, sc1_l)
        if i % 2 == 0:
            q_c, k_c, v_c = _qkv(xm_c, attn_w_qkv[j])
            o_c = _context_self_attention(q_c, k_c, v_c) @ attn_w_o[j]
            q_l, k_l, v_l = _qkv(xm_l, attn_w_qkv[j])
            o_l = _neighbourhood_attention(q_l, k_l, v_l, cache_k[:, j], cache_v[:, j], attn_rpb[j]) @ attn_w_o[j]
            new_k.append(k_c)
            new_v.append(v_c)
        else:
            lru_p = (lru_w_in[j], lru_conv_w[j], lru_conv_b[j], lru_w_a[j], lru_b_a[j],
                     lru_w_i[j], lru_b_i[j], lru_lam[j], lru_w_out[j])
            h0_c = jnp.zeros((ctx.shape[0], 2, D_LRU), jnp.float32)
            o_c, h_c = _lru_mixer(xm_c, h0_c, *lru_p)
            o_l, _ = _lru_mixer(xm_l, state_h[:, j], *lru_p)
            new_h.append(h_c)
        ctx = ctx + g1_c[:, None, :] * o_c
        lat = lat + g1_l[:, None, :] * o_l
        f_c = _swiglu(_modulate(ctx, norm_g[i, 1], sh2_c, sc2_c), ffn_w_gu[i], ffn_w_down[i])
        f_l = _swiglu(_modulate(lat, norm_g[i, 1], sh2_l, sc2_l), ffn_w_gu[i], ffn_w_down[i])
        ctx = ctx + g2_c[:, None, :] * f_c
        lat = lat + g2_l[:, None, :] * f_l
    y_prompt = _rms_norm(ctx, final_g)
    y_sample = _rms_norm(lat, final_g)
    return (y_prompt, y_sample, jnp.stack(new_k, axis=1), jnp.stack(new_v, axis=1), jnp.stack(new_h, axis=1))
```

```cpp
#include <hip/hip_runtime.h>
#include <hip/hip_cooperative_groups.h>
#include <cstdio>
#include <cstdint>
namespace cg = cooperative_groups;

#define LAS __attribute__((address_space(3)))
typedef unsigned short bf16_t;
typedef short bf16x8 __attribute__((ext_vector_type(8)));
typedef short s16x4 __attribute__((ext_vector_type(4)));
typedef float f32x4 __attribute__((ext_vector_type(4)));
typedef float f32x2 __attribute__((ext_vector_type(2)));
typedef float f32x16 __attribute__((ext_vector_type(16)));
typedef unsigned u32x4 __attribute__((ext_vector_type(4)));
typedef unsigned u32x2 __attribute__((ext_vector_type(2)));
typedef __bf16 bf16x2_t __attribute__((ext_vector_type(2)));

constexpr int D = 1024, MC = 4096, ML = 8192, MT = MC + ML, FF = 2816, NQKV = 3072, NMOD = 6144;
constexpr float LOG2E = 1.4426950408889634f;
constexpr float RMS_EPS = 1e-6f;

constexpr size_t MiB = 1u << 20;
constexpr size_t WS_MOD = 0;
constexpr size_t WS_FCNT = 768 * 1024;
constexpr size_t WS_SSQ = 512 * 1024;
constexpr size_t WS_WQKV = 1 * MiB, WS_WO = 7 * MiB, WS_WGU = 9 * MiB, WS_WDN = 31 * MiB, WS_WIN = 42 * MiB, WS_WOUT = 46 * MiB, WS_WG = 48 * MiB;
constexpr size_t WS_CK = 49 * MiB, WS_CV = 57 * MiB;
constexpr size_t WS_PF = 49 * MiB;
constexpr size_t WS_XN = 65 * MiB;
constexpr size_t WS_Q = 89 * MiB, WS_K = 113 * MiB, WS_V = 137 * MiB;
constexpr size_t WS_H = 89 * MiB;
constexpr size_t WS_GATE = 89 * MiB, WS_XR = 113 * MiB, WS_Y = 113 * MiB;
constexpr size_t WS_XN2 = 161 * MiB;
constexpr size_t WS_PB = 137 * MiB;
constexpr size_t WS_XB = 185 * MiB;
constexpr size_t WS_HLF = 209 * MiB, WS_HLB = 161 * MiB;
constexpr size_t WS_SUMP = 250 * MiB;
constexpr size_t WS_SUME = 250 * MiB + 512 * 1024;
constexpr size_t WS_SHW = 252 * MiB;
constexpr int SHW_OFF0 = 0, SHW_OFF1 = 9 * 5632, SHW_OFF2 = 9 * 5632 + 9 * 2048;
constexpr size_t WS_END = 256 * MiB;

constexpr int LDS_BYTES = 143360;
constexpr int AB_PITCH = 1056;
constexpr int HST_OFF = 128 * AB_PITCH;

enum { I_x_prompt = 0, I_x_sample = 1, I_c = 2, I_cache_k = 3, I_cache_v = 4, I_state_h = 5, I_c_ctx = 6, I_norm_g = 7, I_w_mod = 8, I_b_mod = 9, I_w_qkv = 10, I_w_o = 11, I_rpb = 12, I_w_in = 13, I_conv_w = 14, I_conv_b = 15, I_w_a = 16, I_b_a = 17, I_w_i = 18, I_b_i = 19, I_lam = 20, I_w_out = 21, I_w_gu = 22, I_w_down = 23, I_final_g = 24, I_out = 25, I_ws = 26 };
constexpr int PTAB_OFF = LDS_BYTES - 256;
struct PT {
    LAS const unsigned long long* t;
    __device__ __forceinline__ unsigned long long raw(int i) const { const unsigned long long v = t[i]; const unsigned lo = __builtin_amdgcn_readfirstlane((unsigned)v), hi = __builtin_amdgcn_readfirstlane((unsigned)(v >> 32)); return ((unsigned long long)hi << 32) | lo; }
    __device__ __forceinline__ const float* f(int i) const { return (const float*)(const __attribute__((address_space(1))) float*)raw(i); }
    __device__ __forceinline__ float* out() const { return (float*)(__attribute__((address_space(1))) float*)raw(I_out); }
    __device__ __forceinline__ unsigned char* ws() const { return (unsigned char*)(__attribute__((address_space(1))) unsigned char*)raw(I_ws); }
};
constexpr size_t OUT_Y = 0, OUT_NK = (size_t)MT * D, OUT_NV = OUT_NK + (size_t)MC * D, OUT_NH = OUT_NV + (size_t)MC * D;
constexpr int CST_OFF = HST_OFF + 1024;
__device__ __forceinline__ int tid_l(int wv) { int l; asm volatile("v_mbcnt_lo_u32_b32 %0, -1, 0\n\tv_mbcnt_hi_u32_b32 %0, -1, %0" : "=v"(l)); return wv * 64 + l; }
__device__ __forceinline__ int bx_l() { int b = blockIdx.x; asm volatile("" : "+s"(b)); return b; }
__device__ __forceinline__ int gd_l() { int g = gridDim.x; asm volatile("" : "+s"(g)); return g; }

constexpr size_t WS_BAR = 448 * 1024;
constexpr int BARST_OFF = PTAB_OFF + 224;
#define XB_TMO      128
#define XB_XCNT(j)  (256  + 64 * (j))
#define XB_XSUB(j)  (1280 + 64 * (j))
#define XB_XGEN(j)  (2304 + 64 * (j))
#define XB_TOP      3328
#define XB_TOPGEN   3392
#define XCD_BAR_WORDS 3456
#define XB_SPIN_CAP (1u << 18)
__device__ __forceinline__ unsigned xb_ld(unsigned* p)              { return __hip_atomic_load(p, __ATOMIC_RELAXED, __HIP_MEMORY_SCOPE_AGENT); }
__device__ __forceinline__ unsigned xb_add(unsigned* p, unsigned v) { return __hip_atomic_fetch_add(p, v, __ATOMIC_RELAXED, __HIP_MEMORY_SCOPE_AGENT); }
__device__ __forceinline__ unsigned xb_xcc_id() { return (unsigned)__builtin_amdgcn_s_getreg((3 << 11) | 20) & 0xFu; }
#define XB_SPIN(cond, bar) do { unsigned _sp = 0; while (cond) { __builtin_amdgcn_s_sleep(1); \
    if ((++_sp & 255u) == 0u) { if (xb_ld(&(bar)[XB_TMO])) break; if (_sp > XB_SPIN_CAP) { atomicAdd(&(bar)[XB_TMO], 1u); break; } } } } while (0)
__device__ __forceinline__ void xcd_barrier_complete(unsigned* bar, unsigned x, unsigned& nloc, unsigned& nx) {
    const unsigned G = gridDim.x;
    unsigned sum, cnt, mine, sp = 0u;
    for (;;) {
        sum = 0u; cnt = 0u; mine = 0u;
#pragma unroll
        for (unsigned j = 0; j < 16; ++j) { const unsigned c = xb_ld(&bar[XB_XCNT(j)]); sum += c; cnt += (c > 0u) ? 1u : 0u; mine = (j == x) ? c : mine; }
        if (sum == G) break;
        __builtin_amdgcn_s_sleep(1);
        if ((++sp & 255u) == 0u) { if (xb_ld(&bar[XB_TMO])) break; if (sp > XB_SPIN_CAP) { atomicAdd(&bar[XB_TMO], 1u); break; } }
    }
    nloc = mine > 0u ? mine : 1u; nx = cnt > 0u ? cnt : 1u;
}
__device__ __forceinline__ void xcd_barrier(const PT pt, LAS unsigned char* lds, int wv) {
    asm volatile("s_waitcnt vmcnt(0)" ::: "memory");
    __syncthreads();
    if (tid_l(wv) == 0) {
        unsigned* bar = (unsigned*)(pt.ws() + WS_BAR);
        volatile LAS unsigned* st = (volatile LAS unsigned*)(lds + BARST_OFF);
        const unsigned x = xb_xcc_id();
        __builtin_amdgcn_s_waitcnt(0);
        unsigned nloc = st[0], nx = st[1];
        if (nloc == 0u) { xcd_barrier_complete(bar, x, nloc, nx); st[0] = nloc; st[1] = nx; }
        const unsigned old = xb_add(&bar[XB_XSUB(x)], 1u);
        const unsigned gen = old / nloc;
        if (old + 1u == (gen + 1u) * nloc) {
            __builtin_amdgcn_fence(__ATOMIC_RELEASE, "agent");
            asm volatile("s_waitcnt vmcnt(0)" ::: "memory");
            const unsigned og = xb_add(&bar[XB_TOP], 1u);
            const unsigned tg = og / nx;
            if (og + 1u == (tg + 1u) * nx) xb_add(&bar[XB_TOPGEN], 1u);
            else XB_SPIN(xb_ld(&bar[XB_TOPGEN]) == tg, bar);
            __builtin_amdgcn_fence(__ATOMIC_ACQUIRE, "agent");
            xb_add(&bar[XB_XGEN(x)], 1u);
            asm volatile("s_waitcnt vmcnt(0)" ::: "memory");
        } else {
            XB_SPIN(xb_ld(&bar[XB_XGEN(x)]) == gen, bar);
            __builtin_amdgcn_fence(__ATOMIC_ACQUIRE, "agent");
            asm volatile("s_waitcnt vmcnt(0)" ::: "memory");
        }
    }
    __syncthreads();
}
__device__ __forceinline__ unsigned pk_bf16(float lo, float hi) { f32x2 v = {lo, hi}; bf16x2_t b = __builtin_convertvector(v, bf16x2_t); return __builtin_bit_cast(unsigned, b); }
__device__ __forceinline__ float bf_lo(unsigned u) { return __uint_as_float(u << 16); }
__device__ __forceinline__ float bf_hi(unsigned u) { return __uint_as_float(u & 0xffff0000u); }
__device__ __forceinline__ float fast_rcp(float x) { return __builtin_amdgcn_rcpf(x); }
__device__ __forceinline__ float fast_exp2(float x) { return __builtin_amdgcn_exp2f(x); }
__device__ __forceinline__ float sigmoid_f(float x) { return fast_rcp(1.f + fast_exp2(-x * LOG2E)); }
__device__ __forceinline__ float silu_f(float x) { return x * sigmoid_f(x); }
__device__ __forceinline__ float gelu_tanh_f(float x) { const float u = 0.7978845608028654f * (x + 0.044715f * x * x * x); return x * sigmoid_f(2.f * u); }
__device__ __forceinline__ float shfl_xor_l(float v, int mask, int lane) { return __int_as_float(__builtin_amdgcn_ds_bpermute((lane ^ mask) << 2, __float_as_int(v))); }
__device__ __forceinline__ float wave_sum(float v, int lane) {
#pragma unroll
    for (int o = 1; o < 64; o <<= 1) v += shfl_xor_l(v, o, lane);
    return v;
}
namespace pg8 {
#define PG8_LAS __attribute__((address_space(3)))
constexpr int BM = 256, BK = 64, HALF = 128, HTB = HALF * BK * 2  , STAGE_BYTES = 8 * HTB, NXCD = 8, WGM = 4;

__host__ __device__ __forceinline__ int lds_byte(int r, int c) { const int st = (r >> 4) * 2 + (c >> 5), rr = r & 15, cc = c & 31, ob = rr * 64 + cc * 2; return st * 1024 + (ob ^ (((ob >> 9) & 1) << 5)); }
__host__ __device__ __forceinline__ void stage_rc(int b, int& R, int& C) { const int st = b / 1024, sb = b % 1024, swz = sb ^ (((sb >> 9) & 1) << 5); R = (st >> 1) * 16 + swz / 64; C = (st & 1) * 32 + (swz % 64) / 2; }
__host__ __device__ __forceinline__ int perm32(int rho) { const int n = rho >> 4, i = rho & 15; return 8 * (i >> 2) + 4 * n + (i & 3); }

struct Unit { int pm, pn; };
struct Gemm { const bf16_t* A; const bf16_t* Bt; int M, N, K, lda, ldb, wv; };

struct StaticOrder {
    int nM, nN, nwg, G, c;
    int reps = 1;
    __host__ __device__ void init(int M, int N, int G_, int c_) { nM = M / BM; nN = N / BM; nwg = nM * nN; G = G_; c = c_; }
    __host__ __device__ bool next(int i, Unit& u) const {
        const long L = (long)(i / reps) * G + c; if (L >= nwg) return false;
        int wgid = (int)L; { const int q = nwg / NXCD, r = nwg % NXCD, xcd = wgid % NXCD, off = wgid / NXCD; wgid = (xcd < r ? xcd * (q + 1) : r * (q + 1) + (xcd - r) * q) + off; }
        const int nig = WGM * nN, gid = wgid / nig, fm = gid * WGM, gsz = (nM - fm) < WGM ? (nM - fm) : WGM;
        u.pm = fm + ((wgid % nig) % gsz); u.pn = (wgid % nig) / gsz; return true;
    }
    __device__ __forceinline__ void a_ready(const Unit&) const {}
    __device__ __forceinline__ void done(const Unit&) const {}
};


template <class Epi, class Sched, bool ALIGN_EPI = false, bool SP2 = false>
__device__ __forceinline__ void gemm_phase(PG8_LAS unsigned char* lds, const Gemm g, const Sched& S, const Epi& E) {
    int wid_ = g.wv; asm volatile("" : "+s"(wid_));
    const int tid = tid_l(wid_), wid = wid_, lane = tid & 63, wr = wid >> 2, wc = wid & 3, fr = lane & 15, fq = lane >> 4;
    const int K = g.K, nt = K / BK;
    unsigned voffA[2], voffB[2];
#pragma unroll
    for (int i = 0; i < 2; ++i) { int R, C; stage_rc(tid * 16 + i * 8192, R, C); const int Rb = Epi::PERM ? ((R & ~31) + perm32(R & 31)) : R;
        voffA[i] = (unsigned)(R * g.lda + C) * 2u; voffB[i] = (unsigned)(Rb * g.ldb + C) * 2u; }
    const size_t kstep = (size_t)(BK * 2);
    const size_t hstepA = (size_t)HALF * g.lda * 2, hstepB = (size_t)HALF * g.ldb * 2;
    const size_t tstepA = 2 * hstepA, tstepB = 2 * hstepB;
    const unsigned ldsw = (unsigned)wid * 1024u;
    const int aoff = lds_byte(wr * 64 + fr, fq * 8), boff = lds_byte(wc * 32 + fr, fq * 8);
#define PG8_SA(b, h) (((b) * 2 + (h)) * HTB)
#define PG8_SB(b, h) ((4 + (b) * 2 + (h)) * HTB)
#define PG8_STAGE(bufoff, gbase, voff) do { _Pragma("unroll") for (int _i = 0; _i < 2; ++_i) \
        __builtin_amdgcn_global_load_lds((const unsigned*)((const char*)(gbase) + (voff)[_i]), (PG8_LAS unsigned*)(lds + (bufoff) + ldsw + _i * 8192), 16, 0, 0); } while (0)
#define PG8_LDA(dst, b, h) do { _Pragma("unroll") for (int m = 0; m < 4; ++m) _Pragma("unroll") for (int k = 0; k < 2; ++k) dst[m][k] = *(const PG8_LAS bf16x8*)(lds + PG8_SA(b, h) + aoff + m * 2048 + k * 1024); } while (0)
#define PG8_LDB(dst, b, h) do { _Pragma("unroll") for (int n = 0; n < 2; ++n) _Pragma("unroll") for (int k = 0; k < 2; ++k) dst[n][k] = *(const PG8_LAS bf16x8*)(lds + PG8_SB(b, h) + boff + n * 2048 + k * 1024); } while (0)
#define PG8_MMA(ai, bj, At, Bt) do { __builtin_amdgcn_s_setprio(1); _Pragma("unroll") for (int m = 0; m < 4; ++m) _Pragma("unroll") for (int n = 0; n < 2; ++n) _Pragma("unroll") for (int k = 0; k < 2; ++k) \
        acc[ai][bj][m][n] = __builtin_amdgcn_mfma_f32_16x16x32_bf16(Bt[n][k], At[m][k], acc[ai][bj][m][n], 0, 0, 0); __builtin_amdgcn_s_setprio(0); } while (0)
#define PG8_WAIT_V(n) asm volatile("s_waitcnt vmcnt(" #n ")" ::: "memory")
#define PG8_WAIT_L(n) asm volatile("s_waitcnt lgkmcnt(" #n ")" ::: "memory")
#define PG8_BAR __builtin_amdgcn_s_barrier()
#define PG8_SCHED __builtin_amdgcn_sched_barrier(0)
    Unit cur, nxt; int ui = 0;
    if (!S.next(0, cur)) return;
    f32x4 acc[2][2][4][2];
#pragma unroll
    for (int a = 0; a < 2; ++a)
#pragma unroll
        for (int b = 0; b < 2; ++b)
#pragma unroll
            for (int m = 0; m < 4; ++m)
#pragma unroll
                for (int n = 0; n < 2; ++n) acc[a][b][m][n] = (f32x4){0.f, 0.f, 0.f, 0.f};
    bf16x8 At[4][2], B0[2][2], B1[2][2];
    const char* cA = (const char*)g.A + (size_t)cur.pm * tstepA; const char* cB = (const char*)g.Bt + (size_t)cur.pn * tstepB;
    S.a_ready(cur);
    if constexpr (SP2) {
        PG8_STAGE(PG8_SB(0, 0), cB, voffB); PG8_STAGE(PG8_SB(0, 1), cB + hstepB, voffB); PG8_STAGE(PG8_SA(0, 0), cA, voffA); PG8_STAGE(PG8_SA(0, 1), cA + hstepA, voffA);
        if (wr == 1) PG8_BAR;
        PG8_WAIT_V(2); PG8_BAR;
        PG8_STAGE(PG8_SB(1, 0), cB + kstep, voffB); PG8_STAGE(PG8_SA(1, 0), cA + kstep, voffA); PG8_STAGE(PG8_SB(1, 1), cB + hstepB + kstep, voffB);
        PG8_WAIT_V(6); PG8_BAR;
    } else {
        PG8_STAGE(PG8_SB(0, 0), cB, voffB); PG8_STAGE(PG8_SA(0, 0), cA, voffA); PG8_STAGE(PG8_SB(0, 1), cB + hstepB, voffB); PG8_STAGE(PG8_SA(0, 1), cA + hstepA, voffA);
        if (wr == 1) PG8_BAR;
        PG8_WAIT_V(4); PG8_BAR;
        PG8_STAGE(PG8_SB(1, 0), cB + kstep, voffB); PG8_STAGE(PG8_SA(1, 0), cA + kstep, voffA); PG8_STAGE(PG8_SB(1, 1), cB + hstepB + kstep, voffB);
        PG8_WAIT_V(6); PG8_BAR;
    }
    for (;;) {
        const bool has_next = S.next(ui + 1, nxt);
        const char* nA = has_next ? (const char*)g.A + (size_t)nxt.pm * tstepA : cA; const char* nB = has_next ? (const char*)g.Bt + (size_t)nxt.pn * tstepB : cB;
        for (int t = 0; t < nt; t += 2) {
            const bool last = (t == nt - 2);
            const char* a1 = cA + (size_t)(t + 1) * kstep;
            const char* a2 = last ? nA : cA + (size_t)(t + 2) * kstep; const char* b2 = last ? nB : cB + (size_t)(t + 2) * kstep;
            const char* a3 = a2 + kstep; const char* b3 = b2 + kstep;
            if (last && has_next) S.a_ready(nxt);
            if constexpr (SP2) {
            PG8_LDB(B0, 0, 0); PG8_LDB(B1, 0, 1); PG8_SCHED; PG8_LDA(At, 0, 0); PG8_STAGE(PG8_SA(1, 1), a1 + hstepA, voffA);
            PG8_WAIT_V(8); PG8_WAIT_L(0); PG8_BAR; PG8_MMA(0, 0, At, B0); PG8_MMA(0, 1, At, B1); PG8_BAR; PG8_SCHED;
            PG8_LDA(At, 0, 1); PG8_STAGE(PG8_SB(0, 0), b2, voffB); PG8_STAGE(PG8_SB(0, 1), b2 + hstepB, voffB); PG8_STAGE(PG8_SA(0, 0), a2, voffA);
            PG8_WAIT_V(8); PG8_WAIT_L(0); PG8_BAR; PG8_MMA(1, 0, At, B0); PG8_MMA(1, 1, At, B1); PG8_BAR; PG8_SCHED;
            PG8_LDB(B0, 1, 0); PG8_LDB(B1, 1, 1); PG8_SCHED; PG8_LDA(At, 1, 0); PG8_STAGE(PG8_SA(0, 1), a2 + hstepA, voffA);
            PG8_WAIT_V(8); PG8_WAIT_L(0); PG8_BAR; PG8_MMA(0, 0, At, B0); PG8_MMA(0, 1, At, B1); PG8_BAR; PG8_SCHED;
            PG8_LDA(At, 1, 1); PG8_STAGE(PG8_SB(1, 0), b3, voffB); PG8_STAGE(PG8_SB(1, 1), b3 + hstepB, voffB); PG8_STAGE(PG8_SA(1, 0), a3, voffA);
            PG8_WAIT_V(8); PG8_WAIT_L(0); PG8_BAR; PG8_MMA(1, 0, At, B0); PG8_MMA(1, 1, At, B1); PG8_BAR; PG8_SCHED;
            } else {
            PG8_LDB(B0, 0, 0); PG8_SCHED; PG8_LDA(At, 0, 0); PG8_STAGE(PG8_SA(1, 1), a1 + hstepA, voffA);
            PG8_WAIT_L(8); PG8_BAR; PG8_WAIT_L(0); PG8_MMA(0, 0, At, B0); PG8_BAR; PG8_SCHED;
            PG8_LDB(B1, 0, 1); PG8_STAGE(PG8_SB(0, 0), b2, voffB);
            PG8_BAR; PG8_WAIT_L(0); PG8_MMA(0, 1, At, B1); PG8_BAR;
            PG8_LDA(At, 0, 1); PG8_STAGE(PG8_SA(0, 0), a2, voffA);
            PG8_BAR; PG8_WAIT_L(0); PG8_MMA(1, 0, At, B0); PG8_BAR; PG8_SCHED;
            PG8_STAGE(PG8_SB(0, 1), b2 + hstepB, voffB);
            PG8_WAIT_V(6); PG8_BAR; PG8_MMA(1, 1, At, B1); PG8_BAR;
            PG8_LDB(B0, 1, 0); PG8_SCHED; PG8_LDA(At, 1, 0); PG8_STAGE(PG8_SA(0, 1), a2 + hstepA, voffA);
            PG8_WAIT_L(8); PG8_BAR; PG8_WAIT_L(0); PG8_MMA(0, 0, At, B0); PG8_BAR; PG8_SCHED;
            PG8_LDB(B1, 1, 1); PG8_STAGE(PG8_SB(1, 0), b3, voffB);
            PG8_BAR; PG8_WAIT_L(0); PG8_MMA(0, 1, At, B1); PG8_BAR;
            PG8_LDA(At, 1, 1); PG8_STAGE(PG8_SA(1, 0), a3, voffA);
            PG8_BAR; PG8_WAIT_L(0); PG8_MMA(1, 0, At, B0); PG8_BAR; PG8_SCHED;
            PG8_STAGE(PG8_SB(1, 1), b3 + hstepB, voffB);
            PG8_WAIT_V(6); PG8_BAR; PG8_MMA(1, 1, At, B1); PG8_BAR;
            }
        }
        if constexpr (ALIGN_EPI) { if (wr == 0) PG8_BAR; }
        if constexpr (!Epi::AFTER_DRAIN) { E(acc, cur, wr, wc, fr, fq); S.done(cur); }
        if (!has_next) break;
#pragma unroll
        for (int a = 0; a < 2; ++a)
#pragma unroll
            for (int b = 0; b < 2; ++b)
#pragma unroll
                for (int m = 0; m < 4; ++m)
#pragma unroll
                    for (int n = 0; n < 2; ++n) acc[a][b][m][n] = (f32x4){0.f, 0.f, 0.f, 0.f};
        cur = nxt; cA = nA; cB = nB; ++ui;
        if constexpr (ALIGN_EPI) { if (wr == 1) PG8_BAR; }
    }
    PG8_WAIT_V(0);
    if constexpr (!ALIGN_EPI) { if (wr == 0) PG8_BAR; }
    PG8_BAR;
    if constexpr (Epi::AFTER_DRAIN) { E.fused(acc, cur, wr, wc, fr, fq, lds, wid, lane); S.done(cur); }
#undef PG8_SA
#undef PG8_SB
#undef PG8_STAGE
#undef PG8_LDA
#undef PG8_LDB
#undef PG8_MMA
#undef PG8_WAIT_V
#undef PG8_WAIT_L
#undef PG8_BAR
#undef PG8_SCHED
}
}

namespace pg8 {
struct OneUnit {
    __device__ bool next(int i, Unit& u) const { if (i) return false; u.pm = 0; u.pn = 0; return true; }
    __device__ __forceinline__ void a_ready(const Unit&) const {}
    __device__ __forceinline__ void done(const Unit&) const {}
};
typedef f32x4 AccT[2][2][4][2];

struct EpiQKV {
    static constexpr bool PERM = true, AFTER_DRAIN = false;
    bf16_t* Q; float* newk; float qscale;
    __device__ __forceinline__ void operator()(const AccT& acc, const Unit& u, int wr, int wc, int fr, int fq) const {
        const int t = u.pn >> 2;
        bf16_t* base = Q + (size_t)t * MT * D;
        const float sc = t == 0 ? qscale : 1.f;
        float* fo = newk + (size_t)(t - 1) * MC * D;
        const bool wf = (t != 0) && (u.pm < MC / 256);
        const int colt = (u.pn & 3) * 256 + wc * 32 + 8 * fq, row0 = u.pm * 256 + wr * 64 + fr;
#pragma unroll
        for (int ai = 0; ai < 2; ++ai)
#pragma unroll
            for (int m = 0; m < 4; ++m) {
                const size_t ro = (size_t)(row0 + ai * 128 + m * 16) * D;
#pragma unroll
                for (int bj = 0; bj < 2; ++bj) {
                    const f32x4 v0 = acc[ai][bj][m][0] * sc, v1 = acc[ai][bj][m][1] * sc;
                    u32x4 w; w.x = pk_bf16(v0[0], v0[1]); w.y = pk_bf16(v0[2], v0[3]); w.z = pk_bf16(v1[0], v1[1]); w.w = pk_bf16(v1[2], v1[3]);
                    *(u32x4*)(base + ro + colt + bj * 128) = w;
                    if (wf) { *(f32x4*)(fo + ro + colt + bj * 128) = v0; *(f32x4*)(fo + ro + colt + bj * 128 + 4) = v1; }
                }
            }
    }
};
template <bool FUSE, bool SRCF32> struct EpiResT {
    static constexpr bool PERM = true, AFTER_DRAIN = false;
    const float *xa, *xb;
    bf16_t* xres;
    const float* gate;
    bf16_t* XNo; const float* gn; const float* scv; float* ssq;
    __device__ __forceinline__ void operator()(const AccT& acc, const Unit& u, int wr, int wc, int fr, int fq) const {
        const bool isc = u.pm < MC / 256;
        const int cv = isc ? 8 : ((u.pm - MC / 256) >> 2);
        const float* src = isc ? xa : xb - (size_t)MC * D;
        const int col0 = u.pn * 256 + wc * 32 + 8 * fq, row0 = u.pm * 256 + wr * 64 + fr;
        f32x4 gv[2][2], gm[2][2];
#pragma unroll
        for (int bj = 0; bj < 2; ++bj)
#pragma unroll
            for (int n = 0; n < 2; ++n) {
                const int c = col0 + bj * 128 + n * 4;
                gv[bj][n] = *(const f32x4*)(gate + (size_t)cv * NMOD + c);
                if (FUSE) gm[bj][n] = *(const f32x4*)(gn + c) * (*(const f32x4*)(scv + (size_t)cv * NMOD + c) + 1.f);
            }
#pragma unroll
        for (int ai = 0; ai < 2; ++ai)
#pragma unroll
        for (int mp = 0; mp < 2; ++mp) {
            f32x4 xs[2][2][2];
#pragma unroll
            for (int mm = 0; mm < 2; ++mm)
#pragma unroll
                for (int bj = 0; bj < 2; ++bj) {
                    const size_t o = (size_t)(row0 + ai * 128 + (2 * mp + mm) * 16) * D + col0 + bj * 128;
                    if (SRCF32) { xs[mm][bj][0] = *(const f32x4*)(src + o); xs[mm][bj][1] = *(const f32x4*)(src + o + 4); }
                    else { const u32x4 w = *(const u32x4*)(xres + o); xs[mm][bj][0] = (f32x4){bf_lo(w.x), bf_hi(w.x), bf_lo(w.y), bf_hi(w.y)}; xs[mm][bj][1] = (f32x4){bf_lo(w.z), bf_hi(w.z), bf_lo(w.w), bf_hi(w.w)}; }
                }
            asm volatile("" ::: "memory");
#pragma unroll
            for (int mm = 0; mm < 2; ++mm) {
                const int m = 2 * mp + mm;
                const int row = row0 + ai * 128 + m * 16;
                const size_t ro = (size_t)row * D + col0;
                float sq = 0.f;
#pragma unroll
                for (int bj = 0; bj < 2; ++bj) {
                    const f32x4 x0 = xs[mm][bj][0] + gv[bj][0] * acc[ai][bj][m][0], x1 = xs[mm][bj][1] + gv[bj][1] * acc[ai][bj][m][1];
                    { u32x4 w; w.x = pk_bf16(x0[0], x0[1]); w.y = pk_bf16(x0[2], x0[3]); w.z = pk_bf16(x1[0], x1[1]); w.w = pk_bf16(x1[2], x1[3]); *(u32x4*)(xres + ro + bj * 128) = w; }
                    if (FUSE) {
                        sq += ((x0[0] * x0[0] + x0[1] * x0[1]) + (x0[2] * x0[2] + x0[3] * x0[3])) + ((x1[0] * x1[0] + x1[1] * x1[1]) + (x1[2] * x1[2] + x1[3] * x1[3]));
                        const f32x4 y0 = x0 * gm[bj][0], y1 = x1 * gm[bj][1];
                        u32x4 w; w.x = pk_bf16(y0[0], y0[1]); w.y = pk_bf16(y0[2], y0[3]); w.z = pk_bf16(y1[0], y1[1]); w.w = pk_bf16(y1[2], y1[3]);
                        *(u32x4*)(XNo + ro + bj * 128) = w;
                    }
                }
                if (FUSE) { sq += shfl_xor_l(sq, 16, fr + 16 * fq); sq += shfl_xor_l(sq, 32, fr + 16 * fq); if (fq == 0) unsafeAtomicAdd(ssq + row, sq); }
            }
            asm volatile("" ::: "memory");
        }
    }
};
struct EpiResFinal {
    static constexpr bool PERM = true, AFTER_DRAIN = false;
    const bf16_t* xres; const float* gate; float* ssq; unsigned* cnt; const float* gfin; float* out;
    __device__ __forceinline__ void operator()(const AccT& acc_c, const Unit& u, int wr, int wc, int fr, int fq) const {
        AccT& acc = const_cast<AccT&>(acc_c);
        const int cv = u.pm < MC / 256 ? 8 : ((u.pm - MC / 256) >> 2);
        const int col0 = u.pn * 256 + wc * 32 + 8 * fq, row0 = u.pm * 256 + wr * 64 + fr, lane = fr + 16 * fq;
        f32x4 gv[2][2];
#pragma unroll
        for (int bj = 0; bj < 2; ++bj)
#pragma unroll
            for (int n = 0; n < 2; ++n) gv[bj][n] = *(const f32x4*)(gate + (size_t)cv * NMOD + col0 + bj * 128 + n * 4);
#pragma unroll
        for (int ai = 0; ai < 2; ++ai)
#pragma unroll
        for (int mp = 0; mp < 2; ++mp) {
            u32x4 xs[2][2];
#pragma unroll
            for (int mm = 0; mm < 2; ++mm)
#pragma unroll
                for (int bj = 0; bj < 2; ++bj) xs[mm][bj] = *(const u32x4*)(xres + (size_t)(row0 + ai * 128 + (2 * mp + mm) * 16) * D + col0 + bj * 128);
            asm volatile("" ::: "memory");
#pragma unroll
            for (int mm = 0; mm < 2; ++mm) {
                const int m = 2 * mp + mm;
                float sq = 0.f;
#pragma unroll
                for (int bj = 0; bj < 2; ++bj) {
                    const u32x4 w = xs[mm][bj];
                    const f32x4 x0 = (f32x4){bf_lo(w.x), bf_hi(w.x), bf_lo(w.y), bf_hi(w.y)} + gv[bj][0] * acc[ai][bj][m][0], x1 = (f32x4){bf_lo(w.z), bf_hi(w.z), bf_lo(w.w), bf_hi(w.w)} + gv[bj][1] * acc[ai][bj][m][1];
                    acc[ai][bj][m][0] = x0; acc[ai][bj][m][1] = x1;
                    sq += ((x0[0] * x0[0] + x0[1] * x0[1]) + (x0[2] * x0[2] + x0[3] * x0[3])) + ((x1[0] * x1[0] + x1[1] * x1[1]) + (x1[2] * x1[2] + x1[3] * x1[3]));
                }
                sq += shfl_xor_l(sq, 16, lane); sq += shfl_xor_l(sq, 32, lane);
                if (fq == 0) unsafeAtomicAdd(ssq + row0 + ai * 128 + m * 16, sq);
            }
        }
        asm volatile("s_waitcnt vmcnt(0)" ::: "memory");
        unsigned* c = cnt + 64 * u.pm;
        if (lane == 0) __hip_atomic_fetch_add(c, 1u, __ATOMIC_RELAXED, __HIP_MEMORY_SCOPE_AGENT);
        { unsigned sp = 0;
          while ((unsigned)__builtin_amdgcn_readfirstlane(__hip_atomic_load(c, __ATOMIC_RELAXED, __HIP_MEMORY_SCOPE_AGENT)) < 32u) { __builtin_amdgcn_s_sleep(2); if (++sp > (1u << 20)) break; } }
        float rs[2][4];
#pragma unroll
        for (int ai = 0; ai < 2; ++ai)
#pragma unroll
            for (int m = 0; m < 4; ++m) rs[ai][m] = __hip_atomic_load(ssq + row0 + ai * 128 + m * 16, __ATOMIC_RELAXED, __HIP_MEMORY_SCOPE_AGENT);
        f32x4 gf[2][2];
#pragma unroll
        for (int bj = 0; bj < 2; ++bj)
#pragma unroll
            for (int n = 0; n < 2; ++n) gf[bj][n] = *(const f32x4*)(gfin + col0 + bj * 128 + n * 4);
#pragma unroll
        for (int ai = 0; ai < 2; ++ai)
#pragma unroll
            for (int m = 0; m < 4; ++m) {
                const float rstd = __builtin_amdgcn_rsqf(rs[ai][m] * (1.f / D) + RMS_EPS);
                float* op = out + (size_t)(row0 + ai * 128 + m * 16) * D + col0;
#pragma unroll
                for (int bj = 0; bj < 2; ++bj) { *(f32x4*)(op + bj * 128) = acc[ai][bj][m][0] * rstd * gf[bj][0]; *(f32x4*)(op + bj * 128 + 4) = acc[ai][bj][m][1] * rstd * gf[bj][1]; }
            }
    }
};
struct EpiSwiglu {
    static constexpr bool PERM = true, AFTER_DRAIN = false;
    bf16_t* H; const float* ssq; const float* shw;
    __device__ __forceinline__ void operator()(const AccT& acc, const Unit& u, int wr, int wc, int fr, int fq) const {
        const int cv = u.pm < MC / 256 ? 8 : ((u.pm - MC / 256) >> 2);
        const int col0 = u.pn * 128 + wc * 32 + 8 * fq, row0 = u.pm * 256 + wr * 64 + fr;
        const float* sp = shw + (size_t)cv * 2 * FF + u.pn * 256 + wc * 32 + 8 * fq;
        const f32x4 sg0 = *(const f32x4*)(sp), sg1 = *(const f32x4*)(sp + 4), su0 = *(const f32x4*)(sp + 128), su1 = *(const f32x4*)(sp + 132);
        float rs[2][4];
#pragma unroll
        for (int ai = 0; ai < 2; ++ai)
#pragma unroll
            for (int m = 0; m < 4; ++m) rs[ai][m] = ssq[row0 + ai * 128 + m * 16];
        asm volatile("" ::: "memory");
#pragma unroll
        for (int ai = 0; ai < 2; ++ai)
#pragma unroll
            for (int m = 0; m < 4; ++m) rs[ai][m] = __builtin_amdgcn_rsqf(rs[ai][m] * (1.f / D) + RMS_EPS);
#pragma unroll
        for (int ai = 0; ai < 2; ++ai)
#pragma unroll
            for (int m = 0; m < 4; ++m) {
                const int row = row0 + ai * 128 + m * 16;
                const float rstd = rs[ai][m];
                float o[8];
#pragma unroll
                for (int n = 0; n < 2; ++n) {
                    const f32x4 gq = acc[ai][0][m][n] * rstd + (n ? sg1 : sg0), uq = acc[ai][1][m][n] * rstd + (n ? su1 : su0);
#pragma unroll
                    for (int j = 0; j < 4; ++j) o[n * 4 + j] = silu_f(gq[j]) * uq[j];
                }
                u32x4 w; w.x = pk_bf16(o[0], o[1]); w.y = pk_bf16(o[2], o[3]); w.z = pk_bf16(o[4], o[5]); w.w = pk_bf16(o[6], o[7]);
                *(u32x4*)(H + (size_t)row * FF + col0) = w;
            }
    }
};
struct EpiWin {
    static constexpr bool PERM = true, AFTER_DRAIN = false;
    bf16_t *G, *XR; const float* ssq; const float* shw;
    __device__ __forceinline__ void operator()(const AccT& acc, const Unit& u, int wr, int wc, int fr, int fq) const {
        const bool isg = u.pn < 4;
        const int cv = u.pm < MC / 256 ? 8 : ((u.pm - MC / 256) >> 2);
        bf16_t* base = isg ? G : XR;
        const int colt = (u.pn & 3) * 256 + wc * 32 + 8 * fq, row0 = u.pm * 256 + wr * 64 + fr;
        const float* sp = shw + (size_t)cv * 2 * D + u.pn * 256 + wc * 32 + 8 * fq;
        f32x4 sv[2][2];
#pragma unroll
        for (int bj = 0; bj < 2; ++bj) { sv[bj][0] = *(const f32x4*)(sp + bj * 128); sv[bj][1] = *(const f32x4*)(sp + bj * 128 + 4); }
        float rs[2][4];
#pragma unroll
        for (int ai = 0; ai < 2; ++ai)
#pragma unroll
            for (int m = 0; m < 4; ++m) rs[ai][m] = ssq[row0 + ai * 128 + m * 16];
        asm volatile("" ::: "memory");
#pragma unroll
        for (int ai = 0; ai < 2; ++ai)
#pragma unroll
            for (int m = 0; m < 4; ++m) rs[ai][m] = __builtin_amdgcn_rsqf(rs[ai][m] * (1.f / D) + RMS_EPS);
#pragma unroll
        for (int ai = 0; ai < 2; ++ai)
#pragma unroll
            for (int m = 0; m < 4; ++m) {
                const int row = row0 + ai * 128 + m * 16;
                const float rstd = rs[ai][m];
#pragma unroll
                for (int bj = 0; bj < 2; ++bj) {
                    f32x4 v0 = acc[ai][bj][m][0] * rstd + sv[bj][0], v1 = acc[ai][bj][m][1] * rstd + sv[bj][1];
                    if (isg) {
#pragma unroll
                        for (int j = 0; j < 4; ++j) { v0[j] = gelu_tanh_f(v0[j]); v1[j] = gelu_tanh_f(v1[j]); }
                    }
                    u32x4 w; w.x = pk_bf16(v0[0], v0[1]); w.y = pk_bf16(v0[2], v0[3]); w.z = pk_bf16(v1[0], v1[1]); w.w = pk_bf16(v1[2], v1[3]);
                    *(u32x4*)(base + (size_t)row * D + colt + bj * 128) = w;
                }
            }
    }
};
struct EpiLru {
    static constexpr bool PERM = true, AFTER_DRAIN = true;
    LAS const unsigned long long* ptab;
    const float* h0;
    int row_base, cb, dir, q;

    template <int AI>
    __device__ __forceinline__ void half(const AccT& acc, int wr, int wc, int fr, int fq, PG8_LAS unsigned char* lds, int tid,
                                         const u32x4 (&xall)[4], bf16_t* HL, bf16_t* PP) const {
#pragma unroll
        for (int m = 0; m < 4; ++m) {
            const int tl = wr * 64 + m * 16 + fr;
            const size_t row = (size_t)(row_base + AI * 128 + tl);
#pragma unroll
            for (int n = 0; n < 2; ++n) {
                asm volatile("" ::: "memory");
                const int chl = wc * 32 + 8 * fq + 4 * n;
                const PG8_LAS f32x4* cst = (const PG8_LAS f32x4*)(lds + CST_OFF + chl * 4);
                const f32x4 ba = cst[0], bi = cst[32], L2 = cst[64];
                u32x2 xw; xw.x = n ? xall[m].z : xall[m].x; xw.y = n ? xall[m].w : xall[m].y;
                const f32x4 xc = {bf_lo(xw.x), bf_hi(xw.x), bf_lo(xw.y), bf_hi(xw.y)};
                f32x4 av, bv;
#pragma unroll
                for (int j = 0; j < 4; ++j) {
                    const float za = acc[AI][0][m][n][j] + ba[j], zi = acc[AI][1][m][n][j] + bi[j];
                    const float r = sigmoid_f(za), ig = sigmoid_f(zi);
                    const float a = fast_exp2(r * L2[j]);
                    av[j] = a; bv[j] = __builtin_amdgcn_sqrtf(1.f - a * a) * (ig * xc[j]);
                }
                PG8_LAS f32x4* dst = (PG8_LAS f32x4*)(lds + tl * AB_PITCH + chl * 8);
                dst[0] = (f32x4){av[0], bv[0], av[1], bv[1]}; dst[1] = (f32x4){av[2], bv[2], av[3], bv[3]};
            }
        }
        __syncthreads();
        if (tid < 128) {
            PG8_LAS float* hst = (PG8_LAS float*)(lds + HST_OFF);
            float h = hst[tid], P = hst[128 + tid];
            PG8_LAS f32x2* col = (PG8_LAS f32x2*)(lds + tid * 8);
            if (dir == 0) {
#pragma unroll 8
                for (int t = 0; t < 128; ++t) { PG8_LAS f32x2* p = (PG8_LAS f32x2*)((PG8_LAS unsigned char*)col + t * AB_PITCH); const f32x2 ab = *p; h = ab.x * h + ab.y; P *= ab.x; *p = (f32x2){h, P}; }
            } else {
#pragma unroll 8
                for (int t = 127; t >= 0; --t) { PG8_LAS f32x2* p = (PG8_LAS f32x2*)((PG8_LAS unsigned char*)col + t * AB_PITCH); const f32x2 ab = *p; h = ab.x * h + ab.y; P *= ab.x; *p = (f32x2){h, P}; }
            }
            hst[tid] = h; hst[128 + tid] = P;
        }
        __syncthreads();
        const bool lat = row_base >= MC;
#pragma unroll
        for (int it = 0; it < 8; ++it) {
            const int idx = it * 512 + tid, tl = idx >> 5, c4 = (idx & 31) * 4;
            const PG8_LAS f32x4* src = (const PG8_LAS f32x4*)(lds + tl * AB_PITCH + c4 * 8);
            const f32x4 s0 = src[0], s1 = src[1];
            const size_t row = (size_t)(row_base + AI * 128 + tl);
            { u32x2 wh; wh.x = pk_bf16(s0[0], s0[2]); wh.y = pk_bf16(s1[0], s1[2]); *(u32x2*)(HL + row * D + cb + c4) = wh; }
            if (lat) { u32x2 w; w.x = pk_bf16(s0[1], s0[3]); w.y = pk_bf16(s1[1], s1[3]); *(u32x2*)(PP + (row - MC) * D + cb + c4) = w; }
        }
        __syncthreads();
    }
    __device__ __forceinline__ void fused(AccT& acc, const Unit&, int wr, int wc, int fr, int fq, PG8_LAS unsigned char* lds, int wid, int lane) const {
        const int tid = wid * 64 + lane;
        const PT pt{ptab};
        unsigned char* ws = pt.ws();
        PG8_LAS float* hst = (PG8_LAS float*)(lds + HST_OFF);
        PG8_LAS float* cst = (PG8_LAS float*)(lds + CST_OFF);
        if (tid < 128) {
            hst[tid] = h0 ? h0[cb + tid] : 0.f; hst[128 + tid] = 1.f;
            const int ch = dir * D + cb + tid;
            cst[tid] = pt.f(I_b_a)[ch]; cst[128 + tid] = pt.f(I_b_i)[ch];
            const float l = pt.f(I_lam)[ch];
            const float x = __expf(-l);
            const float sp = x < 0.03f ? x * (1.f - x * (0.5f - x * (0.33333334f - 0.25f * x))) : __logf(1.f + x);
            cst[256 + tid] = -8.0f * sp * LOG2E;
        }
        __syncthreads();
        const bf16_t* XC = (const bf16_t*)(ws + WS_XN);
        bf16_t* HL = (bf16_t*)(ws + (dir ? WS_HLB : WS_HLF));
        bf16_t* PP = (bf16_t*)(ws + (dir ? WS_PB : WS_PF));
        u32x4 xc0[4], xc1[4];
#pragma unroll
        for (int m = 0; m < 4; ++m) {
            xc0[m] = *(const u32x4*)(XC + (size_t)(row_base + wr * 64 + m * 16 + fr) * D + cb + wc * 32 + 8 * fq);
            xc1[m] = *(const u32x4*)(XC + (size_t)(row_base + 128 + wr * 64 + m * 16 + fr) * D + cb + wc * 32 + 8 * fq);
        }
        if (dir == 0) { half<0>(acc, wr, wc, fr, fq, lds, tid, xc0, HL, PP); half<1>(acc, wr, wc, fr, fq, lds, tid, xc1, HL, PP); }
        else          { half<1>(acc, wr, wc, fr, fq, lds, tid, xc1, HL, PP); half<0>(acc, wr, wc, fr, fq, lds, tid, xc0, HL, PP); }
        if (tid < 128) {
            const float h = hst[tid], P = hst[128 + tid];
            float* sumE = (float*)(ws + WS_SUME) + (size_t)dir * 48 * D; float* sumP = (float*)(ws + WS_SUMP) + (size_t)dir * 48 * D;
            sumE[(size_t)q * D + cb + tid] = h; sumP[(size_t)q * D + cb + tid] = P;
            if (row_base < MC) pt.out()[OUT_NH + (size_t)q * 2 * D + dir * D + cb + tid] = h;
        }
        __syncthreads();
    }
};
}
namespace att {
constexpr int KP = 144, VP = 136;
constexpr int K_OFF = 0, V_OFF = 2 * 64 * KP, F_OFF = V_OFF + 2 * 64 * KP, T_OFF = F_OFF + 8 * 32 * 4, A_END = T_OFF + 640 * 4;
typedef short v4i16_t __attribute__((ext_vector_type(4)));
#define MFMA32(a, b, c) __builtin_amdgcn_mfma_f32_32x32x16_bf16((a), (b), (c), 0, 0, 0)
__device__ __forceinline__ float max2f(float a, float b) { float r; asm("v_max_f32_e32 %0, %1, %2" : "=v"(r) : "v"(a), "v"(b)); return r; }
__device__ __forceinline__ float max3f(float a, float b, float c) { float r; asm("v_max3_f32 %0, %1, %2, %3" : "=v"(r) : "v"(a), "v"(b), "v"(c)); return r; }
__device__ __forceinline__ int crow(int r, int hi) { return (r & 3) + 8 * (r >> 2) + 4 * hi; }

template <bool NA>
__device__ __forceinline__ void unit(int wv, LAS unsigned char* lds, int b, int h, int g, const bf16_t* __restrict__ Qb, const bf16_t* __restrict__ Kb, const bf16_t* __restrict__ Vb,
                                     const bf16_t* __restrict__ CK, const bf16_t* __restrict__ CV, bf16_t* __restrict__ Ob, const float* __restrict__ rpb) {
    int wid_ = wv; asm volatile("" : "+s"(wid_));
    const int tid = tid_l(wid_), lane = tid & 63, wid = wid_, r32 = lane & 31, hi = lane >> 5;
    LAS float* fscr = (LAS float*)(lds + F_OFF) + wid * 32;
    LAS float* tab = (LAS float*)(lds + T_OFF);
    if (NA) { for (int i = tid; i < 15 * 31; i += 512) { const int dr = i / 31, dc = i % 31; tab[64 + dr * 32 + dc] = rpb[(h * 15 + dr) * 31 + dc] * LOG2E; } }
    int qrow, nlat, ntile, Rlo = 0, rq = 0, rs = 0;
    if (NA) {
        rq = 4 * g + (wid >> 1); rs = min(max(rq - 4, 0), 8);
        qrow = MC + b * 1024 + rq * 64 + 32 * (wid & 1) + r32;
        Rlo = min(max(4 * g - 4, 0), 8); const int Rhi = min(max(4 * g - 1, 0), 8) + 8;
        nlat = Rhi - Rlo; ntile = nlat + 8;
    } else { qrow = b * 256 + 32 * wid + r32; nlat = 4; ntile = 4; }
    const int qc = 32 * (wid & 1) + r32, cs = min(max(qc - 8, 0), 48);
    f32x16 pen0, pen1;
#pragma unroll
    for (int i = 0; i < 16; ++i) { const int kc = (i & 3) + 8 * (i >> 2) + 4 * hi - cs; pen0[i] = (NA && (unsigned)kc >= 16u) ? -1e30f : 0.f; pen1[i] = (NA && (unsigned)(kc + 32) >= 16u) ? -1e30f : 0.f; }
    bf16x8 qr[4];
#pragma unroll
    for (int s = 0; s < 4; ++s) qr[s] = *(const bf16x8*)(Qb + (size_t)qrow * D + h * 64 + 16 * s + 8 * hi);
    const int lkey = tid >> 3, lch = tid & 7;
    auto src_row = [&](int t) -> size_t {
        if (NA) return t < nlat ? (size_t)(MC + b * 1024 + (Rlo + t) * 64) : (size_t)(b * 512 + (t - nlat) * 64);
        return (size_t)(b * 256 + t * 64);
    };
    u32x4 kreg, vreg;
    auto gload = [&](int t) {
        const bool cache = NA && t >= nlat;
        const bf16_t* kp = cache ? CK : Kb; const bf16_t* vp = cache ? CV : Vb;
        const size_t off = (src_row(t) + lkey) * D + h * 64 + 8 * lch;
        kreg = *(const u32x4*)(kp + off); vreg = *(const u32x4*)(vp + off);
    };
    auto lstore = [&](int buf) {
        *(LAS u32x4*)(lds + K_OFF + buf * 64 * KP + lkey * KP + lch * 16) = kreg;
        *(LAS u32x4*)(lds + V_OFF + buf * 64 * KP + lkey * KP + lch * 16) = vreg;
    };
    float m_run = -1e30f, l_run = 0.f;
    f32x16 o0, o1;
#pragma unroll
    for (int i = 0; i < 16; ++i) { o0[i] = 0.f; o1[i] = 0.f; }
    gload(0); lstore(0);
    asm volatile("" :: "v"(qr[0]), "v"(qr[1]), "v"(qr[2]), "v"(qr[3]));
    __syncthreads();
    for (int t = 0; t < ntile; ++t) {
        const int buf = t & 1;
        if (t + 1 < ntile) gload(t + 1);
        bool active = true, biased = false; int dr = 0;
        if (NA && t < nlat) { const int R = Rlo + t; active = (R >= rs) && (R < rs + 8); biased = true; dr = R - rq + 7; }
        if (active) {
            f32x16 p0, p1;
#pragma unroll
            for (int i = 0; i < 16; ++i) { p0[i] = 0.f; p1[i] = 0.f; }
            const LAS unsigned char* kb = lds + K_OFF + buf * 64 * KP + r32 * KP + 16 * hi;
#pragma unroll
            for (int s = 0; s < 4; ++s) {
                const bf16x8 k0 = *(const LAS bf16x8*)(kb + 32 * s), k1 = *(const LAS bf16x8*)(kb + 32 * KP + 32 * s);
                p0 = MFMA32(k0, qr[s], p0); p1 = MFMA32(k1, qr[s], p1);
            }
            if (biased) {
                const LAS float* tb = tab + 64 + dr * 32 + (4 * hi - qc + 15);
                f32x16 b0, b1;
#pragma unroll
                for (int i = 0; i < 16; ++i) { const int kc = (i & 3) + 8 * (i >> 2); b0[i] = tb[kc]; b1[i] = tb[kc + 32]; }
                p0 += b0; p1 += b1; p0 += pen0; p1 += pen1;
            }
            float mxa = max3f(p0[0], p0[1], p0[2]), mxb = max3f(p0[3], p0[4], p0[5]), mxc = max3f(p1[0], p1[1], p1[2]), mxd = max3f(p1[3], p1[4], p1[5]);
            mxa = max3f(mxa, p0[6], p0[7]); mxb = max3f(mxb, p0[8], p0[9]); mxc = max3f(mxc, p1[6], p1[7]); mxd = max3f(mxd, p1[8], p1[9]);
            mxa = max3f(mxa, p0[10], p0[11]); mxb = max3f(mxb, p0[12], p0[13]); mxc = max3f(mxc, p1[10], p1[11]); mxd = max3f(mxd, p1[12], p1[13]);
            mxa = max3f(mxa, p0[14], p0[15]); mxc = max3f(mxc, p1[14], p1[15]);
            float mx = max2f(max2f(mxa, mxb), max2f(mxc, mxd));
            mx = max2f(mx, shfl_xor_l(mx, 32, lane));
            const float mnew = max2f(m_run, mx);
            const float f = fast_exp2(m_run - mnew);
            m_run = mnew;
            p0 -= mnew; p1 -= mnew;
#pragma unroll
            for (int i = 0; i < 16; ++i) { p0[i] = fast_exp2(p0[i]); p1[i] = fast_exp2(p1[i]); }
            f32x4 ls4 = {0.f, 0.f, 0.f, 0.f};
#pragma unroll
            for (int i = 0; i < 16; i += 4) ls4 += (f32x4){p0[i], p0[i + 1], p0[i + 2], p0[i + 3]} + (f32x4){p1[i], p1[i + 1], p1[i + 2], p1[i + 3]};
            const float ls = (ls4[0] + ls4[1]) + (ls4[2] + ls4[3]);
            l_run = l_run * f + ls;
            if (__any(f != 1.f)) {
                if (hi == 0) fscr[r32] = f;
                asm volatile("s_waitcnt lgkmcnt(0)" ::: "memory");
#pragma unroll
                for (int i = 0; i < 16; ++i) { const float fi = fscr[crow(i, hi)]; o0[i] *= fi; o1[i] *= fi; }
                asm volatile("s_waitcnt lgkmcnt(0)" ::: "memory");
            }
            bf16x8 pa[2][2];
#pragma unroll
            for (int s = 0; s < 2; ++s) {
                u32x4 w0, w1;
                w0.x = pk_bf16(p0[8 * s + 0], p0[8 * s + 1]); w0.y = pk_bf16(p0[8 * s + 2], p0[8 * s + 3]); w0.z = pk_bf16(p0[8 * s + 4], p0[8 * s + 5]); w0.w = pk_bf16(p0[8 * s + 6], p0[8 * s + 7]);
                w1.x = pk_bf16(p1[8 * s + 0], p1[8 * s + 1]); w1.y = pk_bf16(p1[8 * s + 2], p1[8 * s + 3]); w1.z = pk_bf16(p1[8 * s + 4], p1[8 * s + 5]); w1.w = pk_bf16(p1[8 * s + 6], p1[8 * s + 7]);
                pa[0][s] = __builtin_bit_cast(bf16x8, w0); pa[1][s] = __builtin_bit_cast(bf16x8, w1);
            }
            const int i16 = lane & 15, g16 = (lane >> 4) & 1;
            const LAS unsigned char* vb = lds + V_OFF + buf * 64 * KP + (4 * hi + (i16 >> 2)) * KP + (16 * g16 + 4 * (i16 & 3)) * 2;
#pragma unroll
            for (int blk = 0; blk < 2; ++blk)
#pragma unroll
                for (int s = 0; s < 2; ++s) {
                    const int ko = (32 * blk + 16 * s) * KP;
                    const s16x4 a0 = __builtin_bit_cast(s16x4, __builtin_amdgcn_ds_read_tr16_b64_v4i16((LAS v4i16_t*)(vb + ko))), a1 = __builtin_bit_cast(s16x4, __builtin_amdgcn_ds_read_tr16_b64_v4i16((LAS v4i16_t*)(vb + ko + 8 * KP)));
                    const s16x4 c0 = __builtin_bit_cast(s16x4, __builtin_amdgcn_ds_read_tr16_b64_v4i16((LAS v4i16_t*)(vb + ko + 64))), c1 = __builtin_bit_cast(s16x4, __builtin_amdgcn_ds_read_tr16_b64_v4i16((LAS v4i16_t*)(vb + ko + 8 * KP + 64)));
                    const bf16x8 v0 = __builtin_shufflevector(a0, a1, 0, 1, 2, 3, 4, 5, 6, 7), v1 = __builtin_shufflevector(c0, c1, 0, 1, 2, 3, 4, 5, 6, 7);
                    o0 = MFMA32(pa[blk][s], v0, o0); o1 = MFMA32(pa[blk][s], v1, o1);
                }
        }
        if (t + 1 < ntile) lstore(buf ^ 1);
        __syncthreads();
    }
    l_run += shfl_xor_l(l_run, 32, lane);
    if (hi == 0) fscr[r32] = fast_rcp(l_run);
    asm volatile("s_waitcnt lgkmcnt(0)" ::: "memory");
    const int qbase = qrow - r32;
    LAS unsigned char* stg = lds + K_OFF + wid * (32 * KP);
#pragma unroll
    for (int i = 0; i < 16; ++i) {
        const int qi = crow(i, hi); const float li = fscr[qi];
        LAS unsigned short* sp = (LAS unsigned short*)(stg + qi * KP + r32 * 2);
        sp[0] = (unsigned short)(pk_bf16(o0[i] * li, 0.f) & 0xffff); sp[32] = (unsigned short)(pk_bf16(o1[i] * li, 0.f) & 0xffff);
    }
    asm volatile("s_waitcnt lgkmcnt(0)" ::: "memory");
    {
        const int row = lane >> 1, half = lane & 1;
        bf16_t* op = Ob + (size_t)(qbase + row) * D + h * 64 + half * 32;
#pragma unroll
        for (int j = 0; j < 4; ++j) *(u32x4*)(op + 8 * j) = *(const LAS u32x4*)(stg + row * KP + half * 64 + 16 * j);
    }
    __syncthreads();
}
}
#ifndef REP_P4
#define REP_P4 1
#endif
#ifndef REP_ADA
#define REP_ADA 1
#endif
#ifndef REP_PRO
#define REP_PRO 1
#endif
#ifndef REP_FILL
#define REP_FILL 1
#endif
#ifndef REP_ATT
#define REP_ATT 1
#endif
#ifndef REP_GEMM
#define REP_GEMM 1
#endif
#ifndef REP_THIN
#define REP_THIN 1
#endif
#ifndef REP_LRU
#define REP_LRU 1
#endif
#ifndef REP_SYNC
#define REP_SYNC 1
#endif
struct Args {
    const float *x_prompt, *x_sample, *c, *cache_k, *cache_v, *state_h, *c_ctx, *norm_g, *w_mod, *b_mod, *w_qkv, *w_o, *rpb, *w_in, *conv_w, *conv_b,
                *w_a, *b_a, *w_i, *b_i, *lam, *w_out, *w_gu, *w_down, *final_g;
    float* out; unsigned char* ws;
};

__device__ __forceinline__ void tr_item(const float* __restrict__ W, int ldw, int k0, int n0, bf16_t* __restrict__ dst, int ldd, LAS float* scr, int lane) {
    float tv[32];
#pragma unroll
    for (int i = 0; i < 32; ++i) { const int kk = 2 * i + (lane >> 5); tv[i] = W[(size_t)(k0 + kk) * ldw + n0 + (lane & 31)]; }
#pragma unroll
    for (int i = 0; i < 32; ++i) { const int kk = 2 * i + (lane >> 5); scr[kk * 33 + (lane & 31)] = tv[i]; }
    asm volatile("s_waitcnt lgkmcnt(0)" ::: "memory");
    const int c = lane & 7;
#pragma unroll
    for (int j = 0; j < 4; ++j) {
        const int n = (lane >> 3) + 8 * j; const LAS float* s = scr + (8 * c) * 33 + n;
        u32x4 o; o.x = pk_bf16(s[0 * 33], s[1 * 33]); o.y = pk_bf16(s[2 * 33], s[3 * 33]); o.z = pk_bf16(s[4 * 33], s[5 * 33]); o.w = pk_bf16(s[6 * 33], s[7 * 33]);
        *(u32x4*)(dst + (size_t)n * ldd + k0 + 8 * c) = o;
    }
    asm volatile("s_waitcnt lgkmcnt(0)" ::: "memory");
}

__device__ __forceinline__ void tr_items(int wv, const PT pt, LAS unsigned char* lds, int it0, int it1, int gwr, int ngw) {
    const int lane = tid_l(wv) & 63;
    unsigned char* ws = pt.ws();
    {
        LAS float* scr = (LAS float*)(lds + wv * 8448);
        constexpr int I_QKV = 16 * 96, I_WO = 16 * 32, I_GU = 16 * 176, I_DN = 44 * 32, I_WIN = 16 * 64, I_WOUT = 16 * 32, I_G = 32 * 8;
        for (int it = it0 + gwr; it < it1; it += ngw) {
            int r = it;
            if (r < I_QKV) { const int kb = r / 96, nb = r % 96; tr_item(pt.f(I_w_qkv), NQKV, 64 * kb, 32 * nb, (bf16_t*)(ws + WS_WQKV) + (size_t)(32 * nb) * D, D, scr, lane); continue; } r -= I_QKV;
            if (r < I_WO) { const int kb = r / 32, nb = r % 32; tr_item(pt.f(I_w_o), D, 64 * kb, 32 * nb, (bf16_t*)(ws + WS_WO) + (size_t)(32 * nb) * D, D, scr, lane); continue; } r -= I_WO;
#pragma unroll 1
            for (int l = 0; l < 2; ++l) {
                if (r >= 0 && r < I_GU) { const int kb = r / 176, nb = r % 176; const int n0 = 32 * nb, half = n0 >= FF ? 1 : 0, c0 = n0 - half * FF;
                    const int drow = 256 * (c0 >> 7) + 128 * half + (c0 & 127);
                    tr_item(pt.f(I_w_gu) + (size_t)l * D * 2 * FF, 2 * FF, 64 * kb, n0, (bf16_t*)(ws + WS_WGU) + ((size_t)l * 2 * FF + drow) * D, D, scr, lane); r = -1; break; } r -= I_GU;
                if (r >= 0 && r < I_DN) { const int kb = r / 32, nb = r % 32;
                    tr_item(pt.f(I_w_down) + (size_t)l * FF * D, D, 64 * kb, 32 * nb, (bf16_t*)(ws + WS_WDN) + ((size_t)l * D + 32 * nb) * FF, FF, scr, lane); r = -1; break; } r -= I_DN;
            }
            if (r < 0) continue;
            if (r < I_WIN) { const int kb = r / 64, nb = r % 64; tr_item(pt.f(I_w_in), 2 * D, 64 * kb, 32 * nb, (bf16_t*)(ws + WS_WIN) + (size_t)(32 * nb) * D, D, scr, lane); continue; } r -= I_WIN;
            if (r < I_WOUT) { const int kb = r / 32, nb = r % 32; tr_item(pt.f(I_w_out), D, 64 * kb, 32 * nb, (bf16_t*)(ws + WS_WOUT) + (size_t)(32 * nb) * D, D, scr, lane); continue; } r -= I_WOUT;
            { const int mat = r >> 3, sub = r & 7, kb = sub >> 2, nb = sub & 3;
              const int gsel = mat >> 4, dir = (mat >> 3) & 1, blk = mat & 7;
              const float* src = (gsel ? pt.f(I_w_i) : pt.f(I_w_a)) + (size_t)(dir * 8 + blk) * 128 * 128;
              tr_item(src, 128, 64 * kb, 32 * nb, (bf16_t*)(ws + WS_WG) + ((size_t)((blk * 2 + dir) * 256 + gsel * 128 + 32 * nb)) * 128, 128, scr, lane); }
        }
    }
}

__device__ __forceinline__ void adaln_tasks(int wv, const PT pt, LAS unsigned char* lds, int l, int rank, int nb) {
    const int tid = tid_l(wv);
    LAS float* sl = (LAS float*)(lds + 70000);
    LAS float* red = (LAS float*)lds;
    float* mod = (float*)(pt.ws() + WS_MOD);
#pragma unroll 1
    for (int task = rank; task < 256; task += nb) {
        const int cg_ = task >> 3, kr = task & 7, col0 = cg_ * 192;
        __syncthreads();
        for (int i = tid; i < 9 * 128; i += 512) { const int cv = i >> 7, k = kr * 128 + (i & 127); const float v = cv < 8 ? pt.f(I_c)[cv * D + k] : pt.f(I_c_ctx)[k]; sl[i] = silu_f(v); }
        __syncthreads();
        if (tid < 384) {
            const int q = tid % 48, ks = tid / 48;
            float acc[9][4];
#pragma unroll
            for (int cv = 0; cv < 9; ++cv) { acc[cv][0] = 0.f; acc[cv][1] = 0.f; acc[cv][2] = 0.f; acc[cv][3] = 0.f; }
            const float* wp = pt.f(I_w_mod) + ((size_t)l * D + kr * 128 + ks * 16) * NMOD + col0 + 4 * q;
            f32x4 w[16];
#pragma unroll
            for (int k = 0; k < 16; ++k) w[k] = *(const f32x4*)(wp + (size_t)k * NMOD);
#pragma unroll
            for (int k = 0; k < 16; ++k) {
#pragma unroll
                for (int cv = 0; cv < 9; ++cv) { const float s = sl[cv * 128 + ks * 16 + k]; acc[cv][0] += s * w[k][0]; acc[cv][1] += s * w[k][1]; acc[cv][2] += s * w[k][2]; acc[cv][3] += s * w[k][3]; }
            }
#pragma unroll
            for (int cv = 0; cv < 9; ++cv) *(LAS f32x4*)(red + (ks * 9 + cv) * 192 + 4 * q) = (f32x4){acc[cv][0], acc[cv][1], acc[cv][2], acc[cv][3]};
        }
        __syncthreads();
        for (int i = tid; i < 9 * 192; i += 512) {
            const int cv = i / 192, cc = i % 192; float s = 0.f;
#pragma unroll
            for (int ks = 0; ks < 8; ++ks) s += red[(ks * 9 + cv) * 192 + cc];
            if (kr == 0) s += pt.f(I_b_mod)[l * NMOD + col0 + cc];
            unsafeAtomicAdd(mod + ((size_t)l * 9 + cv) * NMOD + col0 + cc, s);
        }
    }
    __syncthreads();
}

__device__ __forceinline__ void cache_conv(int wv, const PT pt, int rank, int nb) {
    const int tid = tid_l(wv);
    unsigned char* ws = pt.ws();
    const size_t n4 = (size_t)MC * D / 4;
#pragma unroll 8
    for (size_t i = (size_t)rank * 512 + tid; i < 2 * n4; i += (size_t)nb * 512) {
        const bool isv = i >= n4; const size_t j = isv ? i - n4 : i;
        const f32x4 v = *((const f32x4*)(isv ? pt.f(I_cache_v) : pt.f(I_cache_k)) + j);
        u32x2 w; w.x = pk_bf16(v[0], v[1]); w.y = pk_bf16(v[2], v[3]);
        *((u32x2*)(ws + (isv ? WS_CV : WS_CK)) + j) = w;
    }
}

__device__ __forceinline__ void p0_prologue(int wv, const PT pt, LAS unsigned char* lds) {
    const int tid = tid_l(wv), lane = tid & 63, wave = tid >> 6;
    const int G = gd_l(), bxl = bx_l(), gw = bxl * 8 + wave, NGW = G * 8;
    unsigned char* ws = pt.ws();
    adaln_tasks(wv, pt, lds, 0, bxl, G);
    for (int rp_ = 0; rp_ < REP_PRO; ++rp_) tr_items(wv, pt, lds, 0, 16 * 96, gw, NGW);
}

__device__ __forceinline__ void norm_phase(int wv, const float* xa, const float* xb, const float* g, const float* mod_l, int sh_chunk, bf16_t* XN) {
    const int tid = tid_l(wv), lane = tid & 63, gw = bx_l() * 8 + (tid >> 6), NGW = gd_l() * 8;
#pragma unroll 2
    for (int row = gw; row < MT; row += NGW) {
        const float* xr = row < MC ? xa + (size_t)row * D : xb + (size_t)(row - MC) * D;
        const int cv = row < MC ? 8 : ((row - MC) >> 10);
        const float* shp = mod_l + (size_t)cv * NMOD + sh_chunk * D; const float* scp = shp + D;
        f32x4 v[4], gg4[4], sc4[4], sh4[4]; float s = 0.f;
#pragma unroll
        for (int j = 0; j < 4; ++j) { const int c = 4 * lane + 256 * j; v[j] = *((const f32x4*)xr + lane + 64 * j); gg4[j] = *(const f32x4*)(g + c); sc4[j] = *(const f32x4*)(scp + c); sh4[j] = *(const f32x4*)(shp + c); }
#pragma unroll
        for (int j = 0; j < 4; ++j) s += (v[j][0] * v[j][0] + v[j][1] * v[j][1]) + (v[j][2] * v[j][2] + v[j][3] * v[j][3]);
        const float rstd = 1.f / sqrtf(wave_sum(s, lane) * (1.f / D) + RMS_EPS);
#pragma unroll
        for (int j = 0; j < 4; ++j) {
            const int c = 4 * lane + 256 * j;
            const f32x4 gg = gg4[j], sc = sc4[j], sh = sh4[j];
            const f32x4 y = v[j] * rstd * gg * (sc + 1.f) + sh;
            u32x2 w; w.x = pk_bf16(y[0], y[1]); w.y = pk_bf16(y[2], y[3]);
            *(u32x2*)(XN + (size_t)row * D + c) = w;
        }
    }
}
__device__ __forceinline__ void final_norm_phase(int wv, const bf16_t* XB, float* Y, const float* g) {
    const int tid = tid_l(wv), lane = tid & 63, gw = bx_l() * 8 + (tid >> 6), NGW = gd_l() * 8;
#pragma unroll 2
    for (int row = gw; row < MT; row += NGW) {
        const u32x4* xr = (const u32x4*)(XB + (size_t)row * D);
        f32x4 v[4], gg[4]; float s = 0.f;
#pragma unroll
        for (int j = 0; j < 2; ++j) {
            const u32x4 w = xr[lane + 64 * j];
            v[2 * j] = (f32x4){bf_lo(w.x), bf_hi(w.x), bf_lo(w.y), bf_hi(w.y)}; v[2 * j + 1] = (f32x4){bf_lo(w.z), bf_hi(w.z), bf_lo(w.w), bf_hi(w.w)};
            gg[2 * j] = *(const f32x4*)(g + 8 * lane + 512 * j); gg[2 * j + 1] = *(const f32x4*)(g + 8 * lane + 512 * j + 4);
        }
#pragma unroll
        for (int j = 0; j < 4; ++j) s += (v[j][0] * v[j][0] + v[j][1] * v[j][1]) + (v[j][2] * v[j][2] + v[j][3] * v[j][3]);
        const float rstd = 1.f / sqrtf(wave_sum(s, lane) * (1.f / D) + RMS_EPS);
        float* yr = Y + (size_t)row * D;
#pragma unroll
        for (int j = 0; j < 2; ++j) { *(f32x4*)(yr + 8 * lane + 512 * j) = v[2 * j] * rstd * gg[2 * j]; *(f32x4*)(yr + 8 * lane + 512 * j + 4) = v[2 * j + 1] * rstd * gg[2 * j + 1]; }
    }
}
__device__ __forceinline__ void conv_phase(int wv, const bf16_t* XR, const float* cw, const float* cb, bf16_t* XC) {
    const size_t n8 = (size_t)MT * D / 8;
#pragma unroll 2
    for (size_t i = (size_t)bx_l() * 512 + tid_l(wv), st_ = (size_t)gd_l() * 512; i < n8; i += st_) {
        const int row = (int)(i >> 7), c = (int)(i & 127) * 8;
        int pos, len; if (row < MC) { pos = row & 255; len = 256; } else { pos = (row - MC) & 1023; len = 1024; }
        float y[8];
#pragma unroll
        for (int e = 0; e < 8; ++e) y[e] = cb[c + e];
#pragma unroll
        for (int j = 0; j < 4; ++j) {
            const int p = pos + j - 2;
            if (p >= 0 && p < len) {
                const u32x4 xw = *(const u32x4*)(XR + (size_t)(row + j - 2) * D + c);
                const f32x4 w0 = *(const f32x4*)(cw + j * D + c), w1 = *(const f32x4*)(cw + j * D + c + 4);
                y[0] += w0[0] * bf_lo(xw.x); y[1] += w0[1] * bf_hi(xw.x); y[2] += w0[2] * bf_lo(xw.y); y[3] += w0[3] * bf_hi(xw.y);
                y[4] += w1[0] * bf_lo(xw.z); y[5] += w1[1] * bf_hi(xw.z); y[6] += w1[2] * bf_lo(xw.w); y[7] += w1[3] * bf_hi(xw.w);
            }
        }
        u32x4 o; o.x = pk_bf16(y[0], y[1]); o.y = pk_bf16(y[2], y[3]); o.z = pk_bf16(y[4], y[5]); o.w = pk_bf16(y[6], y[7]);
        *(u32x4*)(XC + (size_t)row * D + c) = o;
    }
}
__device__ __forceinline__ void conv_slab(int wv, const bf16_t* XR, const float* cw, const float* cb, bf16_t* XC, int q, int n) {
    const int tid = tid_l(wv), ch = n * 128 + (tid & 15) * 8, r0 = q * 256 + (tid >> 4) * 8;
    int pos0, len; if (r0 < MC) { pos0 = r0 & 255; len = 256; } else { pos0 = (r0 - MC) & 1023; len = 1024; }
    u32x4 x[11];
#pragma unroll
    for (int i = 0; i < 11; ++i) { const int p = pos0 + i - 2; x[i] = (p >= 0 && p < len) ? *(const u32x4*)(XR + (size_t)(r0 + i - 2) * D + ch) : (u32x4){0u, 0u, 0u, 0u}; }
    f32x4 w0[4], w1[4];
#pragma unroll
    for (int j = 0; j < 4; ++j) { w0[j] = *(const f32x4*)(cw + j * D + ch); w1[j] = *(const f32x4*)(cw + j * D + ch + 4); }
    const f32x4 b0 = *(const f32x4*)(cb + ch), b1 = *(const f32x4*)(cb + ch + 4);
#pragma unroll
    for (int r = 0; r < 8; ++r) {
        f32x4 y0 = b0, y1 = b1;
#pragma unroll
        for (int j = 0; j < 4; ++j) { const u32x4 xw = x[r + j];
            y0 += w0[j] * (f32x4){bf_lo(xw.x), bf_hi(xw.x), bf_lo(xw.y), bf_hi(xw.y)}; y1 += w1[j] * (f32x4){bf_lo(xw.z), bf_hi(xw.z), bf_lo(xw.w), bf_hi(xw.w)}; }
        u32x4 o; o.x = pk_bf16(y0[0], y0[1]); o.y = pk_bf16(y0[2], y0[3]); o.z = pk_bf16(y1[0], y1[1]); o.w = pk_bf16(y1[2], y1[3]);
        *(u32x4*)(XC + (size_t)(r0 + r) * D + ch) = o;
    }
    asm volatile("s_waitcnt vmcnt(0)" ::: "memory");
    __syncthreads();
}

__device__ __forceinline__ void lru_combine_phase(int wv, const unsigned char* ws, bf16_t* Y) {
    const bf16_t* HLF = (const bf16_t*)(ws + WS_HLF); const bf16_t* HLB = (const bf16_t*)(ws + WS_HLB);
    const bf16_t* PF = (const bf16_t*)(ws + WS_PF); const bf16_t* PB = (const bf16_t*)(ws + WS_PB); const bf16_t* GT = (const bf16_t*)(ws + WS_GATE);
    const float* sE = (const float*)(ws + WS_SUME); const float* sP = (const float*)(ws + WS_SUMP);
    const size_t n8 = (size_t)MT * D / 8;
#pragma unroll 2
    for (size_t i = (size_t)bx_l() * 512 + tid_l(wv), st_ = (size_t)gd_l() * 512; i < n8; i += st_) {
        const int row = (int)(i >> 7), c = (int)(i & 127) * 8;
        const size_t off = (size_t)row * D + c;
        const u32x4 hf = *(const u32x4*)(HLF + off), hb = *(const u32x4*)(HLB + off), gt = *(const u32x4*)(GT + off);
        float h[8] = {bf_lo(hf.x) + bf_lo(hb.x), bf_hi(hf.x) + bf_hi(hb.x), bf_lo(hf.y) + bf_lo(hb.y), bf_hi(hf.y) + bf_hi(hb.y),
                      bf_lo(hf.z) + bf_lo(hb.z), bf_hi(hf.z) + bf_hi(hb.z), bf_lo(hf.w) + bf_lo(hb.w), bf_hi(hf.w) + bf_hi(hb.w)};
        if (row >= MC) {
            const int q = row >> 8, ci = (q - 16) & 3, q0 = q - ci;
            const u32x4 pf = *(const u32x4*)(PF + off - (size_t)MC * D), pb = *(const u32x4*)(PB + off - (size_t)MC * D);
            f32x4 tf0 = {0.f, 0.f, 0.f, 0.f}, tf1 = tf0, tb0 = tf0, tb1 = tf0;
            for (int cc = 0; cc < ci; ++cc) { const float* e = sE + (size_t)(q0 + cc) * D + c; const float* p = sP + (size_t)(q0 + cc) * D + c;
                tf0 = *(const f32x4*)e + *(const f32x4*)p * tf0; tf1 = *(const f32x4*)(e + 4) + *(const f32x4*)(p + 4) * tf1; }
            for (int cc = 3; cc > ci; --cc) { const float* e = sE + (size_t)(48 + q0 + cc) * D + c; const float* p = sP + (size_t)(48 + q0 + cc) * D + c;
                tb0 = *(const f32x4*)e + *(const f32x4*)p * tb0; tb1 = *(const f32x4*)(e + 4) + *(const f32x4*)(p + 4) * tb1; }
            h[0] += bf_lo(pf.x) * tf0[0] + bf_lo(pb.x) * tb0[0]; h[1] += bf_hi(pf.x) * tf0[1] + bf_hi(pb.x) * tb0[1];
            h[2] += bf_lo(pf.y) * tf0[2] + bf_lo(pb.y) * tb0[2]; h[3] += bf_hi(pf.y) * tf0[3] + bf_hi(pb.y) * tb0[3];
            h[4] += bf_lo(pf.z) * tf1[0] + bf_lo(pb.z) * tb1[0]; h[5] += bf_hi(pf.z) * tf1[1] + bf_hi(pb.z) * tb1[1];
            h[6] += bf_lo(pf.w) * tf1[2] + bf_lo(pb.w) * tb1[2]; h[7] += bf_hi(pf.w) * tf1[3] + bf_hi(pb.w) * tb1[3];
        }
        u32x4 o;
        o.x = pk_bf16(h[0] * bf_lo(gt.x), h[1] * bf_hi(gt.x)); o.y = pk_bf16(h[2] * bf_lo(gt.y), h[3] * bf_hi(gt.y));
        o.z = pk_bf16(h[4] * bf_lo(gt.z), h[5] * bf_hi(gt.z)); o.w = pk_bf16(h[6] * bf_lo(gt.w), h[7] * bf_hi(gt.w));
        *(u32x4*)(Y + off) = o;
    }
}

#ifndef PG8_SP2
#define PG8_SP2 true
#endif
#ifndef PG8_ALIGN
#define PG8_ALIGN true
#endif

__device__ __forceinline__ void shw_phase(int wv, const PT pt, LAS unsigned char* lds, const bool layer1, int bx, int G) {
    const int tid = tid_l(wv), lane = tid & 63;
    unsigned char* ws = pt.ws();
    const int b1 = (G * 68) >> 8;
    const int site = !layer1 ? 0 : (bx < b1 ? 1 : 2);
    const int lb = site == 2 ? bx - b1 : bx, nb = site == 0 ? G : (site == 1 ? b1 : G - b1);
    LAS float* sl = (LAS float*)lds;
    const float* mod = (const float*)(ws + WS_MOD);
    const int l = site ? 1 : 0, chunk = (site == 1) ? 0 : 3, N = (site == 1) ? 2 * D : 2 * FF;
    const bf16_t* Wt = site == 0 ? (const bf16_t*)(ws + WS_WGU) : (site == 1 ? (const bf16_t*)(ws + WS_WIN) : (const bf16_t*)(ws + WS_WGU) + (size_t)2 * FF * D);
    float* out = (float*)(ws + WS_SHW) + (site == 0 ? SHW_OFF0 : (site == 1 ? SHW_OFF1 : SHW_OFF2));
    __syncthreads();
#pragma unroll
    for (int r = 0; r < 3; ++r) {
        float v[6];
#pragma unroll
        for (int j = 0; j < 6; ++j) { const int i = tid + 512 * (6 * r + j); v[j] = mod[((size_t)l * 9 + (i >> 10)) * NMOD + chunk * D + (i & 1023)]; }
#pragma unroll
        for (int j = 0; j < 6; ++j) sl[tid + 512 * (6 * r + j)] = v[j];
    }
    __syncthreads();
    const int step = nb * 8;
    int n = lb * 8 + wv;
    u32x2 wa[4];
    if (n < N) {
#pragma unroll
        for (int j = 0; j < 4; ++j) wa[j] = *(const u32x2*)(Wt + (size_t)n * D + 4 * lane + 256 * j);
    }
    for (; n < N; n += step) {
        u32x2 wb[4];
        const int n2 = n + step;
        if (n2 < N) {
#pragma unroll
            for (int j = 0; j < 4; ++j) wb[j] = *(const u32x2*)(Wt + (size_t)n2 * D + 4 * lane + 256 * j);
        }
        float res = 0.f;
#pragma unroll
        for (int cv = 0; cv < 9; ++cv) {
            float s = 0.f;
#pragma unroll
            for (int j = 0; j < 4; ++j) { const f32x4 v = *(const LAS f32x4*)(sl + cv * D + 4 * lane + 256 * j); s += (v[0] * bf_lo(wa[j].x) + v[1] * bf_hi(wa[j].x)) + (v[2] * bf_lo(wa[j].y) + v[3] * bf_hi(wa[j].y)); }
            s = wave_sum(s, lane);
            if (lane == cv) res = s;
        }
        if (lane < 9) out[(size_t)lane * N + n] = res;
#pragma unroll
        for (int j = 0; j < 4; ++j) wa[j] = wb[j];
    }
    __syncthreads();
}

#ifndef PHMASK
#define PHMASK 0xffff
#endif
constexpr int PHM = PHMASK;
__global__ void __launch_bounds__(512, 2) fwd_megakernel(Args a) {
    extern __shared__ __attribute__((aligned(16))) unsigned char lds_raw[];
    LAS unsigned char* lds = (LAS unsigned char*)lds_raw;
    cg::grid_group grid = cg::this_grid();
    const int wv = __builtin_amdgcn_readfirstlane(threadIdx.x >> 6);
    {
        LAS unsigned long long* tw = (LAS unsigned long long*)(lds + PTAB_OFF);
        if (threadIdx.x == 0) {
            tw[0] = (unsigned long long)a.x_prompt; tw[1] = (unsigned long long)a.x_sample; tw[2] = (unsigned long long)a.c; tw[3] = (unsigned long long)a.cache_k; tw[4] = (unsigned long long)a.cache_v;
            tw[5] = (unsigned long long)a.state_h; tw[6] = (unsigned long long)a.c_ctx; tw[7] = (unsigned long long)a.norm_g; tw[8] = (unsigned long long)a.w_mod; tw[9] = (unsigned long long)a.b_mod;
            tw[10] = (unsigned long long)a.w_qkv; tw[11] = (unsigned long long)a.w_o; tw[12] = (unsigned long long)a.rpb; tw[13] = (unsigned long long)a.w_in; tw[14] = (unsigned long long)a.conv_w;
            tw[15] = (unsigned long long)a.conv_b; tw[16] = (unsigned long long)a.w_a; tw[17] = (unsigned long long)a.b_a; tw[18] = (unsigned long long)a.w_i; tw[19] = (unsigned long long)a.b_i;
            tw[20] = (unsigned long long)a.lam; tw[21] = (unsigned long long)a.w_out; tw[22] = (unsigned long long)a.w_gu; tw[23] = (unsigned long long)a.w_down; tw[24] = (unsigned long long)a.final_g;
            tw[25] = (unsigned long long)a.out; tw[26] = (unsigned long long)a.ws;
            LAS unsigned* st = (LAS unsigned*)(lds + BARST_OFF); st[0] = 0u; st[1] = 0u;
            (void)xb_add((unsigned*)(a.ws + WS_BAR) + XB_XCNT(xb_xcc_id()), 1u);
        }
        __syncthreads();
        if (a.out == nullptr) grid.sync();
    }
#define GSYNC() do { for (int rs_ = 0; rs_ < REP_SYNC; ++rs_) xcd_barrier(pt, lds, wv); } while (0)
    const PT pt{(LAS const unsigned long long*)(lds + PTAB_OFF)};
#define WSP(off) (pt.ws() + (off))
#define MODP ((float*)WSP(WS_MOD))
#define XNP ((bf16_t*)WSP(WS_XN))
#define XRES (pt.out() + OUT_Y)
#define XBP ((bf16_t*)WSP(WS_XB))
#define SSQP(i) ((float*)WSP(WS_SSQ) + (size_t)(i) * MT)

    if (PHM & 1) p0_prologue(wv, pt, lds);
    GSYNC();
    if (PHM & 2) for (int rep_ = 0; rep_ < REP_THIN; ++rep_) norm_phase(wv, pt.f(I_x_prompt), pt.f(I_x_sample), pt.f(I_norm_g), MODP, 0, XNP);
    GSYNC();
    if (PHM & 4) { pg8::Gemm g{XNP, (const bf16_t*)WSP(WS_WQKV), MT, NQKV, D, D, D, wv}; pg8::StaticOrder S; S.init(MT, NQKV, gd_l(), bx_l()); S.reps = REP_GEMM;
      pg8::EpiQKV E{(bf16_t*)WSP(WS_Q), pt.out() + OUT_NK, 0.125f * LOG2E};
      pg8::gemm_phase<pg8::EpiQKV, pg8::StaticOrder, PG8_ALIGN, PG8_SP2>(lds, g, S, E); }
    {
        const int G_ = gd_l(), c_ = bx_l(), nwg_ = (MT / 256) * (NQKV / 256), maxu_ = (nwg_ + G_ - 1) / G_, full_ = nwg_ - (maxu_ - 1) * G_;
        int rank_ = c_, n_ = G_;
        if (full_ < G_) { rank_ = c_ - full_; n_ = c_ >= full_ ? G_ - full_ : 0; }
        if (n_ > 0) { tr_items(wv, pt, lds, 16 * 96, 16 * 96 + 16 * 32 + 16 * 176 + 44 * 32, rank_ * 8 + wv, n_ * 8); cache_conv(wv, pt, rank_, n_); }
    }
    GSYNC();
    if (PHM & 8) for (int rep_ = 0; rep_ < REP_ATT; ++rep_) for (int vc = bx_l(), G_ = gd_l(); vc < 256; vc += G_) {
        const int bh = vc >> 1;
#pragma unroll 1
        for (int gi = 0; gi < 2; ++gi)
            att::unit<true>(wv, lds, bh >> 4, bh & 15, 2 * (vc & 1) + gi, (const bf16_t*)WSP(WS_Q), (const bf16_t*)WSP(WS_K), (const bf16_t*)WSP(WS_V), (const bf16_t*)WSP(WS_CK), (const bf16_t*)WSP(WS_CV), XNP, pt.f(I_rpb));
        att::unit<false>(wv, lds, vc >> 4, vc & 15, 0, (const bf16_t*)WSP(WS_Q), (const bf16_t*)WSP(WS_K), (const bf16_t*)WSP(WS_V), nullptr, nullptr, XNP, nullptr);
    }
    GSYNC();
    if (PHM & 16)
#pragma unroll 1
    for (int rp_ = REP_P4 - 1; rp_ >= 0; --rp_) { pg8::Gemm g{XNP, (const bf16_t*)WSP(WS_WO), MT, D, D, D, D, wv}; pg8::StaticOrder S; S.init(MT, D, gd_l(), bx_l());
      pg8::EpiResT<true, true> E{pt.f(I_x_prompt), pt.f(I_x_sample), XBP, MODP + 2 * D, (bf16_t*)WSP(WS_XN2), pt.f(I_norm_g) + D, MODP + 4 * D, rp_ ? (float*)WSP(WS_HLF) : SSQP(0)};
      pg8::gemm_phase<pg8::EpiResT<true, true>, pg8::StaticOrder, PG8_ALIGN, PG8_SP2>(lds, g, S, E); }
    {
        const int G_ = gd_l(), c_ = bx_l(), nwg_ = (MT / 256) * (D / 256);
        if (nwg_ < G_) { if (c_ >= nwg_) { adaln_tasks(wv, pt, lds, 1, c_ - nwg_, G_ - nwg_); shw_phase(wv, pt, lds, false, c_ - nwg_, G_ - nwg_); } }
        else { adaln_tasks(wv, pt, lds, 1, c_, G_); shw_phase(wv, pt, lds, false, c_, G_); }
    }
    GSYNC();
    if (PHM & 512) { pg8::Gemm g{(const bf16_t*)WSP(WS_XN2), (const bf16_t*)WSP(WS_WGU), MT, 2 * FF, D, D, D, wv}; pg8::StaticOrder S; S.init(MT, 2 * FF, gd_l(), bx_l()); S.reps = REP_GEMM;
      pg8::EpiSwiglu E{(bf16_t*)WSP(WS_H), SSQP(0), (const float*)WSP(WS_SHW) + SHW_OFF0};
      pg8::gemm_phase<pg8::EpiSwiglu, pg8::StaticOrder, PG8_ALIGN, PG8_SP2>(lds, g, S, E); }
    {
        const int G_ = gd_l(), c_ = bx_l(), nwg_ = (MT / 256) * (2 * FF / 256), maxu_ = (nwg_ + G_ - 1) / G_, full_ = nwg_ - (maxu_ - 1) * G_;
        int rank_ = c_, n_ = G_;
        if (full_ < G_) { rank_ = c_ - full_; n_ = c_ >= full_ ? G_ - full_ : 0; }
        if (n_ > 0) tr_items(wv, pt, lds, 16 * 96 + 16 * 32 + 16 * 176 + 44 * 32, 12288, rank_ * 8 + wv, n_ * 8);
    }
    GSYNC();
    if (PHM & 16) { pg8::Gemm g{(const bf16_t*)WSP(WS_H), (const bf16_t*)WSP(WS_WDN), MT, D, FF, FF, FF, wv}; pg8::StaticOrder S; S.init(MT, D, gd_l(), bx_l());
      pg8::EpiResT<true, false> E{nullptr, nullptr, XBP, MODP + 5 * D, XNP, pt.f(I_norm_g) + 2 * D, MODP + (size_t)9 * NMOD + 1 * D, SSQP(1)};
      pg8::gemm_phase<pg8::EpiResT<true, false>, pg8::StaticOrder, PG8_ALIGN, PG8_SP2>(lds, g, S, E); }
    {
        const int G_ = gd_l(), c_ = bx_l(), nwg_ = (MT / 256) * (D / 256);
        if (nwg_ < G_) { if (c_ >= nwg_) shw_phase(wv, pt, lds, true, c_ - nwg_, G_ - nwg_); }
        else shw_phase(wv, pt, lds, true, c_, G_);
    }
    GSYNC();
    if (PHM & 32) { pg8::Gemm g{XNP, (const bf16_t*)WSP(WS_WIN), MT, 2 * D, D, D, D, wv}; pg8::StaticOrder S; S.init(MT, 2 * D, gd_l(), bx_l()); S.reps = REP_GEMM;
      pg8::EpiWin E{(bf16_t*)WSP(WS_GATE), (bf16_t*)WSP(WS_XR), SSQP(1), (const float*)WSP(WS_SHW) + SHW_OFF1};
      pg8::gemm_phase<pg8::EpiWin, pg8::StaticOrder, PG8_ALIGN, PG8_SP2>(lds, g, S, E); }
    GSYNC();
    if (PHM & 128)
#pragma unroll 1
    for (int uu = bx_l(), G_ = gd_l(); uu < 768 * REP_LRU; uu += G_) {
        const int u = uu % 768;
        const int dir = u & 1, n = (u >> 1) & 7, q = u >> 4;
        const float* h0 = nullptr;
        if (q >= 16) { const int b = (q - 16) >> 2, ci = (q - 16) & 3; if ((dir == 0 && ci == 0) || (dir == 1 && ci == 3)) h0 = pt.f(I_state_h) + ((size_t)b * 2 + dir) * D; }
        conv_slab(wv, (const bf16_t*)WSP(WS_XR), pt.f(I_conv_w), pt.f(I_conv_b), XNP, q, n);
        pg8::Gemm g{XNP + (size_t)q * 256 * D + n * 128, (const bf16_t*)WSP(WS_WG) + (size_t)(n * 2 + dir) * 256 * 128, 256, 256, 128, D, 128, wv};
        pg8::OneUnit S;
        pg8::EpiLru E{pt.t, h0, q * 256, n * 128, dir, q};
        pg8::gemm_phase<pg8::EpiLru, pg8::OneUnit, false, false>(lds, g, S, E);
    }
    GSYNC();
    if (PHM & 256) for (int rep_ = 0; rep_ < REP_THIN; ++rep_) lru_combine_phase(wv, pt.ws(), (bf16_t*)WSP(WS_Y));
    GSYNC();
    if (PHM & 16) { pg8::Gemm g{(const bf16_t*)WSP(WS_Y), (const bf16_t*)WSP(WS_WOUT), MT, D, D, D, D, wv}; pg8::StaticOrder S; S.init(MT, D, gd_l(), bx_l());
      pg8::EpiResT<true, false> E{nullptr, nullptr, XBP, MODP + (size_t)9 * NMOD + 2 * D, XNP, pt.f(I_norm_g) + 3 * D, MODP + (size_t)9 * NMOD + 4 * D, SSQP(2)};
      pg8::gemm_phase<pg8::EpiResT<true, false>, pg8::StaticOrder, PG8_ALIGN, PG8_SP2>(lds, g, S, E); }
    GSYNC();
    if (PHM & 512) { pg8::Gemm g{XNP, (const bf16_t*)WSP(WS_WGU) + (size_t)2 * FF * D, MT, 2 * FF, D, D, D, wv}; pg8::StaticOrder S; S.init(MT, 2 * FF, gd_l(), bx_l()); S.reps = REP_GEMM;
      pg8::EpiSwiglu E{(bf16_t*)WSP(WS_H), SSQP(2), (const float*)WSP(WS_SHW) + SHW_OFF2};
      pg8::gemm_phase<pg8::EpiSwiglu, pg8::StaticOrder, PG8_ALIGN, PG8_SP2>(lds, g, S, E); }
    GSYNC();
    if (gd_l() >= (MT / 256) * (D / 256)) {
        pg8::Gemm g{(const bf16_t*)WSP(WS_H), (const bf16_t*)WSP(WS_WDN) + (size_t)D * FF, MT, D, FF, FF, FF, wv}; pg8::StaticOrder S; S.init(MT, D, gd_l(), bx_l());
        pg8::EpiResFinal E{XBP, MODP + (size_t)9 * NMOD + 5 * D, SSQP(3), (unsigned*)WSP(WS_FCNT), pt.f(I_final_g), XRES};
        pg8::gemm_phase<pg8::EpiResFinal, pg8::StaticOrder, PG8_ALIGN, PG8_SP2>(lds, g, S, E);
    } else {
        { pg8::Gemm g{(const bf16_t*)WSP(WS_H), (const bf16_t*)WSP(WS_WDN) + (size_t)D * FF, MT, D, FF, FF, FF, wv}; pg8::StaticOrder S; S.init(MT, D, gd_l(), bx_l());
          pg8::EpiResT<false, false> E{nullptr, nullptr, XBP, MODP + (size_t)9 * NMOD + 5 * D, nullptr, nullptr, nullptr, nullptr};
          pg8::gemm_phase<pg8::EpiResT<false, false>, pg8::StaticOrder, PG8_ALIGN, PG8_SP2>(lds, g, S, E); }
        GSYNC();
        final_norm_phase(wv, XBP, XRES, pt.f(I_final_g));
    }
}

extern "C" void kernel_launch(void* const* d_in, const int* in_sizes, int n_in, void* d_out, int out_size, void* d_ws, size_t ws_size, hipStream_t stream) {
    static int grid = 0;
    if (grid == 0) {
        int dev = 0, cus = 0, per_cu = 0;
        (void)hipGetDevice(&dev);
        (void)hipDeviceGetAttribute(&cus, hipDeviceAttributeMultiprocessorCount, dev);
        (void)hipFuncSetAttribute((const void*)fwd_megakernel, hipFuncAttributeMaxDynamicSharedMemorySize, LDS_BYTES);
        (void)hipOccupancyMaxActiveBlocksPerMultiprocessor(&per_cu, (const void*)fwd_megakernel, 512, LDS_BYTES);
        if (per_cu < 1) { fprintf(stderr, "kernel_launch: occupancy query says %d blocks per CU\n", per_cu); per_cu = 1; }
        grid = cus * per_cu;
        if (ws_size < WS_END) { fprintf(stderr, "kernel_launch: workspace too small (%zu < %zu)\n", ws_size, (size_t)WS_END); grid = -1; }
    }
    if (grid < 0) return;
    (void)hipMemsetAsync((char*)d_ws + WS_MOD, 0, 1024 * 1024, stream);
    Args a{};
    const float** ap = (const float**)&a;
    for (int i = 0; i < 25; ++i) ap[i] = (const float*)d_in[i];
    a.out = (float*)d_out; a.ws = (unsigned char*)d_ws;
    void* args[] = {&a};
    hipError_t e = hipLaunchCooperativeKernel((const void*)fwd_megakernel, dim3(grid), dim3(512), args, LDS_BYTES, stream);
    if (e != hipSuccess) fprintf(stderr, "cooperative launch failed: %s (grid %d)\n", hipGetErrorString(e), grid);
}
```

```cpp
#include <hip/hip_runtime.h>
#include <hip/hip_cooperative_groups.h>
#include <cstdio>
#include <cstdint>
namespace cg = cooperative_groups;

#define LAS __attribute__((address_space(3)))
typedef unsigned short bf16_t;
typedef short bf16x8 __attribute__((ext_vector_type(8)));
typedef short s16x4 __attribute__((ext_vector_type(4)));
typedef float f32x4 __attribute__((ext_vector_type(4)));
typedef float f32x2 __attribute__((ext_vector_type(2)));
typedef float f32x16 __attribute__((ext_vector_type(16)));
typedef unsigned u32x4 __attribute__((ext_vector_type(4)));
typedef unsigned u32x2 __attribute__((ext_vector_type(2)));
typedef __bf16 bf16x2_t __attribute__((ext_vector_type(2)));

constexpr int D = 1024, MC = 4096, ML = 8192, MT = MC + ML, FF = 2816, NQKV = 3072, NMOD = 6144;
constexpr float LOG2E = 1.4426950408889634f;
constexpr float RMS_EPS = 1e-6f;

constexpr size_t MiB = 1u << 20;
constexpr size_t WS_MOD = 0;
constexpr size_t WS_YCNT = 832 * 1024;
constexpr size_t WS_FCNT = 768 * 1024;
constexpr size_t WS_SSQ = 512 * 1024;
constexpr size_t WS_WQKV = 1 * MiB, WS_WO = 7 * MiB, WS_WGU = 9 * MiB, WS_WDN = 31 * MiB, WS_WIN = 42 * MiB, WS_WOUT = 46 * MiB, WS_WG = 48 * MiB;
constexpr size_t WS_CK = 49 * MiB, WS_CV = 57 * MiB;
constexpr size_t WS_PF = 49 * MiB;
constexpr size_t WS_XN = 65 * MiB;
constexpr size_t WS_Q = 89 * MiB, WS_K = 113 * MiB, WS_V = 137 * MiB;
constexpr size_t WS_H = 89 * MiB;
constexpr size_t WS_GATE = 89 * MiB, WS_XR = 113 * MiB, WS_Y = 113 * MiB;
constexpr size_t WS_XN2 = 161 * MiB;
constexpr size_t WS_PB = 137 * MiB;
constexpr size_t WS_XB = 185 * MiB;
constexpr size_t WS_HLF = 209 * MiB, WS_HLB = 161 * MiB;
constexpr size_t WS_SUMP = 250 * MiB;
constexpr size_t WS_SUME = 250 * MiB + 512 * 1024;
constexpr size_t WS_SHW = 252 * MiB;
constexpr int SHW_OFF0 = 0, SHW_OFF1 = 9 * 5632, SHW_OFF2 = 9 * 5632 + 9 * 2048;
constexpr size_t WS_END = 256 * MiB;

constexpr int LDS_BYTES = 143360;
constexpr int AB_PITCH = 1056;
constexpr int HST_OFF = 128 * AB_PITCH;

enum { I_x_prompt = 0, I_x_sample = 1, I_c = 2, I_cache_k = 3, I_cache_v = 4, I_state_h = 5, I_c_ctx = 6, I_norm_g = 7, I_w_mod = 8, I_b_mod = 9, I_w_qkv = 10, I_w_o = 11, I_rpb = 12, I_w_in = 13, I_conv_w = 14, I_conv_b = 15, I_w_a = 16, I_b_a = 17, I_w_i = 18, I_b_i = 19, I_lam = 20, I_w_out = 21, I_w_gu = 22, I_w_down = 23, I_final_g = 24, I_out = 25, I_ws = 26 };
constexpr int PTAB_OFF = LDS_BYTES - 256;
struct PT {
    LAS const unsigned long long* t;
    __device__ __forceinline__ unsigned long long raw(int i) const { const unsigned long long v = t[i]; const unsigned lo = __builtin_amdgcn_readfirstlane((unsigned)v), hi = __builtin_amdgcn_readfirstlane((unsigned)(v >> 32)); return ((unsigned long long)hi << 32) | lo; }
    __device__ __forceinline__ const float* f(int i) const { return (const float*)(const __attribute__((address_space(1))) float*)raw(i); }
    __device__ __forceinline__ float* out() const { return (float*)(__attribute__((address_space(1))) float*)raw(I_out); }
    __device__ __forceinline__ unsigned char* ws() const { return (unsigned char*)(__attribute__((address_space(1))) unsigned char*)raw(I_ws); }
};
constexpr size_t OUT_Y = 0, OUT_NK = (size_t)MT * D, OUT_NV = OUT_NK + (size_t)MC * D, OUT_NH = OUT_NV + (size_t)MC * D;
constexpr int CST_OFF = HST_OFF + 1024;
__device__ __forceinline__ int tid_l(int wv) { int l; asm volatile("v_mbcnt_lo_u32_b32 %0, -1, 0\n\tv_mbcnt_hi_u32_b32 %0, -1, %0" : "=v"(l)); return wv * 64 + l; }
__device__ __forceinline__ int bx_l() { int b = blockIdx.x; asm volatile("" : "+s"(b)); return b; }
__device__ __forceinline__ int gd_l() { int g = gridDim.x; asm volatile("" : "+s"(g)); return g; }

constexpr size_t WS_BAR = 448 * 1024;
constexpr int BARST_OFF = PTAB_OFF + 224;
#define XB_TMO      128
#define XB_XCNT(j)  (256  + 64 * (j))
#define XB_XSUB(j)  (1280 + 64 * (j))
#define XB_XGEN(j)  (2304 + 64 * (j))
#define XB_TOP      3328
#define XB_TOPGEN   3392
#define XCD_BAR_WORDS 3456
#define XB_SPIN_CAP (1u << 18)
__device__ __forceinline__ unsigned xb_ld(unsigned* p)              { return __hip_atomic_load(p, __ATOMIC_RELAXED, __HIP_MEMORY_SCOPE_AGENT); }
__device__ __forceinline__ unsigned xb_add(unsigned* p, unsigned v) { return __hip_atomic_fetch_add(p, v, __ATOMIC_RELAXED, __HIP_MEMORY_SCOPE_AGENT); }
__device__ __forceinline__ unsigned xb_xcc_id() { return (unsigned)__builtin_amdgcn_s_getreg((3 << 11) | 20) & 0xFu; }
#define XB_SPIN(cond, bar) do { unsigned _sp = 0; while (cond) { __builtin_amdgcn_s_sleep(1); \
    if ((++_sp & 255u) == 0u) { if (xb_ld(&(bar)[XB_TMO])) break; if (_sp > XB_SPIN_CAP) { atomicAdd(&(bar)[XB_TMO], 1u); break; } } } } while (0)
__device__ __forceinline__ void xcd_barrier_complete(unsigned* bar, unsigned x, unsigned& nloc, unsigned& nx) {
    const unsigned G = gridDim.x;
    unsigned sum, cnt, mine, sp = 0u;
    for (;;) {
        sum = 0u; cnt = 0u; mine = 0u;
#pragma unroll
        for (unsigned j = 0; j < 16; ++j) { const unsigned c = xb_ld(&bar[XB_XCNT(j)]); sum += c; cnt += (c > 0u) ? 1u : 0u; mine = (j == x) ? c : mine; }
        if (sum == G) break;
        __builtin_amdgcn_s_sleep(1);
        if ((++sp & 255u) == 0u) { if (xb_ld(&bar[XB_TMO])) break; if (sp > XB_SPIN_CAP) { atomicAdd(&bar[XB_TMO], 1u); break; } }
    }
    nloc = mine > 0u ? mine : 1u; nx = cnt > 0u ? cnt : 1u;
}
__device__ __forceinline__ void xcd_barrier(const PT pt, LAS unsigned char* lds, int wv) {
    asm volatile("s_waitcnt vmcnt(0)" ::: "memory");
    __syncthreads();
    if (tid_l(wv) == 0) {
        unsigned* bar = (unsigned*)(pt.ws() + WS_BAR);
        volatile LAS unsigned* st = (volatile LAS unsigned*)(lds + BARST_OFF);
        const unsigned x = xb_xcc_id();
        __builtin_amdgcn_s_waitcnt(0);
        unsigned nloc = st[0], nx = st[1];
        if (nloc == 0u) { xcd_barrier_complete(bar, x, nloc, nx); st[0] = nloc; st[1] = nx; }
        const unsigned old = xb_add(&bar[XB_XSUB(x)], 1u);
        const unsigned gen = old / nloc;
        if (old + 1u == (gen + 1u) * nloc) {
            __builtin_amdgcn_fence(__ATOMIC_RELEASE, "agent");
            asm volatile("s_waitcnt vmcnt(0)" ::: "memory");
            const unsigned og = xb_add(&bar[XB_TOP], 1u);
            const unsigned tg = og / nx;
            if (og + 1u == (tg + 1u) * nx) xb_add(&bar[XB_TOPGEN], 1u);
            else XB_SPIN(xb_ld(&bar[XB_TOPGEN]) == tg, bar);
            __builtin_amdgcn_fence(__ATOMIC_ACQUIRE, "agent");
            xb_add(&bar[XB_XGEN(x)], 1u);
            asm volatile("s_waitcnt vmcnt(0)" ::: "memory");
        } else {
            XB_SPIN(xb_ld(&bar[XB_XGEN(x)]) == gen, bar);
            __builtin_amdgcn_fence(__ATOMIC_ACQUIRE, "agent");
            asm volatile("s_waitcnt vmcnt(0)" ::: "memory");
        }
    }
    __syncthreads();
}
__device__ __forceinline__ unsigned pk_bf16(float lo, float hi) { f32x2 v = {lo, hi}; bf16x2_t b = __builtin_convertvector(v, bf16x2_t); return __builtin_bit_cast(unsigned, b); }
__device__ __forceinline__ float bf_lo(unsigned u) { return __uint_as_float(u << 16); }
__device__ __forceinline__ float bf_hi(unsigned u) { return __uint_as_float(u & 0xffff0000u); }
__device__ __forceinline__ float fast_rcp(float x) { return __builtin_amdgcn_rcpf(x); }
__device__ __forceinline__ float fast_exp2(float x) { return __builtin_amdgcn_exp2f(x); }
__device__ __forceinline__ float sigmoid_f(float x) { return fast_rcp(1.f + fast_exp2(-x * LOG2E)); }
__device__ __forceinline__ float silu_f(float x) { return x * sigmoid_f(x); }
__device__ __forceinline__ float gelu_tanh_f(float x) { const float u = 0.7978845608028654f * (x + 0.044715f * x * x * x); return x * sigmoid_f(2.f * u); }
__device__ __forceinline__ float shfl_xor_l(float v, int mask, int lane) { return __int_as_float(__builtin_amdgcn_ds_bpermute((lane ^ mask) << 2, __float_as_int(v))); }
__device__ __forceinline__ float wave_sum(float v, int lane) {
#pragma unroll
    for (int o = 1; o < 64; o <<= 1) v += shfl_xor_l(v, o, lane);
    return v;
}
namespace pg8 {
#define PG8_LAS __attribute__((address_space(3)))
constexpr int BM = 256, BK = 64, HALF = 128, HTB = HALF * BK * 2  , STAGE_BYTES = 8 * HTB, NXCD = 8, WGM = 4;

__host__ __device__ __forceinline__ int lds_byte(int r, int c) { const int st = (r >> 4) * 2 + (c >> 5), rr = r & 15, cc = c & 31, ob = rr * 64 + cc * 2; return st * 1024 + (ob ^ (((ob >> 9) & 1) << 5)); }
__host__ __device__ __forceinline__ void stage_rc(int b, int& R, int& C) { const int st = b / 1024, sb = b % 1024, swz = sb ^ (((sb >> 9) & 1) << 5); R = (st >> 1) * 16 + swz / 64; C = (st & 1) * 32 + (swz % 64) / 2; }
__host__ __device__ __forceinline__ int perm32(int rho) { const int n = rho >> 4, i = rho & 15; return 8 * (i >> 2) + 4 * n + (i & 3); }

struct Unit { int pm, pn; };
struct Gemm { const bf16_t* A; const bf16_t* Bt; int M, N, K, lda, ldb, wv; };

struct StaticOrder {
    int nM, nN, nwg, G, c;
    int reps = 1;
    __host__ __device__ __forceinline__ void init(int M, int N, int G_, int c_) { nM = M / BM; nN = N / BM; nwg = nM * nN; G = G_; c = c_; }
    __host__ __device__ __forceinline__ bool next(int i, Unit& u) const {
        const long L = (long)(i / reps) * G + c; if (L >= nwg) return false;
        int wgid = (int)L; { const int q = nwg / NXCD, r = nwg % NXCD, xcd = wgid % NXCD, off = wgid / NXCD; wgid = (xcd < r ? xcd * (q + 1) : r * (q + 1) + (xcd - r) * q) + off; }
        const int nig = WGM * nN, gid = wgid / nig, fm = gid * WGM, gsz = (nM - fm) < WGM ? (nM - fm) : WGM;
        u.pm = fm + ((wgid % nig) % gsz); u.pn = (wgid % nig) / gsz; return true;
    }
    __device__ __forceinline__ void a_ready(const Unit&) const {}
    __device__ __forceinline__ void done(const Unit&) const {}
};


template <class Epi, class Sched, bool ALIGN_EPI = false, bool SP2 = false>
__device__ __forceinline__ void gemm_phase(PG8_LAS unsigned char* lds, const Gemm g, const Sched& S, const Epi& E) {
    int wid_ = g.wv; asm volatile("" : "+s"(wid_));
    const int tid = tid_l(wid_), wid = wid_, lane = tid & 63, wr = wid >> 2, wc = wid & 3, fr = lane & 15, fq = lane >> 4;
    const int K = g.K, nt = K / BK;
    unsigned voffA[2], voffB[2];
#pragma unroll
    for (int i = 0; i < 2; ++i) { int R, C; stage_rc(tid * 16 + i * 8192, R, C); const int Rb = Epi::PERM ? ((R & ~31) + perm32(R & 31)) : R;
        voffA[i] = (unsigned)(R * g.lda + C) * 2u; voffB[i] = (unsigned)(Rb * g.ldb + C) * 2u; }
    const size_t kstep = (size_t)(BK * 2);
    const size_t hstepA = (size_t)HALF * g.lda * 2, hstepB = (size_t)HALF * g.ldb * 2;
    const size_t tstepA = 2 * hstepA, tstepB = 2 * hstepB;
    const unsigned ldsw = (unsigned)wid * 1024u;
    const int aoff = lds_byte(wr * 64 + fr, fq * 8), boff = lds_byte(wc * 32 + fr, fq * 8);
#define PG8_SA(b, h) (((b) * 2 + (h)) * HTB)
#define PG8_SB(b, h) ((4 + (b) * 2 + (h)) * HTB)
#define PG8_STAGE(bufoff, gbase, voff) do { _Pragma("unroll") for (int _i = 0; _i < 2; ++_i) \
        __builtin_amdgcn_global_load_lds((const unsigned*)((const char*)(gbase) + (voff)[_i]), (PG8_LAS unsigned*)(lds + (bufoff) + ldsw + _i * 8192), 16, 0, 0); } while (0)
#define PG8_LDA(dst, b, h) do { _Pragma("unroll") for (int m = 0; m < 4; ++m) _Pragma("unroll") for (int k = 0; k < 2; ++k) dst[m][k] = *(const PG8_LAS bf16x8*)(lds + PG8_SA(b, h) + aoff + m * 2048 + k * 1024); } while (0)
#define PG8_LDB(dst, b, h) do { _Pragma("unroll") for (int n = 0; n < 2; ++n) _Pragma("unroll") for (int k = 0; k < 2; ++k) dst[n][k] = *(const PG8_LAS bf16x8*)(lds + PG8_SB(b, h) + boff + n * 2048 + k * 1024); } while (0)
#define PG8_MMA(ai, bj, At, Bt) do { __builtin_amdgcn_s_setprio(1); _Pragma("unroll") for (int m = 0; m < 4; ++m) _Pragma("unroll") for (int n = 0; n < 2; ++n) _Pragma("unroll") for (int k = 0; k < 2; ++k) \
        acc[ai][bj][m][n] = __builtin_amdgcn_mfma_f32_16x16x32_bf16(Bt[n][k], At[m][k], acc[ai][bj][m][n], 0, 0, 0); __builtin_amdgcn_s_setprio(0); } while (0)
#define PG8_WAIT_V(n) asm volatile("s_waitcnt vmcnt(" #n ")" ::: "memory")
#define PG8_WAIT_L(n) asm volatile("s_waitcnt lgkmcnt(" #n ")" ::: "memory")
#define PG8_BAR __builtin_amdgcn_s_barrier()
#define PG8_SCHED __builtin_amdgcn_sched_barrier(0)
    Unit cur, nxt; int ui = 0;
    if (!S.next(0, cur)) return;
    f32x4 acc[2][2][4][2];
#pragma unroll
    for (int a = 0; a < 2; ++a)
#pragma unroll
        for (int b = 0; b < 2; ++b)
#pragma unroll
            for (int m = 0; m < 4; ++m)
#pragma unroll
                for (int n = 0; n < 2; ++n) acc[a][b][m][n] = (f32x4){0.f, 0.f, 0.f, 0.f};
    bf16x8 At[4][2], B0[2][2], B1[2][2];
    const char* cA = (const char*)g.A + (size_t)cur.pm * tstepA; const char* cB = (const char*)g.Bt + (size_t)cur.pn * tstepB;
    S.a_ready(cur);
    if constexpr (SP2) {
        PG8_STAGE(PG8_SB(0, 0), cB, voffB); PG8_STAGE(PG8_SB(0, 1), cB + hstepB, voffB); PG8_STAGE(PG8_SA(0, 0), cA, voffA); PG8_STAGE(PG8_SA(0, 1), cA + hstepA, voffA);
        if (wr == 1) PG8_BAR;
        PG8_WAIT_V(2); PG8_BAR;
        PG8_STAGE(PG8_SB(1, 0), cB + kstep, voffB); PG8_STAGE(PG8_SA(1, 0), cA + kstep, voffA); PG8_STAGE(PG8_SB(1, 1), cB + hstepB + kstep, voffB);
        PG8_WAIT_V(6); PG8_BAR;
    } else {
        PG8_STAGE(PG8_SB(0, 0), cB, voffB); PG8_STAGE(PG8_SA(0, 0), cA, voffA); PG8_STAGE(PG8_SB(0, 1), cB + hstepB, voffB); PG8_STAGE(PG8_SA(0, 1), cA + hstepA, voffA);
        if (wr == 1) PG8_BAR;
        PG8_WAIT_V(4); PG8_BAR;
        PG8_STAGE(PG8_SB(1, 0), cB + kstep, voffB); PG8_STAGE(PG8_SA(1, 0), cA + kstep, voffA); PG8_STAGE(PG8_SB(1, 1), cB + hstepB + kstep, voffB);
        PG8_WAIT_V(6); PG8_BAR;
    }
    for (;;) {
        const bool has_next = S.next(ui + 1, nxt);
        const char* nA = has_next ? (const char*)g.A + (size_t)nxt.pm * tstepA : cA; const char* nB = has_next ? (const char*)g.Bt + (size_t)nxt.pn * tstepB : cB;
        for (int t = 0; t < nt; t += 2) {
            const bool last = (t == nt - 2);
            const char* a1 = cA + (size_t)(t + 1) * kstep;
            const char* a2 = last ? nA : cA + (size_t)(t + 2) * kstep; const char* b2 = last ? nB : cB + (size_t)(t + 2) * kstep;
            const char* a3 = a2 + kstep; const char* b3 = b2 + kstep;
            if (last && has_next) S.a_ready(nxt);
            if constexpr (SP2) {
            PG8_LDB(B0, 0, 0); PG8_LDB(B1, 0, 1); PG8_SCHED; PG8_LDA(At, 0, 0); PG8_STAGE(PG8_SA(1, 1), a1 + hstepA, voffA);
            PG8_WAIT_V(8); PG8_WAIT_L(0); PG8_BAR; PG8_MMA(0, 0, At, B0); PG8_MMA(0, 1, At, B1); PG8_BAR; PG8_SCHED;
            PG8_LDA(At, 0, 1); PG8_STAGE(PG8_SB(0, 0), b2, voffB); PG8_STAGE(PG8_SB(0, 1), b2 + hstepB, voffB); PG8_STAGE(PG8_SA(0, 0), a2, voffA);
            PG8_WAIT_V(8); PG8_WAIT_L(0); PG8_BAR; PG8_MMA(1, 0, At, B0); PG8_MMA(1, 1, At, B1); PG8_BAR; PG8_SCHED;
            PG8_LDB(B0, 1, 0); PG8_LDB(B1, 1, 1); PG8_SCHED; PG8_LDA(At, 1, 0); PG8_STAGE(PG8_SA(0, 1), a2 + hstepA, voffA);
            PG8_WAIT_V(8); PG8_WAIT_L(0); PG8_BAR; PG8_MMA(0, 0, At, B0); PG8_MMA(0, 1, At, B1); PG8_BAR; PG8_SCHED;
            PG8_LDA(At, 1, 1); PG8_STAGE(PG8_SB(1, 0), b3, voffB); PG8_STAGE(PG8_SB(1, 1), b3 + hstepB, voffB); PG8_STAGE(PG8_SA(1, 0), a3, voffA);
            PG8_WAIT_V(8); PG8_WAIT_L(0); PG8_BAR; PG8_MMA(1, 0, At, B0); PG8_MMA(1, 1, At, B1); PG8_BAR; PG8_SCHED;
            } else {
            PG8_LDB(B0, 0, 0); PG8_SCHED; PG8_LDA(At, 0, 0); PG8_STAGE(PG8_SA(1, 1), a1 + hstepA, voffA);
            PG8_WAIT_L(8); PG8_BAR; PG8_WAIT_L(0); PG8_MMA(0, 0, At, B0); PG8_BAR; PG8_SCHED;
            PG8_LDB(B1, 0, 1); PG8_STAGE(PG8_SB(0, 0), b2, voffB);
            PG8_BAR; PG8_WAIT_L(0); PG8_MMA(0, 1, At, B1); PG8_BAR;
            PG8_LDA(At, 0, 1); PG8_STAGE(PG8_SA(0, 0), a2, voffA);
            PG8_BAR; PG8_WAIT_L(0); PG8_MMA(1, 0, At, B0); PG8_BAR; PG8_SCHED;
            PG8_STAGE(PG8_SB(0, 1), b2 + hstepB, voffB);
            PG8_WAIT_V(6); PG8_BAR; PG8_MMA(1, 1, At, B1); PG8_BAR;
            PG8_LDB(B0, 1, 0); PG8_SCHED; PG8_LDA(At, 1, 0); PG8_STAGE(PG8_SA(0, 1), a2 + hstepA, voffA);
            PG8_WAIT_L(8); PG8_BAR; PG8_WAIT_L(0); PG8_MMA(0, 0, At, B0); PG8_BAR; PG8_SCHED;
            PG8_LDB(B1, 1, 1); PG8_STAGE(PG8_SB(1, 0), b3, voffB);
            PG8_BAR; PG8_WAIT_L(0); PG8_MMA(0, 1, At, B1); PG8_BAR;
            PG8_LDA(At, 1, 1); PG8_STAGE(PG8_SA(1, 0), a3, voffA);
            PG8_BAR; PG8_WAIT_L(0); PG8_MMA(1, 0, At, B0); PG8_BAR; PG8_SCHED;
            PG8_STAGE(PG8_SB(1, 1), b3 + hstepB, voffB);
            PG8_WAIT_V(6); PG8_BAR; PG8_MMA(1, 1, At, B1); PG8_BAR;
            }
        }
        if constexpr (ALIGN_EPI) { if (wr == 0) PG8_BAR; }
        if constexpr (!Epi::AFTER_DRAIN) { E(acc, cur, wr, wc, fr, fq); S.done(cur); }
        if (!has_next) break;
#pragma unroll
        for (int a = 0; a < 2; ++a)
#pragma unroll
            for (int b = 0; b < 2; ++b)
#pragma unroll
                for (int m = 0; m < 4; ++m)
#pragma unroll
                    for (int n = 0; n < 2; ++n) acc[a][b][m][n] = (f32x4){0.f, 0.f, 0.f, 0.f};
        cur = nxt; cA = nA; cB = nB; ++ui;
        if constexpr (ALIGN_EPI) { if (wr == 1) PG8_BAR; }
    }
    PG8_WAIT_V(0);
    if constexpr (!ALIGN_EPI) { if (wr == 0) PG8_BAR; }
    PG8_BAR;
    if constexpr (Epi::AFTER_DRAIN) { E.fused(acc, cur, wr, wc, fr, fq, lds, wid, lane); S.done(cur); }
#undef PG8_SA
#undef PG8_SB
#undef PG8_STAGE
#undef PG8_LDA
#undef PG8_LDB
#undef PG8_MMA
#undef PG8_WAIT_V
#undef PG8_WAIT_L
#undef PG8_BAR
#undef PG8_SCHED
}
}

namespace pg8 {
struct OneUnit {
    __device__ __forceinline__ bool next(int i, Unit& u) const { if (i) return false; u.pm = 0; u.pn = 0; return true; }
    __device__ __forceinline__ void a_ready(const Unit&) const {}
    __device__ __forceinline__ void done(const Unit&) const {}
};
typedef f32x4 AccT[2][2][4][2];

struct EpiQKV {
    static constexpr bool PERM = true, AFTER_DRAIN = false;
    bf16_t* Q; float* newk; float qscale;
    __device__ __forceinline__ void operator()(const AccT& acc, const Unit& u, int wr, int wc, int fr, int fq) const {
        const int t = u.pn >> 2;
        bf16_t* base = Q + (size_t)t * MT * D;
        const float sc = t == 0 ? qscale : 1.f;
        float* fo = newk + (size_t)(t - 1) * MC * D;
        const bool wf = (t != 0) && (u.pm < MC / 256);
        const int colt = (u.pn & 3) * 256 + wc * 32 + 8 * fq, row0 = u.pm * 256 + wr * 64 + fr;
#pragma unroll
        for (int ai = 0; ai < 2; ++ai)
#pragma unroll
            for (int m = 0; m < 4; ++m) {
                const size_t ro = (size_t)(row0 + ai * 128 + m * 16) * D;
#pragma unroll
                for (int bj = 0; bj < 2; ++bj) {
                    const f32x4 v0 = acc[ai][bj][m][0] * sc, v1 = acc[ai][bj][m][1] * sc;
                    u32x4 w; w.x = pk_bf16(v0[0], v0[1]); w.y = pk_bf16(v0[2], v0[3]); w.z = pk_bf16(v1[0], v1[1]); w.w = pk_bf16(v1[2], v1[3]);
                    *(u32x4*)(base + ro + colt + bj * 128) = w;
                    if (wf) { *(f32x4*)(fo + ro + colt + bj * 128) = v0; *(f32x4*)(fo + ro + colt + bj * 128 + 4) = v1; }
                }
            }
    }
};
template <bool FUSE, bool SRCF32> struct EpiResT {
    static constexpr bool PERM = true, AFTER_DRAIN = false;
    const float *xa, *xb;
    bf16_t* xres;
    const float* gate;
    bf16_t* XNo; const float* gn; const float* scv; float* ssq;
    __device__ __forceinline__ void operator()(const AccT& acc, const Unit& u, int wr, int wc, int fr, int fq) const {
        const bool isc = u.pm < MC / 256;
        const int cv = isc ? 8 : ((u.pm - MC / 256) >> 2);
        const float* src = isc ? xa : xb - (size_t)MC * D;
        const int col0 = u.pn * 256 + wc * 32 + 8 * fq, row0 = u.pm * 256 + wr * 64 + fr;
        f32x4 gv[2][2], gm[2][2];
#pragma unroll
        for (int bj = 0; bj < 2; ++bj)
#pragma unroll
            for (int n = 0; n < 2; ++n) {
                const int c = col0 + bj * 128 + n * 4;
                gv[bj][n] = *(const f32x4*)(gate + (size_t)cv * NMOD + c);
                if (FUSE) gm[bj][n] = *(const f32x4*)(gn + c) * (*(const f32x4*)(scv + (size_t)cv * NMOD + c) + 1.f);
            }
#pragma unroll
        for (int ai = 0; ai < 2; ++ai)
#pragma unroll
        for (int mp = 0; mp < 2; ++mp) {
            f32x4 xs[2][2][2];
#pragma unroll
            for (int mm = 0; mm < 2; ++mm)
#pragma unroll
                for (int bj = 0; bj < 2; ++bj) {
                    const size_t o = (size_t)(row0 + ai * 128 + (2 * mp + mm) * 16) * D + col0 + bj * 128;
                    if (SRCF32) { xs[mm][bj][0] = *(const f32x4*)(src + o); xs[mm][bj][1] = *(const f32x4*)(src + o + 4); }
                    else { const u32x4 w = *(const u32x4*)(xres + o); xs[mm][bj][0] = (f32x4){bf_lo(w.x), bf_hi(w.x), bf_lo(w.y), bf_hi(w.y)}; xs[mm][bj][1] = (f32x4){bf_lo(w.z), bf_hi(w.z), bf_lo(w.w), bf_hi(w.w)}; }
                }
            asm volatile("" ::: "memory");
#pragma unroll
            for (int mm = 0; mm < 2; ++mm) {
                const int m = 2 * mp + mm;
                const int row = row0 + ai * 128 + m * 16;
                const size_t ro = (size_t)row * D + col0;
                float sq = 0.f;
#pragma unroll
                for (int bj = 0; bj < 2; ++bj) {
                    const f32x4 x0 = xs[mm][bj][0] + gv[bj][0] * acc[ai][bj][m][0], x1 = xs[mm][bj][1] + gv[bj][1] * acc[ai][bj][m][1];
                    { u32x4 w; w.x = pk_bf16(x0[0], x0[1]); w.y = pk_bf16(x0[2], x0[3]); w.z = pk_bf16(x1[0], x1[1]); w.w = pk_bf16(x1[2], x1[3]); *(u32x4*)(xres + ro + bj * 128) = w; }
                    if (FUSE) {
                        sq += ((x0[0] * x0[0] + x0[1] * x0[1]) + (x0[2] * x0[2] + x0[3] * x0[3])) + ((x1[0] * x1[0] + x1[1] * x1[1]) + (x1[2] * x1[2] + x1[3] * x1[3]));
                        const f32x4 y0 = x0 * gm[bj][0], y1 = x1 * gm[bj][1];
                        u32x4 w; w.x = pk_bf16(y0[0], y0[1]); w.y = pk_bf16(y0[2], y0[3]); w.z = pk_bf16(y1[0], y1[1]); w.w = pk_bf16(y1[2], y1[3]);
                        *(u32x4*)(XNo + ro + bj * 128) = w;
                    }
                }
                if (FUSE) { sq += shfl_xor_l(sq, 16, fr + 16 * fq); sq += shfl_xor_l(sq, 32, fr + 16 * fq); if (fq == 0) unsafeAtomicAdd(ssq + row, sq); }
            }
            asm volatile("" ::: "memory");
        }
    }
};
struct EpiResFinal {
    static constexpr bool PERM = true, AFTER_DRAIN = false;
    const bf16_t* xres; const float* gate; float* ssq; unsigned* cnt; const float* gfin; float* out;
    __device__ __forceinline__ void operator()(const AccT& acc_c, const Unit& u, int wr, int wc, int fr, int fq) const {
        AccT& acc = const_cast<AccT&>(acc_c);
        const int cv = u.pm < MC / 256 ? 8 : ((u.pm - MC / 256) >> 2);
        const int col0 = u.pn * 256 + wc * 32 + 8 * fq, row0 = u.pm * 256 + wr * 64 + fr, lane = fr + 16 * fq;
        f32x4 gv[2][2];
#pragma unroll
        for (int bj = 0; bj < 2; ++bj)
#pragma unroll
            for (int n = 0; n < 2; ++n) gv[bj][n] = *(const f32x4*)(gate + (size_t)cv * NMOD + col0 + bj * 128 + n * 4);
#pragma unroll
        for (int ai = 0; ai < 2; ++ai)
#pragma unroll
        for (int mp = 0; mp < 2; ++mp) {
            u32x4 xs[2][2];
#pragma unroll
            for (int mm = 0; mm < 2; ++mm)
#pragma unroll
                for (int bj = 0; bj < 2; ++bj) xs[mm][bj] = *(const u32x4*)(xres + (size_t)(row0 + ai * 128 + (2 * mp + mm) * 16) * D + col0 + bj * 128);
            asm volatile("" ::: "memory");
#pragma unroll
            for (int mm = 0; mm < 2; ++mm) {
                const int m = 2 * mp + mm;
                float sq = 0.f;
#pragma unroll
                for (int bj = 0; bj < 2; ++bj) {
                    const u32x4 w = xs[mm][bj];
                    const f32x4 x0 = (f32x4){bf_lo(w.x), bf_hi(w.x), bf_lo(w.y), bf_hi(w.y)} + gv[bj][0] * acc[ai][bj][m][0], x1 = (f32x4){bf_lo(w.z), bf_hi(w.z), bf_lo(w.w), bf_hi(w.w)} + gv[bj][1] * acc[ai][bj][m][1];
                    acc[ai][bj][m][0] = x0; acc[ai][bj][m][1] = x1;
                    sq += ((x0[0] * x0[0] + x0[1] * x0[1]) + (x0[2] * x0[2] + x0[3] * x0[3])) + ((x1[0] * x1[0] + x1[1] * x1[1]) + (x1[2] * x1[2] + x1[3] * x1[3]));
                }
                sq += shfl_xor_l(sq, 16, lane); sq += shfl_xor_l(sq, 32, lane);
                if (fq == 0) unsafeAtomicAdd(ssq + row0 + ai * 128 + m * 16, sq);
            }
        }
        asm volatile("s_waitcnt vmcnt(0)" ::: "memory");
        unsigned* c = cnt + 64 * u.pm;
        if (lane == 0) __hip_atomic_fetch_add(c, 1u, __ATOMIC_RELAXED, __HIP_MEMORY_SCOPE_AGENT);
        { unsigned sp = 0;
          while ((unsigned)__builtin_amdgcn_readfirstlane(__hip_atomic_load(c, __ATOMIC_RELAXED, __HIP_MEMORY_SCOPE_AGENT)) < 32u) { __builtin_amdgcn_s_sleep(2); if (++sp > (1u << 20)) break; } }
        float rs[2][4];
#pragma unroll
        for (int ai = 0; ai < 2; ++ai)
#pragma unroll
            for (int m = 0; m < 4; ++m) rs[ai][m] = __hip_atomic_load(ssq + row0 + ai * 128 + m * 16, __ATOMIC_RELAXED, __HIP_MEMORY_SCOPE_AGENT);
        f32x4 gf[2][2];
#pragma unroll
        for (int bj = 0; bj < 2; ++bj)
#pragma unroll
            for (int n = 0; n < 2; ++n) gf[bj][n] = *(const f32x4*)(gfin + col0 + bj * 128 + n * 4);
#pragma unroll
        for (int ai = 0; ai < 2; ++ai)
#pragma unroll
            for (int m = 0; m < 4; ++m) {
                const float rstd = __builtin_amdgcn_rsqf(rs[ai][m] * (1.f / D) + RMS_EPS);
                float* op = out + (size_t)(row0 + ai * 128 + m * 16) * D + col0;
#pragma unroll
                for (int bj = 0; bj < 2; ++bj) { *(f32x4*)(op + bj * 128) = acc[ai][bj][m][0] * rstd * gf[bj][0]; *(f32x4*)(op + bj * 128 + 4) = acc[ai][bj][m][1] * rstd * gf[bj][1]; }
            }
    }
};
struct EpiSwiglu {
    static constexpr bool PERM = true, AFTER_DRAIN = false;
    bf16_t* H; const float* ssq; const float* shw;
    __device__ __forceinline__ void operator()(const AccT& acc, const Unit& u, int wr, int wc, int fr, int fq) const {
        const int cv = u.pm < MC / 256 ? 8 : ((u.pm - MC / 256) >> 2);
        const int col0 = u.pn * 128 + wc * 32 + 8 * fq, row0 = u.pm * 256 + wr * 64 + fr;
        const float* sp = shw + (size_t)cv * 2 * FF + u.pn * 256 + wc * 32 + 8 * fq;
        const f32x4 sg0 = *(const f32x4*)(sp), sg1 = *(const f32x4*)(sp + 4), su0 = *(const f32x4*)(sp + 128), su1 = *(const f32x4*)(sp + 132);
        float rs[2][4];
#pragma unroll
        for (int ai = 0; ai < 2; ++ai)
#pragma unroll
            for (int m = 0; m < 4; ++m) rs[ai][m] = ssq[row0 + ai * 128 + m * 16];
        asm volatile("" ::: "memory");
#pragma unroll
        for (int ai = 0; ai < 2; ++ai)
#pragma unroll
            for (int m = 0; m < 4; ++m) rs[ai][m] = __builtin_amdgcn_rsqf(rs[ai][m] * (1.f / D) + RMS_EPS);
#pragma unroll
        for (int ai = 0; ai < 2; ++ai)
#pragma unroll
            for (int m = 0; m < 4; ++m) {
                const int row = row0 + ai * 128 + m * 16;
                const float rstd = rs[ai][m];
                float o[8];
#pragma unroll
                for (int n = 0; n < 2; ++n) {
                    const f32x4 gq = acc[ai][0][m][n] * rstd + (n ? sg1 : sg0), uq = acc[ai][1][m][n] * rstd + (n ? su1 : su0);
#pragma unroll
                    for (int j = 0; j < 4; ++j) o[n * 4 + j] = silu_f(gq[j]) * uq[j];
                }
                u32x4 w; w.x = pk_bf16(o[0], o[1]); w.y = pk_bf16(o[2], o[3]); w.z = pk_bf16(o[4], o[5]); w.w = pk_bf16(o[6], o[7]);
                *(u32x4*)(H + (size_t)row * FF + col0) = w;
            }
    }
};
struct EpiWin {
    static constexpr bool PERM = true, AFTER_DRAIN = false;
    bf16_t *G, *XR; const float* ssq; const float* shw;
    __device__ __forceinline__ void operator()(const AccT& acc, const Unit& u, int wr, int wc, int fr, int fq) const {
        const bool isg = u.pn < 4;
        const int cv = u.pm < MC / 256 ? 8 : ((u.pm - MC / 256) >> 2);
        bf16_t* base = isg ? G : XR;
        const int colt = (u.pn & 3) * 256 + wc * 32 + 8 * fq, row0 = u.pm * 256 + wr * 64 + fr;
        const float* sp = shw + (size_t)cv * 2 * D + u.pn * 256 + wc * 32 + 8 * fq;
        f32x4 sv[2][2];
#pragma unroll
        for (int bj = 0; bj < 2; ++bj) { sv[bj][0] = *(const f32x4*)(sp + bj * 128); sv[bj][1] = *(const f32x4*)(sp + bj * 128 + 4); }
        float rs[2][4];
#pragma unroll
        for (int ai = 0; ai < 2; ++ai)
#pragma unroll
            for (int m = 0; m < 4; ++m) rs[ai][m] = ssq[row0 + ai * 128 + m * 16];
        asm volatile("" ::: "memory");
#pragma unroll
        for (int ai = 0; ai < 2; ++ai)
#pragma unroll
            for (int m = 0; m < 4; ++m) rs[ai][m] = __builtin_amdgcn_rsqf(rs[ai][m] * (1.f / D) + RMS_EPS);
#pragma unroll
        for (int ai = 0; ai < 2; ++ai)
#pragma unroll
            for (int m = 0; m < 4; ++m) {
                const int row = row0 + ai * 128 + m * 16;
                const float rstd = rs[ai][m];
#pragma unroll
                for (int bj = 0; bj < 2; ++bj) {
                    f32x4 v0 = acc[ai][bj][m][0] * rstd + sv[bj][0], v1 = acc[ai][bj][m][1] * rstd + sv[bj][1];
                    if (isg) {
#pragma unroll
                        for (int j = 0; j < 4; ++j) { v0[j] = gelu_tanh_f(v0[j]); v1[j] = gelu_tanh_f(v1[j]); }
                    }
                    u32x4 w; w.x = pk_bf16(v0[0], v0[1]); w.y = pk_bf16(v0[2], v0[3]); w.z = pk_bf16(v1[0], v1[1]); w.w = pk_bf16(v1[2], v1[3]);
                    *(u32x4*)(base + (size_t)row * D + colt + bj * 128) = w;
                }
            }
    }
};
struct EpiLru {
    static constexpr bool PERM = true, AFTER_DRAIN = true;
    LAS const unsigned long long* ptab;
    const float* h0;
    int row_base, cb, dir, q;

    template <int AI>
    __device__ __forceinline__ void half(const AccT& acc, int wr, int wc, int fr, int fq, PG8_LAS unsigned char* lds, int tid,
                                         const u32x4 (&xall)[4], bf16_t* HL, bf16_t* PP) const {
#pragma unroll
        for (int m = 0; m < 4; ++m) {
            const int tl = wr * 64 + m * 16 + fr;
            const size_t row = (size_t)(row_base + AI * 128 + tl);
#pragma unroll
            for (int n = 0; n < 2; ++n) {
                asm volatile("" ::: "memory");
                const int chl = wc * 32 + 8 * fq + 4 * n;
                const PG8_LAS f32x4* cst = (const PG8_LAS f32x4*)(lds + CST_OFF + chl * 4);
                const f32x4 ba = cst[0], bi = cst[32], L2 = cst[64];
                u32x2 xw; xw.x = n ? xall[m].z : xall[m].x; xw.y = n ? xall[m].w : xall[m].y;
                const f32x4 xc = {bf_lo(xw.x), bf_hi(xw.x), bf_lo(xw.y), bf_hi(xw.y)};
                f32x4 av, bv;
#pragma unroll
                for (int j = 0; j < 4; ++j) {
                    const float za = acc[AI][0][m][n][j] + ba[j], zi = acc[AI][1][m][n][j] + bi[j];
                    const float r = sigmoid_f(za), ig = sigmoid_f(zi);
                    const float a = fast_exp2(r * L2[j]);
                    av[j] = a; bv[j] = __builtin_amdgcn_sqrtf(1.f - a * a) * (ig * xc[j]);
                }
                PG8_LAS f32x4* dst = (PG8_LAS f32x4*)(lds + tl * AB_PITCH + chl * 8);
                dst[0] = (f32x4){av[0], bv[0], av[1], bv[1]}; dst[1] = (f32x4){av[2], bv[2], av[3], bv[3]};
            }
        }
        __syncthreads();
        if (tid < 128) {
            PG8_LAS float* hst = (PG8_LAS float*)(lds + HST_OFF);
            float h = hst[tid], P = hst[128 + tid];
            PG8_LAS f32x2* col = (PG8_LAS f32x2*)(lds + tid * 8);
            if (dir == 0) {
#pragma unroll 8
                for (int t = 0; t < 128; ++t) { PG8_LAS f32x2* p = (PG8_LAS f32x2*)((PG8_LAS unsigned char*)col + t * AB_PITCH); const f32x2 ab = *p; h = ab.x * h + ab.y; P *= ab.x; *p = (f32x2){h, P}; }
            } else {
#pragma unroll 8
                for (int t = 127; t >= 0; --t) { PG8_LAS f32x2* p = (PG8_LAS f32x2*)((PG8_LAS unsigned char*)col + t * AB_PITCH); const f32x2 ab = *p; h = ab.x * h + ab.y; P *= ab.x; *p = (f32x2){h, P}; }
            }
            hst[tid] = h; hst[128 + tid] = P;
        }
        __syncthreads();
        const bool lat = row_base >= MC;
#pragma unroll
        for (int it = 0; it < 8; ++it) {
            const int idx = it * 512 + tid, tl = idx >> 5, c4 = (idx & 31) * 4;
            const PG8_LAS f32x4* src = (const PG8_LAS f32x4*)(lds + tl * AB_PITCH + c4 * 8);
            const f32x4 s0 = src[0], s1 = src[1];
            const size_t row = (size_t)(row_base + AI * 128 + tl);
            { u32x2 wh; wh.x = pk_bf16(s0[0], s0[2]); wh.y = pk_bf16(s1[0], s1[2]); *(u32x2*)(HL + row * D + cb + c4) = wh; }
            if (lat) { u32x2 w; w.x = pk_bf16(s0[1], s0[3]); w.y = pk_bf16(s1[1], s1[3]); *(u32x2*)(PP + (row - MC) * D + cb + c4) = w; }
        }
        __syncthreads();
    }
    __device__ __forceinline__ void fused(AccT& acc, const Unit&, int wr, int wc, int fr, int fq, PG8_LAS unsigned char* lds, int wid, int lane) const {
        const int tid = wid * 64 + lane;
        const PT pt{ptab};
        unsigned char* ws = pt.ws();
        PG8_LAS float* hst = (PG8_LAS float*)(lds + HST_OFF);
        PG8_LAS float* cst = (PG8_LAS float*)(lds + CST_OFF);
        if (tid < 128) {
            hst[tid] = h0 ? h0[cb + tid] : 0.f; hst[128 + tid] = 1.f;
            const int ch = dir * D + cb + tid;
            cst[tid] = pt.f(I_b_a)[ch]; cst[128 + tid] = pt.f(I_b_i)[ch];
            const float l = pt.f(I_lam)[ch];
            const float x = __expf(-l);
            const float sp = x < 0.03f ? x * (1.f - x * (0.5f - x * (0.33333334f - 0.25f * x))) : __logf(1.f + x);
            cst[256 + tid] = -8.0f * sp * LOG2E;
        }
        __syncthreads();
        const bf16_t* XC = (const bf16_t*)(ws + WS_XN);
        bf16_t* HL = (bf16_t*)(ws + (dir ? WS_HLB : WS_HLF));
        bf16_t* PP = (bf16_t*)(ws + (dir ? WS_PB : WS_PF));
        u32x4 xc0[4], xc1[4];
#pragma unroll
        for (int m = 0; m < 4; ++m) {
            xc0[m] = *(const u32x4*)(XC + (size_t)(row_base + wr * 64 + m * 16 + fr) * D + cb + wc * 32 + 8 * fq);
            xc1[m] = *(const u32x4*)(XC + (size_t)(row_base + 128 + wr * 64 + m * 16 + fr) * D + cb + wc * 32 + 8 * fq);
        }
        if (dir == 0) { half<0>(acc, wr, wc, fr, fq, lds, tid, xc0, HL, PP); half<1>(acc, wr, wc, fr, fq, lds, tid, xc1, HL, PP); }
        else          { half<1>(acc, wr, wc, fr, fq, lds, tid, xc1, HL, PP); half<0>(acc, wr, wc, fr, fq, lds, tid, xc0, HL, PP); }
        if (tid < 128) {
            const float h = hst[tid], P = hst[128 + tid];
            float* sumE = (float*)(ws + WS_SUME) + (size_t)dir * 48 * D; float* sumP = (float*)(ws + WS_SUMP) + (size_t)dir * 48 * D;
            sumE[(size_t)q * D + cb + tid] = h; sumP[(size_t)q * D + cb + tid] = P;
            if (row_base < MC) pt.out()[OUT_NH + (size_t)q * 2 * D + dir * D + cb + tid] = h;
        }
        __syncthreads();
    }
};
}
namespace att {
constexpr int KP = 144, VP = 136;
constexpr int K_OFF = 0, V_OFF = 2 * 64 * KP, F_OFF = V_OFF + 2 * 64 * KP, T_OFF = F_OFF + 8 * 32 * 4, A_END = T_OFF + 640 * 4;
typedef short v4i16_t __attribute__((ext_vector_type(4)));
#define MFMA32(a, b, c) __builtin_amdgcn_mfma_f32_32x32x16_bf16((a), (b), (c), 0, 0, 0)
__device__ __forceinline__ float max2f(float a, float b) { float r; asm("v_max_f32_e32 %0, %1, %2" : "=v"(r) : "v"(a), "v"(b)); return r; }
__device__ __forceinline__ float max3f(float a, float b, float c) { float r; asm("v_max3_f32 %0, %1, %2, %3" : "=v"(r) : "v"(a), "v"(b), "v"(c)); return r; }
__device__ __forceinline__ int crow(int r, int hi) { return (r & 3) + 8 * (r >> 2) + 4 * hi; }

template <bool NA>
__device__ __forceinline__ void unit(int wv, LAS unsigned char* lds, int b, int h, int g, const bf16_t* __restrict__ Qb, const bf16_t* __restrict__ Kb, const bf16_t* __restrict__ Vb,
                                     const bf16_t* __restrict__ CK, const bf16_t* __restrict__ CV, bf16_t* __restrict__ Ob, const float* __restrict__ rpb) {
    int wid_ = wv; asm volatile("" : "+s"(wid_));
    const int tid = tid_l(wid_), lane = tid & 63, wid = wid_, r32 = lane & 31, hi = lane >> 5;
    LAS float* fscr = (LAS float*)(lds + F_OFF) + wid * 32;
    LAS float* tab = (LAS float*)(lds + T_OFF);
    if (NA) { for (int i = tid; i < 15 * 31; i += 512) { const int dr = i / 31, dc = i % 31; tab[64 + dr * 32 + dc] = rpb[(h * 15 + dr) * 31 + dc] * LOG2E; } }
    int qrow, nlat, ntile, Rlo = 0, rq = 0, rs = 0;
    if (NA) {
        rq = 4 * g + (wid >> 1); rs = min(max(rq - 4, 0), 8);
        qrow = MC + b * 1024 + rq * 64 + 32 * (wid & 1) + r32;
        Rlo = min(max(4 * g - 4, 0), 8); const int Rhi = min(max(4 * g - 1, 0), 8) + 8;
        nlat = Rhi - Rlo; ntile = nlat + 8;
    } else { qrow = b * 256 + 32 * wid + r32; nlat = 4; ntile = 4; }
    const int qc = 32 * (wid & 1) + r32, cs = min(max(qc - 8, 0), 48);
    f32x16 pen0, pen1;
#pragma unroll
    for (int i = 0; i < 16; ++i) { const int kc = (i & 3) + 8 * (i >> 2) + 4 * hi - cs; pen0[i] = (NA && (unsigned)kc >= 16u) ? -1e30f : 0.f; pen1[i] = (NA && (unsigned)(kc + 32) >= 16u) ? -1e30f : 0.f; }
    bf16x8 qr[4];
#pragma unroll
    for (int s = 0; s < 4; ++s) qr[s] = *(const bf16x8*)(Qb + (size_t)qrow * D + h * 64 + 16 * s + 8 * hi);
    const int lkey = tid >> 3, lch = tid & 7;
    auto src_row = [&](int t) -> size_t {
        if (NA) return t < nlat ? (size_t)(MC + b * 1024 + (Rlo + t) * 64) : (size_t)(b * 512 + (t - nlat) * 64);
        return (size_t)(b * 256 + t * 64);
    };
    u32x4 kreg, vreg;
    auto gload = [&](int t) {
        const bool cache = NA && t >= nlat;
        const bf16_t* kp = cache ? CK : Kb; const bf16_t* vp = cache ? CV : Vb;
        const size_t off = (src_row(t) + lkey) * D + h * 64 + 8 * lch;
        kreg = *(const u32x4*)(kp + off); vreg = *(const u32x4*)(vp + off);
    };
    auto lstore = [&](int buf) {
        *(LAS u32x4*)(lds + K_OFF + buf * 64 * KP + lkey * KP + lch * 16) = kreg;
        *(LAS u32x4*)(lds + V_OFF + buf * 64 * KP + lkey * KP + lch * 16) = vreg;
    };
    float m_run = -1e30f, l_run = 0.f;
    f32x16 o0, o1;
#pragma unroll
    for (int i = 0; i < 16; ++i) { o0[i] = 0.f; o1[i] = 0.f; }
    gload(0); lstore(0);
    asm volatile("" :: "v"(qr[0]), "v"(qr[1]), "v"(qr[2]), "v"(qr[3]));
    __syncthreads();
    for (int t = 0; t < ntile; ++t) {
        const int buf = t & 1;
        if (t + 1 < ntile) gload(t + 1);
        bool active = true, biased = false; int dr = 0;
        if (NA && t < nlat) { const int R = Rlo + t; active = (R >= rs) && (R < rs + 8); biased = true; dr = R - rq + 7; }
        if (active) {
            f32x16 p0, p1;
#pragma unroll
            for (int i = 0; i < 16; ++i) { p0[i] = 0.f; p1[i] = 0.f; }
            const LAS unsigned char* kb = lds + K_OFF + buf * 64 * KP + r32 * KP + 16 * hi;
#pragma unroll
            for (int s = 0; s < 4; ++s) {
                const bf16x8 k0 = *(const LAS bf16x8*)(kb + 32 * s), k1 = *(const LAS bf16x8*)(kb + 32 * KP + 32 * s);
                p0 = MFMA32(k0, qr[s], p0); p1 = MFMA32(k1, qr[s], p1);
            }
            if (biased) {
                const LAS float* tb = tab + 64 + dr * 32 + (4 * hi - qc + 15);
                f32x16 b0, b1;
#pragma unroll
                for (int i = 0; i < 16; ++i) { const int kc = (i & 3) + 8 * (i >> 2); b0[i] = tb[kc]; b1[i] = tb[kc + 32]; }
                p0 += b0; p1 += b1; p0 += pen0; p1 += pen1;
            }
            float mxa = max3f(p0[0], p0[1], p0[2]), mxb = max3f(p0[3], p0[4], p0[5]), mxc = max3f(p1[0], p1[1], p1[2]), mxd = max3f(p1[3], p1[4], p1[5]);
            mxa = max3f(mxa, p0[6], p0[7]); mxb = max3f(mxb, p0[8], p0[9]); mxc = max3f(mxc, p1[6], p1[7]); mxd = max3f(mxd, p1[8], p1[9]);
            mxa = max3f(mxa, p0[10], p0[11]); mxb = max3f(mxb, p0[12], p0[13]); mxc = max3f(mxc, p1[10], p1[11]); mxd = max3f(mxd, p1[12], p1[13]);
            mxa = max3f(mxa, p0[14], p0[15]); mxc = max3f(mxc, p1[14], p1[15]);
            float mx = max2f(max2f(mxa, mxb), max2f(mxc, mxd));
            mx = max2f(mx, shfl_xor_l(mx, 32, lane));
            const float mnew = max2f(m_run, mx);
            const float f = fast_exp2(m_run - mnew);
            m_run = mnew;
            p0 -= mnew; p1 -= mnew;
#pragma unroll
            for (int i = 0; i < 16; ++i) { p0[i] = fast_exp2(p0[i]); p1[i] = fast_exp2(p1[i]); }
            f32x4 ls4 = {0.f, 0.f, 0.f, 0.f};
#pragma unroll
            for (int i = 0; i < 16; i += 4) ls4 += (f32x4){p0[i], p0[i + 1], p0[i + 2], p0[i + 3]} + (f32x4){p1[i], p1[i + 1], p1[i + 2], p1[i + 3]};
            const float ls = (ls4[0] + ls4[1]) + (ls4[2] + ls4[3]);
            l_run = l_run * f + ls;
            if (__any(f != 1.f)) {
                if (hi == 0) fscr[r32] = f;
                asm volatile("s_waitcnt lgkmcnt(0)" ::: "memory");
#pragma unroll
                for (int i = 0; i < 16; ++i) { const float fi = fscr[crow(i, hi)]; o0[i] *= fi; o1[i] *= fi; }
                asm volatile("s_waitcnt lgkmcnt(0)" ::: "memory");
            }
            bf16x8 pa[2][2];
#pragma unroll
            for (int s = 0; s < 2; ++s) {
                u32x4 w0, w1;
                w0.x = pk_bf16(p0[8 * s + 0], p0[8 * s + 1]); w0.y = pk_bf16(p0[8 * s + 2], p0[8 * s + 3]); w0.z = pk_bf16(p0[8 * s + 4], p0[8 * s + 5]); w0.w = pk_bf16(p0[8 * s + 6], p0[8 * s + 7]);
                w1.x = pk_bf16(p1[8 * s + 0], p1[8 * s + 1]); w1.y = pk_bf16(p1[8 * s + 2], p1[8 * s + 3]); w1.z = pk_bf16(p1[8 * s + 4], p1[8 * s + 5]); w1.w = pk_bf16(p1[8 * s + 6], p1[8 * s + 7]);
                pa[0][s] = __builtin_bit_cast(bf16x8, w0); pa[1][s] = __builtin_bit_cast(bf16x8, w1);
            }
            const int i16 = lane & 15, g16 = (lane >> 4) & 1;
            const LAS unsigned char* vb = lds + V_OFF + buf * 64 * KP + (4 * hi + (i16 >> 2)) * KP + (16 * g16 + 4 * (i16 & 3)) * 2;
#pragma unroll
            for (int blk = 0; blk < 2; ++blk)
#pragma unroll
                for (int s = 0; s < 2; ++s) {
                    const int ko = (32 * blk + 16 * s) * KP;
                    const s16x4 a0 = __builtin_bit_cast(s16x4, __builtin_amdgcn_ds_read_tr16_b64_v4i16((LAS v4i16_t*)(vb + ko))), a1 = __builtin_bit_cast(s16x4, __builtin_amdgcn_ds_read_tr16_b64_v4i16((LAS v4i16_t*)(vb + ko + 8 * KP)));
                    const s16x4 c0 = __builtin_bit_cast(s16x4, __builtin_amdgcn_ds_read_tr16_b64_v4i16((LAS v4i16_t*)(vb + ko + 64))), c1 = __builtin_bit_cast(s16x4, __builtin_amdgcn_ds_read_tr16_b64_v4i16((LAS v4i16_t*)(vb + ko + 8 * KP + 64)));
                    const bf16x8 v0 = __builtin_shufflevector(a0, a1, 0, 1, 2, 3, 4, 5, 6, 7), v1 = __builtin_shufflevector(c0, c1, 0, 1, 2, 3, 4, 5, 6, 7);
                    o0 = MFMA32(pa[blk][s], v0, o0); o1 = MFMA32(pa[blk][s], v1, o1);
                }
        }
        if (t + 1 < ntile) lstore(buf ^ 1);
        __syncthreads();
    }
    l_run += shfl_xor_l(l_run, 32, lane);
    if (hi == 0) fscr[r32] = fast_rcp(l_run);
    asm volatile("s_waitcnt lgkmcnt(0)" ::: "memory");
    const int qbase = qrow - r32;
    LAS unsigned char* stg = lds + K_OFF + wid * (32 * KP);
#pragma unroll
    for (int i = 0; i < 16; ++i) {
        const int qi = crow(i, hi); const float li = fscr[qi];
        LAS unsigned short* sp = (LAS unsigned short*)(stg + qi * KP + r32 * 2);
        sp[0] = (unsigned short)(pk_bf16(o0[i] * li, 0.f) & 0xffff); sp[32] = (unsigned short)(pk_bf16(o1[i] * li, 0.f) & 0xffff);
    }
    asm volatile("s_waitcnt lgkmcnt(0)" ::: "memory");
    {
        const int row = lane >> 1, half = lane & 1;
        bf16_t* op = Ob + (size_t)(qbase + row) * D + h * 64 + half * 32;
#pragma unroll
        for (int j = 0; j < 4; ++j) *(u32x4*)(op + 8 * j) = *(const LAS u32x4*)(stg + row * KP + half * 64 + 16 * j);
    }
    __syncthreads();
}
}
#ifndef REP_P4
#define REP_P4 1
#endif
#ifndef REP_ADA
#define REP_ADA 1
#endif
#ifndef REP_PRO
#define REP_PRO 1
#endif
#ifndef REP_FILL
#define REP_FILL 1
#endif
#ifndef REP_ATT
#define REP_ATT 1
#endif
#ifndef REP_GEMM
#define REP_GEMM 1
#endif
#ifndef REP_THIN
#define REP_THIN 1
#endif
#ifndef REP_LRU
#define REP_LRU 1
#endif
#ifndef REP_SYNC
#define REP_SYNC 1
#endif
struct Args {
    const float *x_prompt, *x_sample, *c, *cache_k, *cache_v, *state_h, *c_ctx, *norm_g, *w_mod, *b_mod, *w_qkv, *w_o, *rpb, *w_in, *conv_w, *conv_b,
                *w_a, *b_a, *w_i, *b_i, *lam, *w_out, *w_gu, *w_down, *final_g;
    float* out; unsigned char* ws;
};

__device__ __forceinline__ void tr_item(const float* __restrict__ W, int ldw, int k0, int n0, bf16_t* __restrict__ dst, int ldd, LAS float* scr, int lane) {
    float tv[32];
#pragma unroll
    for (int i = 0; i < 32; ++i) { const int kk = 2 * i + (lane >> 5); tv[i] = W[(size_t)(k0 + kk) * ldw + n0 + (lane & 31)]; }
#pragma unroll
    for (int i = 0; i < 32; ++i) { const int kk = 2 * i + (lane >> 5); scr[kk * 33 + (lane & 31)] = tv[i]; }
    asm volatile("s_waitcnt lgkmcnt(0)" ::: "memory");
    const int c = lane & 7;
#pragma unroll
    for (int j = 0; j < 4; ++j) {
        const int n = (lane >> 3) + 8 * j; const LAS float* s = scr + (8 * c) * 33 + n;
        u32x4 o; o.x = pk_bf16(s[0 * 33], s[1 * 33]); o.y = pk_bf16(s[2 * 33], s[3 * 33]); o.z = pk_bf16(s[4 * 33], s[5 * 33]); o.w = pk_bf16(s[6 * 33], s[7 * 33]);
        *(u32x4*)(dst + (size_t)n * ldd + k0 + 8 * c) = o;
    }
    asm volatile("s_waitcnt lgkmcnt(0)" ::: "memory");
}

__device__ __forceinline__ void tr_items(int wv, const PT pt, LAS unsigned char* lds, int it0, int it1, int gwr, int ngw) {
    const int lane = tid_l(wv) & 63;
    unsigned char* ws = pt.ws();
    {
        LAS float* scr = (LAS float*)(lds + wv * 8448);
        constexpr int I_QKV = 16 * 96, I_WO = 16 * 32, I_GU = 16 * 176, I_DN = 44 * 32, I_WIN = 16 * 64, I_WOUT = 16 * 32, I_G = 32 * 8;
        for (int it = it0 + gwr; it < it1; it += ngw) {
            int r = it;
            if (r < I_QKV) { const int kb = r / 96, nb = r % 96; tr_item(pt.f(I_w_qkv), NQKV, 64 * kb, 32 * nb, (bf16_t*)(ws + WS_WQKV) + (size_t)(32 * nb) * D, D, scr, lane); continue; } r -= I_QKV;
            if (r < I_WO) { const int kb = r / 32, nb = r % 32; tr_item(pt.f(I_w_o), D, 64 * kb, 32 * nb, (bf16_t*)(ws + WS_WO) + (size_t)(32 * nb) * D, D, scr, lane); continue; } r -= I_WO;
#pragma unroll 1
            for (int l = 0; l < 2; ++l) {
                if (r >= 0 && r < I_GU) { const int kb = r / 176, nb = r % 176; const int n0 = 32 * nb, half = n0 >= FF ? 1 : 0, c0 = n0 - half * FF;
                    const int drow = 256 * (c0 >> 7) + 128 * half + (c0 & 127);
                    tr_item(pt.f(I_w_gu) + (size_t)l * D * 2 * FF, 2 * FF, 64 * kb, n0, (bf16_t*)(ws + WS_WGU) + ((size_t)l * 2 * FF + drow) * D, D, scr, lane); r = -1; break; } r -= I_GU;
                if (r >= 0 && r < I_DN) { const int kb = r / 32, nb = r % 32;
                    tr_item(pt.f(I_w_down) + (size_t)l * FF * D, D, 64 * kb, 32 * nb, (bf16_t*)(ws + WS_WDN) + ((size_t)l * D + 32 * nb) * FF, FF, scr, lane); r = -1; break; } r -= I_DN;
            }
            if (r < 0) continue;
            if (r < I_WIN) { const int kb = r / 64, nb = r % 64; tr_item(pt.f(I_w_in), 2 * D, 64 * kb, 32 * nb, (bf16_t*)(ws + WS_WIN) + (size_t)(32 * nb) * D, D, scr, lane); continue; } r -= I_WIN;
            if (r < I_WOUT) { const int kb = r / 32, nb = r % 32; tr_item(pt.f(I_w_out), D, 64 * kb, 32 * nb, (bf16_t*)(ws + WS_WOUT) + (size_t)(32 * nb) * D, D, scr, lane); continue; } r -= I_WOUT;
            { const int mat = r >> 3, sub = r & 7, kb = sub >> 2, nb = sub & 3;
              const int gsel = mat >> 4, dir = (mat >> 3) & 1, blk = mat & 7;
              const float* src = (gsel ? pt.f(I_w_i) : pt.f(I_w_a)) + (size_t)(dir * 8 + blk) * 128 * 128;
              tr_item(src, 128, 64 * kb, 32 * nb, (bf16_t*)(ws + WS_WG) + ((size_t)((blk * 2 + dir) * 256 + gsel * 128 + 32 * nb)) * 128, 128, scr, lane); }
        }
    }
}

__device__ __forceinline__ void adaln_tasks(int wv, const PT pt, LAS unsigned char* lds, int l, int rank, int nb) {
    const int tid = tid_l(wv);
    LAS float* sl = (LAS float*)(lds + 70000);
    LAS float* red = (LAS float*)lds;
    float* mod = (float*)(pt.ws() + WS_MOD);
#pragma unroll 1
    for (int task = rank; task < 256; task += nb) {
        const int cg_ = task >> 3, kr = task & 7, col0 = cg_ * 192;
        __syncthreads();
        for (int i = tid; i < 9 * 128; i += 512) { const int cv = i >> 7, k = kr * 128 + (i & 127); const float v = cv < 8 ? pt.f(I_c)[cv * D + k] : pt.f(I_c_ctx)[k]; sl[i] = silu_f(v); }
        __syncthreads();
        if (tid < 384) {
            const int q = tid % 48, ks = tid / 48;
            float acc[9][4];
#pragma unroll
            for (int cv = 0; cv < 9; ++cv) { acc[cv][0] = 0.f; acc[cv][1] = 0.f; acc[cv][2] = 0.f; acc[cv][3] = 0.f; }
            const float* wp = pt.f(I_w_mod) + ((size_t)l * D + kr * 128 + ks * 16) * NMOD + col0 + 4 * q;
            f32x4 w[16];
#pragma unroll
            for (int k = 0; k < 16; ++k) w[k] = *(const f32x4*)(wp + (size_t)k * NMOD);
#pragma unroll
            for (int k = 0; k < 16; ++k) {
#pragma unroll
                for (int cv = 0; cv < 9; ++cv) { const float s = sl[cv * 128 + ks * 16 + k]; acc[cv][0] += s * w[k][0]; acc[cv][1] += s * w[k][1]; acc[cv][2] += s * w[k][2]; acc[cv][3] += s * w[k][3]; }
            }
#pragma unroll
            for (int cv = 0; cv < 9; ++cv) *(LAS f32x4*)(red + (ks * 9 + cv) * 192 + 4 * q) = (f32x4){acc[cv][0], acc[cv][1], acc[cv][2], acc[cv][3]};
        }
        __syncthreads();
        for (int i = tid; i < 9 * 192; i += 512) {
            const int cv = i / 192, cc = i % 192; float s = 0.f;
#pragma unroll
            for (int ks = 0; ks < 8; ++ks) s += red[(ks * 9 + cv) * 192 + cc];
            if (kr == 0) s += pt.f(I_b_mod)[l * NMOD + col0 + cc];
            unsafeAtomicAdd(mod + ((size_t)l * 9 + cv) * NMOD + col0 + cc, s);
        }
    }
    __syncthreads();
}

__device__ __forceinline__ void cache_conv(int wv, const PT pt, int rank, int nb) {
    const int tid = tid_l(wv);
    unsigned char* ws = pt.ws();
    const size_t n4 = (size_t)MC * D / 4;
#pragma unroll 8
    for (size_t i = (size_t)rank * 512 + tid; i < 2 * n4; i += (size_t)nb * 512) {
        const bool isv = i >= n4; const size_t j = isv ? i - n4 : i;
        const f32x4 v = *((const f32x4*)(isv ? pt.f(I_cache_v) : pt.f(I_cache_k)) + j);
        u32x2 w; w.x = pk_bf16(v[0], v[1]); w.y = pk_bf16(v[2], v[3]);
        *((u32x2*)(ws + (isv ? WS_CV : WS_CK)) + j) = w;
    }
}

__device__ __forceinline__ void p0_prologue(int wv, const PT pt, LAS unsigned char* lds) {
    const int tid = tid_l(wv), lane = tid & 63, wave = tid >> 6;
    const int G = gd_l(), bxl = bx_l(), gw = bxl * 8 + wave, NGW = G * 8;
    unsigned char* ws = pt.ws();
    adaln_tasks(wv, pt, lds, 0, bxl, G);
    for (int rp_ = 0; rp_ < REP_PRO; ++rp_) tr_items(wv, pt, lds, 0, 16 * 96, gw, NGW);
}

__device__ __forceinline__ void norm_phase(int wv, const float* xa, const float* xb, const float* g, const float* mod_l, int sh_chunk, bf16_t* XN) {
    const int tid = tid_l(wv), lane = tid & 63, gw = bx_l() * 8 + (tid >> 6), NGW = gd_l() * 8;
#pragma unroll 2
    for (int row = gw; row < MT; row += NGW) {
        const float* xr = row < MC ? xa + (size_t)row * D : xb + (size_t)(row - MC) * D;
        const int cv = row < MC ? 8 : ((row - MC) >> 10);
        const float* shp = mod_l + (size_t)cv * NMOD + sh_chunk * D; const float* scp = shp + D;
        f32x4 v[4], gg4[4], sc4[4], sh4[4]; float s = 0.f;
#pragma unroll
        for (int j = 0; j < 4; ++j) { const int c = 4 * lane + 256 * j; v[j] = *((const f32x4*)xr + lane + 64 * j); gg4[j] = *(const f32x4*)(g + c); sc4[j] = *(const f32x4*)(scp + c); sh4[j] = *(const f32x4*)(shp + c); }
#pragma unroll
        for (int j = 0; j < 4; ++j) s += (v[j][0] * v[j][0] + v[j][1] * v[j][1]) + (v[j][2] * v[j][2] + v[j][3] * v[j][3]);
        const float rstd = 1.f / sqrtf(wave_sum(s, lane) * (1.f / D) + RMS_EPS);
#pragma unroll
        for (int j = 0; j < 4; ++j) {
            const int c = 4 * lane + 256 * j;
            const f32x4 gg = gg4[j], sc = sc4[j], sh = sh4[j];
            const f32x4 y = v[j] * rstd * gg * (sc + 1.f) + sh;
            u32x2 w; w.x = pk_bf16(y[0], y[1]); w.y = pk_bf16(y[2], y[3]);
            *(u32x2*)(XN + (size_t)row * D + c) = w;
        }
    }
}
__device__ __forceinline__ void final_norm_phase(int wv, const bf16_t* XB, float* Y, const float* g) {
    const int tid = tid_l(wv), lane = tid & 63, gw = bx_l() * 8 + (tid >> 6), NGW = gd_l() * 8;
#pragma unroll 2
    for (int row = gw; row < MT; row += NGW) {
        const u32x4* xr = (const u32x4*)(XB + (size_t)row * D);
        f32x4 v[4], gg[4]; float s = 0.f;
#pragma unroll
        for (int j = 0; j < 2; ++j) {
            const u32x4 w = xr[lane + 64 * j];
            v[2 * j] = (f32x4){bf_lo(w.x), bf_hi(w.x), bf_lo(w.y), bf_hi(w.y)}; v[2 * j + 1] = (f32x4){bf_lo(w.z), bf_hi(w.z), bf_lo(w.w), bf_hi(w.w)};
            gg[2 * j] = *(const f32x4*)(g + 8 * lane + 512 * j); gg[2 * j + 1] = *(const f32x4*)(g + 8 * lane + 512 * j + 4);
        }
#pragma unroll
        for (int j = 0; j < 4; ++j) s += (v[j][0] * v[j][0] + v[j][1] * v[j][1]) + (v[j][2] * v[j][2] + v[j][3] * v[j][3]);
        const float rstd = 1.f / sqrtf(wave_sum(s, lane) * (1.f / D) + RMS_EPS);
        float* yr = Y + (size_t)row * D;
#pragma unroll
        for (int j = 0; j < 2; ++j) { *(f32x4*)(yr + 8 * lane + 512 * j) = v[2 * j] * rstd * gg[2 * j]; *(f32x4*)(yr + 8 * lane + 512 * j + 4) = v[2 * j + 1] * rstd * gg[2 * j + 1]; }
    }
}
__device__ __forceinline__ void conv_phase(int wv, const bf16_t* XR, const float* cw, const float* cb, bf16_t* XC) {
    const size_t n8 = (size_t)MT * D / 8;
#pragma unroll 2
    for (size_t i = (size_t)bx_l() * 512 + tid_l(wv), st_ = (size_t)gd_l() * 512; i < n8; i += st_) {
        const int row = (int)(i >> 7), c = (int)(i & 127) * 8;
        int pos, len; if (row < MC) { pos = row & 255; len = 256; } else { pos = (row - MC) & 1023; len = 1024; }
        float y[8];
#pragma unroll
        for (int e = 0; e < 8; ++e) y[e] = cb[c + e];
#pragma unroll
        for (int j = 0; j < 4; ++j) {
            const int p = pos + j - 2;
            if (p >= 0 && p < len) {
                const u32x4 xw = *(const u32x4*)(XR + (size_t)(row + j - 2) * D + c);
                const f32x4 w0 = *(const f32x4*)(cw + j * D + c), w1 = *(const f32x4*)(cw + j * D + c + 4);
                y[0] += w0[0] * bf_lo(xw.x); y[1] += w0[1] * bf_hi(xw.x); y[2] += w0[2] * bf_lo(xw.y); y[3] += w0[3] * bf_hi(xw.y);
                y[4] += w1[0] * bf_lo(xw.z); y[5] += w1[1] * bf_hi(xw.z); y[6] += w1[2] * bf_lo(xw.w); y[7] += w1[3] * bf_hi(xw.w);
            }
        }
        u32x4 o; o.x = pk_bf16(y[0], y[1]); o.y = pk_bf16(y[2], y[3]); o.z = pk_bf16(y[4], y[5]); o.w = pk_bf16(y[6], y[7]);
        *(u32x4*)(XC + (size_t)row * D + c) = o;
    }
}
__device__ __forceinline__ void conv_slab(int wv, const bf16_t* XR, const float* cw, const float* cb, bf16_t* XC, int q, int n) {
    const int tid = tid_l(wv), ch = n * 128 + (tid & 15) * 8, r0 = q * 256 + (tid >> 4) * 8;
    int pos0, len; if (r0 < MC) { pos0 = r0 & 255; len = 256; } else { pos0 = (r0 - MC) & 1023; len = 1024; }
    u32x4 x[11];
#pragma unroll
    for (int i = 0; i < 11; ++i) { const int p = pos0 + i - 2; x[i] = (p >= 0 && p < len) ? *(const u32x4*)(XR + (size_t)(r0 + i - 2) * D + ch) : (u32x4){0u, 0u, 0u, 0u}; }
    f32x4 w0[4], w1[4];
#pragma unroll
    for (int j = 0; j < 4; ++j) { w0[j] = *(const f32x4*)(cw + j * D + ch); w1[j] = *(const f32x4*)(cw + j * D + ch + 4); }
    const f32x4 b0 = *(const f32x4*)(cb + ch), b1 = *(const f32x4*)(cb + ch + 4);
#pragma unroll
    for (int r = 0; r < 8; ++r) {
        f32x4 y0 = b0, y1 = b1;
#pragma unroll
        for (int j = 0; j < 4; ++j) { const u32x4 xw = x[r + j];
            y0 += w0[j] * (f32x4){bf_lo(xw.x), bf_hi(xw.x), bf_lo(xw.y), bf_hi(xw.y)}; y1 += w1[j] * (f32x4){bf_lo(xw.z), bf_hi(xw.z), bf_lo(xw.w), bf_hi(xw.w)}; }
        u32x4 o; o.x = pk_bf16(y0[0], y0[1]); o.y = pk_bf16(y0[2], y0[3]); o.z = pk_bf16(y1[0], y1[1]); o.w = pk_bf16(y1[2], y1[3]);
        *(u32x4*)(XC + (size_t)(r0 + r) * D + ch) = o;
    }
    asm volatile("s_waitcnt vmcnt(0)" ::: "memory");
    __syncthreads();
}

__device__ __forceinline__ void lru_combine_phase(int wv, const unsigned char* ws, bf16_t* Y) {
    const bf16_t* HLF = (const bf16_t*)(ws + WS_HLF); const bf16_t* HLB = (const bf16_t*)(ws + WS_HLB);
    const bf16_t* PF = (const bf16_t*)(ws + WS_PF); const bf16_t* PB = (const bf16_t*)(ws + WS_PB); const bf16_t* GT = (const bf16_t*)(ws + WS_GATE);
    const float* sE = (const float*)(ws + WS_SUME); const float* sP = (const float*)(ws + WS_SUMP);
    const size_t n8 = (size_t)MT * D / 8;
#pragma unroll 2
    for (size_t i = (size_t)bx_l() * 512 + tid_l(wv), st_ = (size_t)gd_l() * 512; i < n8; i += st_) {
        const int row = (int)(i >> 7), c = (int)(i & 127) * 8;
        const size_t off = (size_t)row * D + c;
        const u32x4 hf = *(const u32x4*)(HLF + off), hb = *(const u32x4*)(HLB + off), gt = *(const u32x4*)(GT + off);
        float h[8] = {bf_lo(hf.x) + bf_lo(hb.x), bf_hi(hf.x) + bf_hi(hb.x), bf_lo(hf.y) + bf_lo(hb.y), bf_hi(hf.y) + bf_hi(hb.y),
                      bf_lo(hf.z) + bf_lo(hb.z), bf_hi(hf.z) + bf_hi(hb.z), bf_lo(hf.w) + bf_lo(hb.w), bf_hi(hf.w) + bf_hi(hb.w)};
        if (row >= MC) {
            const int q = row >> 8, ci = (q - 16) & 3, q0 = q - ci;
            const u32x4 pf = *(const u32x4*)(PF + off - (size_t)MC * D), pb = *(const u32x4*)(PB + off - (size_t)MC * D);
            f32x4 tf0 = {0.f, 0.f, 0.f, 0.f}, tf1 = tf0, tb0 = tf0, tb1 = tf0;
            for (int cc = 0; cc < ci; ++cc) { const float* e = sE + (size_t)(q0 + cc) * D + c; const float* p = sP + (size_t)(q0 + cc) * D + c;
                tf0 = *(const f32x4*)e + *(const f32x4*)p * tf0; tf1 = *(const f32x4*)(e + 4) + *(const f32x4*)(p + 4) * tf1; }
            for (int cc = 3; cc > ci; --cc) { const float* e = sE + (size_t)(48 + q0 + cc) * D + c; const float* p = sP + (size_t)(48 + q0 + cc) * D + c;
                tb0 = *(const f32x4*)e + *(const f32x4*)p * tb0; tb1 = *(const f32x4*)(e + 4) + *(const f32x4*)(p + 4) * tb1; }
            h[0] += bf_lo(pf.x) * tf0[0] + bf_lo(pb.x) * tb0[0]; h[1] += bf_hi(pf.x) * tf0[1] + bf_hi(pb.x) * tb0[1];
            h[2] += bf_lo(pf.y) * tf0[2] + bf_lo(pb.y) * tb0[2]; h[3] += bf_hi(pf.y) * tf0[3] + bf_hi(pb.y) * tb0[3];
            h[4] += bf_lo(pf.z) * tf1[0] + bf_lo(pb.z) * tb1[0]; h[5] += bf_hi(pf.z) * tf1[1] + bf_hi(pb.z) * tb1[1];
            h[6] += bf_lo(pf.w) * tf1[2] + bf_lo(pb.w) * tb1[2]; h[7] += bf_hi(pf.w) * tf1[3] + bf_hi(pb.w) * tb1[3];
        }
        u32x4 o;
        o.x = pk_bf16(h[0] * bf_lo(gt.x), h[1] * bf_hi(gt.x)); o.y = pk_bf16(h[2] * bf_lo(gt.y), h[3] * bf_hi(gt.y));
        o.z = pk_bf16(h[4] * bf_lo(gt.z), h[5] * bf_hi(gt.z)); o.w = pk_bf16(h[6] * bf_lo(gt.w), h[7] * bf_hi(gt.w));
        *(u32x4*)(Y + off) = o;
    }
}

#ifndef PG8_SP2
#define PG8_SP2 true
#endif
#ifndef PG8_ALIGN
#define PG8_ALIGN true
#endif

__device__ __forceinline__ void shw_phase(int wv, const PT pt, LAS unsigned char* lds, const int site, int bx, int G) {
    const int tid = tid_l(wv), lane = tid & 63;
    unsigned char* ws = pt.ws();
    const int lb = bx, nb = G;
    LAS float* sl = (LAS float*)lds;
    const float* mod = (const float*)(ws + WS_MOD);
    const int l = site ? 1 : 0, chunk = (site == 1) ? 0 : 3, N = (site == 1) ? 2 * D : 2 * FF;
    const bf16_t* Wt = site == 0 ? (const bf16_t*)(ws + WS_WGU) : (site == 1 ? (const bf16_t*)(ws + WS_WIN) : (const bf16_t*)(ws + WS_WGU) + (size_t)2 * FF * D);
    float* out = (float*)(ws + WS_SHW) + (site == 0 ? SHW_OFF0 : (site == 1 ? SHW_OFF1 : SHW_OFF2));
    __syncthreads();
#pragma unroll
    for (int r = 0; r < 3; ++r) {
        float v[6];
#pragma unroll
        for (int j = 0; j < 6; ++j) { const int i = tid + 512 * (6 * r + j); v[j] = mod[((size_t)l * 9 + (i >> 10)) * NMOD + chunk * D + (i & 1023)]; }
#pragma unroll
        for (int j = 0; j < 6; ++j) sl[tid + 512 * (6 * r + j)] = v[j];
    }
    __syncthreads();
    const int step = nb * 8;
    int n = lb * 8 + wv;
    u32x2 wa[4];
    if (n < N) {
#pragma unroll
        for (int j = 0; j < 4; ++j) wa[j] = *(const u32x2*)(Wt + (size_t)n * D + 4 * lane + 256 * j);
    }
    for (; n < N; n += step) {
        u32x2 wb[4];
        const int n2 = n + step;
        if (n2 < N) {
#pragma unroll
            for (int j = 0; j < 4; ++j) wb[j] = *(const u32x2*)(Wt + (size_t)n2 * D + 4 * lane + 256 * j);
        }
        float res = 0.f;
#pragma unroll
        for (int cv = 0; cv < 9; ++cv) {
            float s = 0.f;
#pragma unroll
            for (int j = 0; j < 4; ++j) { const f32x4 v = *(const LAS f32x4*)(sl + cv * D + 4 * lane + 256 * j); s += (v[0] * bf_lo(wa[j].x) + v[1] * bf_hi(wa[j].x)) + (v[2] * bf_lo(wa[j].y) + v[3] * bf_hi(wa[j].y)); }
            s = wave_sum(s, lane);
            if (lane == cv) res = s;
        }
        if (lane < 9) out[(size_t)lane * N + n] = res;
#pragma unroll
        for (int j = 0; j < 4; ++j) wa[j] = wb[j];
    }
    __syncthreads();
}

#ifndef PHMASK
#define PHMASK 0xffff
#endif
constexpr int PHM = PHMASK;
__global__ void __launch_bounds__(512, 2) fwd_megakernel(Args a) {
    extern __shared__ __attribute__((aligned(16))) unsigned char lds_raw[];
    LAS unsigned char* lds = (LAS unsigned char*)lds_raw;
    cg::grid_group grid = cg::this_grid();
    const int wv = __builtin_amdgcn_readfirstlane(threadIdx.x >> 6);
    {
        LAS unsigned long long* tw = (LAS unsigned long long*)(lds + PTAB_OFF);
        if (threadIdx.x == 0) {
            tw[0] = (unsigned long long)a.x_prompt; tw[1] = (unsigned long long)a.x_sample; tw[2] = (unsigned long long)a.c; tw[3] = (unsigned long long)a.cache_k; tw[4] = (unsigned long long)a.cache_v;
            tw[5] = (unsigned long long)a.state_h; tw[6] = (unsigned long long)a.c_ctx; tw[7] = (unsigned long long)a.norm_g; tw[8] = (unsigned long long)a.w_mod; tw[9] = (unsigned long long)a.b_mod;
            tw[10] = (unsigned long long)a.w_qkv; tw[11] = (unsigned long long)a.w_o; tw[12] = (unsigned long long)a.rpb; tw[13] = (unsigned long long)a.w_in; tw[14] = (unsigned long long)a.conv_w;
            tw[15] = (unsigned long long)a.conv_b; tw[16] = (unsigned long long)a.w_a; tw[17] = (unsigned long long)a.b_a; tw[18] = (unsigned long long)a.w_i; tw[19] = (unsigned long long)a.b_i;
            tw[20] = (unsigned long long)a.lam; tw[21] = (unsigned long long)a.w_out; tw[22] = (unsigned long long)a.w_gu; tw[23] = (unsigned long long)a.w_down; tw[24] = (unsigned long long)a.final_g;
            tw[25] = (unsigned long long)a.out; tw[26] = (unsigned long long)a.ws;
            LAS unsigned* st = (LAS unsigned*)(lds + BARST_OFF); st[0] = 0u; st[1] = 0u;
            (void)xb_add((unsigned*)(a.ws + WS_BAR) + XB_XCNT(xb_xcc_id()), 1u);
        }
        __syncthreads();
        if (a.out == nullptr) grid.sync();
    }
#define GSYNC() do { for (int rs_ = 0; rs_ < REP_SYNC; ++rs_) xcd_barrier(pt, lds, wv); } while (0)
    const PT pt{(LAS const unsigned long long*)(lds + PTAB_OFF)};
#define WSP(off) (pt.ws() + (off))
#define MODP ((float*)WSP(WS_MOD))
#define XNP ((bf16_t*)WSP(WS_XN))
#define XRES (pt.out() + OUT_Y)
#define XBP ((bf16_t*)WSP(WS_XB))
#define SSQP(i) ((float*)WSP(WS_SSQ) + (size_t)(i) * MT)

    if (PHM & 1) p0_prologue(wv, pt, lds);
    GSYNC();
    if (PHM & 2) for (int rep_ = 0; rep_ < REP_THIN; ++rep_) norm_phase(wv, pt.f(I_x_prompt), pt.f(I_x_sample), pt.f(I_norm_g), MODP, 0, XNP);
    GSYNC();
    if (PHM & 4) { pg8::Gemm g{XNP, (const bf16_t*)WSP(WS_WQKV), MT, NQKV, D, D, D, wv}; pg8::StaticOrder S; S.init(MT, NQKV, gd_l(), bx_l()); S.reps = REP_GEMM;
      pg8::EpiQKV E{(bf16_t*)WSP(WS_Q), pt.out() + OUT_NK, 0.125f * LOG2E};
      pg8::gemm_phase<pg8::EpiQKV, pg8::StaticOrder, PG8_ALIGN, PG8_SP2>(lds, g, S, E); }
    {
        const int G_ = gd_l(), c_ = bx_l(), nwg_ = (MT / 256) * (NQKV / 256), maxu_ = (nwg_ + G_ - 1) / G_, full_ = nwg_ - (maxu_ - 1) * G_;
        int rank_ = c_, n_ = G_;
        if (full_ < G_) { rank_ = c_ - full_; n_ = c_ >= full_ ? G_ - full_ : 0; }
        if (n_ > 0) { tr_items(wv, pt, lds, 16 * 96, 16 * 96 + 16 * 32 + 16 * 176 + 44 * 32, rank_ * 8 + wv, n_ * 8); cache_conv(wv, pt, rank_, n_); }
    }
    GSYNC();
    if (PHM & 8) for (int rep_ = 0; rep_ < REP_ATT; ++rep_) for (int vc = bx_l(), G_ = gd_l(); vc < 256; vc += G_) {
        const int bh = vc >> 1;
#pragma unroll 1
        for (int gi = 0; gi < 2; ++gi)
            att::unit<true>(wv, lds, bh >> 4, bh & 15, 2 * (vc & 1) + gi, (const bf16_t*)WSP(WS_Q), (const bf16_t*)WSP(WS_K), (const bf16_t*)WSP(WS_V), (const bf16_t*)WSP(WS_CK), (const bf16_t*)WSP(WS_CV), XNP, pt.f(I_rpb));
        att::unit<false>(wv, lds, vc >> 4, vc & 15, 0, (const bf16_t*)WSP(WS_Q), (const bf16_t*)WSP(WS_K), (const bf16_t*)WSP(WS_V), nullptr, nullptr, XNP, nullptr);
    }
    GSYNC();
    if (PHM & 16)
#pragma unroll 1
    for (int rp_ = REP_P4 - 1; rp_ >= 0; --rp_) { pg8::Gemm g{XNP, (const bf16_t*)WSP(WS_WO), MT, D, D, D, D, wv}; pg8::StaticOrder S; S.init(MT, D, gd_l(), bx_l());
      pg8::EpiResT<true, true> E{pt.f(I_x_prompt), pt.f(I_x_sample), XBP, MODP + 2 * D, (bf16_t*)WSP(WS_XN2), pt.f(I_norm_g) + D, MODP + 4 * D, rp_ ? (float*)WSP(WS_HLF) : SSQP(0)};
      pg8::gemm_phase<pg8::EpiResT<true, true>, pg8::StaticOrder, PG8_ALIGN, PG8_SP2>(lds, g, S, E); }
    {
        const int G_ = gd_l(), c_ = bx_l(), nwg_ = (MT / 256) * (D / 256);
        if (nwg_ < G_) { if (c_ >= nwg_) { adaln_tasks(wv, pt, lds, 1, c_ - nwg_, G_ - nwg_); shw_phase(wv, pt, lds, 0, c_ - nwg_, G_ - nwg_); } }
        else { adaln_tasks(wv, pt, lds, 1, c_, G_); shw_phase(wv, pt, lds, 0, c_, G_); }
    }
    GSYNC();
    if (PHM & 512) { pg8::Gemm g{(const bf16_t*)WSP(WS_XN2), (const bf16_t*)WSP(WS_WGU), MT, 2 * FF, D, D, D, wv}; pg8::StaticOrder S; S.init(MT, 2 * FF, gd_l(), bx_l()); S.reps = REP_GEMM;
      pg8::EpiSwiglu E{(bf16_t*)WSP(WS_H), SSQP(0), (const float*)WSP(WS_SHW) + SHW_OFF0};
      pg8::gemm_phase<pg8::EpiSwiglu, pg8::StaticOrder, PG8_ALIGN, PG8_SP2>(lds, g, S, E); }
    {
        const int G_ = gd_l(), c_ = bx_l(), nwg_ = (MT / 256) * (2 * FF / 256), maxu_ = (nwg_ + G_ - 1) / G_, full_ = nwg_ - (maxu_ - 1) * G_;
        int rank_ = c_, n_ = G_;
        if (full_ < G_) { rank_ = c_ - full_; n_ = c_ >= full_ ? G_ - full_ : 0; }
        if (n_ > 0) tr_items(wv, pt, lds, 16 * 96 + 16 * 32 + 2 * 16 * 176 + 44 * 32, 12288, rank_ * 8 + wv, n_ * 8);
    }
    GSYNC();
    if (PHM & 16) { pg8::Gemm g{(const bf16_t*)WSP(WS_H), (const bf16_t*)WSP(WS_WDN), MT, D, FF, FF, FF, wv}; pg8::StaticOrder S; S.init(MT, D, gd_l(), bx_l());
      pg8::EpiResT<true, false> E{nullptr, nullptr, XBP, MODP + 5 * D, XNP, pt.f(I_norm_g) + 2 * D, MODP + (size_t)9 * NMOD + 1 * D, SSQP(1)};
      pg8::gemm_phase<pg8::EpiResT<true, false>, pg8::StaticOrder, PG8_ALIGN, PG8_SP2>(lds, g, S, E); }
    {
        const int G_ = gd_l(), c_ = bx_l(), nwg_ = (MT / 256) * (D / 256);
        int rank_ = c_, n_ = G_;
        if (nwg_ < G_) { rank_ = c_ - nwg_; n_ = c_ >= nwg_ ? G_ - nwg_ : 0; }
        if (n_ > 0) { shw_phase(wv, pt, lds, 1, rank_, n_); tr_items(wv, pt, lds, 16 * 96 + 16 * 32 + 16 * 176 + 44 * 32, 16 * 96 + 16 * 32 + 2 * 16 * 176 + 44 * 32, rank_ * 8 + wv, n_ * 8); }
    }
    GSYNC();
    if (PHM & 32) { pg8::Gemm g{XNP, (const bf16_t*)WSP(WS_WIN), MT, 2 * D, D, D, D, wv}; pg8::StaticOrder S; S.init(MT, 2 * D, gd_l(), bx_l()); S.reps = REP_GEMM;
      pg8::EpiWin E{(bf16_t*)WSP(WS_GATE), (bf16_t*)WSP(WS_XR), SSQP(1), (const float*)WSP(WS_SHW) + SHW_OFF1};
      pg8::gemm_phase<pg8::EpiWin, pg8::StaticOrder, PG8_ALIGN, PG8_SP2>(lds, g, S, E); }
    {
        const int G_ = gd_l(), c_ = bx_l(), nwg_ = (MT / 256) * (2 * D / 256), maxu_ = (nwg_ + G_ - 1) / G_, full_ = nwg_ - (maxu_ - 1) * G_;
        int rank_ = c_, n_ = G_;
        if (full_ < G_) { rank_ = c_ - full_; n_ = c_ >= full_ ? G_ - full_ : 0; }
        if (n_ > 0) shw_phase(wv, pt, lds, 2, rank_, n_);
    }
    GSYNC();
    if (PHM & 128)
#pragma unroll 1
    for (int uu = bx_l(), G_ = gd_l(); uu < 768 * REP_LRU; uu += G_) {
        const int u = uu % 768;
        const int dir = u & 1, n = (u >> 1) & 7, q = u >> 4;
        const float* h0 = nullptr;
        if (q >= 16) { const int b = (q - 16) >> 2, ci = (q - 16) & 3; if ((dir == 0 && ci == 0) || (dir == 1 && ci == 3)) h0 = pt.f(I_state_h) + ((size_t)b * 2 + dir) * D; }
        conv_slab(wv, (const bf16_t*)WSP(WS_XR), pt.f(I_conv_w), pt.f(I_conv_b), XNP, q, n);
        pg8::Gemm g{XNP + (size_t)q * 256 * D + n * 128, (const bf16_t*)WSP(WS_WG) + (size_t)(n * 2 + dir) * 256 * 128, 256, 256, 128, D, 128, wv};
        pg8::OneUnit S;
        pg8::EpiLru E{pt.t, h0, q * 256, n * 128, dir, q};
        pg8::gemm_phase<pg8::EpiLru, pg8::OneUnit, false, false>(lds, g, S, E);
    }
    GSYNC();
    if (PHM & 256) for (int rep_ = 0; rep_ < REP_THIN; ++rep_) lru_combine_phase(wv, pt.ws(), (bf16_t*)WSP(WS_Y));
    GSYNC();
    if (PHM & 16) { pg8::Gemm g{(const bf16_t*)WSP(WS_Y), (const bf16_t*)WSP(WS_WOUT), MT, D, D, D, D, wv}; pg8::StaticOrder S; S.init(MT, D, gd_l(), bx_l());
      pg8::EpiResT<true, false> E{nullptr, nullptr, XBP, MODP + (size_t)9 * NMOD + 2 * D, XNP, pt.f(I_norm_g) + 3 * D, MODP + (size_t)9 * NMOD + 4 * D, SSQP(2)};
      pg8::gemm_phase<pg8::EpiResT<true, false>, pg8::StaticOrder, PG8_ALIGN, PG8_SP2>(lds, g, S, E); }
    GSYNC();
    if (PHM & 512) { pg8::Gemm g{XNP, (const bf16_t*)WSP(WS_WGU) + (size_t)2 * FF * D, MT, 2 * FF, D, D, D, wv}; pg8::StaticOrder S; S.init(MT, 2 * FF, gd_l(), bx_l()); S.reps = REP_GEMM;
      pg8::EpiSwiglu E{(bf16_t*)WSP(WS_H), SSQP(2), (const float*)WSP(WS_SHW) + SHW_OFF2};
      pg8::gemm_phase<pg8::EpiSwiglu, pg8::StaticOrder, PG8_ALIGN, PG8_SP2>(lds, g, S, E); }
    GSYNC();
    if (gd_l() >= (MT / 256) * (D / 256)) {
        pg8::Gemm g{(const bf16_t*)WSP(WS_H), (const bf16_t*)WSP(WS_WDN) + (size_t)D * FF, MT, D, FF, FF, FF, wv}; pg8::StaticOrder S; S.init(MT, D, gd_l(), bx_l());
        pg8::EpiResFinal E{XBP, MODP + (size_t)9 * NMOD + 5 * D, SSQP(3), (unsigned*)WSP(WS_FCNT), pt.f(I_final_g), XRES};
        pg8::gemm_phase<pg8::EpiResFinal, pg8::StaticOrder, PG8_ALIGN, PG8_SP2>(lds, g, S, E);
    } else {
        { pg8::Gemm g{(const bf16_t*)WSP(WS_H), (const bf16_t*)WSP(WS_WDN) + (size_t)D * FF, MT, D, FF, FF, FF, wv}; pg8::StaticOrder S; S.init(MT, D, gd_l(), bx_l());
          pg8::EpiResT<false, false> E{nullptr, nullptr, XBP, MODP + (size_t)9 * NMOD + 5 * D, nullptr, nullptr, nullptr, nullptr};
          pg8::gemm_phase<pg8::EpiResT<false, false>, pg8::StaticOrder, PG8_ALIGN, PG8_SP2>(lds, g, S, E); }
        GSYNC();
        final_norm_phase(wv, XBP, XRES, pt.f(I_final_g));
    }
}

extern "C" void kernel_launch(void* const* d_in, const int* in_sizes, int n_in, void* d_out, int out_size, void* d_ws, size_t ws_size, hipStream_t stream) {
    static int grid = 0;
    if (grid == 0) {
        int dev = 0, cus = 0, per_cu = 0;
        (void)hipGetDevice(&dev);
        (void)hipDeviceGetAttribute(&cus, hipDeviceAttributeMultiprocessorCount, dev);
        (void)hipFuncSetAttribute((const void*)fwd_megakernel, hipFuncAttributeMaxDynamicSharedMemorySize, LDS_BYTES);
        (void)hipOccupancyMaxActiveBlocksPerMultiprocessor(&per_cu, (const void*)fwd_megakernel, 512, LDS_BYTES);
        if (per_cu < 1) { fprintf(stderr, "kernel_launch: occupancy query says %d blocks per CU\n", per_cu); per_cu = 1; }
        grid = cus * per_cu;
        if (ws_size < WS_END) { fprintf(stderr, "kernel_launch: workspace too small (%zu < %zu)\n", ws_size, (size_t)WS_END); grid = -1; }
    }
    if (grid < 0) return;
    (void)hipMemsetAsync((char*)d_ws + WS_MOD, 0, 1024 * 1024, stream);
    Args a{};
    const float** ap = (const float**)&a;
    for (int i = 0; i < 25; ++i) ap[i] = (const float*)d_in[i];
    a.out = (float*)d_out; a.ws = (unsigned char*)d_ws;
    void* args[] = {&a};
    hipError_t e = hipLaunchCooperativeKernel((const void*)fwd_megakernel, dim3(grid), dim3(512), args, LDS_BYTES, stream);
    if (e != hipSuccess) fprintf(stderr, "cooperative launch failed: %s (grid %d)\n", hipGetErrorString(e), grid);
}
```

```cpp
#include <hip/hip_runtime.h>
#include <hip/hip_cooperative_groups.h>
#include <cstdio>
#include <cstdint>
namespace cg = cooperative_groups;

#define LAS __attribute__((address_space(3)))
typedef unsigned short bf16_t;
typedef short bf16x8 __attribute__((ext_vector_type(8)));
typedef short s16x4 __attribute__((ext_vector_type(4)));
typedef float f32x4 __attribute__((ext_vector_type(4)));
typedef float f32x2 __attribute__((ext_vector_type(2)));
typedef float f32x16 __attribute__((ext_vector_type(16)));
typedef unsigned u32x4 __attribute__((ext_vector_type(4)));
typedef unsigned u32x2 __attribute__((ext_vector_type(2)));
typedef __bf16 bf16x2_t __attribute__((ext_vector_type(2)));

constexpr int D = 1024, MC = 4096, ML = 8192, MT = MC + ML, FF = 2816, NQKV = 3072, NMOD = 6144;
constexpr float LOG2E = 1.4426950408889634f;
constexpr float RMS_EPS = 1e-6f;

constexpr size_t MiB = 1u << 20;
constexpr size_t WS_MOD = 0;
constexpr size_t WS_YCNT = 832 * 1024;
constexpr size_t WS_FCNT = 768 * 1024;
constexpr size_t WS_SSQ = 512 * 1024;
constexpr size_t WS_WQKV = 1 * MiB, WS_WO = 7 * MiB, WS_WGU = 9 * MiB, WS_WDN = 31 * MiB, WS_WIN = 42 * MiB, WS_WOUT = 46 * MiB, WS_WG = 48 * MiB;
constexpr size_t WS_CK = 49 * MiB, WS_CV = 57 * MiB;
constexpr size_t WS_PF = 49 * MiB;
constexpr size_t WS_XN = 65 * MiB;
constexpr size_t WS_Q = 89 * MiB, WS_K = 113 * MiB, WS_V = 137 * MiB;
constexpr size_t WS_H = 89 * MiB;
constexpr size_t WS_GATE = 89 * MiB, WS_XR = 113 * MiB, WS_Y = 113 * MiB;
constexpr size_t WS_XN2 = 161 * MiB;
constexpr size_t WS_PB = 137 * MiB;
constexpr size_t WS_XB = 185 * MiB;
constexpr size_t WS_HLF = 209 * MiB, WS_HLB = 161 * MiB;
constexpr size_t WS_SUMP = 250 * MiB;
constexpr size_t WS_SUME = 250 * MiB + 512 * 1024;
constexpr size_t WS_SHW = 252 * MiB;
constexpr int SHW_OFF0 = 0, SHW_OFF1 = 9 * 5632, SHW_OFF2 = 9 * 5632 + 9 * 2048;
constexpr size_t WS_END = 256 * MiB;

constexpr int LDS_BYTES = 143360;
constexpr int AB_PITCH = 1056;
constexpr int HST_OFF = 128 * AB_PITCH;

enum { I_x_prompt = 0, I_x_sample = 1, I_c = 2, I_cache_k = 3, I_cache_v = 4, I_state_h = 5, I_c_ctx = 6, I_norm_g = 7, I_w_mod = 8, I_b_mod = 9, I_w_qkv = 10, I_w_o = 11, I_rpb = 12, I_w_in = 13, I_conv_w = 14, I_conv_b = 15, I_w_a = 16, I_b_a = 17, I_w_i = 18, I_b_i = 19, I_lam = 20, I_w_out = 21, I_w_gu = 22, I_w_down = 23, I_final_g = 24, I_out = 25, I_ws = 26 };
constexpr int PTAB_OFF = LDS_BYTES - 256;
struct PT {
    LAS const unsigned long long* t;
    __device__ __forceinline__ unsigned long long raw(int i) const { const unsigned long long v = t[i]; const unsigned lo = __builtin_amdgcn_readfirstlane((unsigned)v), hi = __builtin_amdgcn_readfirstlane((unsigned)(v >> 32)); return ((unsigned long long)hi << 32) | lo; }
    __device__ __forceinline__ const float* f(int i) const { return (const float*)(const __attribute__((address_space(1))) float*)raw(i); }
    __device__ __forceinline__ float* out() const { return (float*)(__attribute__((address_space(1))) float*)raw(I_out); }
    __device__ __forceinline__ unsigned char* ws() const { return (unsigned char*)(__attribute__((address_space(1))) unsigned char*)raw(I_ws); }
};
constexpr size_t OUT_Y = 0, OUT_NK = (size_t)MT * D, OUT_NV = OUT_NK + (size_t)MC * D, OUT_NH = OUT_NV + (size_t)MC * D;
constexpr int CST_OFF = HST_OFF + 1024;
__device__ __forceinline__ int tid_l(int wv) { int l; asm volatile("v_mbcnt_lo_u32_b32 %0, -1, 0\n\tv_mbcnt_hi_u32_b32 %0, -1, %0" : "=v"(l)); return wv * 64 + l; }
__device__ __forceinline__ int bx_l() { int b = blockIdx.x; asm volatile("" : "+s"(b)); return b; }
__device__ __forceinline__ int gd_l() { int g = gridDim.x; asm volatile("" : "+s"(g)); return g; }

constexpr size_t WS_BAR = 448 * 1024;
constexpr int BARST_OFF = PTAB_OFF + 224;
#define XB_TMO      128
#define XB_XCNT(j)  (256  + 64 * (j))
#define XB_XSUB(j)  (1280 + 64 * (j))
#define XB_XGEN(j)  (2304 + 64 * (j))
#define XB_TOP      3328
#define XB_TOPGEN   3392
#define XCD_BAR_WORDS 3456
#define XB_SPIN_CAP (1u << 18)
__device__ __forceinline__ unsigned xb_ld(unsigned* p)              { return __hip_atomic_load(p, __ATOMIC_RELAXED, __HIP_MEMORY_SCOPE_AGENT); }
__device__ __forceinline__ unsigned xb_add(unsigned* p, unsigned v) { return __hip_atomic_fetch_add(p, v, __ATOMIC_RELAXED, __HIP_MEMORY_SCOPE_AGENT); }
__device__ __forceinline__ unsigned xb_xcc_id() { return (unsigned)__builtin_amdgcn_s_getreg((3 << 11) | 20) & 0xFu; }
#define XB_SPIN(cond, bar) do { unsigned _sp = 0; while (cond) { __builtin_amdgcn_s_sleep(1); \
    if ((++_sp & 255u) == 0u) { if (xb_ld(&(bar)[XB_TMO])) break; if (_sp > XB_SPIN_CAP) { atomicAdd(&(bar)[XB_TMO], 1u); break; } } } } while (0)
__device__ __forceinline__ void xcd_barrier_complete(unsigned* bar, unsigned x, unsigned& nloc, unsigned& nx) {
    const unsigned G = gridDim.x;
    unsigned sum, cnt, mine, sp = 0u;
    for (;;) {
        sum = 0u; cnt = 0u; mine = 0u;
#pragma unroll
        for (unsigned j = 0; j < 16; ++j) { const unsigned c = xb_ld(&bar[XB_XCNT(j)]); sum += c; cnt += (c > 0u) ? 1u : 0u; mine = (j == x) ? c : mine; }
        if (sum == G) break;
        __builtin_amdgcn_s_sleep(1);
        if ((++sp & 255u) == 0u) { if (xb_ld(&bar[XB_TMO])) break; if (sp > XB_SPIN_CAP) { atomicAdd(&bar[XB_TMO], 1u); break; } }
    }
    nloc = mine > 0u ? mine : 1u; nx = cnt > 0u ? cnt : 1u;
}
__device__ __forceinline__ void xcd_barrier(const PT pt, LAS unsigned char* lds, int wv) {
    asm volatile("s_waitcnt vmcnt(0)" ::: "memory");
    __syncthreads();
    if (tid_l(wv) == 0) {
        unsigned* bar = (unsigned*)(pt.ws() + WS_BAR);
        volatile LAS unsigned* st = (volatile LAS unsigned*)(lds + BARST_OFF);
        const unsigned x = xb_xcc_id();
        __builtin_amdgcn_s_waitcnt(0);
        unsigned nloc = st[0], nx = st[1];
        if (nloc == 0u) { xcd_barrier_complete(bar, x, nloc, nx); st[0] = nloc; st[1] = nx; }
        const unsigned old = xb_add(&bar[XB_XSUB(x)], 1u);
        const unsigned gen = old / nloc;
        if (old + 1u == (gen + 1u) * nloc) {
            __builtin_amdgcn_fence(__ATOMIC_RELEASE, "agent");
            asm volatile("s_waitcnt vmcnt(0)" ::: "memory");
            const unsigned og = xb_add(&bar[XB_TOP], 1u);
            const unsigned tg = og / nx;
            if (og + 1u == (tg + 1u) * nx) xb_add(&bar[XB_TOPGEN], 1u);
            else XB_SPIN(xb_ld(&bar[XB_TOPGEN]) == tg, bar);
            __builtin_amdgcn_fence(__ATOMIC_ACQUIRE, "agent");
            xb_add(&bar[XB_XGEN(x)], 1u);
            asm volatile("s_waitcnt vmcnt(0)" ::: "memory");
        } else {
            XB_SPIN(xb_ld(&bar[XB_XGEN(x)]) == gen, bar);
            __builtin_amdgcn_fence(__ATOMIC_ACQUIRE, "agent");
            asm volatile("s_waitcnt vmcnt(0)" ::: "memory");
        }
    }
    __syncthreads();
}
__device__ __forceinline__ unsigned pk_bf16(float lo, float hi) { f32x2 v = {lo, hi}; bf16x2_t b = __builtin_convertvector(v, bf16x2_t); return __builtin_bit_cast(unsigned, b); }
__device__ __forceinline__ float bf_lo(unsigned u) { return __uint_as_float(u << 16); }
__device__ __forceinline__ float bf_hi(unsigned u) { return __uint_as_float(u & 0xffff0000u); }
__device__ __forceinline__ float fast_rcp(float x) { return __builtin_amdgcn_rcpf(x); }
__device__ __forceinline__ float fast_exp2(float x) { return __builtin_amdgcn_exp2f(x); }
__device__ __forceinline__ float sigmoid_f(float x) { return fast_rcp(1.f + fast_exp2(-x * LOG2E)); }
__device__ __forceinline__ float silu_f(float x) { return x * sigmoid_f(x); }
__device__ __forceinline__ float gelu_tanh_f(float x) { const float u = 0.7978845608028654f * (x + 0.044715f * x * x * x); return x * sigmoid_f(2.f * u); }
__device__ __forceinline__ float shfl_xor_l(float v, int mask, int lane) { return __int_as_float(__builtin_amdgcn_ds_bpermute((lane ^ mask) << 2, __float_as_int(v))); }
__device__ __forceinline__ float wave_sum(float v, int lane) {
#pragma unroll
    for (int o = 1; o < 64; o <<= 1) v += shfl_xor_l(v, o, lane);
    return v;
}
namespace pg8 {
#define PG8_LAS __attribute__((address_space(3)))
constexpr int BM = 256, BK = 64, HALF = 128, HTB = HALF * BK * 2  , STAGE_BYTES = 8 * HTB, NXCD = 8, WGM = 4;

__host__ __device__ __forceinline__ int lds_byte(int r, int c) { const int st = (r >> 4) * 2 + (c >> 5), rr = r & 15, cc = c & 31, ob = rr * 64 + cc * 2; return st * 1024 + (ob ^ (((ob >> 9) & 1) << 5)); }
__host__ __device__ __forceinline__ void stage_rc(int b, int& R, int& C) { const int st = b / 1024, sb = b % 1024, swz = sb ^ (((sb >> 9) & 1) << 5); R = (st >> 1) * 16 + swz / 64; C = (st & 1) * 32 + (swz % 64) / 2; }
__host__ __device__ __forceinline__ int perm32(int rho) { const int n = rho >> 4, i = rho & 15; return 8 * (i >> 2) + 4 * n + (i & 3); }

struct Unit { int pm, pn; };
struct Gemm { const bf16_t* A; const bf16_t* Bt; int M, N, K, lda, ldb, wv; };

struct StaticOrder {
    int nM, nN, nwg, G, c;
    int reps = 1;
    __host__ __device__ __forceinline__ void init(int M, int N, int G_, int c_) { nM = M / BM; nN = N / BM; nwg = nM * nN; G = G_; c = c_; }
    __host__ __device__ __forceinline__ bool next(int i, Unit& u) const {
        const long L = (long)(i / reps) * G + c; if (L >= nwg) return false;
        int wgid = (int)L; { const int q = nwg / NXCD, r = nwg % NXCD, xcd = wgid % NXCD, off = wgid / NXCD; wgid = (xcd < r ? xcd * (q + 1) : r * (q + 1) + (xcd - r) * q) + off; }
        const int nig = WGM * nN, gid = wgid / nig, fm = gid * WGM, gsz = (nM - fm) < WGM ? (nM - fm) : WGM;
        u.pm = fm + ((wgid % nig) % gsz); u.pn = (wgid % nig) / gsz; return true;
    }
    __device__ __forceinline__ void a_ready(const Unit&) const {}
    __device__ __forceinline__ void done(const Unit&) const {}
};


template <class Epi, class Sched, bool ALIGN_EPI = false, bool SP2 = false>
__device__ __forceinline__ void gemm_phase(PG8_LAS unsigned char* lds, const Gemm g, const Sched& S, const Epi& E) {
    int wid_ = g.wv; asm volatile("" : "+s"(wid_));
    const int tid = tid_l(wid_), wid = wid_, lane = tid & 63, wr = wid >> 2, wc = wid & 3, fr = lane & 15, fq = lane >> 4;
    const int K = g.K, nt = K / BK;
    unsigned voffA[2], voffB[2];
#pragma unroll
    for (int i = 0; i < 2; ++i) { int R, C; stage_rc(tid * 16 + i * 8192, R, C); const int Rb = Epi::PERM ? ((R & ~31) + perm32(R & 31)) : R;
        voffA[i] = (unsigned)(R * g.lda + C) * 2u; voffB[i] = (unsigned)(Rb * g.ldb + C) * 2u; }
    const size_t kstep = (size_t)(BK * 2);
    const size_t hstepA = (size_t)HALF * g.lda * 2, hstepB = (size_t)HALF * g.ldb * 2;
    const size_t tstepA = 2 * hstepA, tstepB = 2 * hstepB;
    const unsigned ldsw = (unsigned)wid * 1024u;
    const int aoff = lds_byte(wr * 64 + fr, fq * 8), boff = lds_byte(wc * 32 + fr, fq * 8);
#define PG8_SA(b, h) (((b) * 2 + (h)) * HTB)
#define PG8_SB(b, h) ((4 + (b) * 2 + (h)) * HTB)
#define PG8_STAGE(bufoff, gbase, voff) do { _Pragma("unroll") for (int _i = 0; _i < 2; ++_i) \
        __builtin_amdgcn_global_load_lds((const unsigned*)((const char*)(gbase) + (voff)[_i]), (PG8_LAS unsigned*)(lds + (bufoff) + ldsw + _i * 8192), 16, 0, 0); } while (0)
#define PG8_LDA(dst, b, h) do { _Pragma("unroll") for (int m = 0; m < 4; ++m) _Pragma("unroll") for (int k = 0; k < 2; ++k) dst[m][k] = *(const PG8_LAS bf16x8*)(lds + PG8_SA(b, h) + aoff + m * 2048 + k * 1024); } while (0)
#define PG8_LDB(dst, b, h) do { _Pragma("unroll") for (int n = 0; n < 2; ++n) _Pragma("unroll") for (int k = 0; k < 2; ++k) dst[n][k] = *(const PG8_LAS bf16x8*)(lds + PG8_SB(b, h) + boff + n * 2048 + k * 1024); } while (0)
#define PG8_MMA(ai, bj, At, Bt) do { __builtin_amdgcn_s_setprio(1); _Pragma("unroll") for (int m = 0; m < 4; ++m) _Pragma("unroll") for (int n = 0; n < 2; ++n) _Pragma("unroll") for (int k = 0; k < 2; ++k) \
        acc[ai][bj][m][n] = __builtin_amdgcn_mfma_f32_16x16x32_bf16(Bt[n][k], At[m][k], acc[ai][bj][m][n], 0, 0, 0); __builtin_amdgcn_s_setprio(0); } while (0)
#define PG8_WAIT_V(n) asm volatile("s_waitcnt vmcnt(" #n ")" ::: "memory")
#define PG8_WAIT_L(n) asm volatile("s_waitcnt lgkmcnt(" #n ")" ::: "memory")
#define PG8_BAR __builtin_amdgcn_s_barrier()
#define PG8_SCHED __builtin_amdgcn_sched_barrier(0)
    Unit cur, nxt; int ui = 0;
    if (!S.next(0, cur)) return;
    f32x4 acc[2][2][4][2];
#pragma unroll
    for (int a = 0; a < 2; ++a)
#pragma unroll
        for (int b = 0; b < 2; ++b)
#pragma unroll
            for (int m = 0; m < 4; ++m)
#pragma unroll
                for (int n = 0; n < 2; ++n) acc[a][b][m][n] = (f32x4){0.f, 0.f, 0.f, 0.f};
    bf16x8 At[4][2], B0[2][2], B1[2][2];
    const char* cA = (const char*)g.A + (size_t)cur.pm * tstepA; const char* cB = (const char*)g.Bt + (size_t)cur.pn * tstepB;
    S.a_ready(cur);
    if constexpr (SP2) {
        PG8_STAGE(PG8_SB(0, 0), cB, voffB); PG8_STAGE(PG8_SB(0, 1), cB + hstepB, voffB); PG8_STAGE(PG8_SA(0, 0), cA, voffA); PG8_STAGE(PG8_SA(0, 1), cA + hstepA, voffA);
        if (wr == 1) PG8_BAR;
        PG8_WAIT_V(2); PG8_BAR;
        PG8_STAGE(PG8_SB(1, 0), cB + kstep, voffB); PG8_STAGE(PG8_SA(1, 0), cA + kstep, voffA); PG8_STAGE(PG8_SB(1, 1), cB + hstepB + kstep, voffB);
        PG8_WAIT_V(6); PG8_BAR;
    } else {
        PG8_STAGE(PG8_SB(0, 0), cB, voffB); PG8_STAGE(PG8_SA(0, 0), cA, voffA); PG8_STAGE(PG8_SB(0, 1), cB + hstepB, voffB); PG8_STAGE(PG8_SA(0, 1), cA + hstepA, voffA);
        if (wr == 1) PG8_BAR;
        PG8_WAIT_V(4); PG8_BAR;
        PG8_STAGE(PG8_SB(1, 0), cB + kstep, voffB); PG8_STAGE(PG8_SA(1, 0), cA + kstep, voffA); PG8_STAGE(PG8_SB(1, 1), cB + hstepB + kstep, voffB);
        PG8_WAIT_V(6); PG8_BAR;
    }
    for (;;) {
        const bool has_next = S.next(ui + 1, nxt);
        const char* nA = has_next ? (const char*)g.A + (size_t)nxt.pm * tstepA : cA; const char* nB = has_next ? (const char*)g.Bt + (size_t)nxt.pn * tstepB : cB;
        for (int t = 0; t < nt; t += 2) {
            const bool last = (t == nt - 2);
            const char* a1 = cA + (size_t)(t + 1) * kstep;
            const char* a2 = last ? nA : cA + (size_t)(t + 2) * kstep; const char* b2 = last ? nB : cB + (size_t)(t + 2) * kstep;
            const char* a3 = a2 + kstep; const char* b3 = b2 + kstep;
            if (last && has_next) S.a_ready(nxt);
            if constexpr (SP2) {
            PG8_LDB(B0, 0, 0); PG8_LDB(B1, 0, 1); PG8_SCHED; PG8_LDA(At, 0, 0); PG8_STAGE(PG8_SA(1, 1), a1 + hstepA, voffA);
            PG8_WAIT_V(8); PG8_WAIT_L(0); PG8_BAR; PG8_MMA(0, 0, At, B0); PG8_MMA(0, 1, At, B1); PG8_BAR; PG8_SCHED;
            PG8_LDA(At, 0, 1); PG8_STAGE(PG8_SB(0, 0), b2, voffB); PG8_STAGE(PG8_SB(0, 1), b2 + hstepB, voffB); PG8_STAGE(PG8_SA(0, 0), a2, voffA);
            PG8_WAIT_V(8); PG8_WAIT_L(0); PG8_BAR; PG8_MMA(1, 0, At, B0); PG8_MMA(1, 1, At, B1); PG8_BAR; PG8_SCHED;
            PG8_LDB(B0, 1, 0); PG8_LDB(B1, 1, 1); PG8_SCHED; PG8_LDA(At, 1, 0); PG8_STAGE(PG8_SA(0, 1), a2 + hstepA, voffA);
            PG8_WAIT_V(8); PG8_WAIT_L(0); PG8_BAR; PG8_MMA(0, 0, At, B0); PG8_MMA(0, 1, At, B1); PG8_BAR; PG8_SCHED;
            PG8_LDA(At, 1, 1); PG8_STAGE(PG8_SB(1, 0), b3, voffB); PG8_STAGE(PG8_SB(1, 1), b3 + hstepB, voffB); PG8_STAGE(PG8_SA(1, 0), a3, voffA);
            PG8_WAIT_V(8); PG8_WAIT_L(0); PG8_BAR; PG8_MMA(1, 0, At, B0); PG8_MMA(1, 1, At, B1); PG8_BAR; PG8_SCHED;
            } else {
            PG8_LDB(B0, 0, 0); PG8_SCHED; PG8_LDA(At, 0, 0); PG8_STAGE(PG8_SA(1, 1), a1 + hstepA, voffA);
            PG8_WAIT_L(8); PG8_BAR; PG8_WAIT_L(0); PG8_MMA(0, 0, At, B0); PG8_BAR; PG8_SCHED;
            PG8_LDB(B1, 0, 1); PG8_STAGE(PG8_SB(0, 0), b2, voffB);
            PG8_BAR; PG8_WAIT_L(0); PG8_MMA(0, 1, At, B1); PG8_BAR;
            PG8_LDA(At, 0, 1); PG8_STAGE(PG8_SA(0, 0), a2, voffA);
            PG8_BAR; PG8_WAIT_L(0); PG8_MMA(1, 0, At, B0); PG8_BAR; PG8_SCHED;
            PG8_STAGE(PG8_SB(0, 1), b2 + hstepB, voffB);
            PG8_WAIT_V(6); PG8_BAR; PG8_MMA(1, 1, At, B1); PG8_BAR;
            PG8_LDB(B0, 1, 0); PG8_SCHED; PG8_LDA(At, 1, 0); PG8_STAGE(PG8_SA(0, 1), a2 + hstepA, voffA);
            PG8_WAIT_L(8); PG8_BAR; PG8_WAIT_L(0); PG8_MMA(0, 0, At, B0); PG8_BAR; PG8_SCHED;
            PG8_LDB(B1, 1, 1); PG8_STAGE(PG8_SB(1, 0), b3, voffB);
            PG8_BAR; PG8_WAIT_L(0); PG8_MMA(0, 1, At, B1); PG8_BAR;
            PG8_LDA(At, 1, 1); PG8_STAGE(PG8_SA(1, 0), a3, voffA);
            PG8_BAR; PG8_WAIT_L(0); PG8_MMA(1, 0, At, B0); PG8_BAR; PG8_SCHED;
            PG8_STAGE(PG8_SB(1, 1), b3 + hstepB, voffB);
            PG8_WAIT_V(6); PG8_BAR; PG8_MMA(1, 1, At, B1); PG8_BAR;
            }
        }
        if constexpr (ALIGN_EPI) { if (wr == 0) PG8_BAR; }
        if constexpr (!Epi::AFTER_DRAIN) { E(acc, cur, wr, wc, fr, fq); S.done(cur); }
        if (!has_next) break;
#pragma unroll
        for (int a = 0; a < 2; ++a)
#pragma unroll
            for (int b = 0; b < 2; ++b)
#pragma unroll
                for (int m = 0; m < 4; ++m)
#pragma unroll
                    for (int n = 0; n < 2; ++n) acc[a][b][m][n] = (f32x4){0.f, 0.f, 0.f, 0.f};
        cur = nxt; cA = nA; cB = nB; ++ui;
        if constexpr (ALIGN_EPI) { if (wr == 1) PG8_BAR; }
    }
    PG8_WAIT_V(0);
    if constexpr (!ALIGN_EPI) { if (wr == 0) PG8_BAR; }
    PG8_BAR;
    if constexpr (Epi::AFTER_DRAIN) { E.fused(acc, cur, wr, wc, fr, fq, lds, wid, lane); S.done(cur); }
#undef PG8_SA
#undef PG8_SB
#undef PG8_STAGE
#undef PG8_LDA
#undef PG8_LDB
#undef PG8_MMA
#undef PG8_WAIT_V
#undef PG8_WAIT_L
#undef PG8_BAR
#undef PG8_SCHED
}
}

namespace pg8 {
struct OneUnit {
    __device__ __forceinline__ bool next(int i, Unit& u) const { if (i) return false; u.pm = 0; u.pn = 0; return true; }
    __device__ __forceinline__ void a_ready(const Unit&) const {}
    __device__ __forceinline__ void done(const Unit&) const {}
};
typedef f32x4 AccT[2][2][4][2];

struct EpiQKV {
    static constexpr bool PERM = true, AFTER_DRAIN = false;
    bf16_t* Q; float* newk; float qscale;
    __device__ __forceinline__ void operator()(const AccT& acc, const Unit& u, int wr, int wc, int fr, int fq) const {
        const int t = u.pn >> 2;
        bf16_t* base = Q + (size_t)t * MT * D;
        const float sc = t == 0 ? qscale : 1.f;
        float* fo = newk + (size_t)(t - 1) * MC * D;
        const bool wf = (t != 0) && (u.pm < MC / 256);
        const int colt = (u.pn & 3) * 256 + wc * 32 + 8 * fq, row0 = u.pm * 256 + wr * 64 + fr;
#pragma unroll
        for (int ai = 0; ai < 2; ++ai)
#pragma unroll
            for (int m = 0; m < 4; ++m) {
                const size_t ro = (size_t)(row0 + ai * 128 + m * 16) * D;
#pragma unroll
                for (int bj = 0; bj < 2; ++bj) {
                    const f32x4 v0 = acc[ai][bj][m][0] * sc, v1 = acc[ai][bj][m][1] * sc;
                    u32x4 w; w.x = pk_bf16(v0[0], v0[1]); w.y = pk_bf16(v0[2], v0[3]); w.z = pk_bf16(v1[0], v1[1]); w.w = pk_bf16(v1[2], v1[3]);
                    *(u32x4*)(base + ro + colt + bj * 128) = w;
                    if (wf) { *(f32x4*)(fo + ro + colt + bj * 128) = v0; *(f32x4*)(fo + ro + colt + bj * 128 + 4) = v1; }
                }
            }
    }
};
template <bool FUSE, bool SRCF32> struct EpiResT {
    static constexpr bool PERM = true, AFTER_DRAIN = false;
    const float *xa, *xb;
    bf16_t* xres;
    const float* gate;
    bf16_t* XNo; const float* gn; const float* scv; float* ssq;
    __device__ __forceinline__ void operator()(const AccT& acc, const Unit& u, int wr, int wc, int fr, int fq) const {
        const bool isc = u.pm < MC / 256;
        const int cv = isc ? 8 : ((u.pm - MC / 256) >> 2);
        const float* src = isc ? xa : xb - (size_t)MC * D;
        const int col0 = u.pn * 256 + wc * 32 + 8 * fq, row0 = u.pm * 256 + wr * 64 + fr;
        f32x4 gv[2][2], gm[2][2];
#pragma unroll
        for (int bj = 0; bj < 2; ++bj)
#pragma unroll
            for (int n = 0; n < 2; ++n) {
                const int c = col0 + bj * 128 + n * 4;
                gv[bj][n] = *(const f32x4*)(gate + (size_t)cv * NMOD + c);
                if (FUSE) gm[bj][n] = *(const f32x4*)(gn + c) * (*(const f32x4*)(scv + (size_t)cv * NMOD + c) + 1.f);
            }
#pragma unroll
        for (int ai = 0; ai < 2; ++ai)
#pragma unroll
        for (int mp = 0; mp < 2; ++mp) {
            f32x4 xs[2][2][2];
#pragma unroll
            for (int mm = 0; mm < 2; ++mm)
#pragma unroll
                for (int bj = 0; bj < 2; ++bj) {
                    const size_t o = (size_t)(row0 + ai * 128 + (2 * mp + mm) * 16) * D + col0 + bj * 128;
                    if (SRCF32) { xs[mm][bj][0] = *(const f32x4*)(src + o); xs[mm][bj][1] = *(const f32x4*)(src + o + 4); }
                    else { const u32x4 w = *(const u32x4*)(xres + o); xs[mm][bj][0] = (f32x4){bf_lo(w.x), bf_hi(w.x), bf_lo(w.y), bf_hi(w.y)}; xs[mm][bj][1] = (f32x4){bf_lo(w.z), bf_hi(w.z), bf_lo(w.w), bf_hi(w.w)}; }
                }
            asm volatile("" ::: "memory");
#pragma unroll
            for (int mm = 0; mm < 2; ++mm) {
                const int m = 2 * mp + mm;
                const int row = row0 + ai * 128 + m * 16;
                const size_t ro = (size_t)row * D + col0;
                float sq = 0.f;
#pragma unroll
                for (int bj = 0; bj < 2; ++bj) {
                    const f32x4 x0 = xs[mm][bj][0] + gv[bj][0] * acc[ai][bj][m][0], x1 = xs[mm][bj][1] + gv[bj][1] * acc[ai][bj][m][1];
                    { u32x4 w; w.x = pk_bf16(x0[0], x0[1]); w.y = pk_bf16(x0[2], x0[3]); w.z = pk_bf16(x1[0], x1[1]); w.w = pk_bf16(x1[2], x1[3]); *(u32x4*)(xres + ro + bj * 128) = w; }
                    if (FUSE) {
                        sq += ((x0[0] * x0[0] + x0[1] * x0[1]) + (x0[2] * x0[2] + x0[3] * x0[3])) + ((x1[0] * x1[0] + x1[1] * x1[1]) + (x1[2] * x1[2] + x1[3] * x1[3]));
                        const f32x4 y0 = x0 * gm[bj][0], y1 = x1 * gm[bj][1];
                        u32x4 w; w.x = pk_bf16(y0[0], y0[1]); w.y = pk_bf16(y0[2], y0[3]); w.z = pk_bf16(y1[0], y1[1]); w.w = pk_bf16(y1[2], y1[3]);
                        *(u32x4*)(XNo + ro + bj * 128) = w;
                    }
                }
                if (FUSE) { sq += shfl_xor_l(sq, 16, fr + 16 * fq); sq += shfl_xor_l(sq, 32, fr + 16 * fq); if (fq == 0) unsafeAtomicAdd(ssq + row, sq); }
            }
            asm volatile("" ::: "memory");
        }
    }
};
struct EpiResFinal {
    static constexpr bool PERM = true, AFTER_DRAIN = false;
    const bf16_t* xres; const float* gate; float* ssq; unsigned* cnt; const float* gfin; float* out;
    __device__ __forceinline__ void operator()(const AccT& acc_c, const Unit& u, int wr, int wc, int fr, int fq) const {
        AccT& acc = const_cast<AccT&>(acc_c);
        const int cv = u.pm < MC / 256 ? 8 : ((u.pm - MC / 256) >> 2);
        const int col0 = u.pn * 256 + wc * 32 + 8 * fq, row0 = u.pm * 256 + wr * 64 + fr, lane = fr + 16 * fq;
        f32x4 gv[2][2];
#pragma unroll
        for (int bj = 0; bj < 2; ++bj)
#pragma unroll
            for (int n = 0; n < 2; ++n) gv[bj][n] = *(const f32x4*)(gate + (size_t)cv * NMOD + col0 + bj * 128 + n * 4);
#pragma unroll
        for (int ai = 0; ai < 2; ++ai)
#pragma unroll
        for (int mp = 0; mp < 2; ++mp) {
            u32x4 xs[2][2];
#pragma unroll
            for (int mm = 0; mm < 2; ++mm)
#pragma unroll
                for (int bj = 0; bj < 2; ++bj) xs[mm][bj] = *(const u32x4*)(xres + (size_t)(row0 + ai * 128 + (2 * mp + mm) * 16) * D + col0 + bj * 128);
            asm volatile("" ::: "memory");
#pragma unroll
            for (int mm = 0; mm < 2; ++mm) {
                const int m = 2 * mp + mm;
                float sq = 0.f;
#pragma unroll
                for (int bj = 0; bj < 2; ++bj) {
                    const u32x4 w = xs[mm][bj];
                    const f32x4 x0 = (f32x4){bf_lo(w.x), bf_hi(w.x), bf_lo(w.y), bf_hi(w.y)} + gv[bj][0] * acc[ai][bj][m][0], x1 = (f32x4){bf_lo(w.z), bf_hi(w.z), bf_lo(w.w), bf_hi(w.w)} + gv[bj][1] * acc[ai][bj][m][1];
                    acc[ai][bj][m][0] = x0; acc[ai][bj][m][1] = x1;
                    sq += ((x0[0] * x0[0] + x0[1] * x0[1]) + (x0[2] * x0[2] + x0[3] * x0[3])) + ((x1[0] * x1[0] + x1[1] * x1[1]) + (x1[2] * x1[2] + x1[3] * x1[3]));
                }
                sq += shfl_xor_l(sq, 16, lane); sq += shfl_xor_l(sq, 32, lane);
                if (fq == 0) unsafeAtomicAdd(ssq + row0 + ai * 128 + m * 16, sq);
            }
        }
        asm volatile("s_waitcnt vmcnt(0)" ::: "memory");
        unsigned* c = cnt + 64 * u.pm;
        if (lane == 0) __hip_atomic_fetch_add(c, 1u, __ATOMIC_RELAXED, __HIP_MEMORY_SCOPE_AGENT);
        { unsigned sp = 0;
          while ((unsigned)__builtin_amdgcn_readfirstlane(__hip_atomic_load(c, __ATOMIC_RELAXED, __HIP_MEMORY_SCOPE_AGENT)) < 32u) { __builtin_amdgcn_s_sleep(2); if (++sp > (1u << 20)) break; } }
        float rs[2][4];
#pragma unroll
        for (int ai = 0; ai < 2; ++ai)
#pragma unroll
            for (int m = 0; m < 4; ++m) rs[ai][m] = __hip_atomic_load(ssq + row0 + ai * 128 + m * 16, __ATOMIC_RELAXED, __HIP_MEMORY_SCOPE_AGENT);
        f32x4 gf[2][2];
#pragma unroll
        for (int bj = 0; bj < 2; ++bj)
#pragma unroll
            for (int n = 0; n < 2; ++n) gf[bj][n] = *(const f32x4*)(gfin + col0 + bj * 128 + n * 4);
#pragma unroll
        for (int ai = 0; ai < 2; ++ai)
#pragma unroll
            for (int m = 0; m < 4; ++m) {
                const float rstd = __builtin_amdgcn_rsqf(rs[ai][m] * (1.f / D) + RMS_EPS);
                float* op = out + (size_t)(row0 + ai * 128 + m * 16) * D + col0;
#pragma unroll
                for (int bj = 0; bj < 2; ++bj) { *(f32x4*)(op + bj * 128) = acc[ai][bj][m][0] * rstd * gf[bj][0]; *(f32x4*)(op + bj * 128 + 4) = acc[ai][bj][m][1] * rstd * gf[bj][1]; }
            }
    }
};
struct EpiSwiglu {
    static constexpr bool PERM = true, AFTER_DRAIN = false;
    bf16_t* H; const float* ssq; const float* shw;
    __device__ __forceinline__ void operator()(const AccT& acc, const Unit& u, int wr, int wc, int fr, int fq) const {
        const int cv = u.pm < MC / 256 ? 8 : ((u.pm - MC / 256) >> 2);
        const int col0 = u.pn * 128 + wc * 32 + 8 * fq, row0 = u.pm * 256 + wr * 64 + fr;
        const float* sp = shw + (size_t)cv * 2 * FF + u.pn * 256 + wc * 32 + 8 * fq;
        const f32x4 sg0 = *(const f32x4*)(sp), sg1 = *(const f32x4*)(sp + 4), su0 = *(const f32x4*)(sp + 128), su1 = *(const f32x4*)(sp + 132);
        float rs[2][4];
#pragma unroll
        for (int ai = 0; ai < 2; ++ai)
#pragma unroll
            for (int m = 0; m < 4; ++m) rs[ai][m] = ssq[row0 + ai * 128 + m * 16];
        asm volatile("" ::: "memory");
#pragma unroll
        for (int ai = 0; ai < 2; ++ai)
#pragma unroll
            for (int m = 0; m < 4; ++m) rs[ai][m] = __builtin_amdgcn_rsqf(rs[ai][m] * (1.f / D) + RMS_EPS);
#pragma unroll
        for (int ai = 0; ai < 2; ++ai)
#pragma unroll
            for (int m = 0; m < 4; ++m) {
                const int row = row0 + ai * 128 + m * 16;
                const float rstd = rs[ai][m];
                float o[8];
#pragma unroll
                for (int n = 0; n < 2; ++n) {
                    const f32x4 gq = acc[ai][0][m][n] * rstd + (n ? sg1 : sg0), uq = acc[ai][1][m][n] * rstd + (n ? su1 : su0);
#pragma unroll
                    for (int j = 0; j < 4; ++j) o[n * 4 + j] = silu_f(gq[j]) * uq[j];
                }
                u32x4 w; w.x = pk_bf16(o[0], o[1]); w.y = pk_bf16(o[2], o[3]); w.z = pk_bf16(o[4], o[5]); w.w = pk_bf16(o[6], o[7]);
                *(u32x4*)(H + (size_t)row * FF + col0) = w;
            }
    }
};
struct EpiWin {
    static constexpr bool PERM = true, AFTER_DRAIN = false;
    bf16_t *G, *XR; const float* ssq; const float* shw;
    __device__ __forceinline__ void operator()(const AccT& acc, const Unit& u, int wr, int wc, int fr, int fq) const {
        const bool isg = u.pn < 4;
        const int cv = u.pm < MC / 256 ? 8 : ((u.pm - MC / 256) >> 2);
        bf16_t* base = isg ? G : XR;
        const int colt = (u.pn & 3) * 256 + wc * 32 + 8 * fq, row0 = u.pm * 256 + wr * 64 + fr;
        const float* sp = shw + (size_t)cv * 2 * D + u.pn * 256 + wc * 32 + 8 * fq;
        f32x4 sv[2][2];
#pragma unroll
        for (int bj = 0; bj < 2; ++bj) { sv[bj][0] = *(const f32x4*)(sp + bj * 128); sv[bj][1] = *(const f32x4*)(sp + bj * 128 + 4); }
        float rs[2][4];
#pragma unroll
        for (int ai = 0; ai < 2; ++ai)
#pragma unroll
            for (int m = 0; m < 4; ++m) rs[ai][m] = ssq[row0 + ai * 128 + m * 16];
        asm volatile("" ::: "memory");
#pragma unroll
        for (int ai = 0; ai < 2; ++ai)
#pragma unroll
            for (int m = 0; m < 4; ++m) rs[ai][m] = __builtin_amdgcn_rsqf(rs[ai][m] * (1.f / D) + RMS_EPS);
#pragma unroll
        for (int ai = 0; ai < 2; ++ai)
#pragma unroll
            for (int m = 0; m < 4; ++m) {
                const int row = row0 + ai * 128 + m * 16;
                const float rstd = rs[ai][m];
#pragma unroll
                for (int bj = 0; bj < 2; ++bj) {
                    f32x4 v0 = acc[ai][bj][m][0] * rstd + sv[bj][0], v1 = acc[ai][bj][m][1] * rstd + sv[bj][1];
                    if (isg) {
#pragma unroll
                        for (int j = 0; j < 4; ++j) { v0[j] = gelu_tanh_f(v0[j]); v1[j] = gelu_tanh_f(v1[j]); }
                    }
                    u32x4 w; w.x = pk_bf16(v0[0], v0[1]); w.y = pk_bf16(v0[2], v0[3]); w.z = pk_bf16(v1[0], v1[1]); w.w = pk_bf16(v1[2], v1[3]);
                    *(u32x4*)(base + (size_t)row * D + colt + bj * 128) = w;
                }
            }
    }
};
struct EpiLru {
    static constexpr bool PERM = true, AFTER_DRAIN = true;
    LAS const unsigned long long* ptab;
    const float* h0;
    int row_base, cb, dir, q;

    template <int AI>
    __device__ __forceinline__ void half(const AccT& acc, int wr, int wc, int fr, int fq, PG8_LAS unsigned char* lds, int tid,
                                         const u32x4 (&xall)[4], bf16_t* HL, bf16_t* PP) const {
#pragma unroll
        for (int m = 0; m < 4; ++m) {
            const int tl = wr * 64 + m * 16 + fr;
            const size_t row = (size_t)(row_base + AI * 128 + tl);
#pragma unroll
            for (int n = 0; n < 2; ++n) {
                asm volatile("" ::: "memory");
                const int chl = wc * 32 + 8 * fq + 4 * n;
                const PG8_LAS f32x4* cst = (const PG8_LAS f32x4*)(lds + CST_OFF + chl * 4);
                const f32x4 ba = cst[0], bi = cst[32], L2 = cst[64];
                u32x2 xw; xw.x = n ? xall[m].z : xall[m].x; xw.y = n ? xall[m].w : xall[m].y;
                const f32x4 xc = {bf_lo(xw.x), bf_hi(xw.x), bf_lo(xw.y), bf_hi(xw.y)};
                f32x4 av, bv;
#pragma unroll
                for (int j = 0; j < 4; ++j) {
                    const float za = acc[AI][0][m][n][j] + ba[j], zi = acc[AI][1][m][n][j] + bi[j];
                    const float r = sigmoid_f(za), ig = sigmoid_f(zi);
                    const float a = fast_exp2(r * L2[j]);
                    av[j] = a; bv[j] = __builtin_amdgcn_sqrtf(1.f - a * a) * (ig * xc[j]);
                }
                PG8_LAS f32x4* dst = (PG8_LAS f32x4*)(lds + tl * AB_PITCH + chl * 8);
                dst[0] = (f32x4){av[0], bv[0], av[1], bv[1]}; dst[1] = (f32x4){av[2], bv[2], av[3], bv[3]};
            }
        }
        __syncthreads();
        if (tid < 128) {
            PG8_LAS float* hst = (PG8_LAS float*)(lds + HST_OFF);
            float h = hst[tid], P = hst[128 + tid];
            PG8_LAS f32x2* col = (PG8_LAS f32x2*)(lds + tid * 8);
            if (dir == 0) {
#pragma unroll 8
                for (int t = 0; t < 128; ++t) { PG8_LAS f32x2* p = (PG8_LAS f32x2*)((PG8_LAS unsigned char*)col + t * AB_PITCH); const f32x2 ab = *p; h = ab.x * h + ab.y; P *= ab.x; *p = (f32x2){h, P}; }
            } else {
#pragma unroll 8
                for (int t = 127; t >= 0; --t) { PG8_LAS f32x2* p = (PG8_LAS f32x2*)((PG8_LAS unsigned char*)col + t * AB_PITCH); const f32x2 ab = *p; h = ab.x * h + ab.y; P *= ab.x; *p = (f32x2){h, P}; }
            }
            hst[tid] = h; hst[128 + tid] = P;
        }
        __syncthreads();
        const bool lat = row_base >= MC;
#pragma unroll
        for (int it = 0; it < 8; ++it) {
            const int idx = it * 512 + tid, tl = idx >> 5, c4 = (idx & 31) * 4;
            const PG8_LAS f32x4* src = (const PG8_LAS f32x4*)(lds + tl * AB_PITCH + c4 * 8);
            const f32x4 s0 = src[0], s1 = src[1];
            const size_t row = (size_t)(row_base + AI * 128 + tl);
            { u32x2 wh; wh.x = pk_bf16(s0[0], s0[2]); wh.y = pk_bf16(s1[0], s1[2]); *(u32x2*)(HL + row * D + cb + c4) = wh; }
            if (lat) { u32x2 w; w.x = pk_bf16(s0[1], s0[3]); w.y = pk_bf16(s1[1], s1[3]); *(u32x2*)(PP + (row - MC) * D + cb + c4) = w; }
        }
        __syncthreads();
    }
    __device__ __forceinline__ void fused(AccT& acc, const Unit&, int wr, int wc, int fr, int fq, PG8_LAS unsigned char* lds, int wid, int lane) const {
        const int tid = wid * 64 + lane;
        const PT pt{ptab};
        unsigned char* ws = pt.ws();
        PG8_LAS float* hst = (PG8_LAS float*)(lds + HST_OFF);
        PG8_LAS float* cst = (PG8_LAS float*)(lds + CST_OFF);
        if (tid < 128) {
            hst[tid] = h0 ? h0[cb + tid] : 0.f; hst[128 + tid] = 1.f;
            const int ch = dir * D + cb + tid;
            cst[tid] = pt.f(I_b_a)[ch]; cst[128 + tid] = pt.f(I_b_i)[ch];
            const float l = pt.f(I_lam)[ch];
            const float x = __expf(-l);
            const float sp = x < 0.03f ? x * (1.f - x * (0.5f - x * (0.33333334f - 0.25f * x))) : __logf(1.f + x);
            cst[256 + tid] = -8.0f * sp * LOG2E;
        }
        __syncthreads();
        const bf16_t* XC = (const bf16_t*)(ws + WS_XN);
        bf16_t* HL = (bf16_t*)(ws + (dir ? WS_HLB : WS_HLF));
        bf16_t* PP = (bf16_t*)(ws + (dir ? WS_PB : WS_PF));
        u32x4 xc0[4], xc1[4];
#pragma unroll
        for (int m = 0; m < 4; ++m) {
            xc0[m] = *(const u32x4*)(XC + (size_t)(row_base + wr * 64 + m * 16 + fr) * D + cb + wc * 32 + 8 * fq);
            xc1[m] = *(const u32x4*)(XC + (size_t)(row_base + 128 + wr * 64 + m * 16 + fr) * D + cb + wc * 32 + 8 * fq);
        }
        if (dir == 0) { half<0>(acc, wr, wc, fr, fq, lds, tid, xc0, HL, PP); half<1>(acc, wr, wc, fr, fq, lds, tid, xc1, HL, PP); }
        else          { half<1>(acc, wr, wc, fr, fq, lds, tid, xc1, HL, PP); half<0>(acc, wr, wc, fr, fq, lds, tid, xc0, HL, PP); }
        if (tid < 128) {
            const float h = hst[tid], P = hst[128 + tid];
            float* sumE = (float*)(ws + WS_SUME) + (size_t)dir * 48 * D; float* sumP = (float*)(ws + WS_SUMP) + (size_t)dir * 48 * D;
            sumE[(size_t)q * D + cb + tid] = h; sumP[(size_t)q * D + cb + tid] = P;
            if (row_base < MC) pt.out()[OUT_NH + (size_t)q * 2 * D + dir * D + cb + tid] = h;
        }
        __syncthreads();
    }
};
}
namespace att {
constexpr int KP = 144, VP = 136;
constexpr int K_OFF = 0, V_OFF = 2 * 64 * KP, F_OFF = V_OFF + 2 * 64 * KP, T_OFF = F_OFF + 8 * 32 * 4, A_END = T_OFF + 640 * 4;
typedef short v4i16_t __attribute__((ext_vector_type(4)));
#define MFMA32(a, b, c) __builtin_amdgcn_mfma_f32_32x32x16_bf16((a), (b), (c), 0, 0, 0)
__device__ __forceinline__ float max2f(float a, float b) { float r; asm("v_max_f32_e32 %0, %1, %2" : "=v"(r) : "v"(a), "v"(b)); return r; }
__device__ __forceinline__ float max3f(float a, float b, float c) { float r; asm("v_max3_f32 %0, %1, %2, %3" : "=v"(r) : "v"(a), "v"(b), "v"(c)); return r; }
__device__ __forceinline__ int crow(int r, int hi) { return (r & 3) + 8 * (r >> 2) + 4 * hi; }

template <bool NA>
__device__ __forceinline__ void unit(int wv, LAS unsigned char* lds, int b, int h, int g, const bf16_t* __restrict__ Qb, const bf16_t* __restrict__ Kb, const bf16_t* __restrict__ Vb,
                                     const bf16_t* __restrict__ CK, const bf16_t* __restrict__ CV, bf16_t* __restrict__ Ob, const float* __restrict__ rpb) {
    int wid_ = wv; asm volatile("" : "+s"(wid_));
    const int tid = tid_l(wid_), lane = tid & 63, wid = wid_, r32 = lane & 31, hi = lane >> 5;
    LAS float* fscr = (LAS float*)(lds + F_OFF) + wid * 32;
    LAS float* tab = (LAS float*)(lds + T_OFF);
    if (NA) { for (int i = tid; i < 15 * 31; i += 512) { const int dr = i / 31, dc = i % 31; tab[64 + dr * 32 + dc] = rpb[(h * 15 + dr) * 31 + dc] * LOG2E; } }
    int qrow, nlat, ntile, Rlo = 0, rq = 0, rs = 0;
    if (NA) {
        rq = 4 * g + (wid >> 1); rs = min(max(rq - 4, 0), 8);
        qrow = MC + b * 1024 + rq * 64 + 32 * (wid & 1) + r32;
        Rlo = min(max(4 * g - 4, 0), 8); const int Rhi = min(max(4 * g - 1, 0), 8) + 8;
        nlat = Rhi - Rlo; ntile = nlat + 8;
    } else { qrow = b * 256 + 32 * wid + r32; nlat = 4; ntile = 4; }
    const int qc = 32 * (wid & 1) + r32, cs = min(max(qc - 8, 0), 48);
    f32x16 pen0, pen1;
#pragma unroll
    for (int i = 0; i < 16; ++i) { const int kc = (i & 3) + 8 * (i >> 2) + 4 * hi - cs; pen0[i] = (NA && (unsigned)kc >= 16u) ? -1e30f : 0.f; pen1[i] = (NA && (unsigned)(kc + 32) >= 16u) ? -1e30f : 0.f; }
    bf16x8 qr[4];
#pragma unroll
    for (int s = 0; s < 4; ++s) qr[s] = *(const bf16x8*)(Qb + (size_t)qrow * D + h * 64 + 16 * s + 8 * hi);
    const int lkey = tid >> 3, lch = tid & 7;
    auto src_row = [&](int t) -> size_t {
        if (NA) return t < nlat ? (size_t)(MC + b * 1024 + (Rlo + t) * 64) : (size_t)(b * 512 + (t - nlat) * 64);
        return (size_t)(b * 256 + t * 64);
    };
    u32x4 kreg, vreg;
    auto gload = [&](int t) {
        const bool cache = NA && t >= nlat;
        const bf16_t* kp = cache ? CK : Kb; const bf16_t* vp = cache ? CV : Vb;
        const size_t off = (src_row(t) + lkey) * D + h * 64 + 8 * lch;
        kreg = *(const u32x4*)(kp + off); vreg = *(const u32x4*)(vp + off);
    };
    auto lstore = [&](int buf) {
        *(LAS u32x4*)(lds + K_OFF + buf * 64 * KP + lkey * KP + lch * 16) = kreg;
        *(LAS u32x4*)(lds + V_OFF + buf * 64 * KP + lkey * KP + lch * 16) = vreg;
    };
    float m_run = -1e30f, l_run = 0.f;
    f32x16 o0, o1;
#pragma unroll
    for (int i = 0; i < 16; ++i) { o0[i] = 0.f; o1[i] = 0.f; }
    gload(0); lstore(0);
    asm volatile("" :: "v"(qr[0]), "v"(qr[1]), "v"(qr[2]), "v"(qr[3]));
    __syncthreads();
    for (int t = 0; t < ntile; ++t) {
        const int buf = t & 1;
        if (t + 1 < ntile) gload(t + 1);
        bool active = true, biased = false; int dr = 0;
        if (NA && t < nlat) { const int R = Rlo + t; active = (R >= rs) && (R < rs + 8); biased = true; dr = R - rq + 7; }
        if (active) {
            f32x16 p0, p1;
#pragma unroll
            for (int i = 0; i < 16; ++i) { p0[i] = 0.f; p1[i] = 0.f; }
            const LAS unsigned char* kb = lds + K_OFF + buf * 64 * KP + r32 * KP + 16 * hi;
#pragma unroll
            for (int s = 0; s < 4; ++s) {
                const bf16x8 k0 = *(const LAS bf16x8*)(kb + 32 * s), k1 = *(const LAS bf16x8*)(kb + 32 * KP + 32 * s);
                p0 = MFMA32(k0, qr[s], p0); p1 = MFMA32(k1, qr[s], p1);
            }
            if (biased) {
                const LAS float* tb = tab + 64 + dr * 32 + (4 * hi - qc + 15);
                f32x16 b0, b1;
#pragma unroll
                for (int i = 0; i < 16; ++i) { const int kc = (i & 3) + 8 * (i >> 2); b0[i] = tb[kc]; b1[i] = tb[kc + 32]; }
                p0 += b0; p1 += b1; p0 += pen0; p1 += pen1;
            }
            float mxa = max3f(p0[0], p0[1], p0[2]), mxb = max3f(p0[3], p0[4], p0[5]), mxc = max3f(p1[0], p1[1], p1[2]), mxd = max3f(p1[3], p1[4], p1[5]);
            mxa = max3f(mxa, p0[6], p0[7]); mxb = max3f(mxb, p0[8], p0[9]); mxc = max3f(mxc, p1[6], p1[7]); mxd = max3f(mxd, p1[8], p1[9]);
            mxa = max3f(mxa, p0[10], p0[11]); mxb = max3f(mxb, p0[12], p0[13]); mxc = max3f(mxc, p1[10], p1[11]); mxd = max3f(mxd, p1[12], p1[13]);
            mxa = max3f(mxa, p0[14], p0[15]); mxc = max3f(mxc, p1[14], p1[15]);
            float mx = max2f(max2f(mxa, mxb), max2f(mxc, mxd));
            mx = max2f(mx, shfl_xor_l(mx, 32, lane));
            const float mnew = max2f(m_run, mx);
            const float f = fast_exp2(m_run - mnew);
            m_run = mnew;
            p0 -= mnew; p1 -= mnew;
#pragma unroll
            for (int i = 0; i < 16; ++i) { p0[i] = fast_exp2(p0[i]); p1[i] = fast_exp2(p1[i]); }
            f32x4 ls4 = {0.f, 0.f, 0.f, 0.f};
#pragma unroll
            for (int i = 0; i < 16; i += 4) ls4 += (f32x4){p0[i], p0[i + 1], p0[i + 2], p0[i + 3]} + (f32x4){p1[i], p1[i + 1], p1[i + 2], p1[i + 3]};
            const float ls = (ls4[0] + ls4[1]) + (ls4[2] + ls4[3]);
            l_run = l_run * f + ls;
            if (__any(f != 1.f)) {
                if (hi == 0) fscr[r32] = f;
                asm volatile("s_waitcnt lgkmcnt(0)" ::: "memory");
#pragma unroll
                for (int i = 0; i < 16; ++i) { const float fi = fscr[crow(i, hi)]; o0[i] *= fi; o1[i] *= fi; }
                asm volatile("s_waitcnt lgkmcnt(0)" ::: "memory");
            }
            bf16x8 pa[2][2];
#pragma unroll
            for (int s = 0; s < 2; ++s) {
                u32x4 w0, w1;
                w0.x = pk_bf16(p0[8 * s + 0], p0[8 * s + 1]); w0.y = pk_bf16(p0[8 * s + 2], p0[8 * s + 3]); w0.z = pk_bf16(p0[8 * s + 4], p0[8 * s + 5]); w0.w = pk_bf16(p0[8 * s + 6], p0[8 * s + 7]);
                w1.x = pk_bf16(p1[8 * s + 0], p1[8 * s + 1]); w1.y = pk_bf16(p1[8 * s + 2], p1[8 * s + 3]); w1.z = pk_bf16(p1[8 * s + 4], p1[8 * s + 5]); w1.w = pk_bf16(p1[8 * s + 6], p1[8 * s + 7]);
                pa[0][s] = __builtin_bit_cast(bf16x8, w0); pa[1][s] = __builtin_bit_cast(bf16x8, w1);
            }
            const int i16 = lane & 15, g16 = (lane >> 4) & 1;
            const LAS unsigned char* vb = lds + V_OFF + buf * 64 * KP + (4 * hi + (i16 >> 2)) * KP + (16 * g16 + 4 * (i16 & 3)) * 2;
#pragma unroll
            for (int blk = 0; blk < 2; ++blk)
#pragma unroll
                for (int s = 0; s < 2; ++s) {
                    const int ko = (32 * blk + 16 * s) * KP;
                    const s16x4 a0 = __builtin_bit_cast(s16x4, __builtin_amdgcn_ds_read_tr16_b64_v4i16((LAS v4i16_t*)(vb + ko))), a1 = __builtin_bit_cast(s16x4, __builtin_amdgcn_ds_read_tr16_b64_v4i16((LAS v4i16_t*)(vb + ko + 8 * KP)));
                    const s16x4 c0 = __builtin_bit_cast(s16x4, __builtin_amdgcn_ds_read_tr16_b64_v4i16((LAS v4i16_t*)(vb + ko + 64))), c1 = __builtin_bit_cast(s16x4, __builtin_amdgcn_ds_read_tr16_b64_v4i16((LAS v4i16_t*)(vb + ko + 8 * KP + 64)));
                    const bf16x8 v0 = __builtin_shufflevector(a0, a1, 0, 1, 2, 3, 4, 5, 6, 7), v1 = __builtin_shufflevector(c0, c1, 0, 1, 2, 3, 4, 5, 6, 7);
                    o0 = MFMA32(pa[blk][s], v0, o0); o1 = MFMA32(pa[blk][s], v1, o1);
                }
        }
        if (t + 1 < ntile) lstore(buf ^ 1);
        __syncthreads();
    }
    l_run += shfl_xor_l(l_run, 32, lane);
    if (hi == 0) fscr[r32] = fast_rcp(l_run);
    asm volatile("s_waitcnt lgkmcnt(0)" ::: "memory");
    const int qbase = qrow - r32;
    LAS unsigned char* stg = lds + K_OFF + wid * (32 * KP);
#pragma unroll
    for (int i = 0; i < 16; ++i) {
        const int qi = crow(i, hi); const float li = fscr[qi];
        LAS unsigned short* sp = (LAS unsigned short*)(stg + qi * KP + r32 * 2);
        sp[0] = (unsigned short)(pk_bf16(o0[i] * li, 0.f) & 0xffff); sp[32] = (unsigned short)(pk_bf16(o1[i] * li, 0.f) & 0xffff);
    }
    asm volatile("s_waitcnt lgkmcnt(0)" ::: "memory");
    {
        const int row = lane >> 1, half = lane & 1;
        bf16_t* op = Ob + (size_t)(qbase + row) * D + h * 64 + half * 32;
#pragma unroll
        for (int j = 0; j < 4; ++j) *(u32x4*)(op + 8 * j) = *(const LAS u32x4*)(stg + row * KP + half * 64 + 16 * j);
    }
    __syncthreads();
}
}
#ifndef REP_P4
#define REP_P4 1
#endif
#ifndef REP_ADA
#define REP_ADA 1
#endif
#ifndef REP_PRO
#define REP_PRO 1
#endif
#ifndef REP_FILL
#define REP_FILL 1
#endif
#ifndef REP_ATT
#define REP_ATT 1
#endif
#ifndef REP_GEMM
#define REP_GEMM 1
#endif
#ifndef REP_THIN
#define REP_THIN 1
#endif
#ifndef REP_LRU
#define REP_LRU 1
#endif
#ifndef REP_SYNC
#define REP_SYNC 1
#endif
struct Args {
    const float *x_prompt, *x_sample, *c, *cache_k, *cache_v, *state_h, *c_ctx, *norm_g, *w_mod, *b_mod, *w_qkv, *w_o, *rpb, *w_in, *conv_w, *conv_b,
                *w_a, *b_a, *w_i, *b_i, *lam, *w_out, *w_gu, *w_down, *final_g;
    float* out; unsigned char* ws;
};

__device__ __forceinline__ void tr_item(const float* __restrict__ W, int ldw, int k0, int n0, bf16_t* __restrict__ dst, int ldd, LAS float* scr, int lane) {
    float tv[32];
#pragma unroll
    for (int i = 0; i < 32; ++i) { const int kk = 2 * i + (lane >> 5); tv[i] = W[(size_t)(k0 + kk) * ldw + n0 + (lane & 31)]; }
#pragma unroll
    for (int i = 0; i < 32; ++i) { const int kk = 2 * i + (lane >> 5); scr[kk * 33 + (lane & 31)] = tv[i]; }
    asm volatile("s_waitcnt lgkmcnt(0)" ::: "memory");
    const int c = lane & 7;
#pragma unroll
    for (int j = 0; j < 4; ++j) {
        const int n = (lane >> 3) + 8 * j; const LAS float* s = scr + (8 * c) * 33 + n;
        u32x4 o; o.x = pk_bf16(s[0 * 33], s[1 * 33]); o.y = pk_bf16(s[2 * 33], s[3 * 33]); o.z = pk_bf16(s[4 * 33], s[5 * 33]); o.w = pk_bf16(s[6 * 33], s[7 * 33]);
        *(u32x4*)(dst + (size_t)n * ldd + k0 + 8 * c) = o;
    }
    asm volatile("s_waitcnt lgkmcnt(0)" ::: "memory");
}

__device__ __forceinline__ void tr_items(int wv, const PT pt, LAS unsigned char* lds, int it0, int it1, int gwr, int ngw) {
    const int lane = tid_l(wv) & 63;
    unsigned char* ws = pt.ws();
    {
        LAS float* scr = (LAS float*)(lds + wv * 8448);
        constexpr int I_QKV = 16 * 96, I_WO = 16 * 32, I_GU = 16 * 176, I_DN = 44 * 32, I_WIN = 16 * 64, I_WOUT = 16 * 32, I_G = 32 * 8;
        for (int it = it0 + gwr; it < it1; it += ngw) {
            int r = it;
            if (r < I_QKV) { const int kb = r / 96, nb = r % 96; tr_item(pt.f(I_w_qkv), NQKV, 64 * kb, 32 * nb, (bf16_t*)(ws + WS_WQKV) + (size_t)(32 * nb) * D, D, scr, lane); continue; } r -= I_QKV;
            if (r < I_WO) { const int kb = r / 32, nb = r % 32; tr_item(pt.f(I_w_o), D, 64 * kb, 32 * nb, (bf16_t*)(ws + WS_WO) + (size_t)(32 * nb) * D, D, scr, lane); continue; } r -= I_WO;
#pragma unroll 1
            for (int l = 0; l < 2; ++l) {
                if (r >= 0 && r < I_GU) { const int kb = r / 176, nb = r % 176; const int n0 = 32 * nb, half = n0 >= FF ? 1 : 0, c0 = n0 - half * FF;
                    const int drow = 256 * (c0 >> 7) + 128 * half + (c0 & 127);
                    tr_item(pt.f(I_w_gu) + (size_t)l * D * 2 * FF, 2 * FF, 64 * kb, n0, (bf16_t*)(ws + WS_WGU) + ((size_t)l * 2 * FF + drow) * D, D, scr, lane); r = -1; break; } r -= I_GU;
                if (r >= 0 && r < I_DN) { const int kb = r / 32, nb = r % 32;
                    tr_item(pt.f(I_w_down) + (size_t)l * FF * D, D, 64 * kb, 32 * nb, (bf16_t*)(ws + WS_WDN) + ((size_t)l * D + 32 * nb) * FF, FF, scr, lane); r = -1; break; } r -= I_DN;
            }
            if (r < 0) continue;
            if (r < I_WIN) { const int kb = r / 64, nb = r % 64; tr_item(pt.f(I_w_in), 2 * D, 64 * kb, 32 * nb, (bf16_t*)(ws + WS_WIN) + (size_t)(32 * nb) * D, D, scr, lane); continue; } r -= I_WIN;
            if (r < I_WOUT) { const int kb = r / 32, nb = r % 32; tr_item(pt.f(I_w_out), D, 64 * kb, 32 * nb, (bf16_t*)(ws + WS_WOUT) + (size_t)(32 * nb) * D, D, scr, lane); continue; } r -= I_WOUT;
            { const int mat = r >> 3, sub = r & 7, kb = sub >> 2, nb = sub & 3;
              const int gsel = mat >> 4, dir = (mat >> 3) & 1, blk = mat & 7;
              const float* src = (gsel ? pt.f(I_w_i) : pt.f(I_w_a)) + (size_t)(dir * 8 + blk) * 128 * 128;
              tr_item(src, 128, 64 * kb, 32 * nb, (bf16_t*)(ws + WS_WG) + ((size_t)((blk * 2 + dir) * 256 + gsel * 128 + 32 * nb)) * 128, 128, scr, lane); }
        }
    }
}

__device__ __forceinline__ void adaln_tasks(int wv, const PT pt, LAS unsigned char* lds, int l, int rank, int nb) {
    const int tid = tid_l(wv);
    LAS float* sl = (LAS float*)(lds + 70000);
    LAS float* red = (LAS float*)lds;
    float* mod = (float*)(pt.ws() + WS_MOD);
#pragma unroll 1
    for (int task = rank; task < 256; task += nb) {
        const int cg_ = task >> 3, kr = task & 7, col0 = cg_ * 192;
        __syncthreads();
        for (int i = tid; i < 9 * 128; i += 512) { const int cv = i >> 7, k = kr * 128 + (i & 127); const float v = cv < 8 ? pt.f(I_c)[cv * D + k] : pt.f(I_c_ctx)[k]; sl[i] = silu_f(v); }
        __syncthreads();
        if (tid < 384) {
            const int q = tid % 48, ks = tid / 48;
            float acc[9][4];
#pragma unroll
            for (int cv = 0; cv < 9; ++cv) { acc[cv][0] = 0.f; acc[cv][1] = 0.f; acc[cv][2] = 0.f; acc[cv][3] = 0.f; }
            const float* wp = pt.f(I_w_mod) + ((size_t)l * D + kr * 128 + ks * 16) * NMOD + col0 + 4 * q;
            f32x4 w[16];
#pragma unroll
            for (int k = 0; k < 16; ++k) w[k] = *(const f32x4*)(wp + (size_t)k * NMOD);
#pragma unroll
            for (int k = 0; k < 16; ++k) {
#pragma unroll
                for (int cv = 0; cv < 9; ++cv) { const float s = sl[cv * 128 + ks * 16 + k]; acc[cv][0] += s * w[k][0]; acc[cv][1] += s * w[k][1]; acc[cv][2] += s * w[k][2]; acc[cv][3] += s * w[k][3]; }
            }
#pragma unroll
            for (int cv = 0; cv < 9; ++cv) *(LAS f32x4*)(red + (ks * 9 + cv) * 192 + 4 * q) = (f32x4){acc[cv][0], acc[cv][1], acc[cv][2], acc[cv][3]};
        }
        __syncthreads();
        for (int i = tid; i < 9 * 192; i += 512) {
            const int cv = i / 192, cc = i % 192; float s = 0.f;
#pragma unroll
            for (int ks = 0; ks < 8; ++ks) s += red[(ks * 9 + cv) * 192 + cc];
            if (kr == 0) s += pt.f(I_b_mod)[l * NMOD + col0 + cc];
            unsafeAtomicAdd(mod + ((size_t)l * 9 + cv) * NMOD + col0 + cc, s);
        }
    }
    __syncthreads();
}

__device__ __forceinline__ void cache_conv(int wv, const PT pt, int rank, int nb) {
    const int tid = tid_l(wv);
    unsigned char* ws = pt.ws();
    const size_t n4 = (size_t)MC * D / 4;
#pragma unroll 8
    for (size_t i = (size_t)rank * 512 + tid; i < 2 * n4; i += (size_t)nb * 512) {
        const bool isv = i >= n4; const size_t j = isv ? i - n4 : i;
        const f32x4 v = *((const f32x4*)(isv ? pt.f(I_cache_v) : pt.f(I_cache_k)) + j);
        u32x2 w; w.x = pk_bf16(v[0], v[1]); w.y = pk_bf16(v[2], v[3]);
        *((u32x2*)(ws + (isv ? WS_CV : WS_CK)) + j) = w;
    }
}

__device__ __forceinline__ void p0_prologue(int wv, const PT pt, LAS unsigned char* lds) {
    const int tid = tid_l(wv), lane = tid & 63, wave = tid >> 6;
    const int G = gd_l(), bxl = bx_l(), gw = bxl * 8 + wave, NGW = G * 8;
    unsigned char* ws = pt.ws();
    adaln_tasks(wv, pt, lds, 0, bxl, G);
    for (int rp_ = 0; rp_ < REP_PRO; ++rp_) tr_items(wv, pt, lds, 0, 16 * 96, gw, NGW);
}

__device__ __forceinline__ void norm_phase(int wv, const float* xa, const float* xb, const float* g, const float* mod_l, int sh_chunk, bf16_t* XN) {
    const int tid = tid_l(wv), lane = tid & 63, gw = bx_l() * 8 + (tid >> 6), NGW = gd_l() * 8;
#pragma unroll 2
    for (int row = gw; row < MT; row += NGW) {
        const float* xr = row < MC ? xa + (size_t)row * D : xb + (size_t)(row - MC) * D;
        const int cv = row < MC ? 8 : ((row - MC) >> 10);
        const float* shp = mod_l + (size_t)cv * NMOD + sh_chunk * D; const float* scp = shp + D;
        f32x4 v[4], gg4[4], sc4[4], sh4[4]; float s = 0.f;
#pragma unroll
        for (int j = 0; j < 4; ++j) { const int c = 4 * lane + 256 * j; v[j] = *((const f32x4*)xr + lane + 64 * j); gg4[j] = *(const f32x4*)(g + c); sc4[j] = *(const f32x4*)(scp + c); sh4[j] = *(const f32x4*)(shp + c); }
#pragma unroll
        for (int j = 0; j < 4; ++j) s += (v[j][0] * v[j][0] + v[j][1] * v[j][1]) + (v[j][2] * v[j][2] + v[j][3] * v[j][3]);
        const float rstd = 1.f / sqrtf(wave_sum(s, lane) * (1.f / D) + RMS_EPS);
#pragma unroll
        for (int j = 0; j < 4; ++j) {
            const int c = 4 * lane + 256 * j;
            const f32x4 gg = gg4[j], sc = sc4[j], sh = sh4[j];
            const f32x4 y = v[j] * rstd * gg * (sc + 1.f) + sh;
            u32x2 w; w.x = pk_bf16(y[0], y[1]); w.y = pk_bf16(y[2], y[3]);
            *(u32x2*)(XN + (size_t)row * D + c) = w;
        }
    }
}
__device__ __forceinline__ void final_norm_phase(int wv, const bf16_t* XB, float* Y, const float* g) {
    const int tid = tid_l(wv), lane = tid & 63, gw = bx_l() * 8 + (tid >> 6), NGW = gd_l() * 8;
#pragma unroll 2
    for (int row = gw; row < MT; row += NGW) {
        const u32x4* xr = (const u32x4*)(XB + (size_t)row * D);
        f32x4 v[4], gg[4]; float s = 0.f;
#pragma unroll
        for (int j = 0; j < 2; ++j) {
            const u32x4 w = xr[lane + 64 * j];
            v[2 * j] = (f32x4){bf_lo(w.x), bf_hi(w.x), bf_lo(w.y), bf_hi(w.y)}; v[2 * j + 1] = (f32x4){bf_lo(w.z), bf_hi(w.z), bf_lo(w.w), bf_hi(w.w)};
            gg[2 * j] = *(const f32x4*)(g + 8 * lane + 512 * j); gg[2 * j + 1] = *(const f32x4*)(g + 8 * lane + 512 * j + 4);
        }
#pragma unroll
        for (int j = 0; j < 4; ++j) s += (v[j][0] * v[j][0] + v[j][1] * v[j][1]) + (v[j][2] * v[j][2] + v[j][3] * v[j][3]);
        const float rstd = 1.f / sqrtf(wave_sum(s, lane) * (1.f / D) + RMS_EPS);
        float* yr = Y + (size_t)row * D;
#pragma unroll
        for (int j = 0; j < 2; ++j) { *(f32x4*)(yr + 8 * lane + 512 * j) = v[2 * j] * rstd * gg[2 * j]; *(f32x4*)(yr + 8 * lane + 512 * j + 4) = v[2 * j + 1] * rstd * gg[2 * j + 1]; }
    }
}
__device__ __forceinline__ void conv_phase(int wv, const bf16_t* XR, const float* cw, const float* cb, bf16_t* XC) {
    const size_t n8 = (size_t)MT * D / 8;
#pragma unroll 2
    for (size_t i = (size_t)bx_l() * 512 + tid_l(wv), st_ = (size_t)gd_l() * 512; i < n8; i += st_) {
        const int row = (int)(i >> 7), c = (int)(i & 127) * 8;
        int pos, len; if (row < MC) { pos = row & 255; len = 256; } else { pos = (row - MC) & 1023; len = 1024; }
        float y[8];
#pragma unroll
        for (int e = 0; e < 8; ++e) y[e] = cb[c + e];
#pragma unroll
        for (int j = 0; j < 4; ++j) {
            const int p = pos + j - 2;
            if (p >= 0 && p < len) {
                const u32x4 xw = *(const u32x4*)(XR + (size_t)(row + j - 2) * D + c);
                const f32x4 w0 = *(const f32x4*)(cw + j * D + c), w1 = *(const f32x4*)(cw + j * D + c + 4);
                y[0] += w0[0] * bf_lo(xw.x); y[1] += w0[1] * bf_hi(xw.x); y[2] += w0[2] * bf_lo(xw.y); y[3] += w0[3] * bf_hi(xw.y);
                y[4] += w1[0] * bf_lo(xw.z); y[5] += w1[1] * bf_hi(xw.z); y[6] += w1[2] * bf_lo(xw.w); y[7] += w1[3] * bf_hi(xw.w);
            }
        }
        u32x4 o; o.x = pk_bf16(y[0], y[1]); o.y = pk_bf16(y[2], y[3]); o.z = pk_bf16(y[4], y[5]); o.w = pk_bf16(y[6], y[7]);
        *(u32x4*)(XC + (size_t)row * D + c) = o;
    }
}
__device__ __forceinline__ void conv_slab(int wv, const bf16_t* XR, const float* cw, const float* cb, bf16_t* XC, int q, int n) {
    const int tid = tid_l(wv), ch = n * 128 + (tid & 15) * 8, r0 = q * 256 + (tid >> 4) * 8;
    int pos0, len; if (r0 < MC) { pos0 = r0 & 255; len = 256; } else { pos0 = (r0 - MC) & 1023; len = 1024; }
    u32x4 x[11];
#pragma unroll
    for (int i = 0; i < 11; ++i) { const int p = pos0 + i - 2; x[i] = (p >= 0 && p < len) ? *(const u32x4*)(XR + (size_t)(r0 + i - 2) * D + ch) : (u32x4){0u, 0u, 0u, 0u}; }
    f32x4 w0[4], w1[4];
#pragma unroll
    for (int j = 0; j < 4; ++j) { w0[j] = *(const f32x4*)(cw + j * D + ch); w1[j] = *(const f32x4*)(cw + j * D + ch + 4); }
    const f32x4 b0 = *(const f32x4*)(cb + ch), b1 = *(const f32x4*)(cb + ch + 4);
#pragma unroll
    for (int r = 0; r < 8; ++r) {
        f32x4 y0 = b0, y1 = b1;
#pragma unroll
        for (int j = 0; j < 4; ++j) { const u32x4 xw = x[r + j];
            y0 += w0[j] * (f32x4){bf_lo(xw.x), bf_hi(xw.x), bf_lo(xw.y), bf_hi(xw.y)}; y1 += w1[j] * (f32x4){bf_lo(xw.z), bf_hi(xw.z), bf_lo(xw.w), bf_hi(xw.w)}; }
        u32x4 o; o.x = pk_bf16(y0[0], y0[1]); o.y = pk_bf16(y0[2], y0[3]); o.z = pk_bf16(y1[0], y1[1]); o.w = pk_bf16(y1[2], y1[3]);
        *(u32x4*)(XC + (size_t)(r0 + r) * D + ch) = o;
    }
    asm volatile("s_waitcnt vmcnt(0)" ::: "memory");
    __syncthreads();
}

__device__ __forceinline__ void lru_combine_phase(int wv, const unsigned char* ws, bf16_t* Y) {
    const bf16_t* HLF = (const bf16_t*)(ws + WS_HLF); const bf16_t* HLB = (const bf16_t*)(ws + WS_HLB);
    const bf16_t* PF = (const bf16_t*)(ws + WS_PF); const bf16_t* PB = (const bf16_t*)(ws + WS_PB); const bf16_t* GT = (const bf16_t*)(ws + WS_GATE);
    const float* sE = (const float*)(ws + WS_SUME); const float* sP = (const float*)(ws + WS_SUMP);
    const size_t n8 = (size_t)MT * D / 8;
#pragma unroll 2
    for (size_t i = (size_t)bx_l() * 512 + tid_l(wv), st_ = (size_t)gd_l() * 512; i < n8; i += st_) {
        const int row = (int)(i >> 7), c = (int)(i & 127) * 8;
        const size_t off = (size_t)row * D + c;
        const u32x4 hf = *(const u32x4*)(HLF + off), hb = *(const u32x4*)(HLB + off), gt = *(const u32x4*)(GT + off);
        float h[8] = {bf_lo(hf.x) + bf_lo(hb.x), bf_hi(hf.x) + bf_hi(hb.x), bf_lo(hf.y) + bf_lo(hb.y), bf_hi(hf.y) + bf_hi(hb.y),
                      bf_lo(hf.z) + bf_lo(hb.z), bf_hi(hf.z) + bf_hi(hb.z), bf_lo(hf.w) + bf_lo(hb.w), bf_hi(hf.w) + bf_hi(hb.w)};
        if (row >= MC) {
            const int q = row >> 8, ci = (q - 16) & 3, q0 = q - ci;
            const u32x4 pf = *(const u32x4*)(PF + off - (size_t)MC * D), pb = *(const u32x4*)(PB + off - (size_t)MC * D);
            f32x4 tf0 = {0.f, 0.f, 0.f, 0.f}, tf1 = tf0, tb0 = tf0, tb1 = tf0;
            for (int cc = 0; cc < ci; ++cc) { const float* e = sE + (size_t)(q0 + cc) * D + c; const float* p = sP + (size_t)(q0 + cc) * D + c;
                tf0 = *(const f32x4*)e + *(const f32x4*)p * tf0; tf1 = *(const f32x4*)(e + 4) + *(const f32x4*)(p + 4) * tf1; }
            for (int cc = 3; cc > ci; --cc) { const float* e = sE + (size_t)(48 + q0 + cc) * D + c; const float* p = sP + (size_t)(48 + q0 + cc) * D + c;
                tb0 = *(const f32x4*)e + *(const f32x4*)p * tb0; tb1 = *(const f32x4*)(e + 4) + *(const f32x4*)(p + 4) * tb1; }
            h[0] += bf_lo(pf.x) * tf0[0] + bf_lo(pb.x) * tb0[0]; h[1] += bf_hi(pf.x) * tf0[1] + bf_hi(pb.x) * tb0[1];
            h[2] += bf_lo(pf.y) * tf0[2] + bf_lo(pb.y) * tb0[2]; h[3] += bf_hi(pf.y) * tf0[3] + bf_hi(pb.y) * tb0[3];
            h[4] += bf_lo(pf.z) * tf1[0] + bf_lo(pb.z) * tb1[0]; h[5] += bf_hi(pf.z) * tf1[1] + bf_hi(pb.z) * tb1[1];
            h[6] += bf_lo(pf.w) * tf1[2] + bf_lo(pb.w) * tb1[2]; h[7] += bf_hi(pf.w) * tf1[3] + bf_hi(pb.w) * tb1[3];
        }
        u32x4 o;
        o.x = pk_bf16(h[0] * bf_lo(gt.x), h[1] * bf_hi(gt.x)); o.y = pk_bf16(h[2] * bf_lo(gt.y), h[3] * bf_hi(gt.y));
        o.z = pk_bf16(h[4] * bf_lo(gt.z), h[5] * bf_hi(gt.z)); o.w = pk_bf16(h[6] * bf_lo(gt.w), h[7] * bf_hi(gt.w));
        *(u32x4*)(Y + off) = o;
    }
}

#ifndef PG8_SP2
#define PG8_SP2 true
#endif
#ifndef PG8_ALIGN
#define PG8_ALIGN true
#endif

__device__ __forceinline__ void shw_phase(int wv, const PT pt, LAS unsigned char* lds, const int site, int bx, int G) {
    const int tid = tid_l(wv), lane = tid & 63;
    unsigned char* ws = pt.ws();
    const int lb = bx, nb = G;
    LAS float* sl = (LAS float*)lds;
    const float* mod = (const float*)(ws + WS_MOD);
    const int l = site ? 1 : 0, chunk = (site == 1) ? 0 : 3, N = (site == 1) ? 2 * D : 2 * FF;
    const bf16_t* Wt = site == 0 ? (const bf16_t*)(ws + WS_WGU) : (site == 1 ? (const bf16_t*)(ws + WS_WIN) : (const bf16_t*)(ws + WS_WGU) + (size_t)2 * FF * D);
    float* out = (float*)(ws + WS_SHW) + (site == 0 ? SHW_OFF0 : (site == 1 ? SHW_OFF1 : SHW_OFF2));
    __syncthreads();
#pragma unroll
    for (int r = 0; r < 3; ++r) {
        float v[6];
#pragma unroll
        for (int j = 0; j < 6; ++j) { const int i = tid + 512 * (6 * r + j); v[j] = mod[((size_t)l * 9 + (i >> 10)) * NMOD + chunk * D + (i & 1023)]; }
#pragma unroll
        for (int j = 0; j < 6; ++j) sl[tid + 512 * (6 * r + j)] = v[j];
    }
    __syncthreads();
    const int step = nb * 8;
    int n = lb * 8 + wv;
    u32x2 wa[4];
    if (n < N) {
#pragma unroll
        for (int j = 0; j < 4; ++j) wa[j] = *(const u32x2*)(Wt + (size_t)n * D + 4 * lane + 256 * j);
    }
    for (; n < N; n += step) {
        u32x2 wb[4];
        const int n2 = n + step;
        if (n2 < N) {
#pragma unroll
            for (int j = 0; j < 4; ++j) wb[j] = *(const u32x2*)(Wt + (size_t)n2 * D + 4 * lane + 256 * j);
        }
        float res = 0.f;
#pragma unroll
        for (int cv = 0; cv < 9; ++cv) {
            float s = 0.f;
#pragma unroll
            for (int j = 0; j < 4; ++j) { const f32x4 v = *(const LAS f32x4*)(sl + cv * D + 4 * lane + 256 * j); s += (v[0] * bf_lo(wa[j].x) + v[1] * bf_hi(wa[j].x)) + (v[2] * bf_lo(wa[j].y) + v[3] * bf_hi(wa[j].y)); }
            s = wave_sum(s, lane);
            if (lane == cv) res = s;
        }
        if (lane < 9) out[(size_t)lane * N + n] = res;
#pragma unroll
        for (int j = 0; j < 4; ++j) wa[j] = wb[j];
    }
    __syncthreads();
}

#ifndef PHMASK
#define PHMASK 0xffff
#endif
constexpr int PHM = PHMASK;
__global__ void __launch_bounds__(512, 2) fwd_megakernel(Args a) {
    extern __shared__ __attribute__((aligned(16))) unsigned char lds_raw[];
    LAS unsigned char* lds = (LAS unsigned char*)lds_raw;
    cg::grid_group grid = cg::this_grid();
    const int wv = __builtin_amdgcn_readfirstlane(threadIdx.x >> 6);
    {
        LAS unsigned long long* tw = (LAS unsigned long long*)(lds + PTAB_OFF);
        if (threadIdx.x == 0) {
            tw[0] = (unsigned long long)a.x_prompt; tw[1] = (unsigned long long)a.x_sample; tw[2] = (unsigned long long)a.c; tw[3] = (unsigned long long)a.cache_k; tw[4] = (unsigned long long)a.cache_v;
            tw[5] = (unsigned long long)a.state_h; tw[6] = (unsigned long long)a.c_ctx; tw[7] = (unsigned long long)a.norm_g; tw[8] = (unsigned long long)a.w_mod; tw[9] = (unsigned long long)a.b_mod;
            tw[10] = (unsigned long long)a.w_qkv; tw[11] = (unsigned long long)a.w_o; tw[12] = (unsigned long long)a.rpb; tw[13] = (unsigned long long)a.w_in; tw[14] = (unsigned long long)a.conv_w;
            tw[15] = (unsigned long long)a.conv_b; tw[16] = (unsigned long long)a.w_a; tw[17] = (unsigned long long)a.b_a; tw[18] = (unsigned long long)a.w_i; tw[19] = (unsigned long long)a.b_i;
            tw[20] = (unsigned long long)a.lam; tw[21] = (unsigned long long)a.w_out; tw[22] = (unsigned long long)a.w_gu; tw[23] = (unsigned long long)a.w_down; tw[24] = (unsigned long long)a.final_g;
            tw[25] = (unsigned long long)a.out; tw[26] = (unsigned long long)a.ws;
            LAS unsigned* st = (LAS unsigned*)(lds + BARST_OFF); st[0] = 0u; st[1] = 0u;
            (void)xb_add((unsigned*)(a.ws + WS_BAR) + XB_XCNT(xb_xcc_id()), 1u);
        }
        __syncthreads();
        if (a.out == nullptr) grid.sync();
    }
#define GSYNC() do { for (int rs_ = 0; rs_ < REP_SYNC; ++rs_) xcd_barrier(pt, lds, wv); } while (0)
    const PT pt{(LAS const unsigned long long*)(lds + PTAB_OFF)};
#define WSP(off) (pt.ws() + (off))
#define MODP ((float*)WSP(WS_MOD))
#define XNP ((bf16_t*)WSP(WS_XN))
#define XRES (pt.out() + OUT_Y)
#define XBP ((bf16_t*)WSP(WS_XB))
#define SSQP(i) ((float*)WSP(WS_SSQ) + (size_t)(i) * MT)

    if (PHM & 1) p0_prologue(wv, pt, lds);
    GSYNC();
    if (PHM & 2) for (int rep_ = 0; rep_ < REP_THIN; ++rep_) norm_phase(wv, pt.f(I_x_prompt), pt.f(I_x_sample), pt.f(I_norm_g), MODP, 0, XNP);
    GSYNC();
    if (PHM & 4) { pg8::Gemm g{XNP, (const bf16_t*)WSP(WS_WQKV), MT, NQKV, D, D, D, wv}; pg8::StaticOrder S; S.init(MT, NQKV, gd_l(), bx_l()); S.reps = REP_GEMM;
      pg8::EpiQKV E{(bf16_t*)WSP(WS_Q), pt.out() + OUT_NK, 0.125f * LOG2E};
      pg8::gemm_phase<pg8::EpiQKV, pg8::StaticOrder, PG8_ALIGN, PG8_SP2>(lds, g, S, E); }
    {
        const int G_ = gd_l(), c_ = bx_l(), nwg_ = (MT / 256) * (NQKV / 256), maxu_ = (nwg_ + G_ - 1) / G_, full_ = nwg_ - (maxu_ - 1) * G_;
        int rank_ = c_, n_ = G_;
        if (full_ < G_) { rank_ = c_ - full_; n_ = c_ >= full_ ? G_ - full_ : 0; }
        if (n_ > 0) { tr_items(wv, pt, lds, 16 * 96, 16 * 96 + 16 * 32 + 16 * 176, rank_ * 8 + wv, n_ * 8); cache_conv(wv, pt, rank_, n_); }
    }
    GSYNC();
    if (PHM & 8) for (int rep_ = 0; rep_ < REP_ATT; ++rep_) for (int vc = bx_l(), G_ = gd_l(); vc < 256; vc += G_) {
        const int bh = vc >> 1;
#pragma unroll 1
        for (int gi = 0; gi < 2; ++gi)
            att::unit<true>(wv, lds, bh >> 4, bh & 15, 2 * (vc & 1) + gi, (const bf16_t*)WSP(WS_Q), (const bf16_t*)WSP(WS_K), (const bf16_t*)WSP(WS_V), (const bf16_t*)WSP(WS_CK), (const bf16_t*)WSP(WS_CV), XNP, pt.f(I_rpb));
        att::unit<false>(wv, lds, vc >> 4, vc & 15, 0, (const bf16_t*)WSP(WS_Q), (const bf16_t*)WSP(WS_K), (const bf16_t*)WSP(WS_V), nullptr, nullptr, XNP, nullptr);
    }
    GSYNC();
    if (PHM & 16)
#pragma unroll 1
    for (int rp_ = REP_P4 - 1; rp_ >= 0; --rp_) { pg8::Gemm g{XNP, (const bf16_t*)WSP(WS_WO), MT, D, D, D, D, wv}; pg8::StaticOrder S; S.init(MT, D, gd_l(), bx_l());
      pg8::EpiResT<true, true> E{pt.f(I_x_prompt), pt.f(I_x_sample), XBP, MODP + 2 * D, (bf16_t*)WSP(WS_XN2), pt.f(I_norm_g) + D, MODP + 4 * D, rp_ ? (float*)WSP(WS_HLF) : SSQP(0)};
      pg8::gemm_phase<pg8::EpiResT<true, true>, pg8::StaticOrder, PG8_ALIGN, PG8_SP2>(lds, g, S, E); }
    {
        const int G_ = gd_l(), c_ = bx_l(), nwg_ = (MT / 256) * (D / 256);
        int rank_ = c_, n_ = G_;
        if (nwg_ < G_) { rank_ = c_ - nwg_; n_ = c_ >= nwg_ ? G_ - nwg_ : 0; }
        if (n_ > 0) { shw_phase(wv, pt, lds, 0, rank_, n_); tr_items(wv, pt, lds, 16 * 96 + 16 * 32 + 16 * 176, 16 * 96 + 16 * 32 + 16 * 176 + 44 * 32, rank_ * 8 + wv, n_ * 8); }
    }
    GSYNC();
    if (PHM & 512) { pg8::Gemm g{(const bf16_t*)WSP(WS_XN2), (const bf16_t*)WSP(WS_WGU), MT, 2 * FF, D, D, D, wv}; pg8::StaticOrder S; S.init(MT, 2 * FF, gd_l(), bx_l()); S.reps = REP_GEMM;
      pg8::EpiSwiglu E{(bf16_t*)WSP(WS_H), SSQP(0), (const float*)WSP(WS_SHW) + SHW_OFF0};
      pg8::gemm_phase<pg8::EpiSwiglu, pg8::StaticOrder, PG8_ALIGN, PG8_SP2>(lds, g, S, E); }
    {
        const int G_ = gd_l(), c_ = bx_l(), nwg_ = (MT / 256) * (2 * FF / 256), maxu_ = (nwg_ + G_ - 1) / G_, full_ = nwg_ - (maxu_ - 1) * G_;
        int rank_ = c_, n_ = G_;
        if (full_ < G_) { rank_ = c_ - full_; n_ = c_ >= full_ ? G_ - full_ : 0; }
        if (n_ > 0) { adaln_tasks(wv, pt, lds, 1, rank_, n_); tr_items(wv, pt, lds, 16 * 96 + 16 * 32 + 2 * 16 * 176 + 44 * 32, 12288, rank_ * 8 + wv, n_ * 8); }
    }
    GSYNC();
    if (PHM & 16) { pg8::Gemm g{(const bf16_t*)WSP(WS_H), (const bf16_t*)WSP(WS_WDN), MT, D, FF, FF, FF, wv}; pg8::StaticOrder S; S.init(MT, D, gd_l(), bx_l());
      pg8::EpiResT<true, false> E{nullptr, nullptr, XBP, MODP + 5 * D, XNP, pt.f(I_norm_g) + 2 * D, MODP + (size_t)9 * NMOD + 1 * D, SSQP(1)};
      pg8::gemm_phase<pg8::EpiResT<true, false>, pg8::StaticOrder, PG8_ALIGN, PG8_SP2>(lds, g, S, E); }
    {
        const int G_ = gd_l(), c_ = bx_l(), nwg_ = (MT / 256) * (D / 256);
        int rank_ = c_, n_ = G_;
        if (nwg_ < G_) { rank_ = c_ - nwg_; n_ = c_ >= nwg_ ? G_ - nwg_ : 0; }
        if (n_ > 0) { shw_phase(wv, pt, lds, 1, rank_, n_); tr_items(wv, pt, lds, 16 * 96 + 16 * 32 + 16 * 176 + 44 * 32, 16 * 96 + 16 * 32 + 2 * 16 * 176 + 44 * 32, rank_ * 8 + wv, n_ * 8); }
    }
    GSYNC();
    if (PHM & 32) { pg8::Gemm g{XNP, (const bf16_t*)WSP(WS_WIN), MT, 2 * D, D, D, D, wv}; pg8::StaticOrder S; S.init(MT, 2 * D, gd_l(), bx_l()); S.reps = REP_GEMM;
      pg8::EpiWin E{(bf16_t*)WSP(WS_GATE), (bf16_t*)WSP(WS_XR), SSQP(1), (const float*)WSP(WS_SHW) + SHW_OFF1};
      pg8::gemm_phase<pg8::EpiWin, pg8::StaticOrder, PG8_ALIGN, PG8_SP2>(lds, g, S, E); }
    {
        const int G_ = gd_l(), c_ = bx_l(), nwg_ = (MT / 256) * (2 * D / 256), maxu_ = (nwg_ + G_ - 1) / G_, full_ = nwg_ - (maxu_ - 1) * G_;
        int rank_ = c_, n_ = G_;
        if (full_ < G_) { rank_ = c_ - full_; n_ = c_ >= full_ ? G_ - full_ : 0; }
        if (n_ > 0) shw_phase(wv, pt, lds, 2, rank_, n_);
    }
    GSYNC();
    if (PHM & 128)
#pragma unroll 1
    for (int uu = bx_l(), G_ = gd_l(); uu < 768 * REP_LRU; uu += G_) {
        const int u = uu % 768;
        const int dir = u & 1, n = (u >> 1) & 7, q = u >> 4;
        const float* h0 = nullptr;
        if (q >= 16) { const int b = (q - 16) >> 2, ci = (q - 16) & 3; if ((dir == 0 && ci == 0) || (dir == 1 && ci == 3)) h0 = pt.f(I_state_h) + ((size_t)b * 2 + dir) * D; }
        conv_slab(wv, (const bf16_t*)WSP(WS_XR), pt.f(I_conv_w), pt.f(I_conv_b), XNP, q, n);
        pg8::Gemm g{XNP + (size_t)q * 256 * D + n * 128, (const bf16_t*)WSP(WS_WG) + (size_t)(n * 2 + dir) * 256 * 128, 256, 256, 128, D, 128, wv};
        pg8::OneUnit S;
        pg8::EpiLru E{pt.t, h0, q * 256, n * 128, dir, q};
        pg8::gemm_phase<pg8::EpiLru, pg8::OneUnit, false, false>(lds, g, S, E);
    }
    GSYNC();
    if (PHM & 256) for (int rep_ = 0; rep_ < REP_THIN; ++rep_) lru_combine_phase(wv, pt.ws(), (bf16_t*)WSP(WS_Y));
    GSYNC();
    if (PHM & 16) { pg8::Gemm g{(const bf16_t*)WSP(WS_Y), (const bf16_t*)WSP(WS_WOUT), MT, D, D, D, D, wv}; pg8::StaticOrder S; S.init(MT, D, gd_l(), bx_l());
      pg8::EpiResT<true, false> E{nullptr, nullptr, XBP, MODP + (size_t)9 * NMOD + 2 * D, XNP, pt.f(I_norm_g) + 3 * D, MODP + (size_t)9 * NMOD + 4 * D, SSQP(2)};
      pg8::gemm_phase<pg8::EpiResT<true, false>, pg8::StaticOrder, PG8_ALIGN, PG8_SP2>(lds, g, S, E); }
    GSYNC();
    if (PHM & 512) { pg8::Gemm g{XNP, (const bf16_t*)WSP(WS_WGU) + (size_t)2 * FF * D, MT, 2 * FF, D, D, D, wv}; pg8::StaticOrder S; S.init(MT, 2 * FF, gd_l(), bx_l()); S.reps = REP_GEMM;
      pg8::EpiSwiglu E{(bf16_t*)WSP(WS_H), SSQP(2), (const float*)WSP(WS_SHW) + SHW_OFF2};
      pg8::gemm_phase<pg8::EpiSwiglu, pg8::StaticOrder, PG8_ALIGN, PG8_SP2>(lds, g, S, E); }
    GSYNC();
    if (gd_l() >= (MT / 256) * (D / 256)) {
        pg8::Gemm g{(const bf16_t*)WSP(WS_H), (const bf16_t*)WSP(WS_WDN) + (size_t)D * FF, MT, D, FF, FF, FF, wv}; pg8::StaticOrder S; S.init(MT, D, gd_l(), bx_l());
        pg8::EpiResFinal E{XBP, MODP + (size_t)9 * NMOD + 5 * D, SSQP(3), (unsigned*)WSP(WS_FCNT), pt.f(I_final_g), XRES};
        pg8::gemm_phase<pg8::EpiResFinal, pg8::StaticOrder, PG8_ALIGN, PG8_SP2>(lds, g, S, E);
    } else {
        { pg8::Gemm g{(const bf16_t*)WSP(WS_H), (const bf16_t*)WSP(WS_WDN) + (size_t)D * FF, MT, D, FF, FF, FF, wv}; pg8::StaticOrder S; S.init(MT, D, gd_l(), bx_l());
          pg8::EpiResT<false, false> E{nullptr, nullptr, XBP, MODP + (size_t)9 * NMOD + 5 * D, nullptr, nullptr, nullptr, nullptr};
          pg8::gemm_phase<pg8::EpiResT<false, false>, pg8::StaticOrder, PG8_ALIGN, PG8_SP2>(lds, g, S, E); }
        GSYNC();
        final_norm_phase(wv, XBP, XRES, pt.f(I_final_g));
    }
}

extern "C" void kernel_launch(void* const* d_in, const int* in_sizes, int n_in, void* d_out, int out_size, void* d_ws, size_t ws_size, hipStream_t stream) {
    static int grid = 0;
    if (grid == 0) {
        int dev = 0, cus = 0, per_cu = 0;
        (void)hipGetDevice(&dev);
        (void)hipDeviceGetAttribute(&cus, hipDeviceAttributeMultiprocessorCount, dev);
        (void)hipFuncSetAttribute((const void*)fwd_megakernel, hipFuncAttributeMaxDynamicSharedMemorySize, LDS_BYTES);
        (void)hipOccupancyMaxActiveBlocksPerMultiprocessor(&per_cu, (const void*)fwd_megakernel, 512, LDS_BYTES);
        if (per_cu < 1) { fprintf(stderr, "kernel_launch: occupancy query says %d blocks per CU\n", per_cu); per_cu = 1; }
        grid = cus * per_cu;
        if (ws_size < WS_END) { fprintf(stderr, "kernel_launch: workspace too small (%zu < %zu)\n", ws_size, (size_t)WS_END); grid = -1; }
    }
    if (grid < 0) return;
    (void)hipMemsetAsync((char*)d_ws + WS_MOD, 0, 1024 * 1024, stream);
    Args a{};
    const float** ap = (const float**)&a;
    for (int i = 0; i < 25; ++i) ap[i] = (const float*)d_in[i];
    a.out = (float*)d_out; a.ws = (unsigned char*)d_ws;
    void* args[] = {&a};
    hipError_t e = hipLaunchCooperativeKernel((const void*)fwd_megakernel, dim3(grid), dim3(512), args, LDS_BYTES, stream);
    if (e != hipSuccess) fprintf(stderr, "cooperative launch failed: %s (grid %d)\n", hipGetErrorString(e), grid);
}
```

```cpp
#include <hip/hip_runtime.h>
#include <hip/hip_cooperative_groups.h>
#include <cstdio>
#include <cstdint>
namespace cg = cooperative_groups;

#define LAS __attribute__((address_space(3)))
typedef unsigned short bf16_t;
typedef short bf16x8 __attribute__((ext_vector_type(8)));
typedef short s16x4 __attribute__((ext_vector_type(4)));
typedef float f32x4 __attribute__((ext_vector_type(4)));
typedef float f32x2 __attribute__((ext_vector_type(2)));
typedef float f32x16 __attribute__((ext_vector_type(16)));
typedef unsigned u32x4 __attribute__((ext_vector_type(4)));
typedef unsigned u32x2 __attribute__((ext_vector_type(2)));
typedef __bf16 bf16x2_t __attribute__((ext_vector_type(2)));

constexpr int D = 1024, MC = 4096, ML = 8192, MT = MC + ML, FF = 2816, NQKV = 3072, NMOD = 6144;
constexpr float LOG2E = 1.4426950408889634f;
constexpr float RMS_EPS = 1e-6f;

constexpr size_t MiB = 1u << 20;
constexpr size_t WS_MOD = 0;
constexpr size_t WS_YCNT = 832 * 1024;
constexpr size_t WS_FCNT = 768 * 1024;
constexpr size_t WS_SSQ = 512 * 1024;
constexpr size_t WS_WQKV = 1 * MiB, WS_WO = 7 * MiB, WS_WGU = 9 * MiB, WS_WDN = 31 * MiB, WS_WIN = 42 * MiB, WS_WOUT = 46 * MiB, WS_WG = 48 * MiB;
constexpr size_t WS_CK = 49 * MiB, WS_CV = 57 * MiB;
constexpr size_t WS_PF = 49 * MiB;
constexpr size_t WS_XN = 65 * MiB;
constexpr size_t WS_Q = 89 * MiB, WS_K = 113 * MiB, WS_V = 137 * MiB;
constexpr size_t WS_H = 89 * MiB;
constexpr size_t WS_GATE = 89 * MiB, WS_XR = 113 * MiB, WS_Y = 113 * MiB;
constexpr size_t WS_XN2 = 161 * MiB;
constexpr size_t WS_PB = 137 * MiB;
constexpr size_t WS_XB = 185 * MiB;
constexpr size_t WS_HLF = 209 * MiB, WS_HLB = 161 * MiB;
constexpr size_t WS_SUMP = 250 * MiB;
constexpr size_t WS_SUME = 250 * MiB + 512 * 1024;
constexpr size_t WS_SHW = 252 * MiB;
constexpr int SHW_OFF0 = 0, SHW_OFF1 = 9 * 5632, SHW_OFF2 = 9 * 5632 + 9 * 2048;
constexpr size_t WS_END = 256 * MiB;

constexpr int LDS_BYTES = 143360;
constexpr int AB_PITCH = 1056;
constexpr int HST_OFF = 128 * AB_PITCH;

enum { I_x_prompt = 0, I_x_sample = 1, I_c = 2, I_cache_k = 3, I_cache_v = 4, I_state_h = 5, I_c_ctx = 6, I_norm_g = 7, I_w_mod = 8, I_b_mod = 9, I_w_qkv = 10, I_w_o = 11, I_rpb = 12, I_w_in = 13, I_conv_w = 14, I_conv_b = 15, I_w_a = 16, I_b_a = 17, I_w_i = 18, I_b_i = 19, I_lam = 20, I_w_out = 21, I_w_gu = 22, I_w_down = 23, I_final_g = 24, I_out = 25, I_ws = 26 };
constexpr int PTAB_OFF = LDS_BYTES - 256;
struct PT {
    LAS const unsigned long long* t;
    __device__ __forceinline__ unsigned long long raw(int i) const { const unsigned long long v = t[i]; const unsigned lo = __builtin_amdgcn_readfirstlane((unsigned)v), hi = __builtin_amdgcn_readfirstlane((unsigned)(v >> 32)); return ((unsigned long long)hi << 32) | lo; }
    __device__ __forceinline__ const float* f(int i) const { return (const float*)(const __attribute__((address_space(1))) float*)raw(i); }
    __device__ __forceinline__ float* out() const { return (float*)(__attribute__((address_space(1))) float*)raw(I_out); }
    __device__ __forceinline__ unsigned char* ws() const { return (unsigned char*)(__attribute__((address_space(1))) unsigned char*)raw(I_ws); }
};
constexpr size_t OUT_Y = 0, OUT_NK = (size_t)MT * D, OUT_NV = OUT_NK + (size_t)MC * D, OUT_NH = OUT_NV + (size_t)MC * D;
constexpr int CST_OFF = HST_OFF + 1024;
__device__ __forceinline__ int tid_l(int wv) { int l; asm volatile("v_mbcnt_lo_u32_b32 %0, -1, 0\n\tv_mbcnt_hi_u32_b32 %0, -1, %0" : "=v"(l)); return wv * 64 + l; }
__device__ __forceinline__ int bx_l() { int b = blockIdx.x; asm volatile("" : "+s"(b)); return b; }
__device__ __forceinline__ int gd_l() { int g = gridDim.x; asm volatile("" : "+s"(g)); return g; }
__device__ __forceinline__ int vcu_l() { const int b = bx_l(), g = gd_l(); return (g & 7) ? b : (b & 7) * (g >> 3) + (b >> 3); }

constexpr size_t WS_BAR = 448 * 1024;
constexpr int BARST_OFF = PTAB_OFF + 224;
#define XB_TMO      128
#define XB_XCNT(j)  (256  + 64 * (j))
#define XB_XSUB(j)  (1280 + 64 * (j))
#define XB_XGEN(j)  (2304 + 64 * (j))
#define XB_TOP      3328
#define XB_TOPGEN   3392
#define XCD_BAR_WORDS 3456
#define XB_SPIN_CAP (1u << 18)
__device__ __forceinline__ unsigned xb_ld(unsigned* p)              { return __hip_atomic_load(p, __ATOMIC_RELAXED, __HIP_MEMORY_SCOPE_AGENT); }
__device__ __forceinline__ unsigned xb_add(unsigned* p, unsigned v) { return __hip_atomic_fetch_add(p, v, __ATOMIC_RELAXED, __HIP_MEMORY_SCOPE_AGENT); }
__device__ __forceinline__ unsigned xb_xcc_id() { return (unsigned)__builtin_amdgcn_s_getreg((3 << 11) | 20) & 0xFu; }
#define XB_SPIN(cond, bar) do { unsigned _sp = 0; while (cond) { __builtin_amdgcn_s_sleep(1); \
    if ((++_sp & 255u) == 0u) { if (xb_ld(&(bar)[XB_TMO])) break; if (_sp > XB_SPIN_CAP) { atomicAdd(&(bar)[XB_TMO], 1u); break; } } } } while (0)
__device__ __forceinline__ void xcd_barrier_complete(unsigned* bar, unsigned x, unsigned& nloc, unsigned& nx) {
    const unsigned G = gridDim.x;
    unsigned sum, cnt, mine, sp = 0u;
    for (;;) {
        sum = 0u; cnt = 0u; mine = 0u;
#pragma unroll
        for (unsigned j = 0; j < 16; ++j) { const unsigned c = xb_ld(&bar[XB_XCNT(j)]); sum += c; cnt += (c > 0u) ? 1u : 0u; mine = (j == x) ? c : mine; }
        if (sum == G) break;
        __builtin_amdgcn_s_sleep(1);
        if ((++sp & 255u) == 0u) { if (xb_ld(&bar[XB_TMO])) break; if (sp > XB_SPIN_CAP) { atomicAdd(&bar[XB_TMO], 1u); break; } }
    }
    nloc = mine > 0u ? mine : 1u; nx = cnt > 0u ? cnt : 1u;
}
__device__ __forceinline__ void xcd_barrier(const PT pt, LAS unsigned char* lds, int wv) {
    asm volatile("s_waitcnt vmcnt(0)" ::: "memory");
    __syncthreads();
    if (tid_l(wv) == 0) {
        unsigned* bar = (unsigned*)(pt.ws() + WS_BAR);
        volatile LAS unsigned* st = (volatile LAS unsigned*)(lds + BARST_OFF);
        const unsigned x = xb_xcc_id();
        __builtin_amdgcn_s_waitcnt(0);
        unsigned nloc = st[0], nx = st[1];
        if (nloc == 0u) { xcd_barrier_complete(bar, x, nloc, nx); st[0] = nloc; st[1] = nx; }
        const unsigned old = xb_add(&bar[XB_XSUB(x)], 1u);
        const unsigned gen = old / nloc;
        if (old + 1u == (gen + 1u) * nloc) {
            __builtin_amdgcn_fence(__ATOMIC_RELEASE, "agent");
            asm volatile("s_waitcnt vmcnt(0)" ::: "memory");
            const unsigned og = xb_add(&bar[XB_TOP], 1u);
            const unsigned tg = og / nx;
            if (og + 1u == (tg + 1u) * nx) xb_add(&bar[XB_TOPGEN], 1u);
            else XB_SPIN(xb_ld(&bar[XB_TOPGEN]) == tg, bar);
            __builtin_amdgcn_fence(__ATOMIC_ACQUIRE, "agent");
            xb_add(&bar[XB_XGEN(x)], 1u);
            asm volatile("s_waitcnt vmcnt(0)" ::: "memory");
        } else {
            XB_SPIN(xb_ld(&bar[XB_XGEN(x)]) == gen, bar);
            __builtin_amdgcn_fence(__ATOMIC_ACQUIRE, "agent");
            asm volatile("s_waitcnt vmcnt(0)" ::: "memory");
        }
    }
    __syncthreads();
}
__device__ __forceinline__ unsigned pk_bf16(float lo, float hi) { f32x2 v = {lo, hi}; bf16x2_t b = __builtin_convertvector(v, bf16x2_t); return __builtin_bit_cast(unsigned, b); }
__device__ __forceinline__ float bf_lo(unsigned u) { return __uint_as_float(u << 16); }
__device__ __forceinline__ float bf_hi(unsigned u) { return __uint_as_float(u & 0xffff0000u); }
__device__ __forceinline__ float fast_rcp(float x) { return __builtin_amdgcn_rcpf(x); }
__device__ __forceinline__ float fast_exp2(float x) { return __builtin_amdgcn_exp2f(x); }
__device__ __forceinline__ float sigmoid_f(float x) { return fast_rcp(1.f + fast_exp2(-x * LOG2E)); }
__device__ __forceinline__ float silu_f(float x) { return x * sigmoid_f(x); }
__device__ __forceinline__ float gelu_tanh_f(float x) { const float u = 0.7978845608028654f * (x + 0.044715f * x * x * x); return x * sigmoid_f(2.f * u); }
__device__ __forceinline__ float shfl_xor_l(float v, int mask, int lane) { return __int_as_float(__builtin_amdgcn_ds_bpermute((lane ^ mask) << 2, __float_as_int(v))); }
__device__ __forceinline__ float wave_sum(float v, int lane) {
#pragma unroll
    for (int o = 1; o < 64; o <<= 1) v += shfl_xor_l(v, o, lane);
    return v;
}
namespace pg8 {
#define PG8_LAS __attribute__((address_space(3)))
constexpr int BM = 256, BK = 64, HALF = 128, HTB = HALF * BK * 2  , STAGE_BYTES = 8 * HTB, NXCD = 8, WGM = 4;

__host__ __device__ __forceinline__ int lds_byte(int r, int c) { const int st = (r >> 4) * 2 + (c >> 5), rr = r & 15, cc = c & 31, ob = rr * 64 + cc * 2; return st * 1024 + (ob ^ (((ob >> 9) & 1) << 5)); }
__host__ __device__ __forceinline__ void stage_rc(int b, int& R, int& C) { const int st = b / 1024, sb = b % 1024, swz = sb ^ (((sb >> 9) & 1) << 5); R = (st >> 1) * 16 + swz / 64; C = (st & 1) * 32 + (swz % 64) / 2; }
__host__ __device__ __forceinline__ int perm32(int rho) { const int n = rho >> 4, i = rho & 15; return 8 * (i >> 2) + 4 * n + (i & 3); }

struct Unit { int pm, pn; };
struct Gemm { const bf16_t* A; const bf16_t* Bt; int M, N, K, lda, ldb, wv; };

struct StaticOrder {
    int nM, nN, nwg, G, c;
    int reps = 1;
    __host__ __device__ __forceinline__ void init(int M, int N, int G_, int c_) { nM = M / BM; nN = N / BM; nwg = nM * nN; G = G_; c = c_; }
    __host__ __device__ __forceinline__ bool next(int i, Unit& u) const {
        const long L = (long)(i / reps) * G + c; if (L >= nwg) return false;
        int wgid = (int)L; { const int q = nwg / NXCD, r = nwg % NXCD, xcd = wgid % NXCD, off = wgid / NXCD; wgid = (xcd < r ? xcd * (q + 1) : r * (q + 1) + (xcd - r) * q) + off; }
        const int nig = WGM * nN, gid = wgid / nig, fm = gid * WGM, gsz = (nM - fm) < WGM ? (nM - fm) : WGM;
        u.pm = fm + ((wgid % nig) % gsz); u.pn = (wgid % nig) / gsz; return true;
    }
    __device__ __forceinline__ void a_ready(const Unit&) const {}
    __device__ __forceinline__ void done(const Unit&) const {}
};


template <class Epi, class Sched, bool ALIGN_EPI = false, bool SP2 = false>
__device__ __forceinline__ void gemm_phase(PG8_LAS unsigned char* lds, const Gemm g, const Sched& S, const Epi& E) {
    int wid_ = g.wv; asm volatile("" : "+s"(wid_));
    const int tid = tid_l(wid_), wid = wid_, lane = tid & 63, wr = wid >> 2, wc = wid & 3, fr = lane & 15, fq = lane >> 4;
    const int K = g.K, nt = K / BK;
    unsigned voffA[2], voffB[2];
#pragma unroll
    for (int i = 0; i < 2; ++i) { int R, C; stage_rc(tid * 16 + i * 8192, R, C); const int Rb = Epi::PERM ? ((R & ~31) + perm32(R & 31)) : R;
        voffA[i] = (unsigned)(R * g.lda + C) * 2u; voffB[i] = (unsigned)(Rb * g.ldb + C) * 2u; }
    const size_t kstep = (size_t)(BK * 2);
    const size_t hstepA = (size_t)HALF * g.lda * 2, hstepB = (size_t)HALF * g.ldb * 2;
    const size_t tstepA = 2 * hstepA, tstepB = 2 * hstepB;
    const unsigned ldsw = (unsigned)wid * 1024u;
    const int aoff = lds_byte(wr * 64 + fr, fq * 8), boff = lds_byte(wc * 32 + fr, fq * 8);
#define PG8_SA(b, h) (((b) * 2 + (h)) * HTB)
#define PG8_SB(b, h) ((4 + (b) * 2 + (h)) * HTB)
#define PG8_STAGE(bufoff, gbase, voff) do { _Pragma("unroll") for (int _i = 0; _i < 2; ++_i) \
        __builtin_amdgcn_global_load_lds((const unsigned*)((const char*)(gbase) + (voff)[_i]), (PG8_LAS unsigned*)(lds + (bufoff) + ldsw + _i * 8192), 16, 0, 0); } while (0)
#define PG8_LDA(dst, b, h) do { _Pragma("unroll") for (int m = 0; m < 4; ++m) _Pragma("unroll") for (int k = 0; k < 2; ++k) dst[m][k] = *(const PG8_LAS bf16x8*)(lds + PG8_SA(b, h) + aoff + m * 2048 + k * 1024); } while (0)
#define PG8_LDB(dst, b, h) do { _Pragma("unroll") for (int n = 0; n < 2; ++n) _Pragma("unroll") for (int k = 0; k < 2; ++k) dst[n][k] = *(const PG8_LAS bf16x8*)(lds + PG8_SB(b, h) + boff + n * 2048 + k * 1024); } while (0)
#define PG8_MMA(ai, bj, At, Bt) do { __builtin_amdgcn_s_setprio(1); _Pragma("unroll") for (int m = 0; m < 4; ++m) _Pragma("unroll") for (int n = 0; n < 2; ++n) _Pragma("unroll") for (int k = 0; k < 2; ++k) \
        acc[ai][bj][m][n] = __builtin_amdgcn_mfma_f32_16x16x32_bf16(Bt[n][k], At[m][k], acc[ai][bj][m][n], 0, 0, 0); __builtin_amdgcn_s_setprio(0); } while (0)
#define PG8_WAIT_V(n) asm volatile("s_waitcnt vmcnt(" #n ")" ::: "memory")
#define PG8_WAIT_L(n) asm volatile("s_waitcnt lgkmcnt(" #n ")" ::: "memory")
#define PG8_BAR __builtin_amdgcn_s_barrier()
#define PG8_SCHED __builtin_amdgcn_sched_barrier(0)
    Unit cur, nxt; int ui = 0;
    if (!S.next(0, cur)) return;
    f32x4 acc[2][2][4][2];
#pragma unroll
    for (int a = 0; a < 2; ++a)
#pragma unroll
        for (int b = 0; b < 2; ++b)
#pragma unroll
            for (int m = 0; m < 4; ++m)
#pragma unroll
                for (int n = 0; n < 2; ++n) acc[a][b][m][n] = (f32x4){0.f, 0.f, 0.f, 0.f};
    bf16x8 At[4][2], B0[2][2], B1[2][2];
    const char* cA = (const char*)g.A + (size_t)cur.pm * tstepA; const char* cB = (const char*)g.Bt + (size_t)cur.pn * tstepB;
    S.a_ready(cur);
    if constexpr (SP2) {
        PG8_STAGE(PG8_SB(0, 0), cB, voffB); PG8_STAGE(PG8_SB(0, 1), cB + hstepB, voffB); PG8_STAGE(PG8_SA(0, 0), cA, voffA); PG8_STAGE(PG8_SA(0, 1), cA + hstepA, voffA);
        if (wr == 1) PG8_BAR;
        PG8_WAIT_V(2); PG8_BAR;
        PG8_STAGE(PG8_SB(1, 0), cB + kstep, voffB); PG8_STAGE(PG8_SA(1, 0), cA + kstep, voffA); PG8_STAGE(PG8_SB(1, 1), cB + hstepB + kstep, voffB);
        PG8_WAIT_V(6); PG8_BAR;
    } else {
        PG8_STAGE(PG8_SB(0, 0), cB, voffB); PG8_STAGE(PG8_SA(0, 0), cA, voffA); PG8_STAGE(PG8_SB(0, 1), cB + hstepB, voffB); PG8_STAGE(PG8_SA(0, 1), cA + hstepA, voffA);
        if (wr == 1) PG8_BAR;
        PG8_WAIT_V(4); PG8_BAR;
        PG8_STAGE(PG8_SB(1, 0), cB + kstep, voffB); PG8_STAGE(PG8_SA(1, 0), cA + kstep, voffA); PG8_STAGE(PG8_SB(1, 1), cB + hstepB + kstep, voffB);
        PG8_WAIT_V(6); PG8_BAR;
    }
    for (;;) {
        const bool has_next = S.next(ui + 1, nxt);
        const char* nA = has_next ? (const char*)g.A + (size_t)nxt.pm * tstepA : cA; const char* nB = has_next ? (const char*)g.Bt + (size_t)nxt.pn * tstepB : cB;
        for (int t = 0; t < nt; t += 2) {
            const bool last = (t == nt - 2);
            const char* a1 = cA + (size_t)(t + 1) * kstep;
            const char* a2 = last ? nA : cA + (size_t)(t + 2) * kstep; const char* b2 = last ? nB : cB + (size_t)(t + 2) * kstep;
            const char* a3 = a2 + kstep; const char* b3 = b2 + kstep;
            if (last && has_next) S.a_ready(nxt);
            if constexpr (SP2) {
            PG8_LDB(B0, 0, 0); PG8_LDB(B1, 0, 1); PG8_SCHED; PG8_LDA(At, 0, 0); PG8_STAGE(PG8_SA(1, 1), a1 + hstepA, voffA);
            PG8_WAIT_V(8); PG8_WAIT_L(0); PG8_BAR; PG8_MMA(0, 0, At, B0); PG8_MMA(0, 1, At, B1); PG8_BAR; PG8_SCHED;
            PG8_LDA(At, 0, 1); PG8_STAGE(PG8_SB(0, 0), b2, voffB); PG8_STAGE(PG8_SB(0, 1), b2 + hstepB, voffB); PG8_STAGE(PG8_SA(0, 0), a2, voffA);
            PG8_WAIT_V(8); PG8_WAIT_L(0); PG8_BAR; PG8_MMA(1, 0, At, B0); PG8_MMA(1, 1, At, B1); PG8_BAR; PG8_SCHED;
            PG8_LDB(B0, 1, 0); PG8_LDB(B1, 1, 1); PG8_SCHED; PG8_LDA(At, 1, 0); PG8_STAGE(PG8_SA(0, 1), a2 + hstepA, voffA);
            PG8_WAIT_V(8); PG8_WAIT_L(0); PG8_BAR; PG8_MMA(0, 0, At, B0); PG8_MMA(0, 1, At, B1); PG8_BAR; PG8_SCHED;
            PG8_LDA(At, 1, 1); PG8_STAGE(PG8_SB(1, 0), b3, voffB); PG8_STAGE(PG8_SB(1, 1), b3 + hstepB, voffB); PG8_STAGE(PG8_SA(1, 0), a3, voffA);
            PG8_WAIT_V(8); PG8_WAIT_L(0); PG8_BAR; PG8_MMA(1, 0, At, B0); PG8_MMA(1, 1, At, B1); PG8_BAR; PG8_SCHED;
            } else {
            PG8_LDB(B0, 0, 0); PG8_SCHED; PG8_LDA(At, 0, 0); PG8_STAGE(PG8_SA(1, 1), a1 + hstepA, voffA);
            PG8_WAIT_L(8); PG8_BAR; PG8_WAIT_L(0); PG8_MMA(0, 0, At, B0); PG8_BAR; PG8_SCHED;
            PG8_LDB(B1, 0, 1); PG8_STAGE(PG8_SB(0, 0), b2, voffB);
            PG8_BAR; PG8_WAIT_L(0); PG8_MMA(0, 1, At, B1); PG8_BAR;
            PG8_LDA(At, 0, 1); PG8_STAGE(PG8_SA(0, 0), a2, voffA);
            PG8_BAR; PG8_WAIT_L(0); PG8_MMA(1, 0, At, B0); PG8_BAR; PG8_SCHED;
            PG8_STAGE(PG8_SB(0, 1), b2 + hstepB, voffB);
            PG8_WAIT_V(6); PG8_BAR; PG8_MMA(1, 1, At, B1); PG8_BAR;
            PG8_LDB(B0, 1, 0); PG8_SCHED; PG8_LDA(At, 1, 0); PG8_STAGE(PG8_SA(0, 1), a2 + hstepA, voffA);
            PG8_WAIT_L(8); PG8_BAR; PG8_WAIT_L(0); PG8_MMA(0, 0, At, B0); PG8_BAR; PG8_SCHED;
            PG8_LDB(B1, 1, 1); PG8_STAGE(PG8_SB(1, 0), b3, voffB);
            PG8_BAR; PG8_WAIT_L(0); PG8_MMA(0, 1, At, B1); PG8_BAR;
            PG8_LDA(At, 1, 1); PG8_STAGE(PG8_SA(1, 0), a3, voffA);
            PG8_BAR; PG8_WAIT_L(0); PG8_MMA(1, 0, At, B0); PG8_BAR; PG8_SCHED;
            PG8_STAGE(PG8_SB(1, 1), b3 + hstepB, voffB);
            PG8_WAIT_V(6); PG8_BAR; PG8_MMA(1, 1, At, B1); PG8_BAR;
            }
        }
        if constexpr (ALIGN_EPI) { if (wr == 0) PG8_BAR; }
        if constexpr (!Epi::AFTER_DRAIN) { E(acc, cur, wr, wc, fr, fq); S.done(cur); }
        if (!has_next) break;
#pragma unroll
        for (int a = 0; a < 2; ++a)
#pragma unroll
            for (int b = 0; b < 2; ++b)
#pragma unroll
                for (int m = 0; m < 4; ++m)
#pragma unroll
                    for (int n = 0; n < 2; ++n) acc[a][b][m][n] = (f32x4){0.f, 0.f, 0.f, 0.f};
        cur = nxt; cA = nA; cB = nB; ++ui;
        if constexpr (ALIGN_EPI) { if (wr == 1) PG8_BAR; }
    }
    PG8_WAIT_V(0);
    if constexpr (!ALIGN_EPI) { if (wr == 0) PG8_BAR; }
    PG8_BAR;
    if constexpr (Epi::AFTER_DRAIN) { E.fused(acc, cur, wr, wc, fr, fq, lds, wid, lane); S.done(cur); }
#undef PG8_SA
#undef PG8_SB
#undef PG8_STAGE
#undef PG8_LDA
#undef PG8_LDB
#undef PG8_MMA
#undef PG8_WAIT_V
#undef PG8_WAIT_L
#undef PG8_BAR
#undef PG8_SCHED
}
}

namespace pg8 {
struct OneUnit {
    __device__ __forceinline__ bool next(int i, Unit& u) const { if (i) return false; u.pm = 0; u.pn = 0; return true; }
    __device__ __forceinline__ void a_ready(const Unit&) const {}
    __device__ __forceinline__ void done(const Unit&) const {}
};
typedef f32x4 AccT[2][2][4][2];

struct EpiQKV {
    static constexpr bool PERM = true, AFTER_DRAIN = false;
    bf16_t* Q; float* newk; float qscale;
    __device__ __forceinline__ void operator()(const AccT& acc, const Unit& u, int wr, int wc, int fr, int fq) const {
        const int t = u.pn >> 2;
        bf16_t* base = Q + (size_t)t * MT * D;
        const float sc = t == 0 ? qscale : 1.f;
        float* fo = newk + (size_t)(t - 1) * MC * D;
        const bool wf = (t != 0) && (u.pm < MC / 256);
        const int colt = (u.pn & 3) * 256 + wc * 32 + 8 * fq, row0 = u.pm * 256 + wr * 64 + fr;
#pragma unroll
        for (int ai = 0; ai < 2; ++ai)
#pragma unroll
            for (int m = 0; m < 4; ++m) {
                const size_t ro = (size_t)(row0 + ai * 128 + m * 16) * D;
#pragma unroll
                for (int bj = 0; bj < 2; ++bj) {
                    const f32x4 v0 = acc[ai][bj][m][0] * sc, v1 = acc[ai][bj][m][1] * sc;
                    u32x4 w; w.x = pk_bf16(v0[0], v0[1]); w.y = pk_bf16(v0[2], v0[3]); w.z = pk_bf16(v1[0], v1[1]); w.w = pk_bf16(v1[2], v1[3]);
                    *(u32x4*)(base + ro + colt + bj * 128) = w;
                    if (wf) { *(f32x4*)(fo + ro + colt + bj * 128) = v0; *(f32x4*)(fo + ro + colt + bj * 128 + 4) = v1; }
                }
            }
    }
};
template <bool FUSE, bool SRCF32> struct EpiResT {
    static constexpr bool PERM = true, AFTER_DRAIN = false;
    const float *xa, *xb;
    bf16_t* xres;
    const float* gate;
    bf16_t* XNo; const float* gn; const float* scv; float* ssq;
    __device__ __forceinline__ void operator()(const AccT& acc, const Unit& u, int wr, int wc, int fr, int fq) const {
        const bool isc = u.pm < MC / 256;
        const int cv = isc ? 8 : ((u.pm - MC / 256) >> 2);
        const float* src = isc ? xa : xb - (size_t)MC * D;
        const int col0 = u.pn * 256 + wc * 32 + 8 * fq, row0 = u.pm * 256 + wr * 64 + fr;
        f32x4 gv[2][2], gm[2][2];
#pragma unroll
        for (int bj = 0; bj < 2; ++bj)
#pragma unroll
            for (int n = 0; n < 2; ++n) {
                const int c = col0 + bj * 128 + n * 4;
                gv[bj][n] = *(const f32x4*)(gate + (size_t)cv * NMOD + c);
                if (FUSE) gm[bj][n] = *(const f32x4*)(gn + c) * (*(const f32x4*)(scv + (size_t)cv * NMOD + c) + 1.f);
            }
#pragma unroll
        for (int ai = 0; ai < 2; ++ai)
#pragma unroll
        for (int mp = 0; mp < 2; ++mp) {
            f32x4 xs[2][2][2];
#pragma unroll
            for (int mm = 0; mm < 2; ++mm)
#pragma unroll
                for (int bj = 0; bj < 2; ++bj) {
                    const size_t o = (size_t)(row0 + ai * 128 + (2 * mp + mm) * 16) * D + col0 + bj * 128;
                    if (SRCF32) { xs[mm][bj][0] = *(const f32x4*)(src + o); xs[mm][bj][1] = *(const f32x4*)(src + o + 4); }
                    else { const u32x4 w = *(const u32x4*)(xres + o); xs[mm][bj][0] = (f32x4){bf_lo(w.x), bf_hi(w.x), bf_lo(w.y), bf_hi(w.y)}; xs[mm][bj][1] = (f32x4){bf_lo(w.z), bf_hi(w.z), bf_lo(w.w), bf_hi(w.w)}; }
                }
            asm volatile("" ::: "memory");
#pragma unroll
            for (int mm = 0; mm < 2; ++mm) {
                const int m = 2 * mp + mm;
                const int row = row0 + ai * 128 + m * 16;
                const size_t ro = (size_t)row * D + col0;
                float sq = 0.f;
#pragma unroll
                for (int bj = 0; bj < 2; ++bj) {
                    const f32x4 x0 = xs[mm][bj][0] + gv[bj][0] * acc[ai][bj][m][0], x1 = xs[mm][bj][1] + gv[bj][1] * acc[ai][bj][m][1];
                    { u32x4 w; w.x = pk_bf16(x0[0], x0[1]); w.y = pk_bf16(x0[2], x0[3]); w.z = pk_bf16(x1[0], x1[1]); w.w = pk_bf16(x1[2], x1[3]); *(u32x4*)(xres + ro + bj * 128) = w; }
                    if (FUSE) {
                        sq += ((x0[0] * x0[0] + x0[1] * x0[1]) + (x0[2] * x0[2] + x0[3] * x0[3])) + ((x1[0] * x1[0] + x1[1] * x1[1]) + (x1[2] * x1[2] + x1[3] * x1[3]));
                        const f32x4 y0 = x0 * gm[bj][0], y1 = x1 * gm[bj][1];
                        u32x4 w; w.x = pk_bf16(y0[0], y0[1]); w.y = pk_bf16(y0[2], y0[3]); w.z = pk_bf16(y1[0], y1[1]); w.w = pk_bf16(y1[2], y1[3]);
                        *(u32x4*)(XNo + ro + bj * 128) = w;
                    }
                }
                if (FUSE) { sq += shfl_xor_l(sq, 16, fr + 16 * fq); sq += shfl_xor_l(sq, 32, fr + 16 * fq); if (fq == 0) unsafeAtomicAdd(ssq + row, sq); }
            }
            asm volatile("" ::: "memory");
        }
    }
};
struct EpiResFinal {
    static constexpr bool PERM = true, AFTER_DRAIN = false;
    const bf16_t* xres; const float* gate; float* ssq; unsigned* cnt; const float* gfin; float* out;
    __device__ __forceinline__ void operator()(const AccT& acc_c, const Unit& u, int wr, int wc, int fr, int fq) const {
        AccT& acc = const_cast<AccT&>(acc_c);
        const int cv = u.pm < MC / 256 ? 8 : ((u.pm - MC / 256) >> 2);
        const int col0 = u.pn * 256 + wc * 32 + 8 * fq, row0 = u.pm * 256 + wr * 64 + fr, lane = fr + 16 * fq;
        f32x4 gv[2][2];
#pragma unroll
        for (int bj = 0; bj < 2; ++bj)
#pragma unroll
            for (int n = 0; n < 2; ++n) gv[bj][n] = *(const f32x4*)(gate + (size_t)cv * NMOD + col0 + bj * 128 + n * 4);
#pragma unroll
        for (int ai = 0; ai < 2; ++ai)
#pragma unroll
        for (int mp = 0; mp < 2; ++mp) {
            u32x4 xs[2][2];
#pragma unroll
            for (int mm = 0; mm < 2; ++mm)
#pragma unroll
                for (int bj = 0; bj < 2; ++bj) xs[mm][bj] = *(const u32x4*)(xres + (size_t)(row0 + ai * 128 + (2 * mp + mm) * 16) * D + col0 + bj * 128);
            asm volatile("" ::: "memory");
#pragma unroll
            for (int mm = 0; mm < 2; ++mm) {
                const int m = 2 * mp + mm;
                float sq = 0.f;
#pragma unroll
                for (int bj = 0; bj < 2; ++bj) {
                    const u32x4 w = xs[mm][bj];
                    const f32x4 x0 = (f32x4){bf_lo(w.x), bf_hi(w.x), bf_lo(w.y), bf_hi(w.y)} + gv[bj][0] * acc[ai][bj][m][0], x1 = (f32x4){bf_lo(w.z), bf_hi(w.z), bf_lo(w.w), bf_hi(w.w)} + gv[bj][1] * acc[ai][bj][m][1];
                    acc[ai][bj][m][0] = x0; acc[ai][bj][m][1] = x1;
                    sq += ((x0[0] * x0[0] + x0[1] * x0[1]) + (x0[2] * x0[2] + x0[3] * x0[3])) + ((x1[0] * x1[0] + x1[1] * x1[1]) + (x1[2] * x1[2] + x1[3] * x1[3]));
                }
                sq += shfl_xor_l(sq, 16, lane); sq += shfl_xor_l(sq, 32, lane);
                if (fq == 0) unsafeAtomicAdd(ssq + row0 + ai * 128 + m * 16, sq);
            }
        }
        asm volatile("s_waitcnt vmcnt(0)" ::: "memory");
        unsigned* c = cnt + 64 * u.pm;
        if (lane == 0) __hip_atomic_fetch_add(c, 1u, __ATOMIC_RELAXED, __HIP_MEMORY_SCOPE_AGENT);
        { unsigned sp = 0;
          while ((unsigned)__builtin_amdgcn_readfirstlane(__hip_atomic_load(c, __ATOMIC_RELAXED, __HIP_MEMORY_SCOPE_AGENT)) < 32u) { __builtin_amdgcn_s_sleep(2); if (++sp > (1u << 20)) break; } }
        float rs[2][4];
#pragma unroll
        for (int ai = 0; ai < 2; ++ai)
#pragma unroll
            for (int m = 0; m < 4; ++m) rs[ai][m] = __hip_atomic_load(ssq + row0 + ai * 128 + m * 16, __ATOMIC_RELAXED, __HIP_MEMORY_SCOPE_AGENT);
        f32x4 gf[2][2];
#pragma unroll
        for (int bj = 0; bj < 2; ++bj)
#pragma unroll
            for (int n = 0; n < 2; ++n) gf[bj][n] = *(const f32x4*)(gfin + col0 + bj * 128 + n * 4);
#pragma unroll
        for (int ai = 0; ai < 2; ++ai)
#pragma unroll
            for (int m = 0; m < 4; ++m) {
                const float rstd = __builtin_amdgcn_rsqf(rs[ai][m] * (1.f / D) + RMS_EPS);
                float* op = out + (size_t)(row0 + ai * 128 + m * 16) * D + col0;
#pragma unroll
                for (int bj = 0; bj < 2; ++bj) { *(f32x4*)(op + bj * 128) = acc[ai][bj][m][0] * rstd * gf[bj][0]; *(f32x4*)(op + bj * 128 + 4) = acc[ai][bj][m][1] * rstd * gf[bj][1]; }
            }
    }
};
struct EpiSwiglu {
    static constexpr bool PERM = true, AFTER_DRAIN = false;
    bf16_t* H; const float* ssq; const float* shw;
    __device__ __forceinline__ void operator()(const AccT& acc, const Unit& u, int wr, int wc, int fr, int fq) const {
        const int cv = u.pm < MC / 256 ? 8 : ((u.pm - MC / 256) >> 2);
        const int col0 = u.pn * 128 + wc * 32 + 8 * fq, row0 = u.pm * 256 + wr * 64 + fr;
        const float* sp = shw + (size_t)cv * 2 * FF + u.pn * 256 + wc * 32 + 8 * fq;
        const f32x4 sg0 = *(const f32x4*)(sp), sg1 = *(const f32x4*)(sp + 4), su0 = *(const f32x4*)(sp + 128), su1 = *(const f32x4*)(sp + 132);
        float rs[2][4];
#pragma unroll
        for (int ai = 0; ai < 2; ++ai)
#pragma unroll
            for (int m = 0; m < 4; ++m) rs[ai][m] = ssq[row0 + ai * 128 + m * 16];
        asm volatile("" ::: "memory");
#pragma unroll
        for (int ai = 0; ai < 2; ++ai)
#pragma unroll
            for (int m = 0; m < 4; ++m) rs[ai][m] = __builtin_amdgcn_rsqf(rs[ai][m] * (1.f / D) + RMS_EPS);
#pragma unroll
        for (int ai = 0; ai < 2; ++ai)
#pragma unroll
            for (int m = 0; m < 4; ++m) {
                const int row = row0 + ai * 128 + m * 16;
                const float rstd = rs[ai][m];
                float o[8];
#pragma unroll
                for (int n = 0; n < 2; ++n) {
                    const f32x4 gq = acc[ai][0][m][n] * rstd + (n ? sg1 : sg0), uq = acc[ai][1][m][n] * rstd + (n ? su1 : su0);
#pragma unroll
                    for (int j = 0; j < 4; ++j) o[n * 4 + j] = silu_f(gq[j]) * uq[j];
                }
                u32x4 w; w.x = pk_bf16(o[0], o[1]); w.y = pk_bf16(o[2], o[3]); w.z = pk_bf16(o[4], o[5]); w.w = pk_bf16(o[6], o[7]);
                *(u32x4*)(H + (size_t)row * FF + col0) = w;
            }
    }
};
struct EpiWin {
    static constexpr bool PERM = true, AFTER_DRAIN = false;
    bf16_t *G, *XR; const float* ssq; const float* shw;
    __device__ __forceinline__ void operator()(const AccT& acc, const Unit& u, int wr, int wc, int fr, int fq) const {
        const bool isg = u.pn < 4;
        const int cv = u.pm < MC / 256 ? 8 : ((u.pm - MC / 256) >> 2);
        bf16_t* base = isg ? G : XR;
        const int colt = (u.pn & 3) * 256 + wc * 32 + 8 * fq, row0 = u.pm * 256 + wr * 64 + fr;
        const float* sp = shw + (size_t)cv * 2 * D + u.pn * 256 + wc * 32 + 8 * fq;
        f32x4 sv[2][2];
#pragma unroll
        for (int bj = 0; bj < 2; ++bj) { sv[bj][0] = *(const f32x4*)(sp + bj * 128); sv[bj][1] = *(const f32x4*)(sp + bj * 128 + 4); }
        float rs[2][4];
#pragma unroll
        for (int ai = 0; ai < 2; ++ai)
#pragma unroll
            for (int m = 0; m < 4; ++m) rs[ai][m] = ssq[row0 + ai * 128 + m * 16];
        asm volatile("" ::: "memory");
#pragma unroll
        for (int ai = 0; ai < 2; ++ai)
#pragma unroll
            for (int m = 0; m < 4; ++m) rs[ai][m] = __builtin_amdgcn_rsqf(rs[ai][m] * (1.f / D) + RMS_EPS);
#pragma unroll
        for (int ai = 0; ai < 2; ++ai)
#pragma unroll
            for (int m = 0; m < 4; ++m) {
                const int row = row0 + ai * 128 + m * 16;
                const float rstd = rs[ai][m];
#pragma unroll
                for (int bj = 0; bj < 2; ++bj) {
                    f32x4 v0 = acc[ai][bj][m][0] * rstd + sv[bj][0], v1 = acc[ai][bj][m][1] * rstd + sv[bj][1];
                    if (isg) {
#pragma unroll
                        for (int j = 0; j < 4; ++j) { v0[j] = gelu_tanh_f(v0[j]); v1[j] = gelu_tanh_f(v1[j]); }
                    }
                    u32x4 w; w.x = pk_bf16(v0[0], v0[1]); w.y = pk_bf16(v0[2], v0[3]); w.z = pk_bf16(v1[0], v1[1]); w.w = pk_bf16(v1[2], v1[3]);
                    *(u32x4*)(base + (size_t)row * D + colt + bj * 128) = w;
                }
            }
    }
};
struct EpiLru {
    static constexpr bool PERM = true, AFTER_DRAIN = true;
    LAS const unsigned long long* ptab;
    const float* h0;
    int row_base, cb, dir, q;

    template <int AI>
    __device__ __forceinline__ void half(const AccT& acc, int wr, int wc, int fr, int fq, PG8_LAS unsigned char* lds, int tid,
                                         const u32x4 (&xall)[4], bf16_t* HL, bf16_t* PP) const {
#pragma unroll
        for (int m = 0; m < 4; ++m) {
            const int tl = wr * 64 + m * 16 + fr;
            const size_t row = (size_t)(row_base + AI * 128 + tl);
#pragma unroll
            for (int n = 0; n < 2; ++n) {
                asm volatile("" ::: "memory");
                const int chl = wc * 32 + 8 * fq + 4 * n;
                const PG8_LAS f32x4* cst = (const PG8_LAS f32x4*)(lds + CST_OFF + chl * 4);
                const f32x4 ba = cst[0], bi = cst[32], L2 = cst[64];
                u32x2 xw; xw.x = n ? xall[m].z : xall[m].x; xw.y = n ? xall[m].w : xall[m].y;
                const f32x4 xc = {bf_lo(xw.x), bf_hi(xw.x), bf_lo(xw.y), bf_hi(xw.y)};
                f32x4 av, bv;
#pragma unroll
                for (int j = 0; j < 4; ++j) {
                    const float za = acc[AI][0][m][n][j] + ba[j], zi = acc[AI][1][m][n][j] + bi[j];
                    const float r = sigmoid_f(za), ig = sigmoid_f(zi);
                    const float a = fast_exp2(r * L2[j]);
                    av[j] = a; bv[j] = __builtin_amdgcn_sqrtf(1.f - a * a) * (ig * xc[j]);
                }
                PG8_LAS f32x4* dst = (PG8_LAS f32x4*)(lds + tl * AB_PITCH + chl * 8);
                dst[0] = (f32x4){av[0], bv[0], av[1], bv[1]}; dst[1] = (f32x4){av[2], bv[2], av[3], bv[3]};
            }
        }
        __syncthreads();
        if (tid < 128) {
            PG8_LAS float* hst = (PG8_LAS float*)(lds + HST_OFF);
            float h = hst[tid], P = hst[128 + tid];
            PG8_LAS f32x2* col = (PG8_LAS f32x2*)(lds + tid * 8);
            if (dir == 0) {
#pragma unroll 8
                for (int t = 0; t < 128; ++t) { PG8_LAS f32x2* p = (PG8_LAS f32x2*)((PG8_LAS unsigned char*)col + t * AB_PITCH); const f32x2 ab = *p; h = ab.x * h + ab.y; P *= ab.x; *p = (f32x2){h, P}; }
            } else {
#pragma unroll 8
                for (int t = 127; t >= 0; --t) { PG8_LAS f32x2* p = (PG8_LAS f32x2*)((PG8_LAS unsigned char*)col + t * AB_PITCH); const f32x2 ab = *p; h = ab.x * h + ab.y; P *= ab.x; *p = (f32x2){h, P}; }
            }
            hst[tid] = h; hst[128 + tid] = P;
        }
        __syncthreads();
        const bool lat = row_base >= MC;
#pragma unroll
        for (int it = 0; it < 8; ++it) {
            const int idx = it * 512 + tid, tl = idx >> 5, c4 = (idx & 31) * 4;
            const PG8_LAS f32x4* src = (const PG8_LAS f32x4*)(lds + tl * AB_PITCH + c4 * 8);
            const f32x4 s0 = src[0], s1 = src[1];
            const size_t row = (size_t)(row_base + AI * 128 + tl);
            { u32x2 wh; wh.x = pk_bf16(s0[0], s0[2]); wh.y = pk_bf16(s1[0], s1[2]); *(u32x2*)(HL + row * D + cb + c4) = wh; }
            if (lat) { u32x2 w; w.x = pk_bf16(s0[1], s0[3]); w.y = pk_bf16(s1[1], s1[3]); *(u32x2*)(PP + (row - MC) * D + cb + c4) = w; }
        }
        __syncthreads();
    }
    __device__ __forceinline__ void fused(AccT& acc, const Unit&, int wr, int wc, int fr, int fq, PG8_LAS unsigned char* lds, int wid, int lane) const {
        const int tid = wid * 64 + lane;
        const PT pt{ptab};
        unsigned char* ws = pt.ws();
        PG8_LAS float* hst = (PG8_LAS float*)(lds + HST_OFF);
        PG8_LAS float* cst = (PG8_LAS float*)(lds + CST_OFF);
        if (tid < 128) {
            hst[tid] = h0 ? h0[cb + tid] : 0.f; hst[128 + tid] = 1.f;
            const int ch = dir * D + cb + tid;
            cst[tid] = pt.f(I_b_a)[ch]; cst[128 + tid] = pt.f(I_b_i)[ch];
            const float l = pt.f(I_lam)[ch];
            const float x = __expf(-l);
            const float sp = x < 0.03f ? x * (1.f - x * (0.5f - x * (0.33333334f - 0.25f * x))) : __logf(1.f + x);
            cst[256 + tid] = -8.0f * sp * LOG2E;
        }
        __syncthreads();
        const bf16_t* XC = (const bf16_t*)(ws + WS_XN);
        bf16_t* HL = (bf16_t*)(ws + (dir ? WS_HLB : WS_HLF));
        bf16_t* PP = (bf16_t*)(ws + (dir ? WS_PB : WS_PF));
        u32x4 xc0[4], xc1[4];
#pragma unroll
        for (int m = 0; m < 4; ++m) {
            xc0[m] = *(const u32x4*)(XC + (size_t)(row_base + wr * 64 + m * 16 + fr) * D + cb + wc * 32 + 8 * fq);
            xc1[m] = *(const u32x4*)(XC + (size_t)(row_base + 128 + wr * 64 + m * 16 + fr) * D + cb + wc * 32 + 8 * fq);
        }
        if (dir == 0) { half<0>(acc, wr, wc, fr, fq, lds, tid, xc0, HL, PP); half<1>(acc, wr, wc, fr, fq, lds, tid, xc1, HL, PP); }
        else          { half<1>(acc, wr, wc, fr, fq, lds, tid, xc1, HL, PP); half<0>(acc, wr, wc, fr, fq, lds, tid, xc0, HL, PP); }
        if (tid < 128) {
            const float h = hst[tid], P = hst[128 + tid];
            float* sumE = (float*)(ws + WS_SUME) + (size_t)dir * 48 * D; float* sumP = (float*)(ws + WS_SUMP) + (size_t)dir * 48 * D;
            sumE[(size_t)q * D + cb + tid] = h; sumP[(size_t)q * D + cb + tid] = P;
            if (row_base < MC) pt.out()[OUT_NH + (size_t)q * 2 * D + dir * D + cb + tid] = h;
        }
        __syncthreads();
    }
};
}
namespace att {
constexpr int KP = 144, VP = 136;
constexpr int K_OFF = 0, V_OFF = 2 * 64 * KP, F_OFF = V_OFF + 2 * 64 * KP, T_OFF = F_OFF + 8 * 32 * 4, A_END = T_OFF + 640 * 4;
typedef short v4i16_t __attribute__((ext_vector_type(4)));
#define MFMA32(a, b, c) __builtin_amdgcn_mfma_f32_32x32x16_bf16((a), (b), (c), 0, 0, 0)
__device__ __forceinline__ float max2f(float a, float b) { float r; asm("v_max_f32_e32 %0, %1, %2" : "=v"(r) : "v"(a), "v"(b)); return r; }
__device__ __forceinline__ float max3f(float a, float b, float c) { float r; asm("v_max3_f32 %0, %1, %2, %3" : "=v"(r) : "v"(a), "v"(b), "v"(c)); return r; }
__device__ __forceinline__ int crow(int r, int hi) { return (r & 3) + 8 * (r >> 2) + 4 * hi; }

template <bool NA>
__device__ __forceinline__ void unit(int wv, LAS unsigned char* lds, int b, int h, int g, const bf16_t* __restrict__ Qb, const bf16_t* __restrict__ Kb, const bf16_t* __restrict__ Vb,
                                     const bf16_t* __restrict__ CK, const bf16_t* __restrict__ CV, bf16_t* __restrict__ Ob, const float* __restrict__ rpb) {
    int wid_ = wv; asm volatile("" : "+s"(wid_));
    const int tid = tid_l(wid_), lane = tid & 63, wid = wid_, r32 = lane & 31, hi = lane >> 5;
    LAS float* fscr = (LAS float*)(lds + F_OFF) + wid * 32;
    LAS float* tab = (LAS float*)(lds + T_OFF);
    if (NA) { for (int i = tid; i < 15 * 31; i += 512) { const int dr = i / 31, dc = i % 31; tab[64 + dr * 32 + dc] = rpb[(h * 15 + dr) * 31 + dc] * LOG2E; } }
    int qrow, nlat, ntile, Rlo = 0, rq = 0, rs = 0;
    if (NA) {
        rq = 4 * g + (wid >> 1); rs = min(max(rq - 4, 0), 8);
        qrow = MC + b * 1024 + rq * 64 + 32 * (wid & 1) + r32;
        Rlo = min(max(4 * g - 4, 0), 8); const int Rhi = min(max(4 * g - 1, 0), 8) + 8;
        nlat = Rhi - Rlo; ntile = nlat + 8;
    } else { qrow = b * 256 + 32 * wid + r32; nlat = 4; ntile = 4; }
    const int qc = 32 * (wid & 1) + r32, cs = min(max(qc - 8, 0), 48);
    f32x16 pen0, pen1;
#pragma unroll
    for (int i = 0; i < 16; ++i) { const int kc = (i & 3) + 8 * (i >> 2) + 4 * hi - cs; pen0[i] = (NA && (unsigned)kc >= 16u) ? -1e30f : 0.f; pen1[i] = (NA && (unsigned)(kc + 32) >= 16u) ? -1e30f : 0.f; }
    bf16x8 qr[4];
#pragma unroll
    for (int s = 0; s < 4; ++s) qr[s] = *(const bf16x8*)(Qb + (size_t)qrow * D + h * 64 + 16 * s + 8 * hi);
    const int lkey = tid >> 3, lch = tid & 7;
    auto src_row = [&](int t) -> size_t {
        if (NA) return t < nlat ? (size_t)(MC + b * 1024 + (Rlo + t) * 64) : (size_t)(b * 512 + (t - nlat) * 64);
        return (size_t)(b * 256 + t * 64);
    };
    u32x4 kreg, vreg;
    auto gload = [&](int t) {
        const bool cache = NA && t >= nlat;
        const bf16_t* kp = cache ? CK : Kb; const bf16_t* vp = cache ? CV : Vb;
        const size_t off = (src_row(t) + lkey) * D + h * 64 + 8 * lch;
        kreg = *(const u32x4*)(kp + off); vreg = *(const u32x4*)(vp + off);
    };
    auto lstore = [&](int buf) {
        *(LAS u32x4*)(lds + K_OFF + buf * 64 * KP + lkey * KP + lch * 16) = kreg;
        *(LAS u32x4*)(lds + V_OFF + buf * 64 * KP + lkey * KP + lch * 16) = vreg;
    };
    float m_run = -1e30f, l_run = 0.f;
    f32x16 o0, o1;
#pragma unroll
    for (int i = 0; i < 16; ++i) { o0[i] = 0.f; o1[i] = 0.f; }
    gload(0); lstore(0);
    asm volatile("" :: "v"(qr[0]), "v"(qr[1]), "v"(qr[2]), "v"(qr[3]));
    __syncthreads();
    for (int t = 0; t < ntile; ++t) {
        const int buf = t & 1;
        if (t + 1 < ntile) gload(t + 1);
        bool active = true, biased = false; int dr = 0;
        if (NA && t < nlat) { const int R = Rlo + t; active = (R >= rs) && (R < rs + 8); biased = true; dr = R - rq + 7; }
        if (active) {
            f32x16 p0, p1;
#pragma unroll
            for (int i = 0; i < 16; ++i) { p0[i] = 0.f; p1[i] = 0.f; }
            const LAS unsigned char* kb = lds + K_OFF + buf * 64 * KP + r32 * KP + 16 * hi;
#pragma unroll
            for (int s = 0; s < 4; ++s) {
                const bf16x8 k0 = *(const LAS bf16x8*)(kb + 32 * s), k1 = *(const LAS bf16x8*)(kb + 32 * KP + 32 * s);
                p0 = MFMA32(k0, qr[s], p0); p1 = MFMA32(k1, qr[s], p1);
            }
            if (biased) {
                const LAS float* tb = tab + 64 + dr * 32 + (4 * hi - qc + 15);
                f32x16 b0, b1;
#pragma unroll
                for (int i = 0; i < 16; ++i) { const int kc = (i & 3) + 8 * (i >> 2); b0[i] = tb[kc]; b1[i] = tb[kc + 32]; }
                p0 += b0; p1 += b1; p0 += pen0; p1 += pen1;
            }
            float mxa = max3f(p0[0], p0[1], p0[2]), mxb = max3f(p0[3], p0[4], p0[5]), mxc = max3f(p1[0], p1[1], p1[2]), mxd = max3f(p1[3], p1[4], p1[5]);
            mxa = max3f(mxa, p0[6], p0[7]); mxb = max3f(mxb, p0[8], p0[9]); mxc = max3f(mxc, p1[6], p1[7]); mxd = max3f(mxd, p1[8], p1[9]);
            mxa = max3f(mxa, p0[10], p0[11]); mxb = max3f(mxb, p0[12], p0[13]); mxc = max3f(mxc, p1[10], p1[11]); mxd = max3f(mxd, p1[12], p1[13]);
            mxa = max3f(mxa, p0[14], p0[15]); mxc = max3f(mxc, p1[14], p1[15]);
            float mx = max2f(max2f(mxa, mxb), max2f(mxc, mxd));
            mx = max2f(mx, shfl_xor_l(mx, 32, lane));
            const float mnew = max2f(m_run, mx);
            const float f = fast_exp2(m_run - mnew);
            m_run = mnew;
            p0 -= mnew; p1 -= mnew;
#pragma unroll
            for (int i = 0; i < 16; ++i) { p0[i] = fast_exp2(p0[i]); p1[i] = fast_exp2(p1[i]); }
            f32x4 ls4 = {0.f, 0.f, 0.f, 0.f};
#pragma unroll
            for (int i = 0; i < 16; i += 4) ls4 += (f32x4){p0[i], p0[i + 1], p0[i + 2], p0[i + 3]} + (f32x4){p1[i], p1[i + 1], p1[i + 2], p1[i + 3]};
            const float ls = (ls4[0] + ls4[1]) + (ls4[2] + ls4[3]);
            l_run = l_run * f + ls;
            if (__any(f != 1.f)) {
                if (hi == 0) fscr[r32] = f;
                asm volatile("s_waitcnt lgkmcnt(0)" ::: "memory");
#pragma unroll
                for (int i = 0; i < 16; ++i) { const float fi = fscr[crow(i, hi)]; o0[i] *= fi; o1[i] *= fi; }
                asm volatile("s_waitcnt lgkmcnt(0)" ::: "memory");
            }
            bf16x8 pa[2][2];
#pragma unroll
            for (int s = 0; s < 2; ++s) {
                u32x4 w0, w1;
                w0.x = pk_bf16(p0[8 * s + 0], p0[8 * s + 1]); w0.y = pk_bf16(p0[8 * s + 2], p0[8 * s + 3]); w0.z = pk_bf16(p0[8 * s + 4], p0[8 * s + 5]); w0.w = pk_bf16(p0[8 * s + 6], p0[8 * s + 7]);
                w1.x = pk_bf16(p1[8 * s + 0], p1[8 * s + 1]); w1.y = pk_bf16(p1[8 * s + 2], p1[8 * s + 3]); w1.z = pk_bf16(p1[8 * s + 4], p1[8 * s + 5]); w1.w = pk_bf16(p1[8 * s + 6], p1[8 * s + 7]);
                pa[0][s] = __builtin_bit_cast(bf16x8, w0); pa[1][s] = __builtin_bit_cast(bf16x8, w1);
            }
            const int i16 = lane & 15, g16 = (lane >> 4) & 1;
            const LAS unsigned char* vb = lds + V_OFF + buf * 64 * KP + (4 * hi + (i16 >> 2)) * KP + (16 * g16 + 4 * (i16 & 3)) * 2;
#pragma unroll
            for (int blk = 0; blk < 2; ++blk)
#pragma unroll
                for (int s = 0; s < 2; ++s) {
                    const int ko = (32 * blk + 16 * s) * KP;
                    const s16x4 a0 = __builtin_bit_cast(s16x4, __builtin_amdgcn_ds_read_tr16_b64_v4i16((LAS v4i16_t*)(vb + ko))), a1 = __builtin_bit_cast(s16x4, __builtin_amdgcn_ds_read_tr16_b64_v4i16((LAS v4i16_t*)(vb + ko + 8 * KP)));
                    const s16x4 c0 = __builtin_bit_cast(s16x4, __builtin_amdgcn_ds_read_tr16_b64_v4i16((LAS v4i16_t*)(vb + ko + 64))), c1 = __builtin_bit_cast(s16x4, __builtin_amdgcn_ds_read_tr16_b64_v4i16((LAS v4i16_t*)(vb + ko + 8 * KP + 64)));
                    const bf16x8 v0 = __builtin_shufflevector(a0, a1, 0, 1, 2, 3, 4, 5, 6, 7), v1 = __builtin_shufflevector(c0, c1, 0, 1, 2, 3, 4, 5, 6, 7);
                    o0 = MFMA32(pa[blk][s], v0, o0); o1 = MFMA32(pa[blk][s], v1, o1);
                }
        }
        if (t + 1 < ntile) lstore(buf ^ 1);
        __syncthreads();
    }
    l_run += shfl_xor_l(l_run, 32, lane);
    if (hi == 0) fscr[r32] = fast_rcp(l_run);
    asm volatile("s_waitcnt lgkmcnt(0)" ::: "memory");
    const int qbase = qrow - r32;
    LAS unsigned char* stg = lds + K_OFF + wid * (32 * KP);
#pragma unroll
    for (int i = 0; i < 16; ++i) {
        const int qi = crow(i, hi); const float li = fscr[qi];
        LAS unsigned short* sp = (LAS unsigned short*)(stg + qi * KP + r32 * 2);
        sp[0] = (unsigned short)(pk_bf16(o0[i] * li, 0.f) & 0xffff); sp[32] = (unsigned short)(pk_bf16(o1[i] * li, 0.f) & 0xffff);
    }
    asm volatile("s_waitcnt lgkmcnt(0)" ::: "memory");
    {
        const int row = lane >> 1, half = lane & 1;
        bf16_t* op = Ob + (size_t)(qbase + row) * D + h * 64 + half * 32;
#pragma unroll
        for (int j = 0; j < 4; ++j) *(u32x4*)(op + 8 * j) = *(const LAS u32x4*)(stg + row * KP + half * 64 + 16 * j);
    }
    __syncthreads();
}
}
#ifndef REP_P4
#define REP_P4 1
#endif
#ifndef REP_ADA
#define REP_ADA 1
#endif
#ifndef REP_PRO
#define REP_PRO 1
#endif
#ifndef REP_FILL
#define REP_FILL 1
#endif
#ifndef REP_ATT
#define REP_ATT 1
#endif
#ifndef REP_GEMM
#define REP_GEMM 1
#endif
#ifndef REP_THIN
#define REP_THIN 1
#endif
#ifndef REP_LRU
#define REP_LRU 1
#endif
#ifndef REP_SYNC
#define REP_SYNC 1
#endif
struct Args {
    const float *x_prompt, *x_sample, *c, *cache_k, *cache_v, *state_h, *c_ctx, *norm_g, *w_mod, *b_mod, *w_qkv, *w_o, *rpb, *w_in, *conv_w, *conv_b,
                *w_a, *b_a, *w_i, *b_i, *lam, *w_out, *w_gu, *w_down, *final_g;
    float* out; unsigned char* ws;
};

__device__ __forceinline__ void tr_item(const float* __restrict__ W, int ldw, int k0, int n0, bf16_t* __restrict__ dst, int ldd, LAS float* scr, int lane) {
    float tv[32];
#pragma unroll
    for (int i = 0; i < 32; ++i) { const int kk = 2 * i + (lane >> 5); tv[i] = W[(size_t)(k0 + kk) * ldw + n0 + (lane & 31)]; }
#pragma unroll
    for (int i = 0; i < 32; ++i) { const int kk = 2 * i + (lane >> 5); scr[kk * 33 + (lane & 31)] = tv[i]; }
    asm volatile("s_waitcnt lgkmcnt(0)" ::: "memory");
    const int c = lane & 7;
#pragma unroll
    for (int j = 0; j < 4; ++j) {
        const int n = (lane >> 3) + 8 * j; const LAS float* s = scr + (8 * c) * 33 + n;
        u32x4 o; o.x = pk_bf16(s[0 * 33], s[1 * 33]); o.y = pk_bf16(s[2 * 33], s[3 * 33]); o.z = pk_bf16(s[4 * 33], s[5 * 33]); o.w = pk_bf16(s[6 * 33], s[7 * 33]);
        *(u32x4*)(dst + (size_t)n * ldd + k0 + 8 * c) = o;
    }
    asm volatile("s_waitcnt lgkmcnt(0)" ::: "memory");
}

__device__ __forceinline__ void tr_items(int wv, const PT pt, LAS unsigned char* lds, int it0, int it1, int gwr, int ngw) {
    const int lane = tid_l(wv) & 63;
    unsigned char* ws = pt.ws();
    {
        LAS float* scr = (LAS float*)(lds + wv * 8448);
        constexpr int I_QKV = 16 * 96, I_WO = 16 * 32, I_GU = 16 * 176, I_DN = 44 * 32, I_WIN = 16 * 64, I_WOUT = 16 * 32, I_G = 32 * 8;
        for (int it = it0 + gwr; it < it1; it += ngw) {
            int r = it;
            if (r < I_QKV) { const int kb = r / 96, nb = r % 96; tr_item(pt.f(I_w_qkv), NQKV, 64 * kb, 32 * nb, (bf16_t*)(ws + WS_WQKV) + (size_t)(32 * nb) * D, D, scr, lane); continue; } r -= I_QKV;
            if (r < I_WO) { const int kb = r / 32, nb = r % 32; tr_item(pt.f(I_w_o), D, 64 * kb, 32 * nb, (bf16_t*)(ws + WS_WO) + (size_t)(32 * nb) * D, D, scr, lane); continue; } r -= I_WO;
#pragma unroll 1
            for (int l = 0; l < 2; ++l) {
                if (r >= 0 && r < I_GU) { const int kb = r / 176, nb = r % 176; const int n0 = 32 * nb, half = n0 >= FF ? 1 : 0, c0 = n0 - half * FF;
                    const int drow = 256 * (c0 >> 7) + 128 * half + (c0 & 127);
                    tr_item(pt.f(I_w_gu) + (size_t)l * D * 2 * FF, 2 * FF, 64 * kb, n0, (bf16_t*)(ws + WS_WGU) + ((size_t)l * 2 * FF + drow) * D, D, scr, lane); r = -1; break; } r -= I_GU;
                if (r >= 0 && r < I_DN) { const int kb = r / 32, nb = r % 32;
                    tr_item(pt.f(I_w_down) + (size_t)l * FF * D, D, 64 * kb, 32 * nb, (bf16_t*)(ws + WS_WDN) + ((size_t)l * D + 32 * nb) * FF, FF, scr, lane); r = -1; break; } r -= I_DN;
            }
            if (r < 0) continue;
            if (r < I_WIN) { const int kb = r / 64, nb = r % 64; tr_item(pt.f(I_w_in), 2 * D, 64 * kb, 32 * nb, (bf16_t*)(ws + WS_WIN) + (size_t)(32 * nb) * D, D, scr, lane); continue; } r -= I_WIN;
            if (r < I_WOUT) { const int kb = r / 32, nb = r % 32; tr_item(pt.f(I_w_out), D, 64 * kb, 32 * nb, (bf16_t*)(ws + WS_WOUT) + (size_t)(32 * nb) * D, D, scr, lane); continue; } r -= I_WOUT;
            { const int mat = r >> 3, sub = r & 7, kb = sub >> 2, nb = sub & 3;
              const int gsel = mat >> 4, dir = (mat >> 3) & 1, blk = mat & 7;
              const float* src = (gsel ? pt.f(I_w_i) : pt.f(I_w_a)) + (size_t)(dir * 8 + blk) * 128 * 128;
              tr_item(src, 128, 64 * kb, 32 * nb, (bf16_t*)(ws + WS_WG) + ((size_t)((blk * 2 + dir) * 256 + gsel * 128 + 32 * nb)) * 128, 128, scr, lane); }
        }
    }
}

__device__ __forceinline__ void adaln_tasks(int wv, const PT pt, LAS unsigned char* lds, int l, int rank, int nb) {
    const int tid = tid_l(wv);
    LAS float* sl = (LAS float*)(lds + 70000);
    LAS float* red = (LAS float*)lds;
    float* mod = (float*)(pt.ws() + WS_MOD);
#pragma unroll 1
    for (int task = rank; task < 256; task += nb) {
        const int cg_ = task >> 3, kr = task & 7, col0 = cg_ * 192;
        __syncthreads();
        for (int i = tid; i < 9 * 128; i += 512) { const int cv = i >> 7, k = kr * 128 + (i & 127); const float v = cv < 8 ? pt.f(I_c)[cv * D + k] : pt.f(I_c_ctx)[k]; sl[i] = silu_f(v); }
        __syncthreads();
        if (tid < 384) {
            const int q = tid % 48, ks = tid / 48;
            float acc[9][4];
#pragma unroll
            for (int cv = 0; cv < 9; ++cv) { acc[cv][0] = 0.f; acc[cv][1] = 0.f; acc[cv][2] = 0.f; acc[cv][3] = 0.f; }
            const float* wp = pt.f(I_w_mod) + ((size_t)l * D + kr * 128 + ks * 16) * NMOD + col0 + 4 * q;
            f32x4 w[16];
#pragma unroll
            for (int k = 0; k < 16; ++k) w[k] = *(const f32x4*)(wp + (size_t)k * NMOD);
#pragma unroll
            for (int k = 0; k < 16; ++k) {
#pragma unroll
                for (int cv = 0; cv < 9; ++cv) { const float s = sl[cv * 128 + ks * 16 + k]; acc[cv][0] += s * w[k][0]; acc[cv][1] += s * w[k][1]; acc[cv][2] += s * w[k][2]; acc[cv][3] += s * w[k][3]; }
            }
#pragma unroll
            for (int cv = 0; cv < 9; ++cv) *(LAS f32x4*)(red + (ks * 9 + cv) * 192 + 4 * q) = (f32x4){acc[cv][0], acc[cv][1], acc[cv][2], acc[cv][3]};
        }
        __syncthreads();
        for (int i = tid; i < 9 * 192; i += 512) {
            const int cv = i / 192, cc = i % 192; float s = 0.f;
#pragma unroll
            for (int ks = 0; ks < 8; ++ks) s += red[(ks * 9 + cv) * 192 + cc];
            if (kr == 0) s += pt.f(I_b_mod)[l * NMOD + col0 + cc];
            unsafeAtomicAdd(mod + ((size_t)l * 9 + cv) * NMOD + col0 + cc, s);
        }
    }
    __syncthreads();
}

__device__ __forceinline__ void cache_conv(int wv, const PT pt, int rank, int nb) {
    const int tid = tid_l(wv);
    unsigned char* ws = pt.ws();
    const size_t n4 = (size_t)MC * D / 4;
#pragma unroll 8
    for (size_t i = (size_t)rank * 512 + tid; i < 2 * n4; i += (size_t)nb * 512) {
        const bool isv = i >= n4; const size_t j = isv ? i - n4 : i;
        const f32x4 v = *((const f32x4*)(isv ? pt.f(I_cache_v) : pt.f(I_cache_k)) + j);
        u32x2 w; w.x = pk_bf16(v[0], v[1]); w.y = pk_bf16(v[2], v[3]);
        *((u32x2*)(ws + (isv ? WS_CV : WS_CK)) + j) = w;
    }
}

__device__ __forceinline__ void p0_prologue(int wv, const PT pt, LAS unsigned char* lds) {
    const int tid = tid_l(wv), lane = tid & 63, wave = tid >> 6;
    const int G = gd_l(), bxl = bx_l(), gw = bxl * 8 + wave, NGW = G * 8;
    unsigned char* ws = pt.ws();
    adaln_tasks(wv, pt, lds, 0, bxl, G);
    for (int rp_ = 0; rp_ < REP_PRO; ++rp_) tr_items(wv, pt, lds, 0, 16 * 96, gw, NGW);
}

__device__ __forceinline__ void norm_phase(int wv, const float* xa, const float* xb, const float* g, const float* mod_l, int sh_chunk, bf16_t* XN) {
    const int tid = tid_l(wv), lane = tid & 63, gw = bx_l() * 8 + (tid >> 6), NGW = gd_l() * 8;
#pragma unroll 2
    for (int row = gw; row < MT; row += NGW) {
        const float* xr = row < MC ? xa + (size_t)row * D : xb + (size_t)(row - MC) * D;
        const int cv = row < MC ? 8 : ((row - MC) >> 10);
        const float* shp = mod_l + (size_t)cv * NMOD + sh_chunk * D; const float* scp = shp + D;
        f32x4 v[4], gg4[4], sc4[4], sh4[4]; float s = 0.f;
#pragma unroll
        for (int j = 0; j < 4; ++j) { const int c = 4 * lane + 256 * j; v[j] = *((const f32x4*)xr + lane + 64 * j); gg4[j] = *(const f32x4*)(g + c); sc4[j] = *(const f32x4*)(scp + c); sh4[j] = *(const f32x4*)(shp + c); }
#pragma unroll
        for (int j = 0; j < 4; ++j) s += (v[j][0] * v[j][0] + v[j][1] * v[j][1]) + (v[j][2] * v[j][2] + v[j][3] * v[j][3]);
        const float rstd = 1.f / sqrtf(wave_sum(s, lane) * (1.f / D) + RMS_EPS);
#pragma unroll
        for (int j = 0; j < 4; ++j) {
            const int c = 4 * lane + 256 * j;
            const f32x4 gg = gg4[j], sc = sc4[j], sh = sh4[j];
            const f32x4 y = v[j] * rstd * gg * (sc + 1.f) + sh;
            u32x2 w; w.x = pk_bf16(y[0], y[1]); w.y = pk_bf16(y[2], y[3]);
            *(u32x2*)(XN + (size_t)row * D + c) = w;
        }
    }
}
__device__ __forceinline__ void final_norm_phase(int wv, const bf16_t* XB, float* Y, const float* g) {
    const int tid = tid_l(wv), lane = tid & 63, gw = bx_l() * 8 + (tid >> 6), NGW = gd_l() * 8;
#pragma unroll 2
    for (int row = gw; row < MT; row += NGW) {
        const u32x4* xr = (const u32x4*)(XB + (size_t)row * D);
        f32x4 v[4], gg[4]; float s = 0.f;
#pragma unroll
        for (int j = 0; j < 2; ++j) {
            const u32x4 w = xr[lane + 64 * j];
            v[2 * j] = (f32x4){bf_lo(w.x), bf_hi(w.x), bf_lo(w.y), bf_hi(w.y)}; v[2 * j + 1] = (f32x4){bf_lo(w.z), bf_hi(w.z), bf_lo(w.w), bf_hi(w.w)};
            gg[2 * j] = *(const f32x4*)(g + 8 * lane + 512 * j); gg[2 * j + 1] = *(const f32x4*)(g + 8 * lane + 512 * j + 4);
        }
#pragma unroll
        for (int j = 0; j < 4; ++j) s += (v[j][0] * v[j][0] + v[j][1] * v[j][1]) + (v[j][2] * v[j][2] + v[j][3] * v[j][3]);
        const float rstd = 1.f / sqrtf(wave_sum(s, lane) * (1.f / D) + RMS_EPS);
        float* yr = Y + (size_t)row * D;
#pragma unroll
        for (int j = 0; j < 2; ++j) { *(f32x4*)(yr + 8 * lane + 512 * j) = v[2 * j] * rstd * gg[2 * j]; *(f32x4*)(yr + 8 * lane + 512 * j + 4) = v[2 * j + 1] * rstd * gg[2 * j + 1]; }
    }
}
__device__ __forceinline__ void conv_phase(int wv, const bf16_t* XR, const float* cw, const float* cb, bf16_t* XC) {
    const size_t n8 = (size_t)MT * D / 8;
#pragma unroll 2
    for (size_t i = (size_t)bx_l() * 512 + tid_l(wv), st_ = (size_t)gd_l() * 512; i < n8; i += st_) {
        const int row = (int)(i >> 7), c = (int)(i & 127) * 8;
        int pos, len; if (row < MC) { pos = row & 255; len = 256; } else { pos = (row - MC) & 1023; len = 1024; }
        float y[8];
#pragma unroll
        for (int e = 0; e < 8; ++e) y[e] = cb[c + e];
#pragma unroll
        for (int j = 0; j < 4; ++j) {
            const int p = pos + j - 2;
            if (p >= 0 && p < len) {
                const u32x4 xw = *(const u32x4*)(XR + (size_t)(row + j - 2) * D + c);
                const f32x4 w0 = *(const f32x4*)(cw + j * D + c), w1 = *(const f32x4*)(cw + j * D + c + 4);
                y[0] += w0[0] * bf_lo(xw.x); y[1] += w0[1] * bf_hi(xw.x); y[2] += w0[2] * bf_lo(xw.y); y[3] += w0[3] * bf_hi(xw.y);
                y[4] += w1[0] * bf_lo(xw.z); y[5] += w1[1] * bf_hi(xw.z); y[6] += w1[2] * bf_lo(xw.w); y[7] += w1[3] * bf_hi(xw.w);
            }
        }
        u32x4 o; o.x = pk_bf16(y[0], y[1]); o.y = pk_bf16(y[2], y[3]); o.z = pk_bf16(y[4], y[5]); o.w = pk_bf16(y[6], y[7]);
        *(u32x4*)(XC + (size_t)row * D + c) = o;
    }
}
__device__ __forceinline__ void conv_slab(int wv, const bf16_t* XR, const float* cw, const float* cb, bf16_t* XC, int q, int n) {
    const int tid = tid_l(wv), ch = n * 128 + (tid & 15) * 8, r0 = q * 256 + (tid >> 4) * 8;
    int pos0, len; if (r0 < MC) { pos0 = r0 & 255; len = 256; } else { pos0 = (r0 - MC) & 1023; len = 1024; }
    u32x4 x[11];
#pragma unroll
    for (int i = 0; i < 11; ++i) { const int p = pos0 + i - 2; x[i] = (p >= 0 && p < len) ? *(const u32x4*)(XR + (size_t)(r0 + i - 2) * D + ch) : (u32x4){0u, 0u, 0u, 0u}; }
    f32x4 w0[4], w1[4];
#pragma unroll
    for (int j = 0; j < 4; ++j) { w0[j] = *(const f32x4*)(cw + j * D + ch); w1[j] = *(const f32x4*)(cw + j * D + ch + 4); }
    const f32x4 b0 = *(const f32x4*)(cb + ch), b1 = *(const f32x4*)(cb + ch + 4);
#pragma unroll
    for (int r = 0; r < 8; ++r) {
        f32x4 y0 = b0, y1 = b1;
#pragma unroll
        for (int j = 0; j < 4; ++j) { const u32x4 xw = x[r + j];
            y0 += w0[j] * (f32x4){bf_lo(xw.x), bf_hi(xw.x), bf_lo(xw.y), bf_hi(xw.y)}; y1 += w1[j] * (f32x4){bf_lo(xw.z), bf_hi(xw.z), bf_lo(xw.w), bf_hi(xw.w)}; }
        u32x4 o; o.x = pk_bf16(y0[0], y0[1]); o.y = pk_bf16(y0[2], y0[3]); o.z = pk_bf16(y1[0], y1[1]); o.w = pk_bf16(y1[2], y1[3]);
        *(u32x4*)(XC + (size_t)(r0 + r) * D + ch) = o;
    }
    asm volatile("s_waitcnt vmcnt(0)" ::: "memory");
    __syncthreads();
}

__device__ __forceinline__ void lru_combine_phase(int wv, const unsigned char* ws, bf16_t* Y) {
    const bf16_t* HLF = (const bf16_t*)(ws + WS_HLF); const bf16_t* HLB = (const bf16_t*)(ws + WS_HLB);
    const bf16_t* PF = (const bf16_t*)(ws + WS_PF); const bf16_t* PB = (const bf16_t*)(ws + WS_PB); const bf16_t* GT = (const bf16_t*)(ws + WS_GATE);
    const float* sE = (const float*)(ws + WS_SUME); const float* sP = (const float*)(ws + WS_SUMP);
    const size_t n8 = (size_t)MT * D / 8;
#pragma unroll 2
    for (size_t i = (size_t)bx_l() * 512 + tid_l(wv), st_ = (size_t)gd_l() * 512; i < n8; i += st_) {
        const int row = (int)(i >> 7), c = (int)(i & 127) * 8;
        const size_t off = (size_t)row * D + c;
        const u32x4 hf = *(const u32x4*)(HLF + off), hb = *(const u32x4*)(HLB + off), gt = *(const u32x4*)(GT + off);
        float h[8] = {bf_lo(hf.x) + bf_lo(hb.x), bf_hi(hf.x) + bf_hi(hb.x), bf_lo(hf.y) + bf_lo(hb.y), bf_hi(hf.y) + bf_hi(hb.y),
                      bf_lo(hf.z) + bf_lo(hb.z), bf_hi(hf.z) + bf_hi(hb.z), bf_lo(hf.w) + bf_lo(hb.w), bf_hi(hf.w) + bf_hi(hb.w)};
        if (row >= MC) {
            const int q = row >> 8, ci = (q - 16) & 3, q0 = q - ci;
            const u32x4 pf = *(const u32x4*)(PF + off - (size_t)MC * D), pb = *(const u32x4*)(PB + off - (size_t)MC * D);
            f32x4 tf0 = {0.f, 0.f, 0.f, 0.f}, tf1 = tf0, tb0 = tf0, tb1 = tf0;
            for (int cc = 0; cc < ci; ++cc) { const float* e = sE + (size_t)(q0 + cc) * D + c; const float* p = sP + (size_t)(q0 + cc) * D + c;
                tf0 = *(const f32x4*)e + *(const f32x4*)p * tf0; tf1 = *(const f32x4*)(e + 4) + *(const f32x4*)(p + 4) * tf1; }
            for (int cc = 3; cc > ci; --cc) { const float* e = sE + (size_t)(48 + q0 + cc) * D + c; const float* p = sP + (size_t)(48 + q0 + cc) * D + c;
                tb0 = *(const f32x4*)e + *(const f32x4*)p * tb0; tb1 = *(const f32x4*)(e + 4) + *(const f32x4*)(p + 4) * tb1; }
            h[0] += bf_lo(pf.x) * tf0[0] + bf_lo(pb.x) * tb0[0]; h[1] += bf_hi(pf.x) * tf0[1] + bf_hi(pb.x) * tb0[1];
            h[2] += bf_lo(pf.y) * tf0[2] + bf_lo(pb.y) * tb0[2]; h[3] += bf_hi(pf.y) * tf0[3] + bf_hi(pb.y) * tb0[3];
            h[4] += bf_lo(pf.z) * tf1[0] + bf_lo(pb.z) * tb1[0]; h[5] += bf_hi(pf.z) * tf1[1] + bf_hi(pb.z) * tb1[1];
            h[6] += bf_lo(pf.w) * tf1[2] + bf_lo(pb.w) * tb1[2]; h[7] += bf_hi(pf.w) * tf1[3] + bf_hi(pb.w) * tb1[3];
        }
        u32x4 o;
        o.x = pk_bf16(h[0] * bf_lo(gt.x), h[1] * bf_hi(gt.x)); o.y = pk_bf16(h[2] * bf_lo(gt.y), h[3] * bf_hi(gt.y));
        o.z = pk_bf16(h[4] * bf_lo(gt.z), h[5] * bf_hi(gt.z)); o.w = pk_bf16(h[6] * bf_lo(gt.w), h[7] * bf_hi(gt.w));
        *(u32x4*)(Y + off) = o;
    }
}

#ifndef PG8_SP2
#define PG8_SP2 true
#endif
#ifndef PG8_ALIGN
#define PG8_ALIGN true
#endif

__device__ __forceinline__ void shw_phase(int wv, const PT pt, LAS unsigned char* lds, const int site, int bx, int G) {
    const int tid = tid_l(wv), lane = tid & 63;
    unsigned char* ws = pt.ws();
    const int lb = bx, nb = G;
    LAS float* sl = (LAS float*)lds;
    const float* mod = (const float*)(ws + WS_MOD);
    const int l = site ? 1 : 0, chunk = (site == 1) ? 0 : 3, N = (site == 1) ? 2 * D : 2 * FF;
    const bf16_t* Wt = site == 0 ? (const bf16_t*)(ws + WS_WGU) : (site == 1 ? (const bf16_t*)(ws + WS_WIN) : (const bf16_t*)(ws + WS_WGU) + (size_t)2 * FF * D);
    float* out = (float*)(ws + WS_SHW) + (site == 0 ? SHW_OFF0 : (site == 1 ? SHW_OFF1 : SHW_OFF2));
    __syncthreads();
#pragma unroll
    for (int r = 0; r < 3; ++r) {
        float v[6];
#pragma unroll
        for (int j = 0; j < 6; ++j) { const int i = tid + 512 * (6 * r + j); v[j] = mod[((size_t)l * 9 + (i >> 10)) * NMOD + chunk * D + (i & 1023)]; }
#pragma unroll
        for (int j = 0; j < 6; ++j) sl[tid + 512 * (6 * r + j)] = v[j];
    }
    __syncthreads();
    const int step = nb * 8;
    int n = lb * 8 + wv;
    u32x2 wa[4];
    if (n < N) {
#pragma unroll
        for (int j = 0; j < 4; ++j) wa[j] = *(const u32x2*)(Wt + (size_t)n * D + 4 * lane + 256 * j);
    }
    for (; n < N; n += step) {
        u32x2 wb[4];
        const int n2 = n + step;
        if (n2 < N) {
#pragma unroll
            for (int j = 0; j < 4; ++j) wb[j] = *(const u32x2*)(Wt + (size_t)n2 * D + 4 * lane + 256 * j);
        }
        float res = 0.f;
#pragma unroll
        for (int cv = 0; cv < 9; ++cv) {
            float s = 0.f;
#pragma unroll
            for (int j = 0; j < 4; ++j) { const f32x4 v = *(const LAS f32x4*)(sl + cv * D + 4 * lane + 256 * j); s += (v[0] * bf_lo(wa[j].x) + v[1] * bf_hi(wa[j].x)) + (v[2] * bf_lo(wa[j].y) + v[3] * bf_hi(wa[j].y)); }
            s = wave_sum(s, lane);
            if (lane == cv) res = s;
        }
        if (lane < 9) out[(size_t)lane * N + n] = res;
#pragma unroll
        for (int j = 0; j < 4; ++j) wa[j] = wb[j];
    }
    __syncthreads();
}

#ifndef PHMASK
#define PHMASK 0xffff
#endif
constexpr int PHM = PHMASK;
__global__ void __launch_bounds__(512, 2) fwd_megakernel(Args a) {
    extern __shared__ __attribute__((aligned(16))) unsigned char lds_raw[];
    LAS unsigned char* lds = (LAS unsigned char*)lds_raw;
    cg::grid_group grid = cg::this_grid();
    const int wv = __builtin_amdgcn_readfirstlane(threadIdx.x >> 6);
    {
        LAS unsigned long long* tw = (LAS unsigned long long*)(lds + PTAB_OFF);
        if (threadIdx.x == 0) {
            tw[0] = (unsigned long long)a.x_prompt; tw[1] = (unsigned long long)a.x_sample; tw[2] = (unsigned long long)a.c; tw[3] = (unsigned long long)a.cache_k; tw[4] = (unsigned long long)a.cache_v;
            tw[5] = (unsigned long long)a.state_h; tw[6] = (unsigned long long)a.c_ctx; tw[7] = (unsigned long long)a.norm_g; tw[8] = (unsigned long long)a.w_mod; tw[9] = (unsigned long long)a.b_mod;
            tw[10] = (unsigned long long)a.w_qkv; tw[11] = (unsigned long long)a.w_o; tw[12] = (unsigned long long)a.rpb; tw[13] = (unsigned long long)a.w_in; tw[14] = (unsigned long long)a.conv_w;
            tw[15] = (unsigned long long)a.conv_b; tw[16] = (unsigned long long)a.w_a; tw[17] = (unsigned long long)a.b_a; tw[18] = (unsigned long long)a.w_i; tw[19] = (unsigned long long)a.b_i;
            tw[20] = (unsigned long long)a.lam; tw[21] = (unsigned long long)a.w_out; tw[22] = (unsigned long long)a.w_gu; tw[23] = (unsigned long long)a.w_down; tw[24] = (unsigned long long)a.final_g;
            tw[25] = (unsigned long long)a.out; tw[26] = (unsigned long long)a.ws;
            LAS unsigned* st = (LAS unsigned*)(lds + BARST_OFF); st[0] = 0u; st[1] = 0u;
            (void)xb_add((unsigned*)(a.ws + WS_BAR) + XB_XCNT(xb_xcc_id()), 1u);
        }
        __syncthreads();
        if (a.out == nullptr) grid.sync();
    }
#define GSYNC() do { for (int rs_ = 0; rs_ < REP_SYNC; ++rs_) xcd_barrier(pt, lds, wv); } while (0)
    const PT pt{(LAS const unsigned long long*)(lds + PTAB_OFF)};
#define WSP(off) (pt.ws() + (off))
#define MODP ((float*)WSP(WS_MOD))
#define XNP ((bf16_t*)WSP(WS_XN))
#define XRES (pt.out() + OUT_Y)
#define XBP ((bf16_t*)WSP(WS_XB))
#define SSQP(i) ((float*)WSP(WS_SSQ) + (size_t)(i) * MT)

    if (PHM & 1) p0_prologue(wv, pt, lds);
    GSYNC();
    if (PHM & 2) for (int rep_ = 0; rep_ < REP_THIN; ++rep_) norm_phase(wv, pt.f(I_x_prompt), pt.f(I_x_sample), pt.f(I_norm_g), MODP, 0, XNP);
    GSYNC();
    if (PHM & 4) { pg8::Gemm g{XNP, (const bf16_t*)WSP(WS_WQKV), MT, NQKV, D, D, D, wv}; pg8::StaticOrder S; S.init(MT, NQKV, gd_l(), bx_l()); S.reps = REP_GEMM;
      pg8::EpiQKV E{(bf16_t*)WSP(WS_Q), pt.out() + OUT_NK, 0.125f * LOG2E};
      pg8::gemm_phase<pg8::EpiQKV, pg8::StaticOrder, PG8_ALIGN, PG8_SP2>(lds, g, S, E); }
    {
        const int G_ = gd_l(), c_ = bx_l(), nwg_ = (MT / 256) * (NQKV / 256), maxu_ = (nwg_ + G_ - 1) / G_, full_ = nwg_ - (maxu_ - 1) * G_;
        int rank_ = c_, n_ = G_;
        if (full_ < G_) { rank_ = c_ - full_; n_ = c_ >= full_ ? G_ - full_ : 0; }
        if (n_ > 0) { tr_items(wv, pt, lds, 16 * 96, 16 * 96 + 16 * 32 + 16 * 176, rank_ * 8 + wv, n_ * 8); cache_conv(wv, pt, rank_, n_); }
    }
    GSYNC();
    if (PHM & 8) for (int rep_ = 0; rep_ < REP_ATT; ++rep_) for (int vc = vcu_l(), G_ = gd_l(); vc < 256; vc += G_) {
        const int bh = vc >> 1;
#pragma unroll 1
        for (int gi = 0; gi < 2; ++gi)
            att::unit<true>(wv, lds, bh >> 4, bh & 15, 2 * (vc & 1) + gi, (const bf16_t*)WSP(WS_Q), (const bf16_t*)WSP(WS_K), (const bf16_t*)WSP(WS_V), (const bf16_t*)WSP(WS_CK), (const bf16_t*)WSP(WS_CV), XNP, pt.f(I_rpb));
        att::unit<false>(wv, lds, vc >> 4, vc & 15, 0, (const bf16_t*)WSP(WS_Q), (const bf16_t*)WSP(WS_K), (const bf16_t*)WSP(WS_V), nullptr, nullptr, XNP, nullptr);
    }
    GSYNC();
    if (PHM & 16)
#pragma unroll 1
    for (int rp_ = REP_P4 - 1; rp_ >= 0; --rp_) { pg8::Gemm g{XNP, (const bf16_t*)WSP(WS_WO), MT, D, D, D, D, wv}; pg8::StaticOrder S; S.init(MT, D, gd_l(), bx_l());
      pg8::EpiResT<true, true> E{pt.f(I_x_prompt), pt.f(I_x_sample), XBP, MODP + 2 * D, (bf16_t*)WSP(WS_XN2), pt.f(I_norm_g) + D, MODP + 4 * D, rp_ ? (float*)WSP(WS_HLF) : SSQP(0)};
      pg8::gemm_phase<pg8::EpiResT<true, true>, pg8::StaticOrder, PG8_ALIGN, PG8_SP2>(lds, g, S, E); }
    {
        const int G_ = gd_l(), c_ = bx_l(), nwg_ = (MT / 256) * (D / 256);
        int rank_ = c_, n_ = G_;
        if (nwg_ < G_) { rank_ = c_ - nwg_; n_ = c_ >= nwg_ ? G_ - nwg_ : 0; }
        if (n_ > 0) { shw_phase(wv, pt, lds, 0, rank_, n_); tr_items(wv, pt, lds, 16 * 96 + 16 * 32 + 16 * 176, 16 * 96 + 16 * 32 + 16 * 176 + 44 * 32, rank_ * 8 + wv, n_ * 8); }
    }
    GSYNC();
    if (PHM & 512) { pg8::Gemm g{(const bf16_t*)WSP(WS_XN2), (const bf16_t*)WSP(WS_WGU), MT, 2 * FF, D, D, D, wv}; pg8::StaticOrder S; S.init(MT, 2 * FF, gd_l(), bx_l()); S.reps = REP_GEMM;
      pg8::EpiSwiglu E{(bf16_t*)WSP(WS_H), SSQP(0), (const float*)WSP(WS_SHW) + SHW_OFF0};
      pg8::gemm_phase<pg8::EpiSwiglu, pg8::StaticOrder, PG8_ALIGN, PG8_SP2>(lds, g, S, E); }
    {
        const int G_ = gd_l(), c_ = bx_l(), nwg_ = (MT / 256) * (2 * FF / 256), maxu_ = (nwg_ + G_ - 1) / G_, full_ = nwg_ - (maxu_ - 1) * G_;
        int rank_ = c_, n_ = G_;
        if (full_ < G_) { rank_ = c_ - full_; n_ = c_ >= full_ ? G_ - full_ : 0; }
        if (n_ > 0) { adaln_tasks(wv, pt, lds, 1, rank_, n_); tr_items(wv, pt, lds, 16 * 96 + 16 * 32 + 2 * 16 * 176 + 44 * 32, 12288, rank_ * 8 + wv, n_ * 8); }
    }
    GSYNC();
    if (PHM & 16) { pg8::Gemm g{(const bf16_t*)WSP(WS_H), (const bf16_t*)WSP(WS_WDN), MT, D, FF, FF, FF, wv}; pg8::StaticOrder S; S.init(MT, D, gd_l(), bx_l());
      pg8::EpiResT<true, false> E{nullptr, nullptr, XBP, MODP + 5 * D, XNP, pt.f(I_norm_g) + 2 * D, MODP + (size_t)9 * NMOD + 1 * D, SSQP(1)};
      pg8::gemm_phase<pg8::EpiResT<true, false>, pg8::StaticOrder, PG8_ALIGN, PG8_SP2>(lds, g, S, E); }
    {
        const int G_ = gd_l(), c_ = bx_l(), nwg_ = (MT / 256) * (D / 256);
        int rank_ = c_, n_ = G_;
        if (nwg_ < G_) { rank_ = c_ - nwg_; n_ = c_ >= nwg_ ? G_ - nwg_ : 0; }
        if (n_ > 0) { shw_phase(wv, pt, lds, 1, rank_, n_); tr_items(wv, pt, lds, 16 * 96 + 16 * 32 + 16 * 176 + 44 * 32, 16 * 96 + 16 * 32 + 2 * 16 * 176 + 44 * 32, rank_ * 8 + wv, n_ * 8); }
    }
    GSYNC();
    if (PHM & 32) { pg8::Gemm g{XNP, (const bf16_t*)WSP(WS_WIN), MT, 2 * D, D, D, D, wv}; pg8::StaticOrder S; S.init(MT, 2 * D, gd_l(), bx_l()); S.reps = REP_GEMM;
      pg8::EpiWin E{(bf16_t*)WSP(WS_GATE), (bf16_t*)WSP(WS_XR), SSQP(1), (const float*)WSP(WS_SHW) + SHW_OFF1};
      pg8::gemm_phase<pg8::EpiWin, pg8::StaticOrder, PG8_ALIGN, PG8_SP2>(lds, g, S, E); }
    {
        const int G_ = gd_l(), c_ = bx_l(), nwg_ = (MT / 256) * (2 * D / 256), maxu_ = (nwg_ + G_ - 1) / G_, full_ = nwg_ - (maxu_ - 1) * G_;
        int rank_ = c_, n_ = G_;
        if (full_ < G_) { rank_ = c_ - full_; n_ = c_ >= full_ ? G_ - full_ : 0; }
        if (n_ > 0) shw_phase(wv, pt, lds, 2, rank_, n_);
    }
    GSYNC();
    if (PHM & 128)
#pragma unroll 1
    for (int uu = vcu_l(), G_ = gd_l(); uu < 768 * REP_LRU; uu += G_) {
        const int u = uu % 768;
        const int dir = u & 1, n = (u >> 1) & 7, q = u >> 4;
        const float* h0 = nullptr;
        if (q >= 16) { const int b = (q - 16) >> 2, ci = (q - 16) & 3; if ((dir == 0 && ci == 0) || (dir == 1 && ci == 3)) h0 = pt.f(I_state_h) + ((size_t)b * 2 + dir) * D; }
        conv_slab(wv, (const bf16_t*)WSP(WS_XR), pt.f(I_conv_w), pt.f(I_conv_b), XNP, q, n);
        pg8::Gemm g{XNP + (size_t)q * 256 * D + n * 128, (const bf16_t*)WSP(WS_WG) + (size_t)(n * 2 + dir) * 256 * 128, 256, 256, 128, D, 128, wv};
        pg8::OneUnit S;
        pg8::EpiLru E{pt.t, h0, q * 256, n * 128, dir, q};
        pg8::gemm_phase<pg8::EpiLru, pg8::OneUnit, false, false>(lds, g, S, E);
    }
    GSYNC();
    if (PHM & 256) for (int rep_ = 0; rep_ < REP_THIN; ++rep_) lru_combine_phase(wv, pt.ws(), (bf16_t*)WSP(WS_Y));
    GSYNC();
    if (PHM & 16) { pg8::Gemm g{(const bf16_t*)WSP(WS_Y), (const bf16_t*)WSP(WS_WOUT), MT, D, D, D, D, wv}; pg8::StaticOrder S; S.init(MT, D, gd_l(), bx_l());
      pg8::EpiResT<true, false> E{nullptr, nullptr, XBP, MODP + (size_t)9 * NMOD + 2 * D, XNP, pt.f(I_norm_g) + 3 * D, MODP + (size_t)9 * NMOD + 4 * D, SSQP(2)};
      pg8::gemm_phase<pg8::EpiResT<true, false>, pg8::StaticOrder, PG8_ALIGN, PG8_SP2>(lds, g, S, E); }
    GSYNC();
    if (PHM & 512) { pg8::Gemm g{XNP, (const bf16_t*)WSP(WS_WGU) + (size_t)2 * FF * D, MT, 2 * FF, D, D, D, wv}; pg8::StaticOrder S; S.init(MT, 2 * FF, gd_l(), bx_l()); S.reps = REP_GEMM;
      pg8::EpiSwiglu E{(bf16_t*)WSP(WS_H), SSQP(2), (const float*)WSP(WS_SHW) + SHW_OFF2};
      pg8::gemm_phase<pg8::EpiSwiglu, pg8::StaticOrder, PG8_ALIGN, PG8_SP2>(lds, g, S, E); }
    GSYNC();
    if (gd_l() >= (MT / 256) * (D / 256)) {
        pg8::Gemm g{(const bf16_t*)WSP(WS_H), (const bf16_t*)WSP(WS_WDN) + (size_t)D * FF, MT, D, FF, FF, FF, wv}; pg8::StaticOrder S; S.init(MT, D, gd_l(), bx_l());
        pg8::EpiResFinal E{XBP, MODP + (size_t)9 * NMOD + 5 * D, SSQP(3), (unsigned*)WSP(WS_FCNT), pt.f(I_final_g), XRES};
        pg8::gemm_phase<pg8::EpiResFinal, pg8::StaticOrder, PG8_ALIGN, PG8_SP2>(lds, g, S, E);
    } else {
        { pg8::Gemm g{(const bf16_t*)WSP(WS_H), (const bf16_t*)WSP(WS_WDN) + (size_t)D * FF, MT, D, FF, FF, FF, wv}; pg8::StaticOrder S; S.init(MT, D, gd_l(), bx_l());
          pg8::EpiResT<false, false> E{nullptr, nullptr, XBP, MODP + (size_t)9 * NMOD + 5 * D, nullptr, nullptr, nullptr, nullptr};
          pg8::gemm_phase<pg8::EpiResT<false, false>, pg8::StaticOrder, PG8_ALIGN, PG8_SP2>(lds, g, S, E); }
        GSYNC();
        final_norm_phase(wv, XBP, XRES, pt.f(I_final_g));
    }
}

extern "C" void kernel_launch(void* const* d_in, const int* in_sizes, int n_in, void* d_out, int out_size, void* d_ws, size_t ws_size, hipStream_t stream) {
    static int grid = 0;
    if (grid == 0) {
        int dev = 0, cus = 0, per_cu = 0;
        (void)hipGetDevice(&dev);
        (void)hipDeviceGetAttribute(&cus, hipDeviceAttributeMultiprocessorCount, dev);
        (void)hipFuncSetAttribute((const void*)fwd_megakernel, hipFuncAttributeMaxDynamicSharedMemorySize, LDS_BYTES);
        (void)hipOccupancyMaxActiveBlocksPerMultiprocessor(&per_cu, (const void*)fwd_megakernel, 512, LDS_BYTES);
        if (per_cu < 1) { fprintf(stderr, "kernel_launch: occupancy query says %d blocks per CU\n", per_cu); per_cu = 1; }
        grid = cus * per_cu;
        if (ws_size < WS_END) { fprintf(stderr, "kernel_launch: workspace too small (%zu < %zu)\n", ws_size, (size_t)WS_END); grid = -1; }
    }
    if (grid < 0) return;
    (void)hipMemsetAsync((char*)d_ws + WS_MOD, 0, 1024 * 1024, stream);
    Args a{};
    const float** ap = (const float**)&a;
    for (int i = 0; i < 25; ++i) ap[i] = (const float*)d_in[i];
    a.out = (float*)d_out; a.ws = (unsigned char*)d_ws;
    void* args[] = {&a};
    hipError_t e = hipLaunchCooperativeKernel((const void*)fwd_megakernel, dim3(grid), dim3(512), args, LDS_BYTES, stream);
    if (e != hipSuccess) fprintf(stderr, "cooperative launch failed: %s (grid %d)\n", hipGetErrorString(e), grid);
}
```

```cpp
#include <hip/hip_runtime.h>
#include <hip/hip_cooperative_groups.h>
#include <cstdio>
#include <cstdint>
namespace cg = cooperative_groups;

#define LAS __attribute__((address_space(3)))
typedef unsigned short bf16_t;
typedef short bf16x8 __attribute__((ext_vector_type(8)));
typedef short s16x4 __attribute__((ext_vector_type(4)));
typedef float f32x4 __attribute__((ext_vector_type(4)));
typedef float f32x2 __attribute__((ext_vector_type(2)));
typedef float f32x16 __attribute__((ext_vector_type(16)));
typedef unsigned u32x4 __attribute__((ext_vector_type(4)));
typedef unsigned u32x2 __attribute__((ext_vector_type(2)));
typedef __bf16 bf16x2_t __attribute__((ext_vector_type(2)));

constexpr int D = 1024, MC = 4096, ML = 8192, MT = MC + ML, FF = 2816, NQKV = 3072, NMOD = 6144;
constexpr float LOG2E = 1.4426950408889634f;
constexpr float RMS_EPS = 1e-6f;

constexpr size_t MiB = 1u << 20;
constexpr size_t WS_MOD = 0;
constexpr size_t WS_YCNT = 832 * 1024;
constexpr size_t WS_FCNT = 768 * 1024;
constexpr size_t WS_SSQ = 512 * 1024;
constexpr size_t WS_WQKV = 1 * MiB, WS_WO = 7 * MiB, WS_WGU = 9 * MiB, WS_WDN = 31 * MiB, WS_WIN = 42 * MiB, WS_WOUT = 46 * MiB, WS_WG = 48 * MiB;
constexpr size_t WS_CK = 49 * MiB, WS_CV = 57 * MiB;
constexpr size_t WS_PF = 49 * MiB;
constexpr size_t WS_XN = 65 * MiB;
constexpr size_t WS_Q = 89 * MiB, WS_K = 113 * MiB, WS_V = 137 * MiB;
constexpr size_t WS_H = 89 * MiB;
constexpr size_t WS_GATE = 89 * MiB, WS_XR = 113 * MiB, WS_Y = 113 * MiB;
constexpr size_t WS_XN2 = 161 * MiB;
constexpr size_t WS_PB = 137 * MiB;
constexpr size_t WS_XB = 185 * MiB;
constexpr size_t WS_HLF = 209 * MiB, WS_HLB = 161 * MiB;
constexpr size_t WS_SUMP = 250 * MiB;
constexpr size_t WS_SUME = 250 * MiB + 512 * 1024;
constexpr size_t WS_SHW = 252 * MiB;
constexpr int SHW_OFF0 = 0, SHW_OFF1 = 9 * 5632, SHW_OFF2 = 9 * 5632 + 9 * 2048;
constexpr size_t WS_END = 256 * MiB;

constexpr int LDS_BYTES = 143360;
constexpr int AB_PITCH = 1056;
constexpr int HST_OFF = 128 * AB_PITCH;

enum { I_x_prompt = 0, I_x_sample = 1, I_c = 2, I_cache_k = 3, I_cache_v = 4, I_state_h = 5, I_c_ctx = 6, I_norm_g = 7, I_w_mod = 8, I_b_mod = 9, I_w_qkv = 10, I_w_o = 11, I_rpb = 12, I_w_in = 13, I_conv_w = 14, I_conv_b = 15, I_w_a = 16, I_b_a = 17, I_w_i = 18, I_b_i = 19, I_lam = 20, I_w_out = 21, I_w_gu = 22, I_w_down = 23, I_final_g = 24, I_out = 25, I_ws = 26 };
constexpr int PTAB_OFF = LDS_BYTES - 256;
struct PT {
    LAS const unsigned long long* t;
    __device__ __forceinline__ unsigned long long raw(int i) const { const unsigned long long v = t[i]; const unsigned lo = __builtin_amdgcn_readfirstlane((unsigned)v), hi = __builtin_amdgcn_readfirstlane((unsigned)(v >> 32)); return ((unsigned long long)hi << 32) | lo; }
    __device__ __forceinline__ const float* f(int i) const { return (const float*)(const __attribute__((address_space(1))) float*)raw(i); }
    __device__ __forceinline__ float* out() const { return (float*)(__attribute__((address_space(1))) float*)raw(I_out); }
    __device__ __forceinline__ unsigned char* ws() const { return (unsigned char*)(__attribute__((address_space(1))) unsigned char*)raw(I_ws); }
};
constexpr size_t OUT_Y = 0, OUT_NK = (size_t)MT * D, OUT_NV = OUT_NK + (size_t)MC * D, OUT_NH = OUT_NV + (size_t)MC * D;
constexpr int CST_OFF = HST_OFF + 1024;
__device__ __forceinline__ int tid_l(int wv) { int l; asm volatile("v_mbcnt_lo_u32_b32 %0, -1, 0\n\tv_mbcnt_hi_u32_b32 %0, -1, %0" : "=v"(l)); return wv * 64 + l; }
__device__ __forceinline__ int bx_l() { int b = blockIdx.x; asm volatile("" : "+s"(b)); return b; }
__device__ __forceinline__ int gd_l() { int g = gridDim.x; asm volatile("" : "+s"(g)); return g; }
__device__ __forceinline__ int vcu_l() { const int b = bx_l(), g = gd_l(); return (g & 7) ? b : (b & 7) * (g >> 3) + (b >> 3); }

constexpr size_t WS_BAR = 448 * 1024;
constexpr int BARST_OFF = PTAB_OFF + 224;
#define XB_TMO      128
#define XB_XCNT(j)  (256  + 64 * (j))
#define XB_XSUB(j)  (1280 + 64 * (j))
#define XB_XGEN(j)  (2304 + 64 * (j))
#define XB_TOP      3328
#define XB_TOPGEN   3392
#define XCD_BAR_WORDS 3456
#define XB_SPIN_CAP (1u << 18)
__device__ __forceinline__ unsigned xb_ld(unsigned* p)              { return __hip_atomic_load(p, __ATOMIC_RELAXED, __HIP_MEMORY_SCOPE_AGENT); }
__device__ __forceinline__ unsigned xb_add(unsigned* p, unsigned v) { return __hip_atomic_fetch_add(p, v, __ATOMIC_RELAXED, __HIP_MEMORY_SCOPE_AGENT); }
__device__ __forceinline__ unsigned xb_xcc_id() { return (unsigned)__builtin_amdgcn_s_getreg((3 << 11) | 20) & 0xFu; }
#define XB_SPIN(cond, bar) do { unsigned _sp = 0; while (cond) { __builtin_amdgcn_s_sleep(1); \
    if ((++_sp & 255u) == 0u) { if (xb_ld(&(bar)[XB_TMO])) break; if (_sp > XB_SPIN_CAP) { atomicAdd(&(bar)[XB_TMO], 1u); break; } } } } while (0)
__device__ __forceinline__ void xcd_barrier_complete(unsigned* bar, unsigned x, unsigned& nloc, unsigned& nx) {
    const unsigned G = gridDim.x;
    unsigned sum, cnt, mine, sp = 0u;
    for (;;) {
        sum = 0u; cnt = 0u; mine = 0u;
#pragma unroll
        for (unsigned j = 0; j < 16; ++j) { const unsigned c = xb_ld(&bar[XB_XCNT(j)]); sum += c; cnt += (c > 0u) ? 1u : 0u; mine = (j == x) ? c : mine; }
        if (sum == G) break;
        __builtin_amdgcn_s_sleep(1);
        if ((++sp & 255u) == 0u) { if (xb_ld(&bar[XB_TMO])) break; if (sp > XB_SPIN_CAP) { atomicAdd(&bar[XB_TMO], 1u); break; } }
    }
    nloc = mine > 0u ? mine : 1u; nx = cnt > 0u ? cnt : 1u;
}
__device__ __forceinline__ void xcd_barrier(const PT pt, LAS unsigned char* lds, int wv) {
    asm volatile("s_waitcnt vmcnt(0)" ::: "memory");
    __syncthreads();
    if (tid_l(wv) == 0) {
        unsigned* bar = (unsigned*)(pt.ws() + WS_BAR);
        volatile LAS unsigned* st = (volatile LAS unsigned*)(lds + BARST_OFF);
        const unsigned x = xb_xcc_id();
        __builtin_amdgcn_s_waitcnt(0);
        unsigned nloc = st[0], nx = st[1];
        if (nloc == 0u) { xcd_barrier_complete(bar, x, nloc, nx); st[0] = nloc; st[1] = nx; }
        const unsigned old = xb_add(&bar[XB_XSUB(x)], 1u);
        const unsigned gen = old / nloc;
        if (old + 1u == (gen + 1u) * nloc) {
            __builtin_amdgcn_fence(__ATOMIC_RELEASE, "agent");
            asm volatile("s_waitcnt vmcnt(0)" ::: "memory");
            const unsigned og = xb_add(&bar[XB_TOP], 1u);
            const unsigned tg = og / nx;
            if (og + 1u == (tg + 1u) * nx) xb_add(&bar[XB_TOPGEN], 1u);
            else XB_SPIN(xb_ld(&bar[XB_TOPGEN]) == tg, bar);
            __builtin_amdgcn_fence(__ATOMIC_ACQUIRE, "agent");
            xb_add(&bar[XB_XGEN(x)], 1u);
            asm volatile("s_waitcnt vmcnt(0)" ::: "memory");
        } else {
            XB_SPIN(xb_ld(&bar[XB_XGEN(x)]) == gen, bar);
            __builtin_amdgcn_fence(__ATOMIC_ACQUIRE, "agent");
            asm volatile("s_waitcnt vmcnt(0)" ::: "memory");
        }
    }
    __syncthreads();
}
__device__ __forceinline__ unsigned pk_bf16(float lo, float hi) { f32x2 v = {lo, hi}; bf16x2_t b = __builtin_convertvector(v, bf16x2_t); return __builtin_bit_cast(unsigned, b); }
__device__ __forceinline__ float bf_lo(unsigned u) { return __uint_as_float(u << 16); }
__device__ __forceinline__ float bf_hi(unsigned u) { return __uint_as_float(u & 0xffff0000u); }
__device__ __forceinline__ float fast_rcp(float x) { return __builtin_amdgcn_rcpf(x); }
__device__ __forceinline__ float fast_exp2(float x) { return __builtin_amdgcn_exp2f(x); }
__device__ __forceinline__ float sigmoid_f(float x) { return fast_rcp(1.f + fast_exp2(-x * LOG2E)); }
__device__ __forceinline__ float silu_f(float x) { return x * sigmoid_f(x); }
__device__ __forceinline__ float gelu_tanh_f(float x) { const float u = 0.7978845608028654f * (x + 0.044715f * x * x * x); return x * sigmoid_f(2.f * u); }
__device__ __forceinline__ float shfl_xor_l(float v, int mask, int lane) { return __int_as_float(__builtin_amdgcn_ds_bpermute((lane ^ mask) << 2, __float_as_int(v))); }
__device__ __forceinline__ float wave_sum(float v, int lane) {
#pragma unroll
    for (int o = 1; o < 64; o <<= 1) v += shfl_xor_l(v, o, lane);
    return v;
}
namespace pg8 {
#define PG8_LAS __attribute__((address_space(3)))
constexpr int BM = 256, BK = 64, HALF = 128, HTB = HALF * BK * 2  , STAGE_BYTES = 8 * HTB, NXCD = 8, WGM = 4;

__host__ __device__ __forceinline__ int lds_byte(int r, int c) { const int st = (r >> 4) * 2 + (c >> 5), rr = r & 15, cc = c & 31, ob = rr * 64 + cc * 2; return st * 1024 + (ob ^ (((ob >> 9) & 1) << 5)); }
__host__ __device__ __forceinline__ void stage_rc(int b, int& R, int& C) { const int st = b / 1024, sb = b % 1024, swz = sb ^ (((sb >> 9) & 1) << 5); R = (st >> 1) * 16 + swz / 64; C = (st & 1) * 32 + (swz % 64) / 2; }
__host__ __device__ __forceinline__ int perm32(int rho) { const int n = rho >> 4, i = rho & 15; return 8 * (i >> 2) + 4 * n + (i & 3); }

struct Unit { int pm, pn; };
struct Gemm { const bf16_t* A; const bf16_t* Bt; int M, N, K, lda, ldb, wv; };

struct StaticOrder {
    int nM, nN, nwg, G, c;
    int reps = 1;
    __host__ __device__ __forceinline__ void init(int M, int N, int G_, int c_) { nM = M / BM; nN = N / BM; nwg = nM * nN; G = G_; c = c_; }
    __host__ __device__ __forceinline__ bool next(int i, Unit& u) const {
        const long L = (long)(i / reps) * G + c; if (L >= nwg) return false;
        int wgid = (int)L; { const int q = nwg / NXCD, r = nwg % NXCD, xcd = wgid % NXCD, off = wgid / NXCD; wgid = (xcd < r ? xcd * (q + 1) : r * (q + 1) + (xcd - r) * q) + off; }
        const int nig = WGM * nN, gid = wgid / nig, fm = gid * WGM, gsz = (nM - fm) < WGM ? (nM - fm) : WGM;
        u.pm = fm + ((wgid % nig) % gsz); u.pn = (wgid % nig) / gsz; return true;
    }
    __device__ __forceinline__ void a_ready(const Unit&) const {}
    __device__ __forceinline__ void done(const Unit&) const {}
};


template <class Epi, class Sched, bool ALIGN_EPI = false, bool SP2 = false>
__device__ __forceinline__ void gemm_phase(PG8_LAS unsigned char* lds, const Gemm g, const Sched& S, const Epi& E) {
    int wid_ = g.wv; asm volatile("" : "+s"(wid_));
    const int tid = tid_l(wid_), wid = wid_, lane = tid & 63, wr = wid >> 2, wc = wid & 3, fr = lane & 15, fq = lane >> 4;
    const int K = g.K, nt = K / BK;
    unsigned voffA[2], voffB[2];
#pragma unroll
    for (int i = 0; i < 2; ++i) { int R, C; stage_rc(tid * 16 + i * 8192, R, C); const int Rb = Epi::PERM ? ((R & ~31) + perm32(R & 31)) : R;
        voffA[i] = (unsigned)(R * g.lda + C) * 2u; voffB[i] = (unsigned)(Rb * g.ldb + C) * 2u; }
    const size_t kstep = (size_t)(BK * 2);
    const size_t hstepA = (size_t)HALF * g.lda * 2, hstepB = (size_t)HALF * g.ldb * 2;
    const size_t tstepA = 2 * hstepA, tstepB = 2 * hstepB;
    const unsigned ldsw = (unsigned)wid * 1024u;
    const int aoff = lds_byte(wr * 64 + fr, fq * 8), boff = lds_byte(wc * 32 + fr, fq * 8);
#define PG8_SA(b, h) (((b) * 2 + (h)) * HTB)
#define PG8_SB(b, h) ((4 + (b) * 2 + (h)) * HTB)
#define PG8_STAGE(bufoff, gbase, voff) do { _Pragma("unroll") for (int _i = 0; _i < 2; ++_i) \
        __builtin_amdgcn_global_load_lds((const unsigned*)((const char*)(gbase) + (voff)[_i]), (PG8_LAS unsigned*)(lds + (bufoff) + ldsw + _i * 8192), 16, 0, 0); } while (0)
#define PG8_LDA(dst, b, h) do { _Pragma("unroll") for (int m = 0; m < 4; ++m) _Pragma("unroll") for (int k = 0; k < 2; ++k) dst[m][k] = *(const PG8_LAS bf16x8*)(lds + PG8_SA(b, h) + aoff + m * 2048 + k * 1024); } while (0)
#define PG8_LDB(dst, b, h) do { _Pragma("unroll") for (int n = 0; n < 2; ++n) _Pragma("unroll") for (int k = 0; k < 2; ++k) dst[n][k] = *(const PG8_LAS bf16x8*)(lds + PG8_SB(b, h) + boff + n * 2048 + k * 1024); } while (0)
#define PG8_MMA(ai, bj, At, Bt) do { __builtin_amdgcn_s_setprio(1); _Pragma("unroll") for (int m = 0; m < 4; ++m) _Pragma("unroll") for (int n = 0; n < 2; ++n) _Pragma("unroll") for (int k = 0; k < 2; ++k) \
        acc[ai][bj][m][n] = __builtin_amdgcn_mfma_f32_16x16x32_bf16(Bt[n][k], At[m][k], acc[ai][bj][m][n], 0, 0, 0); __builtin_amdgcn_s_setprio(0); } while (0)
#define PG8_WAIT_V(n) asm volatile("s_waitcnt vmcnt(" #n ")" ::: "memory")
#define PG8_WAIT_L(n) asm volatile("s_waitcnt lgkmcnt(" #n ")" ::: "memory")
#define PG8_BAR __builtin_amdgcn_s_barrier()
#define PG8_SCHED __builtin_amdgcn_sched_barrier(0)
    Unit cur, nxt; int ui = 0;
    if (!S.next(0, cur)) return;
    f32x4 acc[2][2][4][2];
#pragma unroll
    for (int a = 0; a < 2; ++a)
#pragma unroll
        for (int b = 0; b < 2; ++b)
#pragma unroll
            for (int m = 0; m < 4; ++m)
#pragma unroll
                for (int n = 0; n < 2; ++n) acc[a][b][m][n] = (f32x4){0.f, 0.f, 0.f, 0.f};
    bf16x8 At[4][2], B0[2][2], B1[2][2];
    const char* cA = (const char*)g.A + (size_t)cur.pm * tstepA; const char* cB = (const char*)g.Bt + (size_t)cur.pn * tstepB;
    S.a_ready(cur);
    if constexpr (SP2) {
        PG8_STAGE(PG8_SB(0, 0), cB, voffB); PG8_STAGE(PG8_SB(0, 1), cB + hstepB, voffB); PG8_STAGE(PG8_SA(0, 0), cA, voffA); PG8_STAGE(PG8_SA(0, 1), cA + hstepA, voffA);
        if (wr == 1) PG8_BAR;
        PG8_WAIT_V(2); PG8_BAR;
        PG8_STAGE(PG8_SB(1, 0), cB + kstep, voffB); PG8_STAGE(PG8_SA(1, 0), cA + kstep, voffA); PG8_STAGE(PG8_SB(1, 1), cB + hstepB + kstep, voffB);
        PG8_WAIT_V(6); PG8_BAR;
    } else {
        PG8_STAGE(PG8_SB(0, 0), cB, voffB); PG8_STAGE(PG8_SA(0, 0), cA, voffA); PG8_STAGE(PG8_SB(0, 1), cB + hstepB, voffB); PG8_STAGE(PG8_SA(0, 1), cA + hstepA, voffA);
        if (wr == 1) PG8_BAR;
        PG8_WAIT_V(4); PG8_BAR;
        PG8_STAGE(PG8_SB(1, 0), cB + kstep, voffB); PG8_STAGE(PG8_SA(1, 0), cA + kstep, voffA); PG8_STAGE(PG8_SB(1, 1), cB + hstepB + kstep, voffB);
        PG8_WAIT_V(6); PG8_BAR;
    }
    for (;;) {
        const bool has_next = S.next(ui + 1, nxt);
        const char* nA = has_next ? (const char*)g.A + (size_t)nxt.pm * tstepA : cA; const char* nB = has_next ? (const char*)g.Bt + (size_t)nxt.pn * tstepB : cB;
        for (int t = 0; t < nt; t += 2) {
            const bool last = (t == nt - 2);
            const char* a1 = cA + (size_t)(t + 1) * kstep;
            const char* a2 = last ? nA : cA + (size_t)(t + 2) * kstep; const char* b2 = last ? nB : cB + (size_t)(t + 2) * kstep;
            const char* a3 = a2 + kstep; const char* b3 = b2 + kstep;
            if (last && has_next) S.a_ready(nxt);
            if constexpr (SP2) {
            PG8_LDB(B0, 0, 0); PG8_LDB(B1, 0, 1); PG8_SCHED; PG8_LDA(At, 0, 0); PG8_STAGE(PG8_SA(1, 1), a1 + hstepA, voffA);
            PG8_WAIT_V(8); PG8_WAIT_L(0); PG8_BAR; PG8_MMA(0, 0, At, B0); PG8_MMA(0, 1, At, B1); PG8_BAR; PG8_SCHED;
            PG8_LDA(At, 0, 1); PG8_STAGE(PG8_SB(0, 0), b2, voffB); PG8_STAGE(PG8_SB(0, 1), b2 + hstepB, voffB); PG8_STAGE(PG8_SA(0, 0), a2, voffA);
            PG8_WAIT_V(8); PG8_WAIT_L(0); PG8_BAR; PG8_MMA(1, 0, At, B0); PG8_MMA(1, 1, At, B1); PG8_BAR; PG8_SCHED;
            PG8_LDB(B0, 1, 0); PG8_LDB(B1, 1, 1); PG8_SCHED; PG8_LDA(At, 1, 0); PG8_STAGE(PG8_SA(0, 1), a2 + hstepA, voffA);
            PG8_WAIT_V(8); PG8_WAIT_L(0); PG8_BAR; PG8_MMA(0, 0, At, B0); PG8_MMA(0, 1, At, B1); PG8_BAR; PG8_SCHED;
            PG8_LDA(At, 1, 1); PG8_STAGE(PG8_SB(1, 0), b3, voffB); PG8_STAGE(PG8_SB(1, 1), b3 + hstepB, voffB); PG8_STAGE(PG8_SA(1, 0), a3, voffA);
            PG8_WAIT_V(8); PG8_WAIT_L(0); PG8_BAR; PG8_MMA(1, 0, At, B0); PG8_MMA(1, 1, At, B1); PG8_BAR; PG8_SCHED;
            } else {
            PG8_LDB(B0, 0, 0); PG8_SCHED; PG8_LDA(At, 0, 0); PG8_STAGE(PG8_SA(1, 1), a1 + hstepA, voffA);
            PG8_WAIT_L(8); PG8_BAR; PG8_WAIT_L(0); PG8_MMA(0, 0, At, B0); PG8_BAR; PG8_SCHED;
            PG8_LDB(B1, 0, 1); PG8_STAGE(PG8_SB(0, 0), b2, voffB);
            PG8_BAR; PG8_WAIT_L(0); PG8_MMA(0, 1, At, B1); PG8_BAR;
            PG8_LDA(At, 0, 1); PG8_STAGE(PG8_SA(0, 0), a2, voffA);
            PG8_BAR; PG8_WAIT_L(0); PG8_MMA(1, 0, At, B0); PG8_BAR; PG8_SCHED;
            PG8_STAGE(PG8_SB(0, 1), b2 + hstepB, voffB);
            PG8_WAIT_V(6); PG8_BAR; PG8_MMA(1, 1, At, B1); PG8_BAR;
            PG8_LDB(B0, 1, 0); PG8_SCHED; PG8_LDA(At, 1, 0); PG8_STAGE(PG8_SA(0, 1), a2 + hstepA, voffA);
            PG8_WAIT_L(8); PG8_BAR; PG8_WAIT_L(0); PG8_MMA(0, 0, At, B0); PG8_BAR; PG8_SCHED;
            PG8_LDB(B1, 1, 1); PG8_STAGE(PG8_SB(1, 0), b3, voffB);
            PG8_BAR; PG8_WAIT_L(0); PG8_MMA(0, 1, At, B1); PG8_BAR;
            PG8_LDA(At, 1, 1); PG8_STAGE(PG8_SA(1, 0), a3, voffA);
            PG8_BAR; PG8_WAIT_L(0); PG8_MMA(1, 0, At, B0); PG8_BAR; PG8_SCHED;
            PG8_STAGE(PG8_SB(1, 1), b3 + hstepB, voffB);
            PG8_WAIT_V(6); PG8_BAR; PG8_MMA(1, 1, At, B1); PG8_BAR;
            }
        }
        if constexpr (ALIGN_EPI) { if (wr == 0) PG8_BAR; }
        if constexpr (!Epi::AFTER_DRAIN) { E(acc, cur, wr, wc, fr, fq); S.done(cur); }
        if (!has_next) break;
#pragma unroll
        for (int a = 0; a < 2; ++a)
#pragma unroll
            for (int b = 0; b < 2; ++b)
#pragma unroll
                for (int m = 0; m < 4; ++m)
#pragma unroll
                    for (int n = 0; n < 2; ++n) acc[a][b][m][n] = (f32x4){0.f, 0.f, 0.f, 0.f};
        cur = nxt; cA = nA; cB = nB; ++ui;
        if constexpr (ALIGN_EPI) { if (wr == 1) PG8_BAR; }
    }
    PG8_WAIT_V(0);
    if constexpr (!ALIGN_EPI) { if (wr == 0) PG8_BAR; }
    PG8_BAR;
    if constexpr (Epi::AFTER_DRAIN) { E.fused(acc, cur, wr, wc, fr, fq, lds, wid, lane); S.done(cur); }
#undef PG8_SA
#undef PG8_SB
#undef PG8_STAGE
#undef PG8_LDA
#undef PG8_LDB
#undef PG8_MMA
#undef PG8_WAIT_V
#undef PG8_WAIT_L
#undef PG8_BAR
#undef PG8_SCHED
}
}

namespace pg8 {
struct OneUnit {
    __device__ __forceinline__ bool next(int i, Unit& u) const { if (i) return false; u.pm = 0; u.pn = 0; return true; }
    __device__ __forceinline__ void a_ready(const Unit&) const {}
    __device__ __forceinline__ void done(const Unit&) const {}
};
typedef f32x4 AccT[2][2][4][2];

struct EpiQKV {
    static constexpr bool PERM = true, AFTER_DRAIN = false;
    bf16_t* Q; float* newk; float qscale;
    __device__ __forceinline__ void operator()(const AccT& acc, const Unit& u, int wr, int wc, int fr, int fq) const {
        const int t = u.pn >> 2;
        bf16_t* base = Q + (size_t)t * MT * D;
        const float sc = t == 0 ? qscale : 1.f;
        float* fo = newk + (size_t)(t - 1) * MC * D;
        const bool wf = (t != 0) && (u.pm < MC / 256);
        const int colt = (u.pn & 3) * 256 + wc * 32 + 8 * fq, row0 = u.pm * 256 + wr * 64 + fr;
#pragma unroll
        for (int ai = 0; ai < 2; ++ai)
#pragma unroll
            for (int m = 0; m < 4; ++m) {
                const size_t ro = (size_t)(row0 + ai * 128 + m * 16) * D;
#pragma unroll
                for (int bj = 0; bj < 2; ++bj) {
                    const f32x4 v0 = acc[ai][bj][m][0] * sc, v1 = acc[ai][bj][m][1] * sc;
                    u32x4 w; w.x = pk_bf16(v0[0], v0[1]); w.y = pk_bf16(v0[2], v0[3]); w.z = pk_bf16(v1[0], v1[1]); w.w = pk_bf16(v1[2], v1[3]);
                    *(u32x4*)(base + ro + colt + bj * 128) = w;
                    if (wf) { *(f32x4*)(fo + ro + colt + bj * 128) = v0; *(f32x4*)(fo + ro + colt + bj * 128 + 4) = v1; }
                }
            }
    }
};
template <bool FUSE, bool SRCF32> struct EpiResT {
    static constexpr bool PERM = true, AFTER_DRAIN = false;
    const float *xa, *xb;
    bf16_t* xres;
    const float* gate;
    bf16_t* XNo; const float* gn; const float* scv; float* ssq;
    __device__ __forceinline__ void operator()(const AccT& acc, const Unit& u, int wr, int wc, int fr, int fq) const {
        const bool isc = u.pm < MC / 256;
        const int cv = isc ? 8 : ((u.pm - MC / 256) >> 2);
        const float* src = isc ? xa : xb - (size_t)MC * D;
        const int col0 = u.pn * 256 + wc * 32 + 8 * fq, row0 = u.pm * 256 + wr * 64 + fr;
        f32x4 gv[2][2], gm[2][2];
#pragma unroll
        for (int bj = 0; bj < 2; ++bj)
#pragma unroll
            for (int n = 0; n < 2; ++n) {
                const int c = col0 + bj * 128 + n * 4;
                gv[bj][n] = *(const f32x4*)(gate + (size_t)cv * NMOD + c);
                if (FUSE) gm[bj][n] = *(const f32x4*)(gn + c) * (*(const f32x4*)(scv + (size_t)cv * NMOD + c) + 1.f);
            }
#pragma unroll
        for (int ai = 0; ai < 2; ++ai)
#pragma unroll
        for (int mp = 0; mp < 2; ++mp) {
            f32x4 xs[2][2][2];
#pragma unroll
            for (int mm = 0; mm < 2; ++mm)
#pragma unroll
                for (int bj = 0; bj < 2; ++bj) {
                    const size_t o = (size_t)(row0 + ai * 128 + (2 * mp + mm) * 16) * D + col0 + bj * 128;
                    if (SRCF32) { xs[mm][bj][0] = *(const f32x4*)(src + o); xs[mm][bj][1] = *(const f32x4*)(src + o + 4); }
                    else { const u32x4 w = *(const u32x4*)(xres + o); xs[mm][bj][0] = (f32x4){bf_lo(w.x), bf_hi(w.x), bf_lo(w.y), bf_hi(w.y)}; xs[mm][bj][1] = (f32x4){bf_lo(w.z), bf_hi(w.z), bf_lo(w.w), bf_hi(w.w)}; }
                }
            asm volatile("" ::: "memory");
#pragma unroll
            for (int mm = 0; mm < 2; ++mm) {
                const int m = 2 * mp + mm;
                const int row = row0 + ai * 128 + m * 16;
                const size_t ro = (size_t)row * D + col0;
                float sq = 0.f;
#pragma unroll
                for (int bj = 0; bj < 2; ++bj) {
                    const f32x4 x0 = xs[mm][bj][0] + gv[bj][0] * acc[ai][bj][m][0], x1 = xs[mm][bj][1] + gv[bj][1] * acc[ai][bj][m][1];
                    { u32x4 w; w.x = pk_bf16(x0[0], x0[1]); w.y = pk_bf16(x0[2], x0[3]); w.z = pk_bf16(x1[0], x1[1]); w.w = pk_bf16(x1[2], x1[3]); *(u32x4*)(xres + ro + bj * 128) = w; }
                    if (FUSE) {
                        sq += ((x0[0] * x0[0] + x0[1] * x0[1]) + (x0[2] * x0[2] + x0[3] * x0[3])) + ((x1[0] * x1[0] + x1[1] * x1[1]) + (x1[2] * x1[2] + x1[3] * x1[3]));
                        const f32x4 y0 = x0 * gm[bj][0], y1 = x1 * gm[bj][1];
                        u32x4 w; w.x = pk_bf16(y0[0], y0[1]); w.y = pk_bf16(y0[2], y0[3]); w.z = pk_bf16(y1[0], y1[1]); w.w = pk_bf16(y1[2], y1[3]);
                        *(u32x4*)(XNo + ro + bj * 128) = w;
                    }
                }
                if (FUSE) { sq += shfl_xor_l(sq, 16, fr + 16 * fq); sq += shfl_xor_l(sq, 32, fr + 16 * fq); if (fq == 0) unsafeAtomicAdd(ssq + row, sq); }
            }
            asm volatile("" ::: "memory");
        }
    }
};
struct EpiResFinal {
    static constexpr bool PERM = true, AFTER_DRAIN = false;
    const bf16_t* xres; const float* gate; float* ssq; unsigned* cnt; const float* gfin; float* out;
    __device__ __forceinline__ void operator()(const AccT& acc_c, const Unit& u, int wr, int wc, int fr, int fq) const {
        AccT& acc = const_cast<AccT&>(acc_c);
        const int cv = u.pm < MC / 256 ? 8 : ((u.pm - MC / 256) >> 2);
        const int col0 = u.pn * 256 + wc * 32 + 8 * fq, row0 = u.pm * 256 + wr * 64 + fr, lane = fr + 16 * fq;
        f32x4 gv[2][2];
#pragma unroll
        for (int bj = 0; bj < 2; ++bj)
#pragma unroll
            for (int n = 0; n < 2; ++n) gv[bj][n] = *(const f32x4*)(gate + (size_t)cv * NMOD + col0 + bj * 128 + n * 4);
#pragma unroll
        for (int ai = 0; ai < 2; ++ai)
#pragma unroll
        for (int mp = 0; mp < 2; ++mp) {
            u32x4 xs[2][2];
#pragma unroll
            for (int mm = 0; mm < 2; ++mm)
#pragma unroll
                for (int bj = 0; bj < 2; ++bj) xs[mm][bj] = *(const u32x4*)(xres + (size_t)(row0 + ai * 128 + (2 * mp + mm) * 16) * D + col0 + bj * 128);
            asm volatile("" ::: "memory");
#pragma unroll
            for (int mm = 0; mm < 2; ++mm) {
                const int m = 2 * mp + mm;
                float sq = 0.f;
#pragma unroll
                for (int bj = 0; bj < 2; ++bj) {
                    const u32x4 w = xs[mm][bj];
                    const f32x4 x0 = (f32x4){bf_lo(w.x), bf_hi(w.x), bf_lo(w.y), bf_hi(w.y)} + gv[bj][0] * acc[ai][bj][m][0], x1 = (f32x4){bf_lo(w.z), bf_hi(w.z), bf_lo(w.w), bf_hi(w.w)} + gv[bj][1] * acc[ai][bj][m][1];
                    acc[ai][bj][m][0] = x0; acc[ai][bj][m][1] = x1;
                    sq += ((x0[0] * x0[0] + x0[1] * x0[1]) + (x0[2] * x0[2] + x0[3] * x0[3])) + ((x1[0] * x1[0] + x1[1] * x1[1]) + (x1[2] * x1[2] + x1[3] * x1[3]));
                }
                sq += shfl_xor_l(sq, 16, lane); sq += shfl_xor_l(sq, 32, lane);
                if (fq == 0) unsafeAtomicAdd(ssq + row0 + ai * 128 + m * 16, sq);
            }
        }
        asm volatile("s_waitcnt vmcnt(0)" ::: "memory");
        unsigned* c = cnt + 64 * u.pm;
        if (lane == 0) __hip_atomic_fetch_add(c, 1u, __ATOMIC_RELAXED, __HIP_MEMORY_SCOPE_AGENT);
        { unsigned sp = 0;
          while ((unsigned)__builtin_amdgcn_readfirstlane(__hip_atomic_load(c, __ATOMIC_RELAXED, __HIP_MEMORY_SCOPE_AGENT)) < 32u) { __builtin_amdgcn_s_sleep(2); if (++sp > (1u << 20)) break; } }
        float rs[2][4];
#pragma unroll
        for (int ai = 0; ai < 2; ++ai)
#pragma unroll
            for (int m = 0; m < 4; ++m) rs[ai][m] = __hip_atomic_load(ssq + row0 + ai * 128 + m * 16, __ATOMIC_RELAXED, __HIP_MEMORY_SCOPE_AGENT);
        f32x4 gf[2][2];
#pragma unroll
        for (int bj = 0; bj < 2; ++bj)
#pragma unroll
            for (int n = 0; n < 2; ++n) gf[bj][n] = *(const f32x4*)(gfin + col0 + bj * 128 + n * 4);
#pragma unroll
        for (int ai = 0; ai < 2; ++ai)
#pragma unroll
            for (int m = 0; m < 4; ++m) {
                const float rstd = __builtin_amdgcn_rsqf(rs[ai][m] * (1.f / D) + RMS_EPS);
                float* op = out + (size_t)(row0 + ai * 128 + m * 16) * D + col0;
#pragma unroll
                for (int bj = 0; bj < 2; ++bj) { *(f32x4*)(op + bj * 128) = acc[ai][bj][m][0] * rstd * gf[bj][0]; *(f32x4*)(op + bj * 128 + 4) = acc[ai][bj][m][1] * rstd * gf[bj][1]; }
            }
    }
};
struct EpiSwiglu {
    static constexpr bool PERM = true, AFTER_DRAIN = false;
    bf16_t* H; const float* ssq; const float* shw;
    __device__ __forceinline__ void operator()(const AccT& acc, const Unit& u, int wr, int wc, int fr, int fq) const {
        const int cv = u.pm < MC / 256 ? 8 : ((u.pm - MC / 256) >> 2);
        const int col0 = u.pn * 128 + wc * 32 + 8 * fq, row0 = u.pm * 256 + wr * 64 + fr;
        const float* sp = shw + (size_t)cv * 2 * FF + u.pn * 256 + wc * 32 + 8 * fq;
        const f32x4 sg0 = *(const f32x4*)(sp), sg1 = *(const f32x4*)(sp + 4), su0 = *(const f32x4*)(sp + 128), su1 = *(const f32x4*)(sp + 132);
        float rs[2][4];
#pragma unroll
        for (int ai = 0; ai < 2; ++ai)
#pragma unroll
            for (int m = 0; m < 4; ++m) rs[ai][m] = ssq[row0 + ai * 128 + m * 16];
        asm volatile("" ::: "memory");
#pragma unroll
        for (int ai = 0; ai < 2; ++ai)
#pragma unroll
            for (int m = 0; m < 4; ++m) rs[ai][m] = __builtin_amdgcn_rsqf(rs[ai][m] * (1.f / D) + RMS_EPS);
#pragma unroll
        for (int ai = 0; ai < 2; ++ai)
#pragma unroll
            for (int m = 0; m < 4; ++m) {
                const int row = row0 + ai * 128 + m * 16;
                const float rstd = rs[ai][m];
                float o[8];
#pragma unroll
                for (int n = 0; n < 2; ++n) {
                    const f32x4 gq = acc[ai][0][m][n] * rstd + (n ? sg1 : sg0), uq = acc[ai][1][m][n] * rstd + (n ? su1 : su0);
#pragma unroll
                    for (int j = 0; j < 4; ++j) o[n * 4 + j] = silu_f(gq[j]) * uq[j];
                }
                u32x4 w; w.x = pk_bf16(o[0], o[1]); w.y = pk_bf16(o[2], o[3]); w.z = pk_bf16(o[4], o[5]); w.w = pk_bf16(o[6], o[7]);
                *(u32x4*)(H + (size_t)row * FF + col0) = w;
            }
    }
};
struct EpiWin {
    static constexpr bool PERM = true, AFTER_DRAIN = false;
    bf16_t *G, *XR; const float* ssq; const float* shw;
    __device__ __forceinline__ void operator()(const AccT& acc, const Unit& u, int wr, int wc, int fr, int fq) const {
        const bool isg = u.pn < 4;
        const int cv = u.pm < MC / 256 ? 8 : ((u.pm - MC / 256) >> 2);
        bf16_t* base = isg ? G : XR;
        const int colt = (u.pn & 3) * 256 + wc * 32 + 8 * fq, row0 = u.pm * 256 + wr * 64 + fr;
        const float* sp = shw + (size_t)cv * 2 * D + u.pn * 256 + wc * 32 + 8 * fq;
        f32x4 sv[2][2];
#pragma unroll
        for (int bj = 0; bj < 2; ++bj) { sv[bj][0] = *(const f32x4*)(sp + bj * 128); sv[bj][1] = *(const f32x4*)(sp + bj * 128 + 4); }
        float rs[2][4];
#pragma unroll
        for (int ai = 0; ai < 2; ++ai)
#pragma unroll
            for (int m = 0; m < 4; ++m) rs[ai][m] = ssq[row0 + ai * 128 + m * 16];
        asm volatile("" ::: "memory");
#pragma unroll
        for (int ai = 0; ai < 2; ++ai)
#pragma unroll
            for (int m = 0; m < 4; ++m) rs[ai][m] = __builtin_amdgcn_rsqf(rs[ai][m] * (1.f / D) + RMS_EPS);
#pragma unroll
        for (int ai = 0; ai < 2; ++ai)
#pragma unroll
            for (int m = 0; m < 4; ++m) {
                const int row = row0 + ai * 128 + m * 16;
                const float rstd = rs[ai][m];
#pragma unroll
                for (int bj = 0; bj < 2; ++bj) {
                    f32x4 v0 = acc[ai][bj][m][0] * rstd + sv[bj][0], v1 = acc[ai][bj][m][1] * rstd + sv[bj][1];
                    if (isg) {
#pragma unroll
                        for (int j = 0; j < 4; ++j) { v0[j] = gelu_tanh_f(v0[j]); v1[j] = gelu_tanh_f(v1[j]); }
                    }
                    u32x4 w; w.x = pk_bf16(v0[0], v0[1]); w.y = pk_bf16(v0[2], v0[3]); w.z = pk_bf16(v1[0], v1[1]); w.w = pk_bf16(v1[2], v1[3]);
                    *(u32x4*)(base + (size_t)row * D + colt + bj * 128) = w;
                }
            }
    }
};
struct EpiLru {
    static constexpr bool PERM = true, AFTER_DRAIN = true;
    LAS const unsigned long long* ptab;
    const float* h0;
    int row_base, cb, dir, q;

    template <int AI>
    __device__ __forceinline__ void half(const AccT& acc, int wr, int wc, int fr, int fq, PG8_LAS unsigned char* lds, int tid,
                                         const u32x4 (&xall)[4], bf16_t* HL, bf16_t* PP) const {
#pragma unroll
        for (int m = 0; m < 4; ++m) {
            const int tl = wr * 64 + m * 16 + fr;
            const size_t row = (size_t)(row_base + AI * 128 + tl);
#pragma unroll
            for (int n = 0; n < 2; ++n) {
                asm volatile("" ::: "memory");
                const int chl = wc * 32 + 8 * fq + 4 * n;
                const PG8_LAS f32x4* cst = (const PG8_LAS f32x4*)(lds + CST_OFF + chl * 4);
                const f32x4 ba = cst[0], bi = cst[32], L2 = cst[64];
                u32x2 xw; xw.x = n ? xall[m].z : xall[m].x; xw.y = n ? xall[m].w : xall[m].y;
                const f32x4 xc = {bf_lo(xw.x), bf_hi(xw.x), bf_lo(xw.y), bf_hi(xw.y)};
                f32x4 av, bv;
#pragma unroll
                for (int j = 0; j < 4; ++j) {
                    const float za = acc[AI][0][m][n][j] + ba[j], zi = acc[AI][1][m][n][j] + bi[j];
                    const float r = sigmoid_f(za), ig = sigmoid_f(zi);
                    const float a = fast_exp2(r * L2[j]);
                    av[j] = a; bv[j] = __builtin_amdgcn_sqrtf(1.f - a * a) * (ig * xc[j]);
                }
                PG8_LAS f32x4* dst = (PG8_LAS f32x4*)(lds + tl * AB_PITCH + chl * 8);
                dst[0] = (f32x4){av[0], bv[0], av[1], bv[1]}; dst[1] = (f32x4){av[2], bv[2], av[3], bv[3]};
            }
        }
        __syncthreads();
        if (tid < 128) {
            PG8_LAS float* hst = (PG8_LAS float*)(lds + HST_OFF);
            float h = hst[tid], P = hst[128 + tid];
            PG8_LAS f32x2* col = (PG8_LAS f32x2*)(lds + tid * 8);
            if (dir == 0) {
#pragma unroll 8
                for (int t = 0; t < 128; ++t) { PG8_LAS f32x2* p = (PG8_LAS f32x2*)((PG8_LAS unsigned char*)col + t * AB_PITCH); const f32x2 ab = *p; h = ab.x * h + ab.y; P *= ab.x; *p = (f32x2){h, P}; }
            } else {
#pragma unroll 8
                for (int t = 127; t >= 0; --t) { PG8_LAS f32x2* p = (PG8_LAS f32x2*)((PG8_LAS unsigned char*)col + t * AB_PITCH); const f32x2 ab = *p; h = ab.x * h + ab.y; P *= ab.x; *p = (f32x2){h, P}; }
            }
            hst[tid] = h; hst[128 + tid] = P;
        }
        __syncthreads();
        const bool lat = row_base >= MC;
#pragma unroll
        for (int it = 0; it < 8; ++it) {
            const int idx = it * 512 + tid, tl = idx >> 5, c4 = (idx & 31) * 4;
            const PG8_LAS f32x4* src = (const PG8_LAS f32x4*)(lds + tl * AB_PITCH + c4 * 8);
            const f32x4 s0 = src[0], s1 = src[1];
            const size_t row = (size_t)(row_base + AI * 128 + tl);
            { u32x2 wh; wh.x = pk_bf16(s0[0], s0[2]); wh.y = pk_bf16(s1[0], s1[2]); *(u32x2*)(HL + row * D + cb + c4) = wh; }
            if (lat) { u32x2 w; w.x = pk_bf16(s0[1], s0[3]); w.y = pk_bf16(s1[1], s1[3]); *(u32x2*)(PP + (row - MC) * D + cb + c4) = w; }
        }
        __syncthreads();
    }
    __device__ __forceinline__ void fused(AccT& acc, const Unit&, int wr, int wc, int fr, int fq, PG8_LAS unsigned char* lds, int wid, int lane) const {
        const int tid = wid * 64 + lane;
        const PT pt{ptab};
        unsigned char* ws = pt.ws();
        PG8_LAS float* hst = (PG8_LAS float*)(lds + HST_OFF);
        PG8_LAS float* cst = (PG8_LAS float*)(lds + CST_OFF);
        if (tid < 128) {
            hst[tid] = h0 ? h0[cb + tid] : 0.f; hst[128 + tid] = 1.f;
            const int ch = dir * D + cb + tid;
            cst[tid] = pt.f(I_b_a)[ch]; cst[128 + tid] = pt.f(I_b_i)[ch];
            const float l = pt.f(I_lam)[ch];
            const float x = __expf(-l);
            const float sp = x < 0.03f ? x * (1.f - x * (0.5f - x * (0.33333334f - 0.25f * x))) : __logf(1.f + x);
            cst[256 + tid] = -8.0f * sp * LOG2E;
        }
        __syncthreads();
        const bf16_t* XC = (const bf16_t*)(ws + WS_XN);
        bf16_t* HL = (bf16_t*)(ws + (dir ? WS_HLB : WS_HLF));
        bf16_t* PP = (bf16_t*)(ws + (dir ? WS_PB : WS_PF));
        u32x4 xc0[4], xc1[4];
#pragma unroll
        for (int m = 0; m < 4; ++m) {
            xc0[m] = *(const u32x4*)(XC + (size_t)(row_base + wr * 64 + m * 16 + fr) * D + cb + wc * 32 + 8 * fq);
            xc1[m] = *(const u32x4*)(XC + (size_t)(row_base + 128 + wr * 64 + m * 16 + fr) * D + cb + wc * 32 + 8 * fq);
        }
        if (dir == 0) { half<0>(acc, wr, wc, fr, fq, lds, tid, xc0, HL, PP); half<1>(acc, wr, wc, fr, fq, lds, tid, xc1, HL, PP); }
        else          { half<1>(acc, wr, wc, fr, fq, lds, tid, xc1, HL, PP); half<0>(acc, wr, wc, fr, fq, lds, tid, xc0, HL, PP); }
        if (tid < 128) {
            const float h = hst[tid], P = hst[128 + tid];
            float* sumE = (float*)(ws + WS_SUME) + (size_t)dir * 48 * D; float* sumP = (float*)(ws + WS_SUMP) + (size_t)dir * 48 * D;
            sumE[(size_t)q * D + cb + tid] = h; sumP[(size_t)q * D + cb + tid] = P;
            if (row_base < MC) pt.out()[OUT_NH + (size_t)q * 2 * D + dir * D + cb + tid] = h;
        }
        __syncthreads();
    }
};
}
namespace att {
constexpr int KP = 144, VP = 136;
constexpr int K_OFF = 0, V_OFF = 2 * 64 * KP, F_OFF = V_OFF + 2 * 64 * KP, T_OFF = F_OFF + 8 * 32 * 4, A_END = T_OFF + 640 * 4;
typedef short v4i16_t __attribute__((ext_vector_type(4)));
#define MFMA32(a, b, c) __builtin_amdgcn_mfma_f32_32x32x16_bf16((a), (b), (c), 0, 0, 0)
__device__ __forceinline__ float max2f(float a, float b) { float r; asm("v_max_f32_e32 %0, %1, %2" : "=v"(r) : "v"(a), "v"(b)); return r; }
__device__ __forceinline__ float max3f(float a, float b, float c) { float r; asm("v_max3_f32 %0, %1, %2, %3" : "=v"(r) : "v"(a), "v"(b), "v"(c)); return r; }
__device__ __forceinline__ int crow(int r, int hi) { return (r & 3) + 8 * (r >> 2) + 4 * hi; }

template <bool NA>
__device__ __forceinline__ void unit(int wv, LAS unsigned char* lds, int b, int h, int g, const bf16_t* __restrict__ Qb, const bf16_t* __restrict__ Kb, const bf16_t* __restrict__ Vb,
                                     const bf16_t* __restrict__ CK, const bf16_t* __restrict__ CV, bf16_t* __restrict__ Ob, const float* __restrict__ rpb) {
    int wid_ = wv; asm volatile("" : "+s"(wid_));
    const int tid = tid_l(wid_), lane = tid & 63, wid = wid_, r32 = lane & 31, hi = lane >> 5;
    LAS float* fscr = (LAS float*)(lds + F_OFF) + wid * 32;
    LAS float* tab = (LAS float*)(lds + T_OFF);
    if (NA) { for (int i = tid; i < 15 * 31; i += 512) { const int dr = i / 31, dc = i % 31; tab[64 + dr * 32 + dc] = rpb[(h * 15 + dr) * 31 + dc] * LOG2E; } }
    int qrow, nlat, ntile, Rlo = 0, rq = 0, rs = 0;
    if (NA) {
        rq = 4 * g + (wid >> 1); rs = min(max(rq - 4, 0), 8);
        qrow = MC + b * 1024 + rq * 64 + 32 * (wid & 1) + r32;
        Rlo = min(max(4 * g - 4, 0), 8); const int Rhi = min(max(4 * g - 1, 0), 8) + 8;
        nlat = Rhi - Rlo; ntile = nlat + 8;
    } else { qrow = b * 256 + 32 * wid + r32; nlat = 4; ntile = 4; }
    const int qc = 32 * (wid & 1) + r32, cs = min(max(qc - 8, 0), 48);
    f32x16 pen0, pen1;
#pragma unroll
    for (int i = 0; i < 16; ++i) { const int kc = (i & 3) + 8 * (i >> 2) + 4 * hi - cs; pen0[i] = (NA && (unsigned)kc >= 16u) ? -1e30f : 0.f; pen1[i] = (NA && (unsigned)(kc + 32) >= 16u) ? -1e30f : 0.f; }
    bf16x8 qr[4];
#pragma unroll
    for (int s = 0; s < 4; ++s) qr[s] = *(const bf16x8*)(Qb + (size_t)qrow * D + h * 64 + 16 * s + 8 * hi);
    const int lkey = tid >> 3, lch = tid & 7;
    auto src_row = [&](int t) -> size_t {
        if (NA) return t < nlat ? (size_t)(MC + b * 1024 + (Rlo + t) * 64) : (size_t)(b * 512 + (t - nlat) * 64);
        return (size_t)(b * 256 + t * 64);
    };
    u32x4 kreg, vreg;
    auto gload = [&](int t) {
        const bool cache = NA && t >= nlat;
        const bf16_t* kp = cache ? CK : Kb; const bf16_t* vp = cache ? CV : Vb;
        const size_t off = (src_row(t) + lkey) * D + h * 64 + 8 * lch;
        kreg = *(const u32x4*)(kp + off); vreg = *(const u32x4*)(vp + off);
    };
    auto lstore = [&](int buf) {
        *(LAS u32x4*)(lds + K_OFF + buf * 64 * KP + lkey * KP + lch * 16) = kreg;
        *(LAS u32x4*)(lds + V_OFF + buf * 64 * KP + lkey * KP + lch * 16) = vreg;
    };
    float m_run = -1e30f, l_run = 0.f;
    f32x16 o0, o1;
#pragma unroll
    for (int i = 0; i < 16; ++i) { o0[i] = 0.f; o1[i] = 0.f; }
    gload(0); lstore(0);
    asm volatile("" :: "v"(qr[0]), "v"(qr[1]), "v"(qr[2]), "v"(qr[3]));
    __syncthreads();
    for (int t = 0; t < ntile; ++t) {
        const int buf = t & 1;
        if (t + 1 < ntile) gload(t + 1);
        bool active = true, biased = false; int dr = 0;
        if (NA && t < nlat) { const int R = Rlo + t; active = (R >= rs) && (R < rs + 8); biased = true; dr = R - rq + 7; }
        if (active) {
            f32x16 p0, p1;
#pragma unroll
            for (int i = 0; i < 16; ++i) { p0[i] = 0.f; p1[i] = 0.f; }
            const LAS unsigned char* kb = lds + K_OFF + buf * 64 * KP + r32 * KP + 16 * hi;
#pragma unroll
            for (int s = 0; s < 4; ++s) {
                const bf16x8 k0 = *(const LAS bf16x8*)(kb + 32 * s), k1 = *(const LAS bf16x8*)(kb + 32 * KP + 32 * s);
                p0 = MFMA32(k0, qr[s], p0); p1 = MFMA32(k1, qr[s], p1);
            }
            if (biased) {
                const LAS float* tb = tab + 64 + dr * 32 + (4 * hi - qc + 15);
                f32x16 b0, b1;
#pragma unroll
                for (int i = 0; i < 16; ++i) { const int kc = (i & 3) + 8 * (i >> 2); b0[i] = tb[kc]; b1[i] = tb[kc + 32]; }
                p0 += b0; p1 += b1; p0 += pen0; p1 += pen1;
            }
            float mxa = max3f(p0[0], p0[1], p0[2]), mxb = max3f(p0[3], p0[4], p0[5]), mxc = max3f(p1[0], p1[1], p1[2]), mxd = max3f(p1[3], p1[4], p1[5]);
            mxa = max3f(mxa, p0[6], p0[7]); mxb = max3f(mxb, p0[8], p0[9]); mxc = max3f(mxc, p1[6], p1[7]); mxd = max3f(mxd, p1[8], p1[9]);
            mxa = max3f(mxa, p0[10], p0[11]); mxb = max3f(mxb, p0[12], p0[13]); mxc = max3f(mxc, p1[10], p1[11]); mxd = max3f(mxd, p1[12], p1[13]);
            mxa = max3f(mxa, p0[14], p0[15]); mxc = max3f(mxc, p1[14], p1[15]);
            float mx = max2f(max2f(mxa, mxb), max2f(mxc, mxd));
            mx = max2f(mx, shfl_xor_l(mx, 32, lane));
            const float mnew = max2f(m_run, mx);
            const float f = fast_exp2(m_run - mnew);
            m_run = mnew;
            p0 -= mnew; p1 -= mnew;
#pragma unroll
            for (int i = 0; i < 16; ++i) { p0[i] = fast_exp2(p0[i]); p1[i] = fast_exp2(p1[i]); }
            f32x4 ls4 = {0.f, 0.f, 0.f, 0.f};
#pragma unroll
            for (int i = 0; i < 16; i += 4) ls4 += (f32x4){p0[i], p0[i + 1], p0[i + 2], p0[i + 3]} + (f32x4){p1[i], p1[i + 1], p1[i + 2], p1[i + 3]};
            const float ls = (ls4[0] + ls4[1]) + (ls4[2] + ls4[3]);
            l_run = l_run * f + ls;
            if (__any(f != 1.f)) {
                if (hi == 0) fscr[r32] = f;
                asm volatile("s_waitcnt lgkmcnt(0)" ::: "memory");
#pragma unroll
                for (int i = 0; i < 16; ++i) { const float fi = fscr[crow(i, hi)]; o0[i] *= fi; o1[i] *= fi; }
                asm volatile("s_waitcnt lgkmcnt(0)" ::: "memory");
            }
            bf16x8 pa[2][2];
#pragma unroll
            for (int s = 0; s < 2; ++s) {
                u32x4 w0, w1;
                w0.x = pk_bf16(p0[8 * s + 0], p0[8 * s + 1]); w0.y = pk_bf16(p0[8 * s + 2], p0[8 * s + 3]); w0.z = pk_bf16(p0[8 * s + 4], p0[8 * s + 5]); w0.w = pk_bf16(p0[8 * s + 6], p0[8 * s + 7]);
                w1.x = pk_bf16(p1[8 * s + 0], p1[8 * s + 1]); w1.y = pk_bf16(p1[8 * s + 2], p1[8 * s + 3]); w1.z = pk_bf16(p1[8 * s + 4], p1[8 * s + 5]); w1.w = pk_bf16(p1[8 * s + 6], p1[8 * s + 7]);
                pa[0][s] = __builtin_bit_cast(bf16x8, w0); pa[1][s] = __builtin_bit_cast(bf16x8, w1);
            }
            const int i16 = lane & 15, g16 = (lane >> 4) & 1;
            const LAS unsigned char* vb = lds + V_OFF + buf * 64 * KP + (4 * hi + (i16 >> 2)) * KP + (16 * g16 + 4 * (i16 & 3)) * 2;
#pragma unroll
            for (int blk = 0; blk < 2; ++blk)
#pragma unroll
                for (int s = 0; s < 2; ++s) {
                    const int ko = (32 * blk + 16 * s) * KP;
                    const s16x4 a0 = __builtin_bit_cast(s16x4, __builtin_amdgcn_ds_read_tr16_b64_v4i16((LAS v4i16_t*)(vb + ko))), a1 = __builtin_bit_cast(s16x4, __builtin_amdgcn_ds_read_tr16_b64_v4i16((LAS v4i16_t*)(vb + ko + 8 * KP)));
                    const s16x4 c0 = __builtin_bit_cast(s16x4, __builtin_amdgcn_ds_read_tr16_b64_v4i16((LAS v4i16_t*)(vb + ko + 64))), c1 = __builtin_bit_cast(s16x4, __builtin_amdgcn_ds_read_tr16_b64_v4i16((LAS v4i16_t*)(vb + ko + 8 * KP + 64)));
                    const bf16x8 v0 = __builtin_shufflevector(a0, a1, 0, 1, 2, 3, 4, 5, 6, 7), v1 = __builtin_shufflevector(c0, c1, 0, 1, 2, 3, 4, 5, 6, 7);
                    o0 = MFMA32(pa[blk][s], v0, o0); o1 = MFMA32(pa[blk][s], v1, o1);
                }
        }
        if (t + 1 < ntile) lstore(buf ^ 1);
        __syncthreads();
    }
    l_run += shfl_xor_l(l_run, 32, lane);
    if (hi == 0) fscr[r32] = fast_rcp(l_run);
    asm volatile("s_waitcnt lgkmcnt(0)" ::: "memory");
    const int qbase = qrow - r32;
    LAS unsigned char* stg = lds + K_OFF + wid * (32 * KP);
#pragma unroll
    for (int i = 0; i < 16; ++i) {
        const int qi = crow(i, hi); const float li = fscr[qi];
        LAS unsigned short* sp = (LAS unsigned short*)(stg + qi * KP + r32 * 2);
        sp[0] = (unsigned short)(pk_bf16(o0[i] * li, 0.f) & 0xffff); sp[32] = (unsigned short)(pk_bf16(o1[i] * li, 0.f) & 0xffff);
    }
    asm volatile("s_waitcnt lgkmcnt(0)" ::: "memory");
    {
        const int row = lane >> 1, half = lane & 1;
        bf16_t* op = Ob + (size_t)(qbase + row) * D + h * 64 + half * 32;
#pragma unroll
        for (int j = 0; j < 4; ++j) *(u32x4*)(op + 8 * j) = *(const LAS u32x4*)(stg + row * KP + half * 64 + 16 * j);
    }
    __syncthreads();
}
}
#ifndef REP_P4
#define REP_P4 1
#endif
#ifndef REP_ADA
#define REP_ADA 1
#endif
#ifndef REP_PRO
#define REP_PRO 1
#endif
#ifndef REP_FILL
#define REP_FILL 1
#endif
#ifndef REP_ATT
#define REP_ATT 1
#endif
#ifndef REP_GEMM
#define REP_GEMM 1
#endif
#ifndef REP_THIN
#define REP_THIN 1
#endif
#ifndef REP_LRU
#define REP_LRU 1
#endif
#ifndef REP_SYNC
#define REP_SYNC 1
#endif
struct Args {
    const float *x_prompt, *x_sample, *c, *cache_k, *cache_v, *state_h, *c_ctx, *norm_g, *w_mod, *b_mod, *w_qkv, *w_o, *rpb, *w_in, *conv_w, *conv_b,
                *w_a, *b_a, *w_i, *b_i, *lam, *w_out, *w_gu, *w_down, *final_g;
    float* out; unsigned char* ws;
};

__device__ __forceinline__ void tr_item(const float* __restrict__ W, int ldw, int k0, int n0, bf16_t* __restrict__ dst, int ldd, LAS float* scr, int lane) {
    float tv[32];
#pragma unroll
    for (int i = 0; i < 32; ++i) { const int kk = 2 * i + (lane >> 5); tv[i] = W[(size_t)(k0 + kk) * ldw + n0 + (lane & 31)]; }
#pragma unroll
    for (int i = 0; i < 32; ++i) { const int kk = 2 * i + (lane >> 5); scr[kk * 33 + (lane & 31)] = tv[i]; }
    asm volatile("s_waitcnt lgkmcnt(0)" ::: "memory");
    const int c = lane & 7;
#pragma unroll
    for (int j = 0; j < 4; ++j) {
        const int n = (lane >> 3) + 8 * j; const LAS float* s = scr + (8 * c) * 33 + n;
        u32x4 o; o.x = pk_bf16(s[0 * 33], s[1 * 33]); o.y = pk_bf16(s[2 * 33], s[3 * 33]); o.z = pk_bf16(s[4 * 33], s[5 * 33]); o.w = pk_bf16(s[6 * 33], s[7 * 33]);
        *(u32x4*)(dst + (size_t)n * ldd + k0 + 8 * c) = o;
    }
    asm volatile("s_waitcnt lgkmcnt(0)" ::: "memory");
}

__device__ __forceinline__ void tr_items(int wv, const PT pt, LAS unsigned char* lds, int it0, int it1, int gwr, int ngw) {
    const int lane = tid_l(wv) & 63;
    unsigned char* ws = pt.ws();
    {
        LAS float* scr = (LAS float*)(lds + wv * 8448);
        constexpr int I_QKV = 16 * 96, I_WO = 16 * 32, I_GU = 16 * 176, I_DN = 44 * 32, I_WIN = 16 * 64, I_WOUT = 16 * 32, I_G = 32 * 8;
        for (int it = it0 + gwr; it < it1; it += ngw) {
            int r = it;
            if (r < I_QKV) { const int kb = r / 96, nb = r % 96; tr_item(pt.f(I_w_qkv), NQKV, 64 * kb, 32 * nb, (bf16_t*)(ws + WS_WQKV) + (size_t)(32 * nb) * D, D, scr, lane); continue; } r -= I_QKV;
            if (r < I_WO) { const int kb = r / 32, nb = r % 32; tr_item(pt.f(I_w_o), D, 64 * kb, 32 * nb, (bf16_t*)(ws + WS_WO) + (size_t)(32 * nb) * D, D, scr, lane); continue; } r -= I_WO;
#pragma unroll 1
            for (int l = 0; l < 2; ++l) {
                if (r >= 0 && r < I_GU) { const int kb = r / 176, nb = r % 176; const int n0 = 32 * nb, half = n0 >= FF ? 1 : 0, c0 = n0 - half * FF;
                    const int drow = 256 * (c0 >> 7) + 128 * half + (c0 & 127);
                    tr_item(pt.f(I_w_gu) + (size_t)l * D * 2 * FF, 2 * FF, 64 * kb, n0, (bf16_t*)(ws + WS_WGU) + ((size_t)l * 2 * FF + drow) * D, D, scr, lane); r = -1; break; } r -= I_GU;
                if (r >= 0 && r < I_DN) { const int kb = r / 32, nb = r % 32;
                    tr_item(pt.f(I_w_down) + (size_t)l * FF * D, D, 64 * kb, 32 * nb, (bf16_t*)(ws + WS_WDN) + ((size_t)l * D + 32 * nb) * FF, FF, scr, lane); r = -1; break; } r -= I_DN;
            }
            if (r < 0) continue;
            if (r < I_WIN) { const int kb = r / 64, nb = r % 64; tr_item(pt.f(I_w_in), 2 * D, 64 * kb, 32 * nb, (bf16_t*)(ws + WS_WIN) + (size_t)(32 * nb) * D, D, scr, lane); continue; } r -= I_WIN;
            if (r < I_WOUT) { const int kb = r / 32, nb = r % 32; tr_item(pt.f(I_w_out), D, 64 * kb, 32 * nb, (bf16_t*)(ws + WS_WOUT) + (size_t)(32 * nb) * D, D, scr, lane); continue; } r -= I_WOUT;
            { const int mat = r >> 3, sub = r & 7, kb = sub >> 2, nb = sub & 3;
              const int gsel = mat >> 4, dir = (mat >> 3) & 1, blk = mat & 7;
              const float* src = (gsel ? pt.f(I_w_i) : pt.f(I_w_a)) + (size_t)(dir * 8 + blk) * 128 * 128;
              tr_item(src, 128, 64 * kb, 32 * nb, (bf16_t*)(ws + WS_WG) + ((size_t)((blk * 2 + dir) * 256 + gsel * 128 + 32 * nb)) * 128, 128, scr, lane); }
        }
    }
}

__device__ __forceinline__ void adaln_tasks(int wv, const PT pt, LAS unsigned char* lds, int l, int rank, int nb) {
    const int tid = tid_l(wv);
    LAS float* sl = (LAS float*)(lds + 70000);
    LAS float* red = (LAS float*)lds;
    float* mod = (float*)(pt.ws() + WS_MOD);
#pragma unroll 1
    for (int task = rank; task < 256; task += nb) {
        const int cg_ = task >> 3, kr = task & 7, col0 = cg_ * 192;
        __syncthreads();
        for (int i = tid; i < 9 * 128; i += 512) { const int cv = i >> 7, k = kr * 128 + (i & 127); const float v = cv < 8 ? pt.f(I_c)[cv * D + k] : pt.f(I_c_ctx)[k]; sl[i] = silu_f(v); }
        __syncthreads();
        if (tid < 384) {
            const int q = tid % 48, ks = tid / 48;
            float acc[9][4];
#pragma unroll
            for (int cv = 0; cv < 9; ++cv) { acc[cv][0] = 0.f; acc[cv][1] = 0.f; acc[cv][2] = 0.f; acc[cv][3] = 0.f; }
            const float* wp = pt.f(I_w_mod) + ((size_t)l * D + kr * 128 + ks * 16) * NMOD + col0 + 4 * q;
            f32x4 w[16];
#pragma unroll
            for (int k = 0; k < 16; ++k) w[k] = *(const f32x4*)(wp + (size_t)k * NMOD);
#pragma unroll
            for (int k = 0; k < 16; ++k) {
#pragma unroll
                for (int cv = 0; cv < 9; ++cv) { const float s = sl[cv * 128 + ks * 16 + k]; acc[cv][0] += s * w[k][0]; acc[cv][1] += s * w[k][1]; acc[cv][2] += s * w[k][2]; acc[cv][3] += s * w[k][3]; }
            }
#pragma unroll
            for (int cv = 0; cv < 9; ++cv) *(LAS f32x4*)(red + (ks * 9 + cv) * 192 + 4 * q) = (f32x4){acc[cv][0], acc[cv][1], acc[cv][2], acc[cv][3]};
        }
        __syncthreads();
        for (int i = tid; i < 9 * 192; i += 512) {
            const int cv = i / 192, cc = i % 192; float s = 0.f;
#pragma unroll
            for (int ks = 0; ks < 8; ++ks) s += red[(ks * 9 + cv) * 192 + cc];
            if (kr == 0) s += pt.f(I_b_mod)[l * NMOD + col0 + cc];
            unsafeAtomicAdd(mod + ((size_t)l * 9 + cv) * NMOD + col0 + cc, s);
        }
    }
    __syncthreads();
}

__device__ __forceinline__ void cache_conv(int wv, const PT pt, int rank, int nb) {
    const int tid = tid_l(wv);
    unsigned char* ws = pt.ws();
    const size_t n4 = (size_t)MC * D / 4;
#pragma unroll 8
    for (size_t i = (size_t)rank * 512 + tid; i < 2 * n4; i += (size_t)nb * 512) {
        const bool isv = i >= n4; const size_t j = isv ? i - n4 : i;
        const f32x4 v = *((const f32x4*)(isv ? pt.f(I_cache_v) : pt.f(I_cache_k)) + j);
        u32x2 w; w.x = pk_bf16(v[0], v[1]); w.y = pk_bf16(v[2], v[3]);
        *((u32x2*)(ws + (isv ? WS_CV : WS_CK)) + j) = w;
    }
}

__device__ __forceinline__ void p0_prologue(int wv, const PT pt, LAS unsigned char* lds) {
    const int tid = tid_l(wv), lane = tid & 63, wave = tid >> 6;
    const int G = gd_l(), bxl = bx_l(), gw = bxl * 8 + wave, NGW = G * 8;
    unsigned char* ws = pt.ws();
    adaln_tasks(wv, pt, lds, 0, bxl, G);
    for (int rp_ = 0; rp_ < REP_PRO; ++rp_) tr_items(wv, pt, lds, 0, 16 * 96, gw, NGW);
}

__device__ __forceinline__ void norm_phase(int wv, const float* xa, const float* xb, const float* g, const float* mod_l, int sh_chunk, bf16_t* XN) {
    const int tid = tid_l(wv), lane = tid & 63, gw = bx_l() * 8 + (tid >> 6), NGW = gd_l() * 8;
#pragma unroll 2
    for (int row = gw; row < MT; row += NGW) {
        const float* xr = row < MC ? xa + (size_t)row * D : xb + (size_t)(row - MC) * D;
        const int cv = row < MC ? 8 : ((row - MC) >> 10);
        const float* shp = mod_l + (size_t)cv * NMOD + sh_chunk * D; const float* scp = shp + D;
        f32x4 v[4], gg4[4], sc4[4], sh4[4]; float s = 0.f;
#pragma unroll
        for (int j = 0; j < 4; ++j) { const int c = 4 * lane + 256 * j; v[j] = *((const f32x4*)xr + lane + 64 * j); gg4[j] = *(const f32x4*)(g + c); sc4[j] = *(const f32x4*)(scp + c); sh4[j] = *(const f32x4*)(shp + c); }
#pragma unroll
        for (int j = 0; j < 4; ++j) s += (v[j][0] * v[j][0] + v[j][1] * v[j][1]) + (v[j][2] * v[j][2] + v[j][3] * v[j][3]);
        const float rstd = 1.f / sqrtf(wave_sum(s, lane) * (1.f / D) + RMS_EPS);
#pragma unroll
        for (int j = 0; j < 4; ++j) {
            const int c = 4 * lane + 256 * j;
            const f32x4 gg = gg4[j], sc = sc4[j], sh = sh4[j];
            const f32x4 y = v[j] * rstd * gg * (sc + 1.f) + sh;
            u32x2 w; w.x = pk_bf16(y[0], y[1]); w.y = pk_bf16(y[2], y[3]);
            *(u32x2*)(XN + (size_t)row * D + c) = w;
        }
    }
}
__device__ __forceinline__ void final_norm_phase(int wv, const bf16_t* XB, float* Y, const float* g) {
    const int tid = tid_l(wv), lane = tid & 63, gw = bx_l() * 8 + (tid >> 6), NGW = gd_l() * 8;
#pragma unroll 2
    for (int row = gw; row < MT; row += NGW) {
        const u32x4* xr = (const u32x4*)(XB + (size_t)row * D);
        f32x4 v[4], gg[4]; float s = 0.f;
#pragma unroll
        for (int j = 0; j < 2; ++j) {
            const u32x4 w = xr[lane + 64 * j];
            v[2 * j] = (f32x4){bf_lo(w.x), bf_hi(w.x), bf_lo(w.y), bf_hi(w.y)}; v[2 * j + 1] = (f32x4){bf_lo(w.z), bf_hi(w.z), bf_lo(w.w), bf_hi(w.w)};
            gg[2 * j] = *(const f32x4*)(g + 8 * lane + 512 * j); gg[2 * j + 1] = *(const f32x4*)(g + 8 * lane + 512 * j + 4);
        }
#pragma unroll
        for (int j = 0; j < 4; ++j) s += (v[j][0] * v[j][0] + v[j][1] * v[j][1]) + (v[j][2] * v[j][2] + v[j][3] * v[j][3]);
        const float rstd = 1.f / sqrtf(wave_sum(s, lane) * (1.f / D) + RMS_EPS);
        float* yr = Y + (size_t)row * D;
#pragma unroll
        for (int j = 0; j < 2; ++j) { *(f32x4*)(yr + 8 * lane + 512 * j) = v[2 * j] * rstd * gg[2 * j]; *(f32x4*)(yr + 8 * lane + 512 * j + 4) = v[2 * j + 1] * rstd * gg[2 * j + 1]; }
    }
}
__device__ __forceinline__ void conv_phase(int wv, const bf16_t* XR, const float* cw, const float* cb, bf16_t* XC) {
    const size_t n8 = (size_t)MT * D / 8;
#pragma unroll 2
    for (size_t i = (size_t)bx_l() * 512 + tid_l(wv), st_ = (size_t)gd_l() * 512; i < n8; i += st_) {
        const int row = (int)(i >> 7), c = (int)(i & 127) * 8;
        int pos, len; if (row < MC) { pos = row & 255; len = 256; } else { pos = (row - MC) & 1023; len = 1024; }
        float y[8];
#pragma unroll
        for (int e = 0; e < 8; ++e) y[e] = cb[c + e];
#pragma unroll
        for (int j = 0; j < 4; ++j) {
            const int p = pos + j - 2;
            if (p >= 0 && p < len) {
                const u32x4 xw = *(const u32x4*)(XR + (size_t)(row + j - 2) * D + c);
                const f32x4 w0 = *(const f32x4*)(cw + j * D + c), w1 = *(const f32x4*)(cw + j * D + c + 4);
                y[0] += w0[0] * bf_lo(xw.x); y[1] += w0[1] * bf_hi(xw.x); y[2] += w0[2] * bf_lo(xw.y); y[3] += w0[3] * bf_hi(xw.y);
                y[4] += w1[0] * bf_lo(xw.z); y[5] += w1[1] * bf_hi(xw.z); y[6] += w1[2] * bf_lo(xw.w); y[7] += w1[3] * bf_hi(xw.w);
            }
        }
        u32x4 o; o.x = pk_bf16(y[0], y[1]); o.y = pk_bf16(y[2], y[3]); o.z = pk_bf16(y[4], y[5]); o.w = pk_bf16(y[6], y[7]);
        *(u32x4*)(XC + (size_t)row * D + c) = o;
    }
}
__device__ __forceinline__ void conv_slab(int wv, const bf16_t* XR, const float* cw, const float* cb, bf16_t* XC, int q, int n) {
    const int tid = tid_l(wv), ch = n * 128 + (tid & 15) * 8, r0 = q * 256 + (tid >> 4) * 8;
    int pos0, len; if (r0 < MC) { pos0 = r0 & 255; len = 256; } else { pos0 = (r0 - MC) & 1023; len = 1024; }
    u32x4 x[11];
#pragma unroll
    for (int i = 0; i < 11; ++i) { const int p = pos0 + i - 2; x[i] = (p >= 0 && p < len) ? *(const u32x4*)(XR + (size_t)(r0 + i - 2) * D + ch) : (u32x4){0u, 0u, 0u, 0u}; }
    f32x4 w0[4], w1[4];
#pragma unroll
    for (int j = 0; j < 4; ++j) { w0[j] = *(const f32x4*)(cw + j * D + ch); w1[j] = *(const f32x4*)(cw + j * D + ch + 4); }
    const f32x4 b0 = *(const f32x4*)(cb + ch), b1 = *(const f32x4*)(cb + ch + 4);
#pragma unroll
    for (int r = 0; r < 8; ++r) {
        f32x4 y0 = b0, y1 = b1;
#pragma unroll
        for (int j = 0; j < 4; ++j) { const u32x4 xw = x[r + j];
            y0 += w0[j] * (f32x4){bf_lo(xw.x), bf_hi(xw.x), bf_lo(xw.y), bf_hi(xw.y)}; y1 += w1[j] * (f32x4){bf_lo(xw.z), bf_hi(xw.z), bf_lo(xw.w), bf_hi(xw.w)}; }
        u32x4 o; o.x = pk_bf16(y0[0], y0[1]); o.y = pk_bf16(y0[2], y0[3]); o.z = pk_bf16(y1[0], y1[1]); o.w = pk_bf16(y1[2], y1[3]);
        *(u32x4*)(XC + (size_t)(r0 + r) * D + ch) = o;
    }
    asm volatile("s_waitcnt vmcnt(0)" ::: "memory");
    __syncthreads();
}

__device__ __forceinline__ void lru_combine_phase(int wv, const unsigned char* ws, bf16_t* Y) {
    const bf16_t* HLF = (const bf16_t*)(ws + WS_HLF); const bf16_t* HLB = (const bf16_t*)(ws + WS_HLB);
    const bf16_t* PF = (const bf16_t*)(ws + WS_PF); const bf16_t* PB = (const bf16_t*)(ws + WS_PB); const bf16_t* GT = (const bf16_t*)(ws + WS_GATE);
    const float* sE = (const float*)(ws + WS_SUME); const float* sP = (const float*)(ws + WS_SUMP);
    const size_t n8 = (size_t)MT * D / 8;
#pragma unroll 2
    for (size_t i = (size_t)bx_l() * 512 + tid_l(wv), st_ = (size_t)gd_l() * 512; i < n8; i += st_) {
        const int row = (int)(i >> 7), c = (int)(i & 127) * 8;
        const size_t off = (size_t)row * D + c;
        const u32x4 hf = *(const u32x4*)(HLF + off), hb = *(const u32x4*)(HLB + off), gt = *(const u32x4*)(GT + off);
        float h[8] = {bf_lo(hf.x) + bf_lo(hb.x), bf_hi(hf.x) + bf_hi(hb.x), bf_lo(hf.y) + bf_lo(hb.y), bf_hi(hf.y) + bf_hi(hb.y),
                      bf_lo(hf.z) + bf_lo(hb.z), bf_hi(hf.z) + bf_hi(hb.z), bf_lo(hf.w) + bf_lo(hb.w), bf_hi(hf.w) + bf_hi(hb.w)};
        if (row >= MC) {
            const int q = row >> 8, ci = (q - 16) & 3, q0 = q - ci;
            const u32x4 pf = *(const u32x4*)(PF + off - (size_t)MC * D), pb = *(const u32x4*)(PB + off - (size_t)MC * D);
            f32x4 tf0 = {0.f, 0.f, 0.f, 0.f}, tf1 = tf0, tb0 = tf0, tb1 = tf0;
            for (int cc = 0; cc < ci; ++cc) { const float* e = sE + (size_t)(q0 + cc) * D + c; const float* p = sP + (size_t)(q0 + cc) * D + c;
                tf0 = *(const f32x4*)e + *(const f32x4*)p * tf0; tf1 = *(const f32x4*)(e + 4) + *(const f32x4*)(p + 4) * tf1; }
            for (int cc = 3; cc > ci; --cc) { const float* e = sE + (size_t)(48 + q0 + cc) * D + c; const float* p = sP + (size_t)(48 + q0 + cc) * D + c;
                tb0 = *(const f32x4*)e + *(const f32x4*)p * tb0; tb1 = *(const f32x4*)(e + 4) + *(const f32x4*)(p + 4) * tb1; }
            h[0] += bf_lo(pf.x) * tf0[0] + bf_lo(pb.x) * tb0[0]; h[1] += bf_hi(pf.x) * tf0[1] + bf_hi(pb.x) * tb0[1];
            h[2] += bf_lo(pf.y) * tf0[2] + bf_lo(pb.y) * tb0[2]; h[3] += bf_hi(pf.y) * tf0[3] + bf_hi(pb.y) * tb0[3];
            h[4] += bf_lo(pf.z) * tf1[0] + bf_lo(pb.z) * tb1[0]; h[5] += bf_hi(pf.z) * tf1[1] + bf_hi(pb.z) * tb1[1];
            h[6] += bf_lo(pf.w) * tf1[2] + bf_lo(pb.w) * tb1[2]; h[7] += bf_hi(pf.w) * tf1[3] + bf_hi(pb.w) * tb1[3];
        }
        u32x4 o;
        o.x = pk_bf16(h[0] * bf_lo(gt.x), h[1] * bf_hi(gt.x)); o.y = pk_bf16(h[2] * bf_lo(gt.y), h[3] * bf_hi(gt.y));
        o.z = pk_bf16(h[4] * bf_lo(gt.z), h[5] * bf_hi(gt.z)); o.w = pk_bf16(h[6] * bf_lo(gt.w), h[7] * bf_hi(gt.w));
        *(u32x4*)(Y + off) = o;
    }
}

#ifndef PG8_SP2
#define PG8_SP2 true
#endif
#ifndef PG8_ALIGN
#define PG8_ALIGN true
#endif

__device__ __forceinline__ void shw_phase(int wv, const PT pt, LAS unsigned char* lds, const int site, int bx, int G) {
    const int tid = tid_l(wv), lane = tid & 63;
    unsigned char* ws = pt.ws();
    const int lb = bx, nb = G;
    LAS float* sl = (LAS float*)lds;
    const float* mod = (const float*)(ws + WS_MOD);
    const int l = site ? 1 : 0, chunk = (site == 1) ? 0 : 3, N = (site == 1) ? 2 * D : 2 * FF;
    const bf16_t* Wt = site == 0 ? (const bf16_t*)(ws + WS_WGU) : (site == 1 ? (const bf16_t*)(ws + WS_WIN) : (const bf16_t*)(ws + WS_WGU) + (size_t)2 * FF * D);
    float* out = (float*)(ws + WS_SHW) + (site == 0 ? SHW_OFF0 : (site == 1 ? SHW_OFF1 : SHW_OFF2));
    __syncthreads();
#pragma unroll
    for (int r = 0; r < 3; ++r) {
        float v[6];
#pragma unroll
        for (int j = 0; j < 6; ++j) { const int i = tid + 512 * (6 * r + j); v[j] = mod[((size_t)l * 9 + (i >> 10)) * NMOD + chunk * D + (i & 1023)]; }
#pragma unroll
        for (int j = 0; j < 6; ++j) sl[tid + 512 * (6 * r + j)] = v[j];
    }
    __syncthreads();
    const int step = nb * 8;
    int n = lb * 8 + wv;
    u32x2 wa[4];
    if (n < N) {
#pragma unroll
        for (int j = 0; j < 4; ++j) wa[j] = *(const u32x2*)(Wt + (size_t)n * D + 4 * lane + 256 * j);
    }
    for (; n < N; n += step) {
        u32x2 wb[4];
        const int n2 = n + step;
        if (n2 < N) {
#pragma unroll
            for (int j = 0; j < 4; ++j) wb[j] = *(const u32x2*)(Wt + (size_t)n2 * D + 4 * lane + 256 * j);
        }
        float res = 0.f;
#pragma unroll
        for (int cv = 0; cv < 9; ++cv) {
            float s = 0.f;
#pragma unroll
            for (int j = 0; j < 4; ++j) { const f32x4 v = *(const LAS f32x4*)(sl + cv * D + 4 * lane + 256 * j); s += (v[0] * bf_lo(wa[j].x) + v[1] * bf_hi(wa[j].x)) + (v[2] * bf_lo(wa[j].y) + v[3] * bf_hi(wa[j].y)); }
            s = wave_sum(s, lane);
            if (lane == cv) res = s;
        }
        if (lane < 9) out[(size_t)lane * N + n] = res;
#pragma unroll
        for (int j = 0; j < 4; ++j) wa[j] = wb[j];
    }
    __syncthreads();
}

#ifndef PHMASK
#define PHMASK 0xffff
#endif
constexpr int PHM = PHMASK;
__global__ void __launch_bounds__(512, 2) fwd_megakernel(Args a) {
    extern __shared__ __attribute__((aligned(16))) unsigned char lds_raw[];
    LAS unsigned char* lds = (LAS unsigned char*)lds_raw;
    cg::grid_group grid = cg::this_grid();
    const int wv = __builtin_amdgcn_readfirstlane(threadIdx.x >> 6);
    {
        LAS unsigned long long* tw = (LAS unsigned long long*)(lds + PTAB_OFF);
        if (threadIdx.x == 0) {
            tw[0] = (unsigned long long)a.x_prompt; tw[1] = (unsigned long long)a.x_sample; tw[2] = (unsigned long long)a.c; tw[3] = (unsigned long long)a.cache_k; tw[4] = (unsigned long long)a.cache_v;
            tw[5] = (unsigned long long)a.state_h; tw[6] = (unsigned long long)a.c_ctx; tw[7] = (unsigned long long)a.norm_g; tw[8] = (unsigned long long)a.w_mod; tw[9] = (unsigned long long)a.b_mod;
            tw[10] = (unsigned long long)a.w_qkv; tw[11] = (unsigned long long)a.w_o; tw[12] = (unsigned long long)a.rpb; tw[13] = (unsigned long long)a.w_in; tw[14] = (unsigned long long)a.conv_w;
            tw[15] = (unsigned long long)a.conv_b; tw[16] = (unsigned long long)a.w_a; tw[17] = (unsigned long long)a.b_a; tw[18] = (unsigned long long)a.w_i; tw[19] = (unsigned long long)a.b_i;
            tw[20] = (unsigned long long)a.lam; tw[21] = (unsigned long long)a.w_out; tw[22] = (unsigned long long)a.w_gu; tw[23] = (unsigned long long)a.w_down; tw[24] = (unsigned long long)a.final_g;
            tw[25] = (unsigned long long)a.out; tw[26] = (unsigned long long)a.ws;
            LAS unsigned* st = (LAS unsigned*)(lds + BARST_OFF); st[0] = 0u; st[1] = 0u;
            (void)xb_add((unsigned*)(a.ws + WS_BAR) + XB_XCNT(xb_xcc_id()), 1u);
        }
        __syncthreads();
        if (a.out == nullptr) grid.sync();
    }
#define GSYNC() do { for (int rs_ = 0; rs_ < REP_SYNC; ++rs_) xcd_barrier(pt, lds, wv); } while (0)
    const PT pt{(LAS const unsigned long long*)(lds + PTAB_OFF)};
#define WSP(off) (pt.ws() + (off))
#define MODP ((float*)WSP(WS_MOD))
#define XNP ((bf16_t*)WSP(WS_XN))
#define XRES (pt.out() + OUT_Y)
#define XBP ((bf16_t*)WSP(WS_XB))
#define SSQP(i) ((float*)WSP(WS_SSQ) + (size_t)(i) * MT)

    if (PHM & 1) p0_prologue(wv, pt, lds);
    GSYNC();
    if (PHM & 2) for (int rep_ = 0; rep_ < REP_THIN; ++rep_) norm_phase(wv, pt.f(I_x_prompt), pt.f(I_x_sample), pt.f(I_norm_g), MODP, 0, XNP);
    GSYNC();
    if (PHM & 4) { pg8::Gemm g{XNP, (const bf16_t*)WSP(WS_WQKV), MT, NQKV, D, D, D, wv}; pg8::StaticOrder S; S.init(MT, NQKV, gd_l(), bx_l()); S.reps = REP_GEMM;
      pg8::EpiQKV E{(bf16_t*)WSP(WS_Q), pt.out() + OUT_NK, 0.125f * LOG2E};
      pg8::gemm_phase<pg8::EpiQKV, pg8::StaticOrder, PG8_ALIGN, PG8_SP2>(lds, g, S, E); }
    {
        const int G_ = gd_l(), c_ = bx_l(), nwg_ = (MT / 256) * (NQKV / 256), maxu_ = (nwg_ + G_ - 1) / G_, full_ = nwg_ - (maxu_ - 1) * G_;
        int rank_ = c_, n_ = G_;
        if (full_ < G_) { rank_ = c_ - full_; n_ = c_ >= full_ ? G_ - full_ : 0; }
        if (n_ > 0) { tr_items(wv, pt, lds, 16 * 96, 16 * 96 + 16 * 32 + 16 * 176, rank_ * 8 + wv, n_ * 8); cache_conv(wv, pt, rank_, n_); }
    }
    GSYNC();
    if (PHM & 8) for (int rep_ = 0; rep_ < REP_ATT; ++rep_) for (int vc = vcu_l(), G_ = gd_l(); vc < 256; vc += G_) {
        const int bh = vc >> 1;
#pragma unroll 1
        for (int gi = 0; gi < 2; ++gi)
            att::unit<true>(wv, lds, bh >> 4, bh & 15, 2 * (vc & 1) + gi, (const bf16_t*)WSP(WS_Q), (const bf16_t*)WSP(WS_K), (const bf16_t*)WSP(WS_V), (const bf16_t*)WSP(WS_CK), (const bf16_t*)WSP(WS_CV), XNP, pt.f(I_rpb));
        att::unit<false>(wv, lds, vc >> 4, vc & 15, 0, (const bf16_t*)WSP(WS_Q), (const bf16_t*)WSP(WS_K), (const bf16_t*)WSP(WS_V), nullptr, nullptr, XNP, nullptr);
    }
    GSYNC();
    if (PHM & 16)
#pragma unroll 1
    for (int rp_ = REP_P4 - 1; rp_ >= 0; --rp_) { pg8::Gemm g{XNP, (const bf16_t*)WSP(WS_WO), MT, D, D, D, D, wv}; pg8::StaticOrder S; S.init(MT, D, gd_l(), bx_l());
      pg8::EpiResT<true, true> E{pt.f(I_x_prompt), pt.f(I_x_sample), XBP, MODP + 2 * D, (bf16_t*)WSP(WS_XN2), pt.f(I_norm_g) + D, MODP + 4 * D, rp_ ? (float*)WSP(WS_HLF) : SSQP(0)};
      pg8::gemm_phase<pg8::EpiResT<true, true>, pg8::StaticOrder, false, PG8_SP2>(lds, g, S, E); }
    {
        const int G_ = gd_l(), c_ = bx_l(), nwg_ = (MT / 256) * (D / 256);
        int rank_ = c_, n_ = G_;
        if (nwg_ < G_) { rank_ = c_ - nwg_; n_ = c_ >= nwg_ ? G_ - nwg_ : 0; }
        if (n_ > 0) { shw_phase(wv, pt, lds, 0, rank_, n_); tr_items(wv, pt, lds, 16 * 96 + 16 * 32 + 16 * 176, 16 * 96 + 16 * 32 + 16 * 176 + 44 * 32, rank_ * 8 + wv, n_ * 8); }
    }
    GSYNC();
    if (PHM & 512) { pg8::Gemm g{(const bf16_t*)WSP(WS_XN2), (const bf16_t*)WSP(WS_WGU), MT, 2 * FF, D, D, D, wv}; pg8::StaticOrder S; S.init(MT, 2 * FF, gd_l(), bx_l()); S.reps = REP_GEMM;
      pg8::EpiSwiglu E{(bf16_t*)WSP(WS_H), SSQP(0), (const float*)WSP(WS_SHW) + SHW_OFF0};
      pg8::gemm_phase<pg8::EpiSwiglu, pg8::StaticOrder, PG8_ALIGN, PG8_SP2>(lds, g, S, E); }
    {
        const int G_ = gd_l(), c_ = bx_l(), nwg_ = (MT / 256) * (2 * FF / 256), maxu_ = (nwg_ + G_ - 1) / G_, full_ = nwg_ - (maxu_ - 1) * G_;
        int rank_ = c_, n_ = G_;
        if (full_ < G_) { rank_ = c_ - full_; n_ = c_ >= full_ ? G_ - full_ : 0; }
        if (n_ > 0) { adaln_tasks(wv, pt, lds, 1, rank_, n_); tr_items(wv, pt, lds, 16 * 96 + 16 * 32 + 2 * 16 * 176 + 44 * 32, 12288, rank_ * 8 + wv, n_ * 8); }
    }
    GSYNC();
    if (PHM & 16) { pg8::Gemm g{(const bf16_t*)WSP(WS_H), (const bf16_t*)WSP(WS_WDN), MT, D, FF, FF, FF, wv}; pg8::StaticOrder S; S.init(MT, D, gd_l(), bx_l());
      pg8::EpiResT<true, false> E{nullptr, nullptr, XBP, MODP + 5 * D, XNP, pt.f(I_norm_g) + 2 * D, MODP + (size_t)9 * NMOD + 1 * D, SSQP(1)};
      pg8::gemm_phase<pg8::EpiResT<true, false>, pg8::StaticOrder, false, PG8_SP2>(lds, g, S, E); }
    {
        const int G_ = gd_l(), c_ = bx_l(), nwg_ = (MT / 256) * (D / 256);
        int rank_ = c_, n_ = G_;
        if (nwg_ < G_) { rank_ = c_ - nwg_; n_ = c_ >= nwg_ ? G_ - nwg_ : 0; }
        if (n_ > 0) { shw_phase(wv, pt, lds, 1, rank_, n_); tr_items(wv, pt, lds, 16 * 96 + 16 * 32 + 16 * 176 + 44 * 32, 16 * 96 + 16 * 32 + 2 * 16 * 176 + 44 * 32, rank_ * 8 + wv, n_ * 8); }
    }
    GSYNC();
    if (PHM & 32) { pg8::Gemm g{XNP, (const bf16_t*)WSP(WS_WIN), MT, 2 * D, D, D, D, wv}; pg8::StaticOrder S; S.init(MT, 2 * D, gd_l(), bx_l()); S.reps = REP_GEMM;
      pg8::EpiWin E{(bf16_t*)WSP(WS_GATE), (bf16_t*)WSP(WS_XR), SSQP(1), (const float*)WSP(WS_SHW) + SHW_OFF1};
      pg8::gemm_phase<pg8::EpiWin, pg8::StaticOrder, PG8_ALIGN, PG8_SP2>(lds, g, S, E); }
    {
        const int G_ = gd_l(), c_ = bx_l(), nwg_ = (MT / 256) * (2 * D / 256), maxu_ = (nwg_ + G_ - 1) / G_, full_ = nwg_ - (maxu_ - 1) * G_;
        int rank_ = c_, n_ = G_;
        if (full_ < G_) { rank_ = c_ - full_; n_ = c_ >= full_ ? G_ - full_ : 0; }
        if (n_ > 0) shw_phase(wv, pt, lds, 2, rank_, n_);
    }
    GSYNC();
    if (PHM & 128)
#pragma unroll 1
    for (int uu = vcu_l(), G_ = gd_l(); uu < 768 * REP_LRU; uu += G_) {
        const int u = uu % 768;
        const int dir = u & 1, n = (u >> 1) & 7, q = u >> 4;
        const float* h0 = nullptr;
        if (q >= 16) { const int b = (q - 16) >> 2, ci = (q - 16) & 3; if ((dir == 0 && ci == 0) || (dir == 1 && ci == 3)) h0 = pt.f(I_state_h) + ((size_t)b * 2 + dir) * D; }
        conv_slab(wv, (const bf16_t*)WSP(WS_XR), pt.f(I_conv_w), pt.f(I_conv_b), XNP, q, n);
        pg8::Gemm g{XNP + (size_t)q * 256 * D + n * 128, (const bf16_t*)WSP(WS_WG) + (size_t)(n * 2 + dir) * 256 * 128, 256, 256, 128, D, 128, wv};
        pg8::OneUnit S;
        pg8::EpiLru E{pt.t, h0, q * 256, n * 128, dir, q};
        pg8::gemm_phase<pg8::EpiLru, pg8::OneUnit, false, false>(lds, g, S, E);
    }
    GSYNC();
    if (PHM & 256) for (int rep_ = 0; rep_ < REP_THIN; ++rep_) lru_combine_phase(wv, pt.ws(), (bf16_t*)WSP(WS_Y));
    GSYNC();
    if (PHM & 16) { pg8::Gemm g{(const bf16_t*)WSP(WS_Y), (const bf16_t*)WSP(WS_WOUT), MT, D, D, D, D, wv}; pg8::StaticOrder S; S.init(MT, D, gd_l(), bx_l());
      pg8::EpiResT<true, false> E{nullptr, nullptr, XBP, MODP + (size_t)9 * NMOD + 2 * D, XNP, pt.f(I_norm_g) + 3 * D, MODP + (size_t)9 * NMOD + 4 * D, SSQP(2)};
      pg8::gemm_phase<pg8::EpiResT<true, false>, pg8::StaticOrder, false, PG8_SP2>(lds, g, S, E); }
    GSYNC();
    if (PHM & 512) { pg8::Gemm g{XNP, (const bf16_t*)WSP(WS_WGU) + (size_t)2 * FF * D, MT, 2 * FF, D, D, D, wv}; pg8::StaticOrder S; S.init(MT, 2 * FF, gd_l(), bx_l()); S.reps = REP_GEMM;
      pg8::EpiSwiglu E{(bf16_t*)WSP(WS_H), SSQP(2), (const float*)WSP(WS_SHW) + SHW_OFF2};
      pg8::gemm_phase<pg8::EpiSwiglu, pg8::StaticOrder, PG8_ALIGN, PG8_SP2>(lds, g, S, E); }
    GSYNC();
    if (gd_l() >= (MT / 256) * (D / 256)) {
        pg8::Gemm g{(const bf16_t*)WSP(WS_H), (const bf16_t*)WSP(WS_WDN) + (size_t)D * FF, MT, D, FF, FF, FF, wv}; pg8::StaticOrder S; S.init(MT, D, gd_l(), bx_l());
        pg8::EpiResFinal E{XBP, MODP + (size_t)9 * NMOD + 5 * D, SSQP(3), (unsigned*)WSP(WS_FCNT), pt.f(I_final_g), XRES};
        pg8::gemm_phase<pg8::EpiResFinal, pg8::StaticOrder, true, PG8_SP2>(lds, g, S, E);
    } else {
        { pg8::Gemm g{(const bf16_t*)WSP(WS_H), (const bf16_t*)WSP(WS_WDN) + (size_t)D * FF, MT, D, FF, FF, FF, wv}; pg8::StaticOrder S; S.init(MT, D, gd_l(), bx_l());
          pg8::EpiResT<false, false> E{nullptr, nullptr, XBP, MODP + (size_t)9 * NMOD + 5 * D, nullptr, nullptr, nullptr, nullptr};
          pg8::gemm_phase<pg8::EpiResT<false, false>, pg8::StaticOrder, PG8_ALIGN, PG8_SP2>(lds, g, S, E); }
        GSYNC();
        final_norm_phase(wv, XBP, XRES, pt.f(I_final_g));
    }
}

extern "C" void kernel_launch(void* const* d_in, const int* in_sizes, int n_in, void* d_out, int out_size, void* d_ws, size_t ws_size, hipStream_t stream) {
    static int grid = 0;
    if (grid == 0) {
        int dev = 0, cus = 0, per_cu = 0;
        (void)hipGetDevice(&dev);
        (void)hipDeviceGetAttribute(&cus, hipDeviceAttributeMultiprocessorCount, dev);
        (void)hipFuncSetAttribute((const void*)fwd_megakernel, hipFuncAttributeMaxDynamicSharedMemorySize, LDS_BYTES);
        (void)hipOccupancyMaxActiveBlocksPerMultiprocessor(&per_cu, (const void*)fwd_megakernel, 512, LDS_BYTES);
        if (per_cu < 1) { fprintf(stderr, "kernel_launch: occupancy query says %d blocks per CU\n", per_cu); per_cu = 1; }
        grid = cus * per_cu;
        if (ws_size < WS_END) { fprintf(stderr, "kernel_launch: workspace too small (%zu < %zu)\n", ws_size, (size_t)WS_END); grid = -1; }
    }
    if (grid < 0) return;
    (void)hipMemsetAsync((char*)d_ws + WS_MOD, 0, 1024 * 1024, stream);
    Args a{};
    const float** ap = (const float**)&a;
    for (int i = 0; i < 25; ++i) ap[i] = (const float*)d_in[i];
    a.out = (float*)d_out; a.ws = (unsigned char*)d_ws;
    void* args[] = {&a};
    hipError_t e = hipLaunchCooperativeKernel((const void*)fwd_megakernel, dim3(grid), dim3(512), args, LDS_BYTES, stream);
    if (e != hipSuccess) fprintf(stderr, "cooperative launch failed: %s (grid %d)\n", hipGetErrorString(e), grid);
}
```

```cpp
#include <hip/hip_runtime.h>
#include <hip/hip_cooperative_groups.h>
#include <cstdio>
#include <cstdint>
namespace cg = cooperative_groups;

#define LAS __attribute__((address_space(3)))
typedef unsigned short bf16_t;
typedef short bf16x8 __attribute__((ext_vector_type(8)));
typedef short s16x4 __attribute__((ext_vector_type(4)));
typedef float f32x4 __attribute__((ext_vector_type(4)));
typedef float f32x2 __attribute__((ext_vector_type(2)));
typedef float f32x16 __attribute__((ext_vector_type(16)));
typedef unsigned u32x4 __attribute__((ext_vector_type(4)));
typedef unsigned u32x2 __attribute__((ext_vector_type(2)));
typedef __bf16 bf16x2_t __attribute__((ext_vector_type(2)));

constexpr int D = 1024, MC = 4096, ML = 8192, MT = MC + ML, FF = 2816, NQKV = 3072, NMOD = 6144;
constexpr float LOG2E = 1.4426950408889634f;
constexpr float RMS_EPS = 1e-6f;

constexpr size_t MiB = 1u << 20;
constexpr size_t WS_MOD = 0;
constexpr size_t WS_YCNT = 832 * 1024;
constexpr size_t WS_FCNT = 768 * 1024;
constexpr size_t WS_SSQ = 512 * 1024;
constexpr size_t WS_WQKV = 1 * MiB, WS_WO = 7 * MiB, WS_WGU = 9 * MiB, WS_WDN = 31 * MiB, WS_WIN = 42 * MiB, WS_WOUT = 46 * MiB, WS_WG = 48 * MiB;
constexpr size_t WS_CK = 49 * MiB, WS_CV = 57 * MiB;
constexpr size_t WS_PF = 49 * MiB;
constexpr size_t WS_XN = 65 * MiB;
constexpr size_t WS_Q = 89 * MiB, WS_K = 113 * MiB, WS_V = 137 * MiB;
constexpr size_t WS_H = 89 * MiB;
constexpr size_t WS_GATE = 89 * MiB, WS_XR = 113 * MiB, WS_Y = 113 * MiB;
constexpr size_t WS_XN2 = 161 * MiB;
constexpr size_t WS_PB = 137 * MiB;
constexpr size_t WS_XB = 185 * MiB;
constexpr size_t WS_HLF = 209 * MiB, WS_HLB = 161 * MiB;
constexpr size_t WS_SUMP = 250 * MiB;
constexpr size_t WS_SUME = 250 * MiB + 512 * 1024;
constexpr size_t WS_SHW = 252 * MiB;
constexpr int SHW_OFF0 = 0, SHW_OFF1 = 9 * 5632, SHW_OFF2 = 9 * 5632 + 9 * 2048;
constexpr size_t WS_END = 256 * MiB;

constexpr int LDS_BYTES = 143360;
constexpr int AB_PITCH = 1056;
constexpr int HST_OFF = 128 * AB_PITCH;

enum { I_x_prompt = 0, I_x_sample = 1, I_c = 2, I_cache_k = 3, I_cache_v = 4, I_state_h = 5, I_c_ctx = 6, I_norm_g = 7, I_w_mod = 8, I_b_mod = 9, I_w_qkv = 10, I_w_o = 11, I_rpb = 12, I_w_in = 13, I_conv_w = 14, I_conv_b = 15, I_w_a = 16, I_b_a = 17, I_w_i = 18, I_b_i = 19, I_lam = 20, I_w_out = 21, I_w_gu = 22, I_w_down = 23, I_final_g = 24, I_out = 25, I_ws = 26 };
constexpr int PTAB_OFF = LDS_BYTES - 256;
struct PT {
    LAS const unsigned long long* t;
    __device__ __forceinline__ unsigned long long raw(int i) const { const unsigned long long v = t[i]; const unsigned lo = __builtin_amdgcn_readfirstlane((unsigned)v), hi = __builtin_amdgcn_readfirstlane((unsigned)(v >> 32)); return ((unsigned long long)hi << 32) | lo; }
    __device__ __forceinline__ const float* f(int i) const { return (const float*)(const __attribute__((address_space(1))) float*)raw(i); }
    __device__ __forceinline__ float* out() const { return (float*)(__attribute__((address_space(1))) float*)raw(I_out); }
    __device__ __forceinline__ unsigned char* ws() const { return (unsigned char*)(__attribute__((address_space(1))) unsigned char*)raw(I_ws); }
};
constexpr size_t OUT_Y = 0, OUT_NK = (size_t)MT * D, OUT_NV = OUT_NK + (size_t)MC * D, OUT_NH = OUT_NV + (size_t)MC * D;
constexpr int CST_OFF = HST_OFF + 1024;
__device__ __forceinline__ int tid_l(int wv) { int l; asm volatile("v_mbcnt_lo_u32_b32 %0, -1, 0\n\tv_mbcnt_hi_u32_b32 %0, -1, %0" : "=v"(l)); return wv * 64 + l; }
__device__ __forceinline__ int bx_l() { int b = blockIdx.x; asm volatile("" : "+s"(b)); return b; }
__device__ __forceinline__ int gd_l() { int g = gridDim.x; asm volatile("" : "+s"(g)); return g; }
__device__ __forceinline__ int vcu_l() { const int b = bx_l(), g = gd_l(); return (g & 7) ? b : (b & 7) * (g >> 3) + (b >> 3); }

constexpr size_t WS_BAR = 448 * 1024;
constexpr int BARST_OFF = PTAB_OFF + 224;
#define XB_TMO      128
#define XB_XCNT(j)  (256  + 64 * (j))
#define XB_XSUB(j)  (1280 + 64 * (j))
#define XB_XGEN(j)  (2304 + 64 * (j))
#define XB_TOP      3328
#define XB_TOPGEN   3392
#define XCD_BAR_WORDS 3456
#define XB_SPIN_CAP (1u << 18)
__device__ __forceinline__ unsigned xb_ld(unsigned* p)              { return __hip_atomic_load(p, __ATOMIC_RELAXED, __HIP_MEMORY_SCOPE_AGENT); }
__device__ __forceinline__ unsigned xb_add(unsigned* p, unsigned v) { return __hip_atomic_fetch_add(p, v, __ATOMIC_RELAXED, __HIP_MEMORY_SCOPE_AGENT); }
__device__ __forceinline__ unsigned xb_xcc_id() { return (unsigned)__builtin_amdgcn_s_getreg((3 << 11) | 20) & 0xFu; }
#define XB_SPIN(cond, bar) do { unsigned _sp = 0; while (cond) { __builtin_amdgcn_s_sleep(1); \
    if ((++_sp & 255u) == 0u) { if (xb_ld(&(bar)[XB_TMO])) break; if (_sp > XB_SPIN_CAP) { atomicAdd(&(bar)[XB_TMO], 1u); break; } } } } while (0)
__device__ __forceinline__ void xcd_barrier_complete(unsigned* bar, unsigned x, unsigned& nloc, unsigned& nx) {
    const unsigned G = gridDim.x;
    unsigned sum, cnt, mine, sp = 0u;
    for (;;) {
        sum = 0u; cnt = 0u; mine = 0u;
#pragma unroll
        for (unsigned j = 0; j < 16; ++j) { const unsigned c = xb_ld(&bar[XB_XCNT(j)]); sum += c; cnt += (c > 0u) ? 1u : 0u; mine = (j == x) ? c : mine; }
        if (sum == G) break;
        __builtin_amdgcn_s_sleep(1);
        if ((++sp & 255u) == 0u) { if (xb_ld(&bar[XB_TMO])) break; if (sp > XB_SPIN_CAP) { atomicAdd(&bar[XB_TMO], 1u); break; } }
    }
    nloc = mine > 0u ? mine : 1u; nx = cnt > 0u ? cnt : 1u;
}
__device__ __forceinline__ void xcd_barrier(const PT pt, LAS unsigned char* lds, int wv) {
    asm volatile("s_waitcnt vmcnt(0)" ::: "memory");
    __syncthreads();
    if (tid_l(wv) == 0) {
        unsigned* bar = (unsigned*)(pt.ws() + WS_BAR);
        volatile LAS unsigned* st = (volatile LAS unsigned*)(lds + BARST_OFF);
        const unsigned x = xb_xcc_id();
        __builtin_amdgcn_s_waitcnt(0);
        unsigned nloc = st[0], nx = st[1];
        if (nloc == 0u) { xcd_barrier_complete(bar, x, nloc, nx); st[0] = nloc; st[1] = nx; }
        const unsigned old = xb_add(&bar[XB_XSUB(x)], 1u);
        const unsigned gen = old / nloc;
        if (old + 1u == (gen + 1u) * nloc) {
            __builtin_amdgcn_fence(__ATOMIC_RELEASE, "agent");
            asm volatile("s_waitcnt vmcnt(0)" ::: "memory");
            const unsigned og = xb_add(&bar[XB_TOP], 1u);
            const unsigned tg = og / nx;
            if (og + 1u == (tg + 1u) * nx) xb_add(&bar[XB_TOPGEN], 1u);
            else XB_SPIN(xb_ld(&bar[XB_TOPGEN]) == tg, bar);
            __builtin_amdgcn_fence(__ATOMIC_ACQUIRE, "agent");
            xb_add(&bar[XB_XGEN(x)], 1u);
            asm volatile("s_waitcnt vmcnt(0)" ::: "memory");
        } else {
            XB_SPIN(xb_ld(&bar[XB_XGEN(x)]) == gen, bar);
            __builtin_amdgcn_fence(__ATOMIC_ACQUIRE, "agent");
            asm volatile("s_waitcnt vmcnt(0)" ::: "memory");
        }
    }
    __syncthreads();
}
__device__ __forceinline__ unsigned pk_bf16(float lo, float hi) { f32x2 v = {lo, hi}; bf16x2_t b = __builtin_convertvector(v, bf16x2_t); return __builtin_bit_cast(unsigned, b); }
__device__ __forceinline__ float bf_lo(unsigned u) { return __uint_as_float(u << 16); }
__device__ __forceinline__ float bf_hi(unsigned u) { return __uint_as_float(u & 0xffff0000u); }
__device__ __forceinline__ float fast_rcp(float x) { return __builtin_amdgcn_rcpf(x); }
__device__ __forceinline__ float fast_exp2(float x) { return __builtin_amdgcn_exp2f(x); }
__device__ __forceinline__ float sigmoid_f(float x) { return fast_rcp(1.f + fast_exp2(-x * LOG2E)); }
__device__ __forceinline__ float silu_f(float x) { return x * sigmoid_f(x); }
__device__ __forceinline__ float gelu_tanh_f(float x) { const float u = 0.7978845608028654f * (x + 0.044715f * x * x * x); return x * sigmoid_f(2.f * u); }
__device__ __forceinline__ float shfl_xor_l(float v, int mask, int lane) { return __int_as_float(__builtin_amdgcn_ds_bpermute((lane ^ mask) << 2, __float_as_int(v))); }
__device__ __forceinline__ float wave_sum(float v, int lane) {
#pragma unroll
    for (int o = 1; o < 64; o <<= 1) v += shfl_xor_l(v, o, lane);
    return v;
}
namespace pg8 {
#define PG8_LAS __attribute__((address_space(3)))
constexpr int BM = 256, BK = 64, HALF = 128, HTB = HALF * BK * 2  , STAGE_BYTES = 8 * HTB, NXCD = 8, WGM = 4;

__host__ __device__ __forceinline__ int lds_byte(int r, int c) { const int st = (r >> 4) * 2 + (c >> 5), rr = r & 15, cc = c & 31, ob = rr * 64 + cc * 2; return st * 1024 + (ob ^ (((ob >> 9) & 1) << 5)); }
__host__ __device__ __forceinline__ void stage_rc(int b, int& R, int& C) { const int st = b / 1024, sb = b % 1024, swz = sb ^ (((sb >> 9) & 1) << 5); R = (st >> 1) * 16 + swz / 64; C = (st & 1) * 32 + (swz % 64) / 2; }
__host__ __device__ __forceinline__ int perm32(int rho) { const int n = rho >> 4, i = rho & 15; return 8 * (i >> 2) + 4 * n + (i & 3); }

struct Unit { int pm, pn; };
struct Gemm { const bf16_t* A; const bf16_t* Bt; int M, N, K, lda, ldb, wv; };

struct StaticOrder {
    int nM, nN, nwg, G, c;
    int reps = 1;
    __host__ __device__ __forceinline__ void init(int M, int N, int G_, int c_) { nM = M / BM; nN = N / BM; nwg = nM * nN; G = G_; c = c_; }
    __host__ __device__ __forceinline__ bool next(int i, Unit& u) const {
        const long L = (long)(i / reps) * G + c; if (L >= nwg) return false;
        int wgid = (int)L; { const int q = nwg / NXCD, r = nwg % NXCD, xcd = wgid % NXCD, off = wgid / NXCD; wgid = (xcd < r ? xcd * (q + 1) : r * (q + 1) + (xcd - r) * q) + off; }
        const int nig = WGM * nN, gid = wgid / nig, fm = gid * WGM, gsz = (nM - fm) < WGM ? (nM - fm) : WGM;
        u.pm = fm + ((wgid % nig) % gsz); u.pn = (wgid % nig) / gsz; return true;
    }
    __device__ __forceinline__ void a_ready(const Unit&) const {}
    __device__ __forceinline__ void done(const Unit&) const {}
};


template <class Epi, class Sched, bool ALIGN_EPI = false, bool SP2 = false>
__device__ __forceinline__ void gemm_phase(PG8_LAS unsigned char* lds, const Gemm g, const Sched& S, const Epi& E) {
    int wid_ = g.wv; asm volatile("" : "+s"(wid_));
    const int tid = tid_l(wid_), wid = wid_, lane = tid & 63, wr = wid >> 2, wc = wid & 3, fr = lane & 15, fq = lane >> 4;
    const int K = g.K, nt = K / BK;
    unsigned voffA[2], voffB[2];
#pragma unroll
    for (int i = 0; i < 2; ++i) { int R, C; stage_rc(tid * 16 + i * 8192, R, C); const int Rb = Epi::PERM ? ((R & ~31) + perm32(R & 31)) : R;
        voffA[i] = (unsigned)(R * g.lda + C) * 2u; voffB[i] = (unsigned)(Rb * g.ldb + C) * 2u; }
    const size_t kstep = (size_t)(BK * 2);
    const size_t hstepA = (size_t)HALF * g.lda * 2, hstepB = (size_t)HALF * g.ldb * 2;
    const size_t tstepA = 2 * hstepA, tstepB = 2 * hstepB;
    const unsigned ldsw = (unsigned)wid * 1024u;
    const int aoff = lds_byte(wr * 64 + fr, fq * 8), boff = lds_byte(wc * 32 + fr, fq * 8);
#define PG8_SA(b, h) (((b) * 2 + (h)) * HTB)
#define PG8_SB(b, h) ((4 + (b) * 2 + (h)) * HTB)
#define PG8_STAGE(bufoff, gbase, voff) do { _Pragma("unroll") for (int _i = 0; _i < 2; ++_i) \
        __builtin_amdgcn_global_load_lds((const unsigned*)((const char*)(gbase) + (voff)[_i]), (PG8_LAS unsigned*)(lds + (bufoff) + ldsw + _i * 8192), 16, 0, 0); } while (0)
#define PG8_LDA(dst, b, h) do { _Pragma("unroll") for (int m = 0; m < 4; ++m) _Pragma("unroll") for (int k = 0; k < 2; ++k) dst[m][k] = *(const PG8_LAS bf16x8*)(lds + PG8_SA(b, h) + aoff + m * 2048 + k * 1024); } while (0)
#define PG8_LDB(dst, b, h) do { _Pragma("unroll") for (int n = 0; n < 2; ++n) _Pragma("unroll") for (int k = 0; k < 2; ++k) dst[n][k] = *(const PG8_LAS bf16x8*)(lds + PG8_SB(b, h) + boff + n * 2048 + k * 1024); } while (0)
#define PG8_MMA(ai, bj, At, Bt) do { __builtin_amdgcn_s_setprio(1); _Pragma("unroll") for (int m = 0; m < 4; ++m) _Pragma("unroll") for (int n = 0; n < 2; ++n) _Pragma("unroll") for (int k = 0; k < 2; ++k) \
        acc[ai][bj][m][n] = __builtin_amdgcn_mfma_f32_16x16x32_bf16(Bt[n][k], At[m][k], acc[ai][bj][m][n], 0, 0, 0); __builtin_amdgcn_s_setprio(0); } while (0)
#define PG8_WAIT_V(n) asm volatile("s_waitcnt vmcnt(" #n ")" ::: "memory")
#define PG8_WAIT_L(n) asm volatile("s_waitcnt lgkmcnt(" #n ")" ::: "memory")
#define PG8_BAR __builtin_amdgcn_s_barrier()
#define PG8_SCHED __builtin_amdgcn_sched_barrier(0)
    Unit cur, nxt; int ui = 0;
    if (!S.next(0, cur)) return;
    f32x4 acc[2][2][4][2];
#pragma unroll
    for (int a = 0; a < 2; ++a)
#pragma unroll
        for (int b = 0; b < 2; ++b)
#pragma unroll
            for (int m = 0; m < 4; ++m)
#pragma unroll
                for (int n = 0; n < 2; ++n) acc[a][b][m][n] = (f32x4){0.f, 0.f, 0.f, 0.f};
    bf16x8 At[4][2], B0[2][2], B1[2][2];
    const char* cA = (const char*)g.A + (size_t)cur.pm * tstepA; const char* cB = (const char*)g.Bt + (size_t)cur.pn * tstepB;
    S.a_ready(cur);
    if constexpr (SP2) {
        PG8_STAGE(PG8_SB(0, 0), cB, voffB); PG8_STAGE(PG8_SB(0, 1), cB + hstepB, voffB); PG8_STAGE(PG8_SA(0, 0), cA, voffA); PG8_STAGE(PG8_SA(0, 1), cA + hstepA, voffA);
        if (wr == 1) PG8_BAR;
        PG8_WAIT_V(2); PG8_BAR;
        PG8_STAGE(PG8_SB(1, 0), cB + kstep, voffB); PG8_STAGE(PG8_SA(1, 0), cA + kstep, voffA); PG8_STAGE(PG8_SB(1, 1), cB + hstepB + kstep, voffB);
        PG8_WAIT_V(6); PG8_BAR;
    } else {
        PG8_STAGE(PG8_SB(0, 0), cB, voffB); PG8_STAGE(PG8_SA(0, 0), cA, voffA); PG8_STAGE(PG8_SB(0, 1), cB + hstepB, voffB); PG8_STAGE(PG8_SA(0, 1), cA + hstepA, voffA);
        if (wr == 1) PG8_BAR;
        PG8_WAIT_V(4); PG8_BAR;
        PG8_STAGE(PG8_SB(1, 0), cB + kstep, voffB); PG8_STAGE(PG8_SA(1, 0), cA + kstep, voffA); PG8_STAGE(PG8_SB(1, 1), cB + hstepB + kstep, voffB);
        PG8_WAIT_V(6); PG8_BAR;
    }
    for (;;) {
        const bool has_next = S.next(ui + 1, nxt);
        const char* nA = has_next ? (const char*)g.A + (size_t)nxt.pm * tstepA : cA; const char* nB = has_next ? (const char*)g.Bt + (size_t)nxt.pn * tstepB : cB;
        for (int t = 0; t < nt; t += 2) {
            const bool last = (t == nt - 2);
            const char* a1 = cA + (size_t)(t + 1) * kstep;
            const char* a2 = last ? nA : cA + (size_t)(t + 2) * kstep; const char* b2 = last ? nB : cB + (size_t)(t + 2) * kstep;
            const char* a3 = a2 + kstep; const char* b3 = b2 + kstep;
            if (last && has_next) S.a_ready(nxt);
            if constexpr (SP2) {
            PG8_LDB(B0, 0, 0); PG8_LDB(B1, 0, 1); PG8_SCHED; PG8_LDA(At, 0, 0); PG8_STAGE(PG8_SA(1, 1), a1 + hstepA, voffA);
            PG8_WAIT_V(8); PG8_WAIT_L(0); PG8_BAR; PG8_MMA(0, 0, At, B0); PG8_MMA(0, 1, At, B1); PG8_BAR; PG8_SCHED;
            PG8_LDA(At, 0, 1); PG8_STAGE(PG8_SB(0, 0), b2, voffB); PG8_STAGE(PG8_SB(0, 1), b2 + hstepB, voffB); PG8_STAGE(PG8_SA(0, 0), a2, voffA);
            PG8_WAIT_V(8); PG8_WAIT_L(0); PG8_BAR; PG8_MMA(1, 0, At, B0); PG8_MMA(1, 1, At, B1); PG8_BAR; PG8_SCHED;
            PG8_LDB(B0, 1, 0); PG8_LDB(B1, 1, 1); PG8_SCHED; PG8_LDA(At, 1, 0); PG8_STAGE(PG8_SA(0, 1), a2 + hstepA, voffA);
            PG8_WAIT_V(8); PG8_WAIT_L(0); PG8_BAR; PG8_MMA(0, 0, At, B0); PG8_MMA(0, 1, At, B1); PG8_BAR; PG8_SCHED;
            PG8_LDA(At, 1, 1); PG8_STAGE(PG8_SB(1, 0), b3, voffB); PG8_STAGE(PG8_SB(1, 1), b3 + hstepB, voffB); PG8_STAGE(PG8_SA(1, 0), a3, voffA);
            PG8_WAIT_V(8); PG8_WAIT_L(0); PG8_BAR; PG8_MMA(1, 0, At, B0); PG8_MMA(1, 1, At, B1); PG8_BAR; PG8_SCHED;
            } else {
            PG8_LDB(B0, 0, 0); PG8_SCHED; PG8_LDA(At, 0, 0); PG8_STAGE(PG8_SA(1, 1), a1 + hstepA, voffA);
            PG8_WAIT_L(8); PG8_BAR; PG8_WAIT_L(0); PG8_MMA(0, 0, At, B0); PG8_BAR; PG8_SCHED;
            PG8_LDB(B1, 0, 1); PG8_STAGE(PG8_SB(0, 0), b2, voffB);
            PG8_BAR; PG8_WAIT_L(0); PG8_MMA(0, 1, At, B1); PG8_BAR;
            PG8_LDA(At, 0, 1); PG8_STAGE(PG8_SA(0, 0), a2, voffA);
            PG8_BAR; PG8_WAIT_L(0); PG8_MMA(1, 0, At, B0); PG8_BAR; PG8_SCHED;
            PG8_STAGE(PG8_SB(0, 1), b2 + hstepB, voffB);
            PG8_WAIT_V(6); PG8_BAR; PG8_MMA(1, 1, At, B1); PG8_BAR;
            PG8_LDB(B0, 1, 0); PG8_SCHED; PG8_LDA(At, 1, 0); PG8_STAGE(PG8_SA(0, 1), a2 + hstepA, voffA);
            PG8_WAIT_L(8); PG8_BAR; PG8_WAIT_L(0); PG8_MMA(0, 0, At, B0); PG8_BAR; PG8_SCHED;
            PG8_LDB(B1, 1, 1); PG8_STAGE(PG8_SB(1, 0), b3, voffB);
            PG8_BAR; PG8_WAIT_L(0); PG8_MMA(0, 1, At, B1); PG8_BAR;
            PG8_LDA(At, 1, 1); PG8_STAGE(PG8_SA(1, 0), a3, voffA);
            PG8_BAR; PG8_WAIT_L(0); PG8_MMA(1, 0, At, B0); PG8_BAR; PG8_SCHED;
            PG8_STAGE(PG8_SB(1, 1), b3 + hstepB, voffB);
            PG8_WAIT_V(6); PG8_BAR; PG8_MMA(1, 1, At, B1); PG8_BAR;
            }
        }
        if constexpr (ALIGN_EPI) { if (wr == 0) PG8_BAR; }
        if constexpr (!Epi::AFTER_DRAIN) { E(acc, cur, wr, wc, fr, fq); S.done(cur); }
        if (!has_next) break;
#pragma unroll
        for (int a = 0; a < 2; ++a)
#pragma unroll
            for (int b = 0; b < 2; ++b)
#pragma unroll
                for (int m = 0; m < 4; ++m)
#pragma unroll
                    for (int n = 0; n < 2; ++n) acc[a][b][m][n] = (f32x4){0.f, 0.f, 0.f, 0.f};
        cur = nxt; cA = nA; cB = nB; ++ui;
        if constexpr (ALIGN_EPI) { if (wr == 1) PG8_BAR; }
    }
    PG8_WAIT_V(0);
    if constexpr (!ALIGN_EPI) { if (wr == 0) PG8_BAR; }
    PG8_BAR;
    if constexpr (Epi::AFTER_DRAIN) { E.fused(acc, cur, wr, wc, fr, fq, lds, wid, lane); S.done(cur); }
#undef PG8_SA
#undef PG8_SB
#undef PG8_STAGE
#undef PG8_LDA
#undef PG8_LDB
#undef PG8_MMA
#undef PG8_WAIT_V
#undef PG8_WAIT_L
#undef PG8_BAR
#undef PG8_SCHED
}
}

namespace pg8 {
struct OneUnit {
    __device__ __forceinline__ bool next(int i, Unit& u) const { if (i) return false; u.pm = 0; u.pn = 0; return true; }
    __device__ __forceinline__ void a_ready(const Unit&) const {}
    __device__ __forceinline__ void done(const Unit&) const {}
};
typedef f32x4 AccT[2][2][4][2];

struct EpiQKV {
    static constexpr bool PERM = true, AFTER_DRAIN = false;
    bf16_t* Q; float* newk; float qscale;
    __device__ __forceinline__ void operator()(const AccT& acc, const Unit& u, int wr, int wc, int fr, int fq) const {
        const int t = u.pn >> 2;
        bf16_t* base = Q + (size_t)t * MT * D;
        const float sc = t == 0 ? qscale : 1.f;
        float* fo = newk + (size_t)(t - 1) * MC * D;
        const bool wf = (t != 0) && (u.pm < MC / 256);
        const int colt = (u.pn & 3) * 256 + wc * 32 + 8 * fq, row0 = u.pm * 256 + wr * 64 + fr;
#pragma unroll
        for (int ai = 0; ai < 2; ++ai)
#pragma unroll
            for (int m = 0; m < 4; ++m) {
                const size_t ro = (size_t)(row0 + ai * 128 + m * 16) * D;
#pragma unroll
                for (int bj = 0; bj < 2; ++bj) {
                    const f32x4 v0 = acc[ai][bj][m][0] * sc, v1 = acc[ai][bj][m][1] * sc;
                    u32x4 w; w.x = pk_bf16(v0[0], v0[1]); w.y = pk_bf16(v0[2], v0[3]); w.z = pk_bf16(v1[0], v1[1]); w.w = pk_bf16(v1[2], v1[3]);
                    *(u32x4*)(base + ro + colt + bj * 128) = w;
                    if (wf) { *(f32x4*)(fo + ro + colt + bj * 128) = v0; *(f32x4*)(fo + ro + colt + bj * 128 + 4) = v1; }
                }
            }
    }
};
template <bool FUSE, bool SRCF32> struct EpiResT {
    static constexpr bool PERM = true, AFTER_DRAIN = false;
    const float *xa, *xb;
    bf16_t* xres;
    const float* gate;
    bf16_t* XNo; const float* gn; const float* scv; float* ssq;
    __device__ __forceinline__ void operator()(const AccT& acc, const Unit& u, int wr, int wc, int fr, int fq) const {
        const bool isc = u.pm < MC / 256;
        const int cv = isc ? 8 : ((u.pm - MC / 256) >> 2);
        const float* src = isc ? xa : xb - (size_t)MC * D;
        const int col0 = u.pn * 256 + wc * 32 + 8 * fq, row0 = u.pm * 256 + wr * 64 + fr;
        f32x4 gv[2][2], gm[2][2];
#pragma unroll
        for (int bj = 0; bj < 2; ++bj)
#pragma unroll
            for (int n = 0; n < 2; ++n) {
                const int c = col0 + bj * 128 + n * 4;
                gv[bj][n] = *(const f32x4*)(gate + (size_t)cv * NMOD + c);
                if (FUSE) gm[bj][n] = *(const f32x4*)(gn + c) * (*(const f32x4*)(scv + (size_t)cv * NMOD + c) + 1.f);
            }
#pragma unroll
        for (int ai = 0; ai < 2; ++ai)
#pragma unroll
        for (int mp = 0; mp < 2; ++mp) {
            f32x4 xs[2][2][2];
#pragma unroll
            for (int mm = 0; mm < 2; ++mm)
#pragma unroll
                for (int bj = 0; bj < 2; ++bj) {
                    const size_t o = (size_t)(row0 + ai * 128 + (2 * mp + mm) * 16) * D + col0 + bj * 128;
                    if (SRCF32) { xs[mm][bj][0] = *(const f32x4*)(src + o); xs[mm][bj][1] = *(const f32x4*)(src + o + 4); }
                    else { const u32x4 w = *(const u32x4*)(xres + o); xs[mm][bj][0] = (f32x4){bf_lo(w.x), bf_hi(w.x), bf_lo(w.y), bf_hi(w.y)}; xs[mm][bj][1] = (f32x4){bf_lo(w.z), bf_hi(w.z), bf_lo(w.w), bf_hi(w.w)}; }
                }
            asm volatile("" ::: "memory");
#pragma unroll
            for (int mm = 0; mm < 2; ++mm) {
                const int m = 2 * mp + mm;
                const int row = row0 + ai * 128 + m * 16;
                const size_t ro = (size_t)row * D + col0;
                float sq = 0.f;
#pragma unroll
                for (int bj = 0; bj < 2; ++bj) {
                    const f32x4 x0 = xs[mm][bj][0] + gv[bj][0] * acc[ai][bj][m][0], x1 = xs[mm][bj][1] + gv[bj][1] * acc[ai][bj][m][1];
                    { u32x4 w; w.x = pk_bf16(x0[0], x0[1]); w.y = pk_bf16(x0[2], x0[3]); w.z = pk_bf16(x1[0], x1[1]); w.w = pk_bf16(x1[2], x1[3]); *(u32x4*)(xres + ro + bj * 128) = w; }
                    if (FUSE) {
                        sq += ((x0[0] * x0[0] + x0[1] * x0[1]) + (x0[2] * x0[2] + x0[3] * x0[3])) + ((x1[0] * x1[0] + x1[1] * x1[1]) + (x1[2] * x1[2] + x1[3] * x1[3]));
                        const f32x4 y0 = x0 * gm[bj][0], y1 = x1 * gm[bj][1];
                        u32x4 w; w.x = pk_bf16(y0[0], y0[1]); w.y = pk_bf16(y0[2], y0[3]); w.z = pk_bf16(y1[0], y1[1]); w.w = pk_bf16(y1[2], y1[3]);
                        *(u32x4*)(XNo + ro + bj * 128) = w;
                    }
                }
                if (FUSE) { sq += shfl_xor_l(sq, 16, fr + 16 * fq); sq += shfl_xor_l(sq, 32, fr + 16 * fq); if (fq == 0) unsafeAtomicAdd(ssq + row, sq); }
            }
            asm volatile("" ::: "memory");
        }
    }
};
struct EpiResFinal {
    static constexpr bool PERM = true, AFTER_DRAIN = false;
    const bf16_t* xres; const float* gate; float* ssq; unsigned* cnt; const float* gfin; float* out;
    __device__ __forceinline__ void operator()(const AccT& acc_c, const Unit& u, int wr, int wc, int fr, int fq) const {
        AccT& acc = const_cast<AccT&>(acc_c);
        const int cv = u.pm < MC / 256 ? 8 : ((u.pm - MC / 256) >> 2);
        const int col0 = u.pn * 256 + wc * 32 + 8 * fq, row0 = u.pm * 256 + wr * 64 + fr, lane = fr + 16 * fq;
        f32x4 gv[2][2];
#pragma unroll
        for (int bj = 0; bj < 2; ++bj)
#pragma unroll
            for (int n = 0; n < 2; ++n) gv[bj][n] = *(const f32x4*)(gate + (size_t)cv * NMOD + col0 + bj * 128 + n * 4);
#pragma unroll
        for (int ai = 0; ai < 2; ++ai)
#pragma unroll
        for (int mp = 0; mp < 2; ++mp) {
            u32x4 xs[2][2];
#pragma unroll
            for (int mm = 0; mm < 2; ++mm)
#pragma unroll
                for (int bj = 0; bj < 2; ++bj) xs[mm][bj] = *(const u32x4*)(xres + (size_t)(row0 + ai * 128 + (2 * mp + mm) * 16) * D + col0 + bj * 128);
            asm volatile("" ::: "memory");
#pragma unroll
            for (int mm = 0; mm < 2; ++mm) {
                const int m = 2 * mp + mm;
                float sq = 0.f;
#pragma unroll
                for (int bj = 0; bj < 2; ++bj) {
                    const u32x4 w = xs[mm][bj];
                    const f32x4 x0 = (f32x4){bf_lo(w.x), bf_hi(w.x), bf_lo(w.y), bf_hi(w.y)} + gv[bj][0] * acc[ai][bj][m][0], x1 = (f32x4){bf_lo(w.z), bf_hi(w.z), bf_lo(w.w), bf_hi(w.w)} + gv[bj][1] * acc[ai][bj][m][1];
                    acc[ai][bj][m][0] = x0; acc[ai][bj][m][1] = x1;
                    sq += ((x0[0] * x0[0] + x0[1] * x0[1]) + (x0[2] * x0[2] + x0[3] * x0[3])) + ((x1[0] * x1[0] + x1[1] * x1[1]) + (x1[2] * x1[2] + x1[3] * x1[3]));
                }
                sq += shfl_xor_l(sq, 16, lane); sq += shfl_xor_l(sq, 32, lane);
                if (fq == 0) unsafeAtomicAdd(ssq + row0 + ai * 128 + m * 16, sq);
            }
        }
        asm volatile("s_waitcnt vmcnt(0)" ::: "memory");
        unsigned* c = cnt + 64 * u.pm;
        if (lane == 0) __hip_atomic_fetch_add(c, 1u, __ATOMIC_RELAXED, __HIP_MEMORY_SCOPE_AGENT);
        { unsigned sp = 0;
          while ((unsigned)__builtin_amdgcn_readfirstlane(__hip_atomic_load(c, __ATOMIC_RELAXED, __HIP_MEMORY_SCOPE_AGENT)) < 32u) { __builtin_amdgcn_s_sleep(2); if (++sp > (1u << 20)) break; } }
        float rs[2][4];
#pragma unroll
        for (int ai = 0; ai < 2; ++ai)
#pragma unroll
            for (int m = 0; m < 4; ++m) rs[ai][m] = __hip_atomic_load(ssq + row0 + ai * 128 + m * 16, __ATOMIC_RELAXED, __HIP_MEMORY_SCOPE_AGENT);
        f32x4 gf[2][2];
#pragma unroll
        for (int bj = 0; bj < 2; ++bj)
#pragma unroll
            for (int n = 0; n < 2; ++n) gf[bj][n] = *(const f32x4*)(gfin + col0 + bj * 128 + n * 4);
#pragma unroll
        for (int ai = 0; ai < 2; ++ai)
#pragma unroll
            for (int m = 0; m < 4; ++m) {
                const float rstd = __builtin_amdgcn_rsqf(rs[ai][m] * (1.f / D) + RMS_EPS);
                float* op = out + (size_t)(row0 + ai * 128 + m * 16) * D + col0;
#pragma unroll
                for (int bj = 0; bj < 2; ++bj) { *(f32x4*)(op + bj * 128) = acc[ai][bj][m][0] * rstd * gf[bj][0]; *(f32x4*)(op + bj * 128 + 4) = acc[ai][bj][m][1] * rstd * gf[bj][1]; }
            }
    }
};
struct EpiSwiglu {
    static constexpr bool PERM = true, AFTER_DRAIN = false;
    bf16_t* H; const float* ssq; const float* shw;
    __device__ __forceinline__ void operator()(const AccT& acc, const Unit& u, int wr, int wc, int fr, int fq) const {
        const int cv = u.pm < MC / 256 ? 8 : ((u.pm - MC / 256) >> 2);
        const int col0 = u.pn * 128 + wc * 32 + 8 * fq, row0 = u.pm * 256 + wr * 64 + fr;
        const float* sp = shw + (size_t)cv * 2 * FF + u.pn * 256 + wc * 32 + 8 * fq;
        const f32x4 sg0 = *(const f32x4*)(sp), sg1 = *(const f32x4*)(sp + 4), su0 = *(const f32x4*)(sp + 128), su1 = *(const f32x4*)(sp + 132);
        float rs[2][4];
#pragma unroll
        for (int ai = 0; ai < 2; ++ai)
#pragma unroll
            for (int m = 0; m < 4; ++m) rs[ai][m] = ssq[row0 + ai * 128 + m * 16];
        asm volatile("" ::: "memory");
#pragma unroll
        for (int ai = 0; ai < 2; ++ai)
#pragma unroll
            for (int m = 0; m < 4; ++m) rs[ai][m] = __builtin_amdgcn_rsqf(rs[ai][m] * (1.f / D) + RMS_EPS);
#pragma unroll
        for (int ai = 0; ai < 2; ++ai)
#pragma unroll
            for (int m = 0; m < 4; ++m) {
                const int row = row0 + ai * 128 + m * 16;
                const float rstd = rs[ai][m];
                float o[8];
#pragma unroll
                for (int n = 0; n < 2; ++n) {
                    const f32x4 gq = acc[ai][0][m][n] * rstd + (n ? sg1 : sg0), uq = acc[ai][1][m][n] * rstd + (n ? su1 : su0);
#pragma unroll
                    for (int j = 0; j < 4; ++j) o[n * 4 + j] = silu_f(gq[j]) * uq[j];
                }
                u32x4 w; w.x = pk_bf16(o[0], o[1]); w.y = pk_bf16(o[2], o[3]); w.z = pk_bf16(o[4], o[5]); w.w = pk_bf16(o[6], o[7]);
                *(u32x4*)(H + (size_t)row * FF + col0) = w;
            }
    }
};
struct EpiWin {
    static constexpr bool PERM = true, AFTER_DRAIN = false;
    bf16_t *G, *XR; const float* ssq; const float* shw;
    __device__ __forceinline__ void operator()(const AccT& acc, const Unit& u, int wr, int wc, int fr, int fq) const {
        const bool isg = u.pn < 4;
        const int cv = u.pm < MC / 256 ? 8 : ((u.pm - MC / 256) >> 2);
        bf16_t* base = isg ? G : XR;
        const int colt = (u.pn & 3) * 256 + wc * 32 + 8 * fq, row0 = u.pm * 256 + wr * 64 + fr;
        const float* sp = shw + (size_t)cv * 2 * D + u.pn * 256 + wc * 32 + 8 * fq;
        f32x4 sv[2][2];
#pragma unroll
        for (int bj = 0; bj < 2; ++bj) { sv[bj][0] = *(const f32x4*)(sp + bj * 128); sv[bj][1] = *(const f32x4*)(sp + bj * 128 + 4); }
        float rs[2][4];
#pragma unroll
        for (int ai = 0; ai < 2; ++ai)
#pragma unroll
            for (int m = 0; m < 4; ++m) rs[ai][m] = ssq[row0 + ai * 128 + m * 16];
        asm volatile("" ::: "memory");
#pragma unroll
        for (int ai = 0; ai < 2; ++ai)
#pragma unroll
            for (int m = 0; m < 4; ++m) rs[ai][m] = __builtin_amdgcn_rsqf(rs[ai][m] * (1.f / D) + RMS_EPS);
#pragma unroll
        for (int ai = 0; ai < 2; ++ai)
#pragma unroll
            for (int m = 0; m < 4; ++m) {
                const int row = row0 + ai * 128 + m * 16;
                const float rstd = rs[ai][m];
#pragma unroll
                for (int bj = 0; bj < 2; ++bj) {
                    f32x4 v0 = acc[ai][bj][m][0] * rstd + sv[bj][0], v1 = acc[ai][bj][m][1] * rstd + sv[bj][1];
                    if (isg) {
#pragma unroll
                        for (int j = 0; j < 4; ++j) { v0[j] = gelu_tanh_f(v0[j]); v1[j] = gelu_tanh_f(v1[j]); }
                    }
                    u32x4 w; w.x = pk_bf16(v0[0], v0[1]); w.y = pk_bf16(v0[2], v0[3]); w.z = pk_bf16(v1[0], v1[1]); w.w = pk_bf16(v1[2], v1[3]);
                    *(u32x4*)(base + (size_t)row * D + colt + bj * 128) = w;
                }
            }
    }
};
struct EpiLru {
    static constexpr bool PERM = true, AFTER_DRAIN = true;
    LAS const unsigned long long* ptab;
    const float* h0;
    int row_base, cb, dir, q;

    template <int AI>
    __device__ __forceinline__ void half(const AccT& acc, int wr, int wc, int fr, int fq, PG8_LAS unsigned char* lds, int tid,
                                         const u32x4 (&xall)[4], bf16_t* HL, bf16_t* PP) const {
#pragma unroll
        for (int m = 0; m < 4; ++m) {
            const int tl = wr * 64 + m * 16 + fr;
            const size_t row = (size_t)(row_base + AI * 128 + tl);
#pragma unroll
            for (int n = 0; n < 2; ++n) {
                asm volatile("" ::: "memory");
                const int chl = wc * 32 + 8 * fq + 4 * n;
                const PG8_LAS f32x4* cst = (const PG8_LAS f32x4*)(lds + CST_OFF + chl * 4);
                const f32x4 ba = cst[0], bi = cst[32], L2 = cst[64];
                u32x2 xw; xw.x = n ? xall[m].z : xall[m].x; xw.y = n ? xall[m].w : xall[m].y;
                const f32x4 xc = {bf_lo(xw.x), bf_hi(xw.x), bf_lo(xw.y), bf_hi(xw.y)};
                f32x4 av, bv;
#pragma unroll
                for (int j = 0; j < 4; ++j) {
                    const float za = acc[AI][0][m][n][j] + ba[j], zi = acc[AI][1][m][n][j] + bi[j];
                    const float r = sigmoid_f(za), ig = sigmoid_f(zi);
                    const float a = fast_exp2(r * L2[j]);
                    av[j] = a; bv[j] = __builtin_amdgcn_sqrtf(1.f - a * a) * (ig * xc[j]);
                }
                PG8_LAS f32x4* dst = (PG8_LAS f32x4*)(lds + tl * AB_PITCH + chl * 8);
                dst[0] = (f32x4){av[0], bv[0], av[1], bv[1]}; dst[1] = (f32x4){av[2], bv[2], av[3], bv[3]};
            }
        }
        __syncthreads();
        if (tid < 128) {
            PG8_LAS float* hst = (PG8_LAS float*)(lds + HST_OFF);
            float h = hst[tid], P = hst[128 + tid];
            PG8_LAS f32x2* col = (PG8_LAS f32x2*)(lds + tid * 8);
            if (dir == 0) {
#pragma unroll 8
                for (int t = 0; t < 128; ++t) { PG8_LAS f32x2* p = (PG8_LAS f32x2*)((PG8_LAS unsigned char*)col + t * AB_PITCH); const f32x2 ab = *p; h = ab.x * h + ab.y; P *= ab.x; *p = (f32x2){h, P}; }
            } else {
#pragma unroll 8
                for (int t = 127; t >= 0; --t) { PG8_LAS f32x2* p = (PG8_LAS f32x2*)((PG8_LAS unsigned char*)col + t * AB_PITCH); const f32x2 ab = *p; h = ab.x * h + ab.y; P *= ab.x; *p = (f32x2){h, P}; }
            }
            hst[tid] = h; hst[128 + tid] = P;
        }
        __syncthreads();
        const bool lat = row_base >= MC;
#pragma unroll
        for (int it = 0; it < 8; ++it) {
            const int idx = it * 512 + tid, tl = idx >> 5, c4 = (idx & 31) * 4;
            const PG8_LAS f32x4* src = (const PG8_LAS f32x4*)(lds + tl * AB_PITCH + c4 * 8);
            const f32x4 s0 = src[0], s1 = src[1];
            const size_t row = (size_t)(row_base + AI * 128 + tl);
            { u32x2 wh; wh.x = pk_bf16(s0[0], s0[2]); wh.y = pk_bf16(s1[0], s1[2]); *(u32x2*)(HL + row * D + cb + c4) = wh; }
            if (lat) { u32x2 w; w.x = pk_bf16(s0[1], s0[3]); w.y = pk_bf16(s1[1], s1[3]); *(u32x2*)(PP + (row - MC) * D + cb + c4) = w; }
        }
        __syncthreads();
    }
    __device__ __forceinline__ void fused(AccT& acc, const Unit&, int wr, int wc, int fr, int fq, PG8_LAS unsigned char* lds, int wid, int lane) const {
        const int tid = wid * 64 + lane;
        const PT pt{ptab};
        unsigned char* ws = pt.ws();
        PG8_LAS float* hst = (PG8_LAS float*)(lds + HST_OFF);
        PG8_LAS float* cst = (PG8_LAS float*)(lds + CST_OFF);
        if (tid < 128) {
            hst[tid] = h0 ? h0[cb + tid] : 0.f; hst[128 + tid] = 1.f;
            const int ch = dir * D + cb + tid;
            cst[tid] = pt.f(I_b_a)[ch]; cst[128 + tid] = pt.f(I_b_i)[ch];
            const float l = pt.f(I_lam)[ch];
            const float x = __expf(-l);
            const float sp = x < 0.03f ? x * (1.f - x * (0.5f - x * (0.33333334f - 0.25f * x))) : __logf(1.f + x);
            cst[256 + tid] = -8.0f * sp * LOG2E;
        }
        __syncthreads();
        const bf16_t* XC = (const bf16_t*)(ws + WS_XN);
        bf16_t* HL = (bf16_t*)(ws + (dir ? WS_HLB : WS_HLF));
        bf16_t* PP = (bf16_t*)(ws + (dir ? WS_PB : WS_PF));
        u32x4 xc0[4], xc1[4];
#pragma unroll
        for (int m = 0; m < 4; ++m) {
            xc0[m] = *(const u32x4*)(XC + (size_t)(row_base + wr * 64 + m * 16 + fr) * D + cb + wc * 32 + 8 * fq);
            xc1[m] = *(const u32x4*)(XC + (size_t)(row_base + 128 + wr * 64 + m * 16 + fr) * D + cb + wc * 32 + 8 * fq);
        }
        if (dir == 0) { half<0>(acc, wr, wc, fr, fq, lds, tid, xc0, HL, PP); half<1>(acc, wr, wc, fr, fq, lds, tid, xc1, HL, PP); }
        else          { half<1>(acc, wr, wc, fr, fq, lds, tid, xc1, HL, PP); half<0>(acc, wr, wc, fr, fq, lds, tid, xc0, HL, PP); }
        if (tid < 128) {
            const float h = hst[tid], P = hst[128 + tid];
            float* sumE = (float*)(ws + WS_SUME) + (size_t)dir * 48 * D; float* sumP = (float*)(ws + WS_SUMP) + (size_t)dir * 48 * D;
            sumE[(size_t)q * D + cb + tid] = h; sumP[(size_t)q * D + cb + tid] = P;
            if (row_base < MC) pt.out()[OUT_NH + (size_t)q * 2 * D + dir * D + cb + tid] = h;
        }
        __syncthreads();
    }
};
}
namespace att {
constexpr int KP = 144, VP = 136;
constexpr int K_OFF = 0, V_OFF = 2 * 64 * KP, F_OFF = V_OFF + 2 * 64 * KP, T_OFF = F_OFF + 8 * 32 * 4, A_END = T_OFF + 640 * 4;
typedef short v4i16_t __attribute__((ext_vector_type(4)));
#define MFMA32(a, b, c) __builtin_amdgcn_mfma_f32_32x32x16_bf16((a), (b), (c), 0, 0, 0)
__device__ __forceinline__ float max2f(float a, float b) { float r; asm("v_max_f32_e32 %0, %1, %2" : "=v"(r) : "v"(a), "v"(b)); return r; }
__device__ __forceinline__ float max3f(float a, float b, float c) { float r; asm("v_max3_f32 %0, %1, %2, %3" : "=v"(r) : "v"(a), "v"(b), "v"(c)); return r; }
__device__ __forceinline__ int crow(int r, int hi) { return (r & 3) + 8 * (r >> 2) + 4 * hi; }

template <bool NA>
__device__ __forceinline__ void unit(int wv, LAS unsigned char* lds, int b, int h, int g, const bf16_t* __restrict__ Qb, const bf16_t* __restrict__ Kb, const bf16_t* __restrict__ Vb,
                                     const float* __restrict__ CK, const float* __restrict__ CV, bf16_t* __restrict__ Ob, const float* __restrict__ rpb) {
    int wid_ = wv; asm volatile("" : "+s"(wid_));
    const int tid = tid_l(wid_), lane = tid & 63, wid = wid_, r32 = lane & 31, hi = lane >> 5;
    LAS float* fscr = (LAS float*)(lds + F_OFF) + wid * 32;
    LAS float* tab = (LAS float*)(lds + T_OFF);
    if (NA) { for (int i = tid; i < 15 * 31; i += 512) { const int dr = i / 31, dc = i % 31; tab[64 + dr * 32 + dc] = rpb[(h * 15 + dr) * 31 + dc] * LOG2E; } }
    int qrow, nlat, ntile, Rlo = 0, rq = 0, rs = 0;
    if (NA) {
        rq = 4 * g + (wid >> 1); rs = min(max(rq - 4, 0), 8);
        qrow = MC + b * 1024 + rq * 64 + 32 * (wid & 1) + r32;
        Rlo = min(max(4 * g - 4, 0), 8); const int Rhi = min(max(4 * g - 1, 0), 8) + 8;
        nlat = Rhi - Rlo; ntile = nlat + 8;
    } else { qrow = b * 256 + 32 * wid + r32; nlat = 4; ntile = 4; }
    const int qc = 32 * (wid & 1) + r32, cs = min(max(qc - 8, 0), 48);
    f32x16 pen0, pen1;
#pragma unroll
    for (int i = 0; i < 16; ++i) { const int kc = (i & 3) + 8 * (i >> 2) + 4 * hi - cs; pen0[i] = (NA && (unsigned)kc >= 16u) ? -1e30f : 0.f; pen1[i] = (NA && (unsigned)(kc + 32) >= 16u) ? -1e30f : 0.f; }
    bf16x8 qr[4];
#pragma unroll
    for (int s = 0; s < 4; ++s) qr[s] = *(const bf16x8*)(Qb + (size_t)qrow * D + h * 64 + 16 * s + 8 * hi);
    const int lkey = tid >> 3, lch = tid & 7;
    auto src_row = [&](int t) -> size_t {
        if (NA) return t < nlat ? (size_t)(MC + b * 1024 + (Rlo + t) * 64) : (size_t)(b * 512 + (t - nlat) * 64);
        return (size_t)(b * 256 + t * 64);
    };
    u32x4 kreg = {0u, 0u, 0u, 0u}, vreg = kreg, kreg2 = kreg, vreg2 = kreg;
    auto gload = [&](int t) {
        const bool cache = NA && t >= nlat;
        const size_t off = (src_row(t) + lkey) * D + h * 64 + 8 * lch;
        const unsigned char* kp = cache ? (const unsigned char*)CK + off * 4 : (const unsigned char*)Kb + off * 2;
        const unsigned char* vp = cache ? (const unsigned char*)CV + off * 4 : (const unsigned char*)Vb + off * 2;
        const size_t second = cache ? 16 : 0;
        kreg = *(const u32x4*)kp; kreg2 = *(const u32x4*)(kp + second);
        vreg = *(const u32x4*)vp; vreg2 = *(const u32x4*)(vp + second);
    };
    auto lstore = [&](int buf, int t) {
        LAS u32x4* kd = (LAS u32x4*)(lds + K_OFF + buf * 64 * KP + lkey * KP + lch * 16);
        LAS u32x4* vd = (LAS u32x4*)(lds + V_OFF + buf * 64 * KP + lkey * KP + lch * 16);
        if (NA && t >= nlat) {
            *kd = (u32x4){pk_bf16(__uint_as_float(kreg.x), __uint_as_float(kreg.y)), pk_bf16(__uint_as_float(kreg.z), __uint_as_float(kreg.w)),
                          pk_bf16(__uint_as_float(kreg2.x), __uint_as_float(kreg2.y)), pk_bf16(__uint_as_float(kreg2.z), __uint_as_float(kreg2.w))};
            *vd = (u32x4){pk_bf16(__uint_as_float(vreg.x), __uint_as_float(vreg.y)), pk_bf16(__uint_as_float(vreg.z), __uint_as_float(vreg.w)),
                          pk_bf16(__uint_as_float(vreg2.x), __uint_as_float(vreg2.y)), pk_bf16(__uint_as_float(vreg2.z), __uint_as_float(vreg2.w))};
        } else { *kd = kreg; *vd = vreg; }
    };
    float m_run = -1e30f, l_run = 0.f;
    f32x16 o0, o1;
#pragma unroll
    for (int i = 0; i < 16; ++i) { o0[i] = 0.f; o1[i] = 0.f; }
    gload(0); lstore(0, 0);
    asm volatile("" :: "v"(qr[0]), "v"(qr[1]), "v"(qr[2]), "v"(qr[3]));
    __syncthreads();
    for (int t = 0; t < ntile; ++t) {
        const int buf = t & 1;
        if (t + 1 < ntile) gload(t + 1);
        bool active = true, biased = false; int dr = 0;
        if (NA && t < nlat) { const int R = Rlo + t; active = (R >= rs) && (R < rs + 8); biased = true; dr = R - rq + 7; }
        if (active) {
            f32x16 p0, p1;
#pragma unroll
            for (int i = 0; i < 16; ++i) { p0[i] = 0.f; p1[i] = 0.f; }
            const LAS unsigned char* kb = lds + K_OFF + buf * 64 * KP + r32 * KP + 16 * hi;
#pragma unroll
            for (int s = 0; s < 4; ++s) {
                const bf16x8 k0 = *(const LAS bf16x8*)(kb + 32 * s), k1 = *(const LAS bf16x8*)(kb + 32 * KP + 32 * s);
                p0 = MFMA32(k0, qr[s], p0); p1 = MFMA32(k1, qr[s], p1);
            }
            if (biased) {
                const LAS float* tb = tab + 64 + dr * 32 + (4 * hi - qc + 15);
                f32x16 b0, b1;
#pragma unroll
                for (int i = 0; i < 16; ++i) { const int kc = (i & 3) + 8 * (i >> 2); b0[i] = tb[kc]; b1[i] = tb[kc + 32]; }
                p0 += b0; p1 += b1; p0 += pen0; p1 += pen1;
            }
            float mxa = max3f(p0[0], p0[1], p0[2]), mxb = max3f(p0[3], p0[4], p0[5]), mxc = max3f(p1[0], p1[1], p1[2]), mxd = max3f(p1[3], p1[4], p1[5]);
            mxa = max3f(mxa, p0[6], p0[7]); mxb = max3f(mxb, p0[8], p0[9]); mxc = max3f(mxc, p1[6], p1[7]); mxd = max3f(mxd, p1[8], p1[9]);
            mxa = max3f(mxa, p0[10], p0[11]); mxb = max3f(mxb, p0[12], p0[13]); mxc = max3f(mxc, p1[10], p1[11]); mxd = max3f(mxd, p1[12], p1[13]);
            mxa = max3f(mxa, p0[14], p0[15]); mxc = max3f(mxc, p1[14], p1[15]);
            float mx = max2f(max2f(mxa, mxb), max2f(mxc, mxd));
            mx = max2f(mx, shfl_xor_l(mx, 32, lane));
            const float mnew = max2f(m_run, mx);
            const float f = fast_exp2(m_run - mnew);
            m_run = mnew;
            p0 -= mnew; p1 -= mnew;
#pragma unroll
            for (int i = 0; i < 16; ++i) { p0[i] = fast_exp2(p0[i]); p1[i] = fast_exp2(p1[i]); }
            f32x4 ls4 = {0.f, 0.f, 0.f, 0.f};
#pragma unroll
            for (int i = 0; i < 16; i += 4) ls4 += (f32x4){p0[i], p0[i + 1], p0[i + 2], p0[i + 3]} + (f32x4){p1[i], p1[i + 1], p1[i + 2], p1[i + 3]};
            const float ls = (ls4[0] + ls4[1]) + (ls4[2] + ls4[3]);
            l_run = l_run * f + ls;
            if (__any(f != 1.f)) {
                if (hi == 0) fscr[r32] = f;
                asm volatile("s_waitcnt lgkmcnt(0)" ::: "memory");
#pragma unroll
                for (int i = 0; i < 16; ++i) { const float fi = fscr[crow(i, hi)]; o0[i] *= fi; o1[i] *= fi; }
                asm volatile("s_waitcnt lgkmcnt(0)" ::: "memory");
            }
            bf16x8 pa[2][2];
#pragma unroll
            for (int s = 0; s < 2; ++s) {
                u32x4 w0, w1;
                w0.x = pk_bf16(p0[8 * s + 0], p0[8 * s + 1]); w0.y = pk_bf16(p0[8 * s + 2], p0[8 * s + 3]); w0.z = pk_bf16(p0[8 * s + 4], p0[8 * s + 5]); w0.w = pk_bf16(p0[8 * s + 6], p0[8 * s + 7]);
                w1.x = pk_bf16(p1[8 * s + 0], p1[8 * s + 1]); w1.y = pk_bf16(p1[8 * s + 2], p1[8 * s + 3]); w1.z = pk_bf16(p1[8 * s + 4], p1[8 * s + 5]); w1.w = pk_bf16(p1[8 * s + 6], p1[8 * s + 7]);
                pa[0][s] = __builtin_bit_cast(bf16x8, w0); pa[1][s] = __builtin_bit_cast(bf16x8, w1);
            }
            const int i16 = lane & 15, g16 = (lane >> 4) & 1;
            const LAS unsigned char* vb = lds + V_OFF + buf * 64 * KP + (4 * hi + (i16 >> 2)) * KP + (16 * g16 + 4 * (i16 & 3)) * 2;
#pragma unroll
            for (int blk = 0; blk < 2; ++blk)
#pragma unroll
                for (int s = 0; s < 2; ++s) {
                    const int ko = (32 * blk + 16 * s) * KP;
                    const s16x4 a0 = __builtin_bit_cast(s16x4, __builtin_amdgcn_ds_read_tr16_b64_v4i16((LAS v4i16_t*)(vb + ko))), a1 = __builtin_bit_cast(s16x4, __builtin_amdgcn_ds_read_tr16_b64_v4i16((LAS v4i16_t*)(vb + ko + 8 * KP)));
                    const s16x4 c0 = __builtin_bit_cast(s16x4, __builtin_amdgcn_ds_read_tr16_b64_v4i16((LAS v4i16_t*)(vb + ko + 64))), c1 = __builtin_bit_cast(s16x4, __builtin_amdgcn_ds_read_tr16_b64_v4i16((LAS v4i16_t*)(vb + ko + 8 * KP + 64)));
                    const bf16x8 v0 = __builtin_shufflevector(a0, a1, 0, 1, 2, 3, 4, 5, 6, 7), v1 = __builtin_shufflevector(c0, c1, 0, 1, 2, 3, 4, 5, 6, 7);
                    o0 = MFMA32(pa[blk][s], v0, o0); o1 = MFMA32(pa[blk][s], v1, o1);
                }
        }
        if (t + 1 < ntile) lstore(buf ^ 1, t + 1);
        __syncthreads();
    }
    l_run += shfl_xor_l(l_run, 32, lane);
    if (hi == 0) fscr[r32] = fast_rcp(l_run);
    asm volatile("s_waitcnt lgkmcnt(0)" ::: "memory");
    const int qbase = qrow - r32;
    LAS unsigned char* stg = lds + K_OFF + wid * (32 * KP);
#pragma unroll
    for (int i = 0; i < 16; ++i) {
        const int qi = crow(i, hi); const float li = fscr[qi];
        LAS unsigned short* sp = (LAS unsigned short*)(stg + qi * KP + r32 * 2);
        sp[0] = (unsigned short)(pk_bf16(o0[i] * li, 0.f) & 0xffff); sp[32] = (unsigned short)(pk_bf16(o1[i] * li, 0.f) & 0xffff);
    }
    asm volatile("s_waitcnt lgkmcnt(0)" ::: "memory");
    {
        const int row = lane >> 1, half = lane & 1;
        bf16_t* op = Ob + (size_t)(qbase + row) * D + h * 64 + half * 32;
#pragma unroll
        for (int j = 0; j < 4; ++j) *(u32x4*)(op + 8 * j) = *(const LAS u32x4*)(stg + row * KP + half * 64 + 16 * j);
    }
    __syncthreads();
}
}
#ifndef REP_P4
#define REP_P4 1
#endif
#ifndef REP_ADA
#define REP_ADA 1
#endif
#ifndef REP_PRO
#define REP_PRO 1
#endif
#ifndef REP_FILL
#define REP_FILL 1
#endif
#ifndef REP_ATT
#define REP_ATT 1
#endif
#ifndef REP_GEMM
#define REP_GEMM 1
#endif
#ifndef REP_THIN
#define REP_THIN 1
#endif
#ifndef REP_LRU
#define REP_LRU 1
#endif
#ifndef REP_SYNC
#define REP_SYNC 1
#endif
struct Args {
    const float *x_prompt, *x_sample, *c, *cache_k, *cache_v, *state_h, *c_ctx, *norm_g, *w_mod, *b_mod, *w_qkv, *w_o, *rpb, *w_in, *conv_w, *conv_b,
                *w_a, *b_a, *w_i, *b_i, *lam, *w_out, *w_gu, *w_down, *final_g;
    float* out; unsigned char* ws;
};

__device__ __forceinline__ void tr_item(const float* __restrict__ W, int ldw, int k0, int n0, bf16_t* __restrict__ dst, int ldd, LAS float* scr, int lane) {
    float tv[32];
#pragma unroll
    for (int i = 0; i < 32; ++i) { const int kk = 2 * i + (lane >> 5); tv[i] = W[(size_t)(k0 + kk) * ldw + n0 + (lane & 31)]; }
#pragma unroll
    for (int i = 0; i < 32; ++i) { const int kk = 2 * i + (lane >> 5); scr[kk * 33 + (lane & 31)] = tv[i]; }
    asm volatile("s_waitcnt lgkmcnt(0)" ::: "memory");
    const int c = lane & 7;
#pragma unroll
    for (int j = 0; j < 4; ++j) {
        const int n = (lane >> 3) + 8 * j; const LAS float* s = scr + (8 * c) * 33 + n;
        u32x4 o; o.x = pk_bf16(s[0 * 33], s[1 * 33]); o.y = pk_bf16(s[2 * 33], s[3 * 33]); o.z = pk_bf16(s[4 * 33], s[5 * 33]); o.w = pk_bf16(s[6 * 33], s[7 * 33]);
        *(u32x4*)(dst + (size_t)n * ldd + k0 + 8 * c) = o;
    }
    asm volatile("s_waitcnt lgkmcnt(0)" ::: "memory");
}

__device__ __forceinline__ void tr_items(int wv, const PT pt, LAS unsigned char* lds, int it0, int it1, int gwr, int ngw) {
    const int lane = tid_l(wv) & 63;
    unsigned char* ws = pt.ws();
    {
        LAS float* scr = (LAS float*)(lds + wv * 8448);
        constexpr int I_QKV = 16 * 96, I_WO = 16 * 32, I_GU = 16 * 176, I_DN = 44 * 32, I_WIN = 16 * 64, I_WOUT = 16 * 32, I_G = 32 * 8;
        for (int it = it0 + gwr; it < it1; it += ngw) {
            int r = it;
            if (r < I_QKV) { const int kb = r / 96, nb = r % 96; tr_item(pt.f(I_w_qkv), NQKV, 64 * kb, 32 * nb, (bf16_t*)(ws + WS_WQKV) + (size_t)(32 * nb) * D, D, scr, lane); continue; } r -= I_QKV;
            if (r < I_WO) { const int kb = r / 32, nb = r % 32; tr_item(pt.f(I_w_o), D, 64 * kb, 32 * nb, (bf16_t*)(ws + WS_WO) + (size_t)(32 * nb) * D, D, scr, lane); continue; } r -= I_WO;
#pragma unroll 1
            for (int l = 0; l < 2; ++l) {
                if (r >= 0 && r < I_GU) { const int kb = r / 176, nb = r % 176; const int n0 = 32 * nb, half = n0 >= FF ? 1 : 0, c0 = n0 - half * FF;
                    const int drow = 256 * (c0 >> 7) + 128 * half + (c0 & 127);
                    tr_item(pt.f(I_w_gu) + (size_t)l * D * 2 * FF, 2 * FF, 64 * kb, n0, (bf16_t*)(ws + WS_WGU) + ((size_t)l * 2 * FF + drow) * D, D, scr, lane); r = -1; break; } r -= I_GU;
                if (r >= 0 && r < I_DN) { const int kb = r / 32, nb = r % 32;
                    tr_item(pt.f(I_w_down) + (size_t)l * FF * D, D, 64 * kb, 32 * nb, (bf16_t*)(ws + WS_WDN) + ((size_t)l * D + 32 * nb) * FF, FF, scr, lane); r = -1; break; } r -= I_DN;
            }
            if (r < 0) continue;
            if (r < I_WIN) { const int kb = r / 64, nb = r % 64; tr_item(pt.f(I_w_in), 2 * D, 64 * kb, 32 * nb, (bf16_t*)(ws + WS_WIN) + (size_t)(32 * nb) * D, D, scr, lane); continue; } r -= I_WIN;
            if (r < I_WOUT) { const int kb = r / 32, nb = r % 32; tr_item(pt.f(I_w_out), D, 64 * kb, 32 * nb, (bf16_t*)(ws + WS_WOUT) + (size_t)(32 * nb) * D, D, scr, lane); continue; } r -= I_WOUT;
            { const int mat = r >> 3, sub = r & 7, kb = sub >> 2, nb = sub & 3;
              const int gsel = mat >> 4, dir = (mat >> 3) & 1, blk = mat & 7;
              const float* src = (gsel ? pt.f(I_w_i) : pt.f(I_w_a)) + (size_t)(dir * 8 + blk) * 128 * 128;
              tr_item(src, 128, 64 * kb, 32 * nb, (bf16_t*)(ws + WS_WG) + ((size_t)((blk * 2 + dir) * 256 + gsel * 128 + 32 * nb)) * 128, 128, scr, lane); }
        }
    }
}

__device__ __forceinline__ void adaln_tasks(int wv, const PT pt, LAS unsigned char* lds, int l, int rank, int nb) {
    const int tid = tid_l(wv);
    LAS float* sl = (LAS float*)(lds + 70000);
    LAS float* red = (LAS float*)lds;
    float* mod = (float*)(pt.ws() + WS_MOD);
#pragma unroll 1
    for (int task = rank; task < 256; task += nb) {
        const int cg_ = task >> 3, kr = task & 7, col0 = cg_ * 192;
        __syncthreads();
        for (int i = tid; i < 9 * 128; i += 512) { const int cv = i >> 7, k = kr * 128 + (i & 127); const float v = cv < 8 ? pt.f(I_c)[cv * D + k] : pt.f(I_c_ctx)[k]; sl[i] = silu_f(v); }
        __syncthreads();
        if (tid < 384) {
            const int q = tid % 48, ks = tid / 48;
            float acc[9][4];
#pragma unroll
            for (int cv = 0; cv < 9; ++cv) { acc[cv][0] = 0.f; acc[cv][1] = 0.f; acc[cv][2] = 0.f; acc[cv][3] = 0.f; }
            const float* wp = pt.f(I_w_mod) + ((size_t)l * D + kr * 128 + ks * 16) * NMOD + col0 + 4 * q;
            f32x4 w[16];
#pragma unroll
            for (int k = 0; k < 16; ++k) w[k] = *(const f32x4*)(wp + (size_t)k * NMOD);
#pragma unroll
            for (int k = 0; k < 16; ++k) {
#pragma unroll
                for (int cv = 0; cv < 9; ++cv) { const float s = sl[cv * 128 + ks * 16 + k]; acc[cv][0] += s * w[k][0]; acc[cv][1] += s * w[k][1]; acc[cv][2] += s * w[k][2]; acc[cv][3] += s * w[k][3]; }
            }
#pragma unroll
            for (int cv = 0; cv < 9; ++cv) *(LAS f32x4*)(red + (ks * 9 + cv) * 192 + 4 * q) = (f32x4){acc[cv][0], acc[cv][1], acc[cv][2], acc[cv][3]};
        }
        __syncthreads();
        for (int i = tid; i < 9 * 192; i += 512) {
            const int cv = i / 192, cc = i % 192; float s = 0.f;
#pragma unroll
            for (int ks = 0; ks < 8; ++ks) s += red[(ks * 9 + cv) * 192 + cc];
            if (kr == 0) s += pt.f(I_b_mod)[l * NMOD + col0 + cc];
            unsafeAtomicAdd(mod + ((size_t)l * 9 + cv) * NMOD + col0 + cc, s);
        }
    }
    __syncthreads();
}

__device__ __forceinline__ void cache_conv(int wv, const PT pt, int rank, int nb) {
    const int tid = tid_l(wv);
    unsigned char* ws = pt.ws();
    const size_t n4 = (size_t)MC * D / 4;
#pragma unroll 8
    for (size_t i = (size_t)rank * 512 + tid; i < 2 * n4; i += (size_t)nb * 512) {
        const bool isv = i >= n4; const size_t j = isv ? i - n4 : i;
        const f32x4 v = *((const f32x4*)(isv ? pt.f(I_cache_v) : pt.f(I_cache_k)) + j);
        u32x2 w; w.x = pk_bf16(v[0], v[1]); w.y = pk_bf16(v[2], v[3]);
        *((u32x2*)(ws + (isv ? WS_CV : WS_CK)) + j) = w;
    }
}

__device__ __forceinline__ void p0_prologue(int wv, const PT pt, LAS unsigned char* lds) {
    const int tid = tid_l(wv), lane = tid & 63, wave = tid >> 6;
    const int G = gd_l(), bxl = bx_l(), gw = bxl * 8 + wave, NGW = G * 8;
    unsigned char* ws = pt.ws();
    adaln_tasks(wv, pt, lds, 0, bxl, G);
    for (int rp_ = 0; rp_ < REP_PRO; ++rp_) tr_items(wv, pt, lds, 0, 16 * 96, gw, NGW);
}

__device__ __forceinline__ void norm_phase(int wv, const float* xa, const float* xb, const float* g, const float* mod_l, int sh_chunk, bf16_t* XN) {
    const int tid = tid_l(wv), lane = tid & 63, gw = bx_l() * 8 + (tid >> 6), NGW = gd_l() * 8;
#pragma unroll 2
    for (int row = gw; row < MT; row += NGW) {
        const float* xr = row < MC ? xa + (size_t)row * D : xb + (size_t)(row - MC) * D;
        const int cv = row < MC ? 8 : ((row - MC) >> 10);
        const float* shp = mod_l + (size_t)cv * NMOD + sh_chunk * D; const float* scp = shp + D;
        f32x4 v[4], gg4[4], sc4[4], sh4[4]; float s = 0.f;
#pragma unroll
        for (int j = 0; j < 4; ++j) { const int c = 4 * lane + 256 * j; v[j] = *((const f32x4*)xr + lane + 64 * j); gg4[j] = *(const f32x4*)(g + c); sc4[j] = *(const f32x4*)(scp + c); sh4[j] = *(const f32x4*)(shp + c); }
#pragma unroll
        for (int j = 0; j < 4; ++j) s += (v[j][0] * v[j][0] + v[j][1] * v[j][1]) + (v[j][2] * v[j][2] + v[j][3] * v[j][3]);
        const float rstd = 1.f / sqrtf(wave_sum(s, lane) * (1.f / D) + RMS_EPS);
#pragma unroll
        for (int j = 0; j < 4; ++j) {
            const int c = 4 * lane + 256 * j;
            const f32x4 gg = gg4[j], sc = sc4[j], sh = sh4[j];
            const f32x4 y = v[j] * rstd * gg * (sc + 1.f) + sh;
            u32x2 w; w.x = pk_bf16(y[0], y[1]); w.y = pk_bf16(y[2], y[3]);
            *(u32x2*)(XN + (size_t)row * D + c) = w;
        }
    }
}
__device__ __forceinline__ void final_norm_phase(int wv, const bf16_t* XB, float* Y, const float* g) {
    const int tid = tid_l(wv), lane = tid & 63, gw = bx_l() * 8 + (tid >> 6), NGW = gd_l() * 8;
#pragma unroll 2
    for (int row = gw; row < MT; row += NGW) {
        const u32x4* xr = (const u32x4*)(XB + (size_t)row * D);
        f32x4 v[4], gg[4]; float s = 0.f;
#pragma unroll
        for (int j = 0; j < 2; ++j) {
            const u32x4 w = xr[lane + 64 * j];
            v[2 * j] = (f32x4){bf_lo(w.x), bf_hi(w.x), bf_lo(w.y), bf_hi(w.y)}; v[2 * j + 1] = (f32x4){bf_lo(w.z), bf_hi(w.z), bf_lo(w.w), bf_hi(w.w)};
            gg[2 * j] = *(const f32x4*)(g + 8 * lane + 512 * j); gg[2 * j + 1] = *(const f32x4*)(g + 8 * lane + 512 * j + 4);
        }
#pragma unroll
        for (int j = 0; j < 4; ++j) s += (v[j][0] * v[j][0] + v[j][1] * v[j][1]) + (v[j][2] * v[j][2] + v[j][3] * v[j][3]);
        const float rstd = 1.f / sqrtf(wave_sum(s, lane) * (1.f / D) + RMS_EPS);
        float* yr = Y + (size_t)row * D;
#pragma unroll
        for (int j = 0; j < 2; ++j) { *(f32x4*)(yr + 8 * lane + 512 * j) = v[2 * j] * rstd * gg[2 * j]; *(f32x4*)(yr + 8 * lane + 512 * j + 4) = v[2 * j + 1] * rstd * gg[2 * j + 1]; }
    }
}
__device__ __forceinline__ void conv_phase(int wv, const bf16_t* XR, const float* cw, const float* cb, bf16_t* XC) {
    const size_t n8 = (size_t)MT * D / 8;
#pragma unroll 2
    for (size_t i = (size_t)bx_l() * 512 + tid_l(wv), st_ = (size_t)gd_l() * 512; i < n8; i += st_) {
        const int row = (int)(i >> 7), c = (int)(i & 127) * 8;
        int pos, len; if (row < MC) { pos = row & 255; len = 256; } else { pos = (row - MC) & 1023; len = 1024; }
        float y[8];
#pragma unroll
        for (int e = 0; e < 8; ++e) y[e] = cb[c + e];
#pragma unroll
        for (int j = 0; j < 4; ++j) {
            const int p = pos + j - 2;
            if (p >= 0 && p < len) {
                const u32x4 xw = *(const u32x4*)(XR + (size_t)(row + j - 2) * D + c);
                const f32x4 w0 = *(const f32x4*)(cw + j * D + c), w1 = *(const f32x4*)(cw + j * D + c + 4);
                y[0] += w0[0] * bf_lo(xw.x); y[1] += w0[1] * bf_hi(xw.x); y[2] += w0[2] * bf_lo(xw.y); y[3] += w0[3] * bf_hi(xw.y);
                y[4] += w1[0] * bf_lo(xw.z); y[5] += w1[1] * bf_hi(xw.z); y[6] += w1[2] * bf_lo(xw.w); y[7] += w1[3] * bf_hi(xw.w);
            }
        }
        u32x4 o; o.x = pk_bf16(y[0], y[1]); o.y = pk_bf16(y[2], y[3]); o.z = pk_bf16(y[4], y[5]); o.w = pk_bf16(y[6], y[7]);
        *(u32x4*)(XC + (size_t)row * D + c) = o;
    }
}
__device__ __forceinline__ void conv_slab(int wv, const bf16_t* XR, const float* cw, const float* cb, bf16_t* XC, int q, int n) {
    const int tid = tid_l(wv), ch = n * 128 + (tid & 15) * 8, r0 = q * 256 + (tid >> 4) * 8;
    int pos0, len; if (r0 < MC) { pos0 = r0 & 255; len = 256; } else { pos0 = (r0 - MC) & 1023; len = 1024; }
    u32x4 x[11];
#pragma unroll
    for (int i = 0; i < 11; ++i) { const int p = pos0 + i - 2; x[i] = (p >= 0 && p < len) ? *(const u32x4*)(XR + (size_t)(r0 + i - 2) * D + ch) : (u32x4){0u, 0u, 0u, 0u}; }
    f32x4 w0[4], w1[4];
#pragma unroll
    for (int j = 0; j < 4; ++j) { w0[j] = *(const f32x4*)(cw + j * D + ch); w1[j] = *(const f32x4*)(cw + j * D + ch + 4); }
    const f32x4 b0 = *(const f32x4*)(cb + ch), b1 = *(const f32x4*)(cb + ch + 4);
#pragma unroll
    for (int r = 0; r < 8; ++r) {
        f32x4 y0 = b0, y1 = b1;
#pragma unroll
        for (int j = 0; j < 4; ++j) { const u32x4 xw = x[r + j];
            y0 += w0[j] * (f32x4){bf_lo(xw.x), bf_hi(xw.x), bf_lo(xw.y), bf_hi(xw.y)}; y1 += w1[j] * (f32x4){bf_lo(xw.z), bf_hi(xw.z), bf_lo(xw.w), bf_hi(xw.w)}; }
        u32x4 o; o.x = pk_bf16(y0[0], y0[1]); o.y = pk_bf16(y0[2], y0[3]); o.z = pk_bf16(y1[0], y1[1]); o.w = pk_bf16(y1[2], y1[3]);
        *(u32x4*)(XC + (size_t)(r0 + r) * D + ch) = o;
    }
    asm volatile("s_waitcnt vmcnt(0)" ::: "memory");
    __syncthreads();
}

__device__ __forceinline__ void lru_combine_phase(int wv, const unsigned char* ws, bf16_t* Y) {
    const bf16_t* HLF = (const bf16_t*)(ws + WS_HLF); const bf16_t* HLB = (const bf16_t*)(ws + WS_HLB);
    const bf16_t* PF = (const bf16_t*)(ws + WS_PF); const bf16_t* PB = (const bf16_t*)(ws + WS_PB); const bf16_t* GT = (const bf16_t*)(ws + WS_GATE);
    const float* sE = (const float*)(ws + WS_SUME); const float* sP = (const float*)(ws + WS_SUMP);
    const size_t n8 = (size_t)MT * D / 8;
#pragma unroll 2
    for (size_t i = (size_t)bx_l() * 512 + tid_l(wv), st_ = (size_t)gd_l() * 512; i < n8; i += st_) {
        const int row = (int)(i >> 7), c = (int)(i & 127) * 8;
        const size_t off = (size_t)row * D + c;
        const u32x4 hf = *(const u32x4*)(HLF + off), hb = *(const u32x4*)(HLB + off), gt = *(const u32x4*)(GT + off);
        float h[8] = {bf_lo(hf.x) + bf_lo(hb.x), bf_hi(hf.x) + bf_hi(hb.x), bf_lo(hf.y) + bf_lo(hb.y), bf_hi(hf.y) + bf_hi(hb.y),
                      bf_lo(hf.z) + bf_lo(hb.z), bf_hi(hf.z) + bf_hi(hb.z), bf_lo(hf.w) + bf_lo(hb.w), bf_hi(hf.w) + bf_hi(hb.w)};
        if (row >= MC) {
            const int q = row >> 8, ci = (q - 16) & 3, q0 = q - ci;
            const u32x4 pf = *(const u32x4*)(PF + off - (size_t)MC * D), pb = *(const u32x4*)(PB + off - (size_t)MC * D);
            f32x4 tf0 = {0.f, 0.f, 0.f, 0.f}, tf1 = tf0, tb0 = tf0, tb1 = tf0;
            for (int cc = 0; cc < ci; ++cc) { const float* e = sE + (size_t)(q0 + cc) * D + c; const float* p = sP + (size_t)(q0 + cc) * D + c;
                tf0 = *(const f32x4*)e + *(const f32x4*)p * tf0; tf1 = *(const f32x4*)(e + 4) + *(const f32x4*)(p + 4) * tf1; }
            for (int cc = 3; cc > ci; --cc) { const float* e = sE + (size_t)(48 + q0 + cc) * D + c; const float* p = sP + (size_t)(48 + q0 + cc) * D + c;
                tb0 = *(const f32x4*)e + *(const f32x4*)p * tb0; tb1 = *(const f32x4*)(e + 4) + *(const f32x4*)(p + 4) * tb1; }
            h[0] += bf_lo(pf.x) * tf0[0] + bf_lo(pb.x) * tb0[0]; h[1] += bf_hi(pf.x) * tf0[1] + bf_hi(pb.x) * tb0[1];
            h[2] += bf_lo(pf.y) * tf0[2] + bf_lo(pb.y) * tb0[2]; h[3] += bf_hi(pf.y) * tf0[3] + bf_hi(pb.y) * tb0[3];
            h[4] += bf_lo(pf.z) * tf1[0] + bf_lo(pb.z) * tb1[0]; h[5] += bf_hi(pf.z) * tf1[1] + bf_hi(pb.z) * tb1[1];
            h[6] += bf_lo(pf.w) * tf1[2] + bf_lo(pb.w) * tb1[2]; h[7] += bf_hi(pf.w) * tf1[3] + bf_hi(pb.w) * tb1[3];
        }
        u32x4 o;
        o.x = pk_bf16(h[0] * bf_lo(gt.x), h[1] * bf_hi(gt.x)); o.y = pk_bf16(h[2] * bf_lo(gt.y), h[3] * bf_hi(gt.y));
        o.z = pk_bf16(h[4] * bf_lo(gt.z), h[5] * bf_hi(gt.z)); o.w = pk_bf16(h[6] * bf_lo(gt.w), h[7] * bf_hi(gt.w));
        *(u32x4*)(Y + off) = o;
    }
}

#ifndef PG8_SP2
#define PG8_SP2 true
#endif
#ifndef PG8_ALIGN
#define PG8_ALIGN true
#endif

__device__ __forceinline__ void shw_phase(int wv, const PT pt, LAS unsigned char* lds, const int site, int bx, int G) {
    const int tid = tid_l(wv), lane = tid & 63;
    unsigned char* ws = pt.ws();
    const int lb = bx, nb = G;
    LAS float* sl = (LAS float*)lds;
    const float* mod = (const float*)(ws + WS_MOD);
    const int l = site ? 1 : 0, chunk = (site == 1) ? 0 : 3, N = (site == 1) ? 2 * D : 2 * FF;
    const bf16_t* Wt = site == 0 ? (const bf16_t*)(ws + WS_WGU) : (site == 1 ? (const bf16_t*)(ws + WS_WIN) : (const bf16_t*)(ws + WS_WGU) + (size_t)2 * FF * D);
    float* out = (float*)(ws + WS_SHW) + (site == 0 ? SHW_OFF0 : (site == 1 ? SHW_OFF1 : SHW_OFF2));
    __syncthreads();
#pragma unroll
    for (int r = 0; r < 3; ++r) {
        float v[6];
#pragma unroll
        for (int j = 0; j < 6; ++j) { const int i = tid + 512 * (6 * r + j); v[j] = mod[((size_t)l * 9 + (i >> 10)) * NMOD + chunk * D + (i & 1023)]; }
#pragma unroll
        for (int j = 0; j < 6; ++j) sl[tid + 512 * (6 * r + j)] = v[j];
    }
    __syncthreads();
    const int step = nb * 8;
    int n = lb * 8 + wv;
    u32x2 wa[4];
    if (n < N) {
#pragma unroll
        for (int j = 0; j < 4; ++j) wa[j] = *(const u32x2*)(Wt + (size_t)n * D + 4 * lane + 256 * j);
    }
    for (; n < N; n += step) {
        u32x2 wb[4];
        const int n2 = n + step;
        if (n2 < N) {
#pragma unroll
            for (int j = 0; j < 4; ++j) wb[j] = *(const u32x2*)(Wt + (size_t)n2 * D + 4 * lane + 256 * j);
        }
        float res = 0.f;
#pragma unroll
        for (int cv = 0; cv < 9; ++cv) {
            float s = 0.f;
#pragma unroll
            for (int j = 0; j < 4; ++j) { const f32x4 v = *(const LAS f32x4*)(sl + cv * D + 4 * lane + 256 * j); s += (v[0] * bf_lo(wa[j].x) + v[1] * bf_hi(wa[j].x)) + (v[2] * bf_lo(wa[j].y) + v[3] * bf_hi(wa[j].y)); }
            s = wave_sum(s, lane);
            if (lane == cv) res = s;
        }
        if (lane < 9) out[(size_t)lane * N + n] = res;
#pragma unroll
        for (int j = 0; j < 4; ++j) wa[j] = wb[j];
    }
    __syncthreads();
}

#ifndef PHMASK
#define PHMASK 0xffff
#endif
constexpr int PHM = PHMASK;
__global__ void __launch_bounds__(512, 2) fwd_megakernel(Args a) {
    extern __shared__ __attribute__((aligned(16))) unsigned char lds_raw[];
    LAS unsigned char* lds = (LAS unsigned char*)lds_raw;
    cg::grid_group grid = cg::this_grid();
    const int wv = __builtin_amdgcn_readfirstlane(threadIdx.x >> 6);
    {
        LAS unsigned long long* tw = (LAS unsigned long long*)(lds + PTAB_OFF);
        if (threadIdx.x == 0) {
            tw[0] = (unsigned long long)a.x_prompt; tw[1] = (unsigned long long)a.x_sample; tw[2] = (unsigned long long)a.c; tw[3] = (unsigned long long)a.cache_k; tw[4] = (unsigned long long)a.cache_v;
            tw[5] = (unsigned long long)a.state_h; tw[6] = (unsigned long long)a.c_ctx; tw[7] = (unsigned long long)a.norm_g; tw[8] = (unsigned long long)a.w_mod; tw[9] = (unsigned long long)a.b_mod;
            tw[10] = (unsigned long long)a.w_qkv; tw[11] = (unsigned long long)a.w_o; tw[12] = (unsigned long long)a.rpb; tw[13] = (unsigned long long)a.w_in; tw[14] = (unsigned long long)a.conv_w;
            tw[15] = (unsigned long long)a.conv_b; tw[16] = (unsigned long long)a.w_a; tw[17] = (unsigned long long)a.b_a; tw[18] = (unsigned long long)a.w_i; tw[19] = (unsigned long long)a.b_i;
            tw[20] = (unsigned long long)a.lam; tw[21] = (unsigned long long)a.w_out; tw[22] = (unsigned long long)a.w_gu; tw[23] = (unsigned long long)a.w_down; tw[24] = (unsigned long long)a.final_g;
            tw[25] = (unsigned long long)a.out; tw[26] = (unsigned long long)a.ws;
            LAS unsigned* st = (LAS unsigned*)(lds + BARST_OFF); st[0] = 0u; st[1] = 0u;
            (void)xb_add((unsigned*)(a.ws + WS_BAR) + XB_XCNT(xb_xcc_id()), 1u);
        }
        __syncthreads();
        if (a.out == nullptr) grid.sync();
    }
#define GSYNC() do { for (int rs_ = 0; rs_ < REP_SYNC; ++rs_) xcd_barrier(pt, lds, wv); } while (0)
    const PT pt{(LAS const unsigned long long*)(lds + PTAB_OFF)};
#define WSP(off) (pt.ws() + (off))
#define MODP ((float*)WSP(WS_MOD))
#define XNP ((bf16_t*)WSP(WS_XN))
#define XRES (pt.out() + OUT_Y)
#define XBP ((bf16_t*)WSP(WS_XB))
#define SSQP(i) ((float*)WSP(WS_SSQ) + (size_t)(i) * MT)

    if (PHM & 1) p0_prologue(wv, pt, lds);
    GSYNC();
    if (PHM & 2) for (int rep_ = 0; rep_ < REP_THIN; ++rep_) norm_phase(wv, pt.f(I_x_prompt), pt.f(I_x_sample), pt.f(I_norm_g), MODP, 0, XNP);
    GSYNC();
    if (PHM & 4) { pg8::Gemm g{XNP, (const bf16_t*)WSP(WS_WQKV), MT, NQKV, D, D, D, wv}; pg8::StaticOrder S; S.init(MT, NQKV, gd_l(), bx_l()); S.reps = REP_GEMM;
      pg8::EpiQKV E{(bf16_t*)WSP(WS_Q), pt.out() + OUT_NK, 0.125f * LOG2E};
      pg8::gemm_phase<pg8::EpiQKV, pg8::StaticOrder, PG8_ALIGN, PG8_SP2>(lds, g, S, E); }
    {
        const int G_ = gd_l(), c_ = bx_l(), nwg_ = (MT / 256) * (NQKV / 256), maxu_ = (nwg_ + G_ - 1) / G_, full_ = nwg_ - (maxu_ - 1) * G_;
        int rank_ = c_, n_ = G_;
        if (full_ < G_) { rank_ = c_ - full_; n_ = c_ >= full_ ? G_ - full_ : 0; }
        if (n_ > 0) { tr_items(wv, pt, lds, 16 * 96, 16 * 96 + 16 * 32 + 16 * 176, rank_ * 8 + wv, n_ * 8); }
    }
    GSYNC();
    if (PHM & 8) for (int rep_ = 0; rep_ < REP_ATT; ++rep_) for (int vc = vcu_l(), G_ = gd_l(); vc < 256; vc += G_) {
        const int bh = vc >> 1;
#pragma unroll 1
        for (int gi = 0; gi < 2; ++gi)
            att::unit<true>(wv, lds, bh >> 4, bh & 15, 2 * (vc & 1) + gi, (const bf16_t*)WSP(WS_Q), (const bf16_t*)WSP(WS_K), (const bf16_t*)WSP(WS_V), pt.f(I_cache_k), pt.f(I_cache_v), XNP, pt.f(I_rpb));
        att::unit<false>(wv, lds, vc >> 4, vc & 15, 0, (const bf16_t*)WSP(WS_Q), (const bf16_t*)WSP(WS_K), (const bf16_t*)WSP(WS_V), nullptr, nullptr, XNP, nullptr);
    }
    GSYNC();
    if (PHM & 16)
#pragma unroll 1
    for (int rp_ = REP_P4 - 1; rp_ >= 0; --rp_) { pg8::Gemm g{XNP, (const bf16_t*)WSP(WS_WO), MT, D, D, D, D, wv}; pg8::StaticOrder S; S.init(MT, D, gd_l(), bx_l());
      pg8::EpiResT<true, true> E{pt.f(I_x_prompt), pt.f(I_x_sample), XBP, MODP + 2 * D, (bf16_t*)WSP(WS_XN2), pt.f(I_norm_g) + D, MODP + 4 * D, rp_ ? (float*)WSP(WS_HLF) : SSQP(0)};
      pg8::gemm_phase<pg8::EpiResT<true, true>, pg8::StaticOrder, false, PG8_SP2>(lds, g, S, E); }
    {
        const int G_ = gd_l(), c_ = bx_l(), nwg_ = (MT / 256) * (D / 256);
        int rank_ = c_, n_ = G_;
        if (nwg_ < G_) { rank_ = c_ - nwg_; n_ = c_ >= nwg_ ? G_ - nwg_ : 0; }
        if (n_ > 0) { shw_phase(wv, pt, lds, 0, rank_, n_); tr_items(wv, pt, lds, 16 * 96 + 16 * 32 + 16 * 176, 16 * 96 + 16 * 32 + 16 * 176 + 44 * 32, rank_ * 8 + wv, n_ * 8); }
    }
    GSYNC();
    if (PHM & 512) { pg8::Gemm g{(const bf16_t*)WSP(WS_XN2), (const bf16_t*)WSP(WS_WGU), MT, 2 * FF, D, D, D, wv}; pg8::StaticOrder S; S.init(MT, 2 * FF, gd_l(), bx_l()); S.reps = REP_GEMM;
      pg8::EpiSwiglu E{(bf16_t*)WSP(WS_H), SSQP(0), (const float*)WSP(WS_SHW) + SHW_OFF0};
      pg8::gemm_phase<pg8::EpiSwiglu, pg8::StaticOrder, PG8_ALIGN, PG8_SP2>(lds, g, S, E); }
    {
        const int G_ = gd_l(), c_ = bx_l(), nwg_ = (MT / 256) * (2 * FF / 256), maxu_ = (nwg_ + G_ - 1) / G_, full_ = nwg_ - (maxu_ - 1) * G_;
        int rank_ = c_, n_ = G_;
        if (full_ < G_) { rank_ = c_ - full_; n_ = c_ >= full_ ? G_ - full_ : 0; }
        if (n_ > 0) { adaln_tasks(wv, pt, lds, 1, rank_, n_); tr_items(wv, pt, lds, 16 * 96 + 16 * 32 + 2 * 16 * 176 + 44 * 32, 12288, rank_ * 8 + wv, n_ * 8); }
    }
    GSYNC();
    if (PHM & 16) { pg8::Gemm g{(const bf16_t*)WSP(WS_H), (const bf16_t*)WSP(WS_WDN), MT, D, FF, FF, FF, wv}; pg8::StaticOrder S; S.init(MT, D, gd_l(), bx_l());
      pg8::EpiResT<true, false> E{nullptr, nullptr, XBP, MODP + 5 * D, XNP, pt.f(I_norm_g) + 2 * D, MODP + (size_t)9 * NMOD + 1 * D, SSQP(1)};
      pg8::gemm_phase<pg8::EpiResT<true, false>, pg8::StaticOrder, false, PG8_SP2>(lds, g, S, E); }
    {
        const int G_ = gd_l(), c_ = bx_l(), nwg_ = (MT / 256) * (D / 256);
        int rank_ = c_, n_ = G_;
        if (nwg_ < G_) { rank_ = c_ - nwg_; n_ = c_ >= nwg_ ? G_ - nwg_ : 0; }
        if (n_ > 0) { shw_phase(wv, pt, lds, 1, rank_, n_); tr_items(wv, pt, lds, 16 * 96 + 16 * 32 + 16 * 176 + 44 * 32, 16 * 96 + 16 * 32 + 2 * 16 * 176 + 44 * 32, rank_ * 8 + wv, n_ * 8); }
    }
    GSYNC();
    if (PHM & 32) { pg8::Gemm g{XNP, (const bf16_t*)WSP(WS_WIN), MT, 2 * D, D, D, D, wv}; pg8::StaticOrder S; S.init(MT, 2 * D, gd_l(), bx_l()); S.reps = REP_GEMM;
      pg8::EpiWin E{(bf16_t*)WSP(WS_GATE), (bf16_t*)WSP(WS_XR), SSQP(1), (const float*)WSP(WS_SHW) + SHW_OFF1};
      pg8::gemm_phase<pg8::EpiWin, pg8::StaticOrder, PG8_ALIGN, PG8_SP2>(lds, g, S, E); }
    {
        const int G_ = gd_l(), c_ = bx_l(), nwg_ = (MT / 256) * (2 * D / 256), maxu_ = (nwg_ + G_ - 1) / G_, full_ = nwg_ - (maxu_ - 1) * G_;
        int rank_ = c_, n_ = G_;
        if (full_ < G_) { rank_ = c_ - full_; n_ = c_ >= full_ ? G_ - full_ : 0; }
        if (n_ > 0) shw_phase(wv, pt, lds, 2, rank_, n_);
    }
    GSYNC();
    if (PHM & 128)
#pragma unroll 1
    for (int uu = vcu_l(), G_ = gd_l(); uu < 768 * REP_LRU; uu += G_) {
        const int u = uu % 768;
        const int dir = u & 1, n = (u >> 1) & 7, q = u >> 4;
        const float* h0 = nullptr;
        if (q >= 16) { const int b = (q - 16) >> 2, ci = (q - 16) & 3; if ((dir == 0 && ci == 0) || (dir == 1 && ci == 3)) h0 = pt.f(I_state_h) + ((size_t)b * 2 + dir) * D; }
        conv_slab(wv, (const bf16_t*)WSP(WS_XR), pt.f(I_conv_w), pt.f(I_conv_b), XNP, q, n);
        pg8::Gemm g{XNP + (size_t)q * 256 * D + n * 128, (const bf16_t*)WSP(WS_WG) + (size_t)(n * 2 + dir) * 256 * 128, 256, 256, 128, D, 128, wv};
        pg8::OneUnit S;
        pg8::EpiLru E{pt.t, h0, q * 256, n * 128, dir, q};
        pg8::gemm_phase<pg8::EpiLru, pg8::OneUnit, false, false>(lds, g, S, E);
    }
    GSYNC();
    if (PHM & 256) for (int rep_ = 0; rep_ < REP_THIN; ++rep_) lru_combine_phase(wv, pt.ws(), (bf16_t*)WSP(WS_Y));
    GSYNC();
    if (PHM & 16) { pg8::Gemm g{(const bf16_t*)WSP(WS_Y), (const bf16_t*)WSP(WS_WOUT), MT, D, D, D, D, wv}; pg8::StaticOrder S; S.init(MT, D, gd_l(), bx_l());
      pg8::EpiResT<true, false> E{nullptr, nullptr, XBP, MODP + (size_t)9 * NMOD + 2 * D, XNP, pt.f(I_norm_g) + 3 * D, MODP + (size_t)9 * NMOD + 4 * D, SSQP(2)};
      pg8::gemm_phase<pg8::EpiResT<true, false>, pg8::StaticOrder, false, PG8_SP2>(lds, g, S, E); }
    GSYNC();
    if (PHM & 512) { pg8::Gemm g{XNP, (const bf16_t*)WSP(WS_WGU) + (size_t)2 * FF * D, MT, 2 * FF, D, D, D, wv}; pg8::StaticOrder S; S.init(MT, 2 * FF, gd_l(), bx_l()); S.reps = REP_GEMM;
      pg8::EpiSwiglu E{(bf16_t*)WSP(WS_H), SSQP(2), (const float*)WSP(WS_SHW) + SHW_OFF2};
      pg8::gemm_phase<pg8::EpiSwiglu, pg8::StaticOrder, PG8_ALIGN, PG8_SP2>(lds, g, S, E); }
    GSYNC();
    if (gd_l() >= (MT / 256) * (D / 256)) {
        pg8::Gemm g{(const bf16_t*)WSP(WS_H), (const bf16_t*)WSP(WS_WDN) + (size_t)D * FF, MT, D, FF, FF, FF, wv}; pg8::StaticOrder S; S.init(MT, D, gd_l(), bx_l());
        pg8::EpiResFinal E{XBP, MODP + (size_t)9 * NMOD + 5 * D, SSQP(3), (unsigned*)WSP(WS_FCNT), pt.f(I_final_g), XRES};
        pg8::gemm_phase<pg8::EpiResFinal, pg8::StaticOrder, true, PG8_SP2>(lds, g, S, E);
    } else {
        { pg8::Gemm g{(const bf16_t*)WSP(WS_H), (const bf16_t*)WSP(WS_WDN) + (size_t)D * FF, MT, D, FF, FF, FF, wv}; pg8::StaticOrder S; S.init(MT, D, gd_l(), bx_l());
          pg8::EpiResT<false, false> E{nullptr, nullptr, XBP, MODP + (size_t)9 * NMOD + 5 * D, nullptr, nullptr, nullptr, nullptr};
          pg8::gemm_phase<pg8::EpiResT<false, false>, pg8::StaticOrder, PG8_ALIGN, PG8_SP2>(lds, g, S, E); }
        GSYNC();
        final_norm_phase(wv, XBP, XRES, pt.f(I_final_g));
    }
}

extern "C" void kernel_launch(void* const* d_in, const int* in_sizes, int n_in, void* d_out, int out_size, void* d_ws, size_t ws_size, hipStream_t stream) {
    static int grid = 0;
    if (grid == 0) {
        int dev = 0, cus = 0, per_cu = 0;
        (void)hipGetDevice(&dev);
        (void)hipDeviceGetAttribute(&cus, hipDeviceAttributeMultiprocessorCount, dev);
        (void)hipFuncSetAttribute((const void*)fwd_megakernel, hipFuncAttributeMaxDynamicSharedMemorySize, LDS_BYTES);
        (void)hipOccupancyMaxActiveBlocksPerMultiprocessor(&per_cu, (const void*)fwd_megakernel, 512, LDS_BYTES);
        if (per_cu < 1) { fprintf(stderr, "kernel_launch: occupancy query says %d blocks per CU\n", per_cu); per_cu = 1; }
        grid = cus * per_cu;
        if (ws_size < WS_END) { fprintf(stderr, "kernel_launch: workspace too small (%zu < %zu)\n", ws_size, (size_t)WS_END); grid = -1; }
    }
    if (grid < 0) return;
    (void)hipMemsetAsync((char*)d_ws + WS_MOD, 0, 1024 * 1024, stream);
    Args a{};
    const float** ap = (const float**)&a;
    for (int i = 0; i < 25; ++i) ap[i] = (const float*)d_in[i];
    a.out = (float*)d_out; a.ws = (unsigned char*)d_ws;
    void* args[] = {&a};
    hipError_t e = hipLaunchCooperativeKernel((const void*)fwd_megakernel, dim3(grid), dim3(512), args, LDS_BYTES, stream);
    if (e != hipSuccess) fprintf(stderr, "cooperative launch failed: %s (grid %d)\n", hipGetErrorString(e), grid);
}
```

```cpp
#include <hip/hip_runtime.h>
#include <hip/hip_cooperative_groups.h>
#include <cstdio>
#include <cstdint>
namespace cg = cooperative_groups;

#define LAS __attribute__((address_space(3)))
typedef unsigned short bf16_t;
typedef short bf16x8 __attribute__((ext_vector_type(8)));
typedef short s16x4 __attribute__((ext_vector_type(4)));
typedef float f32x4 __attribute__((ext_vector_type(4)));
typedef float f32x2 __attribute__((ext_vector_type(2)));
typedef float f32x16 __attribute__((ext_vector_type(16)));
typedef unsigned u32x4 __attribute__((ext_vector_type(4)));
typedef unsigned u32x2 __attribute__((ext_vector_type(2)));
typedef __bf16 bf16x2_t __attribute__((ext_vector_type(2)));

constexpr int D = 1024, MC = 4096, ML = 8192, MT = MC + ML, FF = 2816, NQKV = 3072, NMOD = 6144;
constexpr float LOG2E = 1.4426950408889634f;
constexpr float RMS_EPS = 1e-6f;

constexpr size_t MiB = 1u << 20;
constexpr size_t WS_MOD = 0;
constexpr size_t WS_YCNT = 832 * 1024;
constexpr size_t WS_FCNT = 768 * 1024;
constexpr size_t WS_SSQ = 512 * 1024;
constexpr size_t WS_WQKV = 1 * MiB, WS_WO = 7 * MiB, WS_WGU = 9 * MiB, WS_WDN = 31 * MiB, WS_WIN = 42 * MiB, WS_WOUT = 46 * MiB, WS_WG = 48 * MiB;
constexpr size_t WS_CK = 49 * MiB, WS_CV = 57 * MiB;
constexpr size_t WS_PF = 49 * MiB;
constexpr size_t WS_XN = 65 * MiB;
constexpr size_t WS_Q = 89 * MiB, WS_K = 113 * MiB, WS_V = 137 * MiB;
constexpr size_t WS_H = 89 * MiB;
constexpr size_t WS_GATE = 89 * MiB, WS_XR = 113 * MiB, WS_Y = 113 * MiB;
constexpr size_t WS_XN2 = 161 * MiB;
constexpr size_t WS_PB = 137 * MiB;
constexpr size_t WS_XB = 185 * MiB;
constexpr size_t WS_HLF = 209 * MiB, WS_HLB = 161 * MiB;
constexpr size_t WS_SUMP = 250 * MiB;
constexpr size_t WS_SUME = 250 * MiB + 512 * 1024;
constexpr size_t WS_SHW = 252 * MiB;
constexpr int SHW_OFF0 = 0, SHW_OFF1 = 9 * 5632, SHW_OFF2 = 9 * 5632 + 9 * 2048;
constexpr size_t WS_END = 256 * MiB;

constexpr int LDS_BYTES = 143360;
constexpr int AB_PITCH = 1056;
constexpr int HST_OFF = 128 * AB_PITCH;

enum { I_x_prompt = 0, I_x_sample = 1, I_c = 2, I_cache_k = 3, I_cache_v = 4, I_state_h = 5, I_c_ctx = 6, I_norm_g = 7, I_w_mod = 8, I_b_mod = 9, I_w_qkv = 10, I_w_o = 11, I_rpb = 12, I_w_in = 13, I_conv_w = 14, I_conv_b = 15, I_w_a = 16, I_b_a = 17, I_w_i = 18, I_b_i = 19, I_lam = 20, I_w_out = 21, I_w_gu = 22, I_w_down = 23, I_final_g = 24, I_out = 25, I_ws = 26 };
constexpr int PTAB_OFF = LDS_BYTES - 256;
struct PT {
    LAS const unsigned long long* t;
    __device__ __forceinline__ unsigned long long raw(int i) const { const unsigned long long v = t[i]; const unsigned lo = __builtin_amdgcn_readfirstlane((unsigned)v), hi = __builtin_amdgcn_readfirstlane((unsigned)(v >> 32)); return ((unsigned long long)hi << 32) | lo; }
    __device__ __forceinline__ const float* f(int i) const { return (const float*)(const __attribute__((address_space(1))) float*)raw(i); }
    __device__ __forceinline__ float* out() const { return (float*)(__attribute__((address_space(1))) float*)raw(I_out); }
    __device__ __forceinline__ unsigned char* ws() const { return (unsigned char*)(__attribute__((address_space(1))) unsigned char*)raw(I_ws); }
};
constexpr size_t OUT_Y = 0, OUT_NK = (size_t)MT * D, OUT_NV = OUT_NK + (size_t)MC * D, OUT_NH = OUT_NV + (size_t)MC * D;
constexpr int CST_OFF = HST_OFF + 1024;
__device__ __forceinline__ int tid_l(int wv) { int l; asm volatile("v_mbcnt_lo_u32_b32 %0, -1, 0\n\tv_mbcnt_hi_u32_b32 %0, -1, %0" : "=v"(l)); return wv * 64 + l; }
__device__ __forceinline__ int bx_l() { int b = blockIdx.x; asm volatile("" : "+s"(b)); return b; }
__device__ __forceinline__ int gd_l() { int g = gridDim.x; asm volatile("" : "+s"(g)); return g; }
__device__ __forceinline__ int vcu_l() { const int b = bx_l(), g = gd_l(); return (g & 7) ? b : (b & 7) * (g >> 3) + (b >> 3); }

constexpr size_t WS_BAR = 448 * 1024;
constexpr int BARST_OFF = PTAB_OFF + 224;
#define XB_TMO      128
#define XB_XCNT(j)  (256  + 64 * (j))
#define XB_XSUB(j)  (1280 + 64 * (j))
#define XB_XGEN(j)  (2304 + 64 * (j))
#define XB_TOP      3328
#define XB_TOPGEN   3392
#define XCD_BAR_WORDS 3456
#define XB_SPIN_CAP (1u << 18)
__device__ __forceinline__ unsigned xb_ld(unsigned* p)              { return __hip_atomic_load(p, __ATOMIC_RELAXED, __HIP_MEMORY_SCOPE_AGENT); }
__device__ __forceinline__ unsigned xb_add(unsigned* p, unsigned v) { return __hip_atomic_fetch_add(p, v, __ATOMIC_RELAXED, __HIP_MEMORY_SCOPE_AGENT); }
__device__ __forceinline__ unsigned xb_xcc_id() { return (unsigned)__builtin_amdgcn_s_getreg((3 << 11) | 20) & 0xFu; }
#define XB_SPIN(cond, bar) do { unsigned _sp = 0; while (cond) { __builtin_amdgcn_s_sleep(1); \
    if ((++_sp & 255u) == 0u) { if (xb_ld(&(bar)[XB_TMO])) break; if (_sp > XB_SPIN_CAP) { atomicAdd(&(bar)[XB_TMO], 1u); break; } } } } while (0)
__device__ __forceinline__ void xcd_barrier_complete(unsigned* bar, unsigned x, unsigned& nloc, unsigned& nx) {
    const unsigned G = gridDim.x;
    unsigned sum, cnt, mine, sp = 0u;
    for (;;) {
        sum = 0u; cnt = 0u; mine = 0u;
#pragma unroll
        for (unsigned j = 0; j < 16; ++j) { const unsigned c = xb_ld(&bar[XB_XCNT(j)]); sum += c; cnt += (c > 0u) ? 1u : 0u; mine = (j == x) ? c : mine; }
        if (sum == G) break;
        __builtin_amdgcn_s_sleep(1);
        if ((++sp & 255u) == 0u) { if (xb_ld(&bar[XB_TMO])) break; if (sp > XB_SPIN_CAP) { atomicAdd(&bar[XB_TMO], 1u); break; } }
    }
    nloc = mine > 0u ? mine : 1u; nx = cnt > 0u ? cnt : 1u;
}
__device__ __forceinline__ void xcd_barrier(const PT pt, LAS unsigned char* lds, int wv) {
    asm volatile("s_waitcnt vmcnt(0)" ::: "memory");
    __syncthreads();
    if (tid_l(wv) == 0) {
        unsigned* bar = (unsigned*)(pt.ws() + WS_BAR);
        volatile LAS unsigned* st = (volatile LAS unsigned*)(lds + BARST_OFF);
        const unsigned x = xb_xcc_id();
        __builtin_amdgcn_s_waitcnt(0);
        unsigned nloc = st[0], nx = st[1];
        if (nloc == 0u) { xcd_barrier_complete(bar, x, nloc, nx); st[0] = nloc; st[1] = nx; }
        const unsigned old = xb_add(&bar[XB_XSUB(x)], 1u);
        const unsigned gen = old / nloc;
        if (old + 1u == (gen + 1u) * nloc) {
            __builtin_amdgcn_fence(__ATOMIC_RELEASE, "agent");
            asm volatile("s_waitcnt vmcnt(0)" ::: "memory");
            const unsigned og = xb_add(&bar[XB_TOP], 1u);
            const unsigned tg = og / nx;
            if (og + 1u == (tg + 1u) * nx) xb_add(&bar[XB_TOPGEN], 1u);
            else XB_SPIN(xb_ld(&bar[XB_TOPGEN]) == tg, bar);
            __builtin_amdgcn_fence(__ATOMIC_ACQUIRE, "agent");
            xb_add(&bar[XB_XGEN(x)], 1u);
            asm volatile("s_waitcnt vmcnt(0)" ::: "memory");
        } else {
            XB_SPIN(xb_ld(&bar[XB_XGEN(x)]) == gen, bar);
            __builtin_amdgcn_fence(__ATOMIC_ACQUIRE, "agent");
            asm volatile("s_waitcnt vmcnt(0)" ::: "memory");
        }
    }
    __syncthreads();
}
__device__ __forceinline__ unsigned pk_bf16(float lo, float hi) { f32x2 v = {lo, hi}; bf16x2_t b = __builtin_convertvector(v, bf16x2_t); return __builtin_bit_cast(unsigned, b); }
__device__ __forceinline__ float bf_lo(unsigned u) { return __uint_as_float(u << 16); }
__device__ __forceinline__ float bf_hi(unsigned u) { return __uint_as_float(u & 0xffff0000u); }
__device__ __forceinline__ float fast_rcp(float x) { return __builtin_amdgcn_rcpf(x); }
__device__ __forceinline__ float fast_exp2(float x) { return __builtin_amdgcn_exp2f(x); }
__device__ __forceinline__ float sigmoid_f(float x) { return fast_rcp(1.f + fast_exp2(-x * LOG2E)); }
__device__ __forceinline__ float silu_f(float x) { return x * sigmoid_f(x); }
__device__ __forceinline__ float gelu_tanh_f(float x) { const float u = 0.7978845608028654f * (x + 0.044715f * x * x * x); return x * sigmoid_f(2.f * u); }
__device__ __forceinline__ float shfl_xor_l(float v, int mask, int lane) { return __int_as_float(__builtin_amdgcn_ds_bpermute((lane ^ mask) << 2, __float_as_int(v))); }
__device__ __forceinline__ float wave_sum(float v, int lane) {
#pragma unroll
    for (int o = 1; o < 64; o <<= 1) v += shfl_xor_l(v, o, lane);
    return v;
}
namespace pg8 {
#define PG8_LAS __attribute__((address_space(3)))
constexpr int BM = 256, BK = 64, HALF = 128, HTB = HALF * BK * 2  , STAGE_BYTES = 8 * HTB, NXCD = 8, WGM = 4;

__host__ __device__ __forceinline__ int lds_byte(int r, int c) { const int st = (r >> 4) * 2 + (c >> 5), rr = r & 15, cc = c & 31, ob = rr * 64 + cc * 2; return st * 1024 + (ob ^ (((ob >> 9) & 1) << 5)); }
__host__ __device__ __forceinline__ void stage_rc(int b, int& R, int& C) { const int st = b / 1024, sb = b % 1024, swz = sb ^ (((sb >> 9) & 1) << 5); R = (st >> 1) * 16 + swz / 64; C = (st & 1) * 32 + (swz % 64) / 2; }
__host__ __device__ __forceinline__ int perm32(int rho) { const int n = rho >> 4, i = rho & 15; return 8 * (i >> 2) + 4 * n + (i & 3); }

struct Unit { int pm, pn; };
struct Gemm { const bf16_t* A; const bf16_t* Bt; int M, N, K, lda, ldb, wv; };

struct StaticOrder {
    int nM, nN, nwg, G, c;
    int reps = 1;
    __host__ __device__ __forceinline__ void init(int M, int N, int G_, int c_) { nM = M / BM; nN = N / BM; nwg = nM * nN; G = G_; c = c_; }
    __host__ __device__ __forceinline__ bool next(int i, Unit& u) const {
        const long L = (long)(i / reps) * G + c; if (L >= nwg) return false;
        int wgid = (int)L; { const int q = nwg / NXCD, r = nwg % NXCD, xcd = wgid % NXCD, off = wgid / NXCD; wgid = (xcd < r ? xcd * (q + 1) : r * (q + 1) + (xcd - r) * q) + off; }
        const int nig = WGM * nN, gid = wgid / nig, fm = gid * WGM, gsz = (nM - fm) < WGM ? (nM - fm) : WGM;
        u.pm = fm + ((wgid % nig) % gsz); u.pn = (wgid % nig) / gsz; return true;
    }
    __device__ __forceinline__ void a_ready(const Unit&) const {}
    __device__ __forceinline__ void done(const Unit&) const {}
};


template <class Epi, class Sched, bool ALIGN_EPI = false, bool SP2 = false>
__device__ __forceinline__ void gemm_phase(PG8_LAS unsigned char* lds, const Gemm g, const Sched& S, const Epi& E) {
    int wid_ = g.wv; asm volatile("" : "+s"(wid_));
    const int tid = tid_l(wid_), wid = wid_, lane = tid & 63, wr = wid >> 2, wc = wid & 3, fr = lane & 15, fq = lane >> 4;
    const int K = g.K, nt = K / BK;
    unsigned voffA[2], voffB[2];
#pragma unroll
    for (int i = 0; i < 2; ++i) { int R, C; stage_rc(tid * 16 + i * 8192, R, C); const int Rb = Epi::PERM ? ((R & ~31) + perm32(R & 31)) : R;
        voffA[i] = (unsigned)(R * g.lda + C) * 2u; voffB[i] = (unsigned)(Rb * g.ldb + C) * 2u; }
    const size_t kstep = (size_t)(BK * 2);
    const size_t hstepA = (size_t)HALF * g.lda * 2, hstepB = (size_t)HALF * g.ldb * 2;
    const size_t tstepA = 2 * hstepA, tstepB = 2 * hstepB;
    const unsigned ldsw = (unsigned)wid * 1024u;
    const int aoff = lds_byte(wr * 64 + fr, fq * 8), boff = lds_byte(wc * 32 + fr, fq * 8);
#define PG8_SA(b, h) (((b) * 2 + (h)) * HTB)
#define PG8_SB(b, h) ((4 + (b) * 2 + (h)) * HTB)
#define PG8_STAGE(bufoff, gbase, voff) do { _Pragma("unroll") for (int _i = 0; _i < 2; ++_i) \
        __builtin_amdgcn_global_load_lds((const unsigned*)((const char*)(gbase) + (voff)[_i]), (PG8_LAS unsigned*)(lds + (bufoff) + ldsw + _i * 8192), 16, 0, 0); } while (0)
#define PG8_LDA(dst, b, h) do { _Pragma("unroll") for (int m = 0; m < 4; ++m) _Pragma("unroll") for (int k = 0; k < 2; ++k) dst[m][k] = *(const PG8_LAS bf16x8*)(lds + PG8_SA(b, h) + aoff + m * 2048 + k * 1024); } while (0)
#define PG8_LDB(dst, b, h) do { _Pragma("unroll") for (int n = 0; n < 2; ++n) _Pragma("unroll") for (int k = 0; k < 2; ++k) dst[n][k] = *(const PG8_LAS bf16x8*)(lds + PG8_SB(b, h) + boff + n * 2048 + k * 1024); } while (0)
#define PG8_MMA(ai, bj, At, Bt) do { __builtin_amdgcn_s_setprio(1); _Pragma("unroll") for (int m = 0; m < 4; ++m) _Pragma("unroll") for (int n = 0; n < 2; ++n) _Pragma("unroll") for (int k = 0; k < 2; ++k) \
        acc[ai][bj][m][n] = __builtin_amdgcn_mfma_f32_16x16x32_bf16(Bt[n][k], At[m][k], acc[ai][bj][m][n], 0, 0, 0); __builtin_amdgcn_s_setprio(0); } while (0)
#define PG8_WAIT_V(n) asm volatile("s_waitcnt vmcnt(" #n ")" ::: "memory")
#define PG8_WAIT_L(n) asm volatile("s_waitcnt lgkmcnt(" #n ")" ::: "memory")
#define PG8_BAR __builtin_amdgcn_s_barrier()
#define PG8_SCHED __builtin_amdgcn_sched_barrier(0)
    Unit cur, nxt; int ui = 0;
    if (!S.next(0, cur)) return;
    f32x4 acc[2][2][4][2];
#pragma unroll
    for (int a = 0; a < 2; ++a)
#pragma unroll
        for (int b = 0; b < 2; ++b)
#pragma unroll
            for (int m = 0; m < 4; ++m)
#pragma unroll
                for (int n = 0; n < 2; ++n) acc[a][b][m][n] = (f32x4){0.f, 0.f, 0.f, 0.f};
    bf16x8 At[4][2], B0[2][2], B1[2][2];
    const char* cA = (const char*)g.A + (size_t)cur.pm * tstepA; const char* cB = (const char*)g.Bt + (size_t)cur.pn * tstepB;
    S.a_ready(cur);
    if constexpr (SP2) {
        PG8_STAGE(PG8_SB(0, 0), cB, voffB); PG8_STAGE(PG8_SB(0, 1), cB + hstepB, voffB); PG8_STAGE(PG8_SA(0, 0), cA, voffA); PG8_STAGE(PG8_SA(0, 1), cA + hstepA, voffA);
        if (wr == 1) PG8_BAR;
        PG8_WAIT_V(2); PG8_BAR;
        PG8_STAGE(PG8_SB(1, 0), cB + kstep, voffB); PG8_STAGE(PG8_SA(1, 0), cA + kstep, voffA); PG8_STAGE(PG8_SB(1, 1), cB + hstepB + kstep, voffB);
        PG8_WAIT_V(6); PG8_BAR;
    } else {
        PG8_STAGE(PG8_SB(0, 0), cB, voffB); PG8_STAGE(PG8_SA(0, 0), cA, voffA); PG8_STAGE(PG8_SB(0, 1), cB + hstepB, voffB); PG8_STAGE(PG8_SA(0, 1), cA + hstepA, voffA);
        if (wr == 1) PG8_BAR;
        PG8_WAIT_V(4); PG8_BAR;
        PG8_STAGE(PG8_SB(1, 0), cB + kstep, voffB); PG8_STAGE(PG8_SA(1, 0), cA + kstep, voffA); PG8_STAGE(PG8_SB(1, 1), cB + hstepB + kstep, voffB);
        PG8_WAIT_V(6); PG8_BAR;
    }
    for (;;) {
        const bool has_next = S.next(ui + 1, nxt);
        const char* nA = has_next ? (const char*)g.A + (size_t)nxt.pm * tstepA : cA; const char* nB = has_next ? (const char*)g.Bt + (size_t)nxt.pn * tstepB : cB;
        for (int t = 0; t < nt; t += 2) {
            const bool last = (t == nt - 2);
            const char* a1 = cA + (size_t)(t + 1) * kstep;
            const char* a2 = last ? nA : cA + (size_t)(t + 2) * kstep; const char* b2 = last ? nB : cB + (size_t)(t + 2) * kstep;
            const char* a3 = a2 + kstep; const char* b3 = b2 + kstep;
            if (last && has_next) S.a_ready(nxt);
            if constexpr (SP2) {
            PG8_LDB(B0, 0, 0); PG8_LDB(B1, 0, 1); PG8_SCHED; PG8_LDA(At, 0, 0); PG8_STAGE(PG8_SA(1, 1), a1 + hstepA, voffA);
            PG8_WAIT_V(8); PG8_WAIT_L(0); PG8_BAR; PG8_MMA(0, 0, At, B0); PG8_MMA(0, 1, At, B1); PG8_BAR; PG8_SCHED;
            PG8_LDA(At, 0, 1); PG8_STAGE(PG8_SB(0, 0), b2, voffB); PG8_STAGE(PG8_SB(0, 1), b2 + hstepB, voffB); PG8_STAGE(PG8_SA(0, 0), a2, voffA);
            PG8_WAIT_V(8); PG8_WAIT_L(0); PG8_BAR; PG8_MMA(1, 0, At, B0); PG8_MMA(1, 1, At, B1); PG8_BAR; PG8_SCHED;
            PG8_LDB(B0, 1, 0); PG8_LDB(B1, 1, 1); PG8_SCHED; PG8_LDA(At, 1, 0); PG8_STAGE(PG8_SA(0, 1), a2 + hstepA, voffA);
            PG8_WAIT_V(8); PG8_WAIT_L(0); PG8_BAR; PG8_MMA(0, 0, At, B0); PG8_MMA(0, 1, At, B1); PG8_BAR; PG8_SCHED;
            PG8_LDA(At, 1, 1); PG8_STAGE(PG8_SB(1, 0), b3, voffB); PG8_STAGE(PG8_SB(1, 1), b3 + hstepB, voffB); PG8_STAGE(PG8_SA(1, 0), a3, voffA);
            PG8_WAIT_V(8); PG8_WAIT_L(0); PG8_BAR; PG8_MMA(1, 0, At, B0); PG8_MMA(1, 1, At, B1); PG8_BAR; PG8_SCHED;
            } else {
            PG8_LDB(B0, 0, 0); PG8_SCHED; PG8_LDA(At, 0, 0); PG8_STAGE(PG8_SA(1, 1), a1 + hstepA, voffA);
            PG8_WAIT_L(8); PG8_BAR; PG8_WAIT_L(0); PG8_MMA(0, 0, At, B0); PG8_BAR; PG8_SCHED;
            PG8_LDB(B1, 0, 1); PG8_STAGE(PG8_SB(0, 0), b2, voffB);
            PG8_BAR; PG8_WAIT_L(0); PG8_MMA(0, 1, At, B1); PG8_BAR;
            PG8_LDA(At, 0, 1); PG8_STAGE(PG8_SA(0, 0), a2, voffA);
            PG8_BAR; PG8_WAIT_L(0); PG8_MMA(1, 0, At, B0); PG8_BAR; PG8_SCHED;
            PG8_STAGE(PG8_SB(0, 1), b2 + hstepB, voffB);
            PG8_WAIT_V(6); PG8_BAR; PG8_MMA(1, 1, At, B1); PG8_BAR;
            PG8_LDB(B0, 1, 0); PG8_SCHED; PG8_LDA(At, 1, 0); PG8_STAGE(PG8_SA(0, 1), a2 + hstepA, voffA);
            PG8_WAIT_L(8); PG8_BAR; PG8_WAIT_L(0); PG8_MMA(0, 0, At, B0); PG8_BAR; PG8_SCHED;
            PG8_LDB(B1, 1, 1); PG8_STAGE(PG8_SB(1, 0), b3, voffB);
            PG8_BAR; PG8_WAIT_L(0); PG8_MMA(0, 1, At, B1); PG8_BAR;
            PG8_LDA(At, 1, 1); PG8_STAGE(PG8_SA(1, 0), a3, voffA);
            PG8_BAR; PG8_WAIT_L(0); PG8_MMA(1, 0, At, B0); PG8_BAR; PG8_SCHED;
            PG8_STAGE(PG8_SB(1, 1), b3 + hstepB, voffB);
            PG8_WAIT_V(6); PG8_BAR; PG8_MMA(1, 1, At, B1); PG8_BAR;
            }
        }
        if constexpr (ALIGN_EPI) { if (wr == 0) PG8_BAR; }
        if constexpr (!Epi::AFTER_DRAIN) { E(acc, cur, wr, wc, fr, fq); S.done(cur); }
        if (!has_next) break;
#pragma unroll
        for (int a = 0; a < 2; ++a)
#pragma unroll
            for (int b = 0; b < 2; ++b)
#pragma unroll
                for (int m = 0; m < 4; ++m)
#pragma unroll
                    for (int n = 0; n < 2; ++n) acc[a][b][m][n] = (f32x4){0.f, 0.f, 0.f, 0.f};
        cur = nxt; cA = nA; cB = nB; ++ui;
        if constexpr (ALIGN_EPI) { if (wr == 1) PG8_BAR; }
    }
    PG8_WAIT_V(0);
    if constexpr (!ALIGN_EPI) { if (wr == 0) PG8_BAR; }
    PG8_BAR;
    if constexpr (Epi::AFTER_DRAIN) { E.fused(acc, cur, wr, wc, fr, fq, lds, wid, lane); S.done(cur); }
#undef PG8_SA
#undef PG8_SB
#undef PG8_STAGE
#undef PG8_LDA
#undef PG8_LDB
#undef PG8_MMA
#undef PG8_WAIT_V
#undef PG8_WAIT_L
#undef PG8_BAR
#undef PG8_SCHED
}
}

namespace pg8 {
struct OneUnit {
    __device__ __forceinline__ bool next(int i, Unit& u) const { if (i) return false; u.pm = 0; u.pn = 0; return true; }
    __device__ __forceinline__ void a_ready(const Unit&) const {}
    __device__ __forceinline__ void done(const Unit&) const {}
};
typedef f32x4 AccT[2][2][4][2];

struct EpiQKV {
    static constexpr bool PERM = true, AFTER_DRAIN = false;
    bf16_t* Q; float* newk; float qscale;
    __device__ __forceinline__ void operator()(const AccT& acc, const Unit& u, int wr, int wc, int fr, int fq) const {
        const int t = u.pn >> 2;
        bf16_t* base = Q + (size_t)t * MT * D;
        const float sc = t == 0 ? qscale : 1.f;
        float* fo = newk + (size_t)(t - 1) * MC * D;
        const bool wf = (t != 0) && (u.pm < MC / 256);
        const int colt = (u.pn & 3) * 256 + wc * 32 + 8 * fq, row0 = u.pm * 256 + wr * 64 + fr;
#pragma unroll
        for (int ai = 0; ai < 2; ++ai)
#pragma unroll
            for (int m = 0; m < 4; ++m) {
                const size_t ro = (size_t)(row0 + ai * 128 + m * 16) * D;
#pragma unroll
                for (int bj = 0; bj < 2; ++bj) {
                    const f32x4 v0 = acc[ai][bj][m][0] * sc, v1 = acc[ai][bj][m][1] * sc;
                    u32x4 w; w.x = pk_bf16(v0[0], v0[1]); w.y = pk_bf16(v0[2], v0[3]); w.z = pk_bf16(v1[0], v1[1]); w.w = pk_bf16(v1[2], v1[3]);
                    *(u32x4*)(base + ro + colt + bj * 128) = w;
                    if (wf) { *(f32x4*)(fo + ro + colt + bj * 128) = v0; *(f32x4*)(fo + ro + colt + bj * 128 + 4) = v1; }
                }
            }
    }
};
template <bool FUSE, bool SRCF32> struct EpiResT {
    static constexpr bool PERM = true, AFTER_DRAIN = false;
    const float *xa, *xb;
    bf16_t* xres;
    const float* gate;
    bf16_t* XNo; const float* gn; const float* scv; float* ssq;
    __device__ __forceinline__ void operator()(const AccT& acc, const Unit& u, int wr, int wc, int fr, int fq) const {
        const bool isc = u.pm < MC / 256;
        const int cv = isc ? 8 : ((u.pm - MC / 256) >> 2);
        const float* src = isc ? xa : xb - (size_t)MC * D;
        const int col0 = u.pn * 256 + wc * 32 + 8 * fq, row0 = u.pm * 256 + wr * 64 + fr;
        f32x4 gv[2][2], gm[2][2];
#pragma unroll
        for (int bj = 0; bj < 2; ++bj)
#pragma unroll
            for (int n = 0; n < 2; ++n) {
                const int c = col0 + bj * 128 + n * 4;
                gv[bj][n] = *(const f32x4*)(gate + (size_t)cv * NMOD + c);
                if (FUSE) gm[bj][n] = *(const f32x4*)(gn + c) * (*(const f32x4*)(scv + (size_t)cv * NMOD + c) + 1.f);
            }
#pragma unroll
        for (int ai = 0; ai < 2; ++ai)
#pragma unroll
        for (int mp = 0; mp < 2; ++mp) {
            f32x4 xs[2][2][2];
#pragma unroll
            for (int mm = 0; mm < 2; ++mm)
#pragma unroll
                for (int bj = 0; bj < 2; ++bj) {
                    const size_t o = (size_t)(row0 + ai * 128 + (2 * mp + mm) * 16) * D + col0 + bj * 128;
                    if (SRCF32) { xs[mm][bj][0] = *(const f32x4*)(src + o); xs[mm][bj][1] = *(const f32x4*)(src + o + 4); }
                    else { const u32x4 w = *(const u32x4*)(xres + o); xs[mm][bj][0] = (f32x4){bf_lo(w.x), bf_hi(w.x), bf_lo(w.y), bf_hi(w.y)}; xs[mm][bj][1] = (f32x4){bf_lo(w.z), bf_hi(w.z), bf_lo(w.w), bf_hi(w.w)}; }
                }
            asm volatile("" ::: "memory");
#pragma unroll
            for (int mm = 0; mm < 2; ++mm) {
                const int m = 2 * mp + mm;
                const int row = row0 + ai * 128 + m * 16;
                const size_t ro = (size_t)row * D + col0;
                float sq = 0.f;
#pragma unroll
                for (int bj = 0; bj < 2; ++bj) {
                    const f32x4 x0 = xs[mm][bj][0] + gv[bj][0] * acc[ai][bj][m][0], x1 = xs[mm][bj][1] + gv[bj][1] * acc[ai][bj][m][1];
                    { u32x4 w; w.x = pk_bf16(x0[0], x0[1]); w.y = pk_bf16(x0[2], x0[3]); w.z = pk_bf16(x1[0], x1[1]); w.w = pk_bf16(x1[2], x1[3]); *(u32x4*)(xres + ro + bj * 128) = w; }
                    if (FUSE) {
                        sq += ((x0[0] * x0[0] + x0[1] * x0[1]) + (x0[2] * x0[2] + x0[3] * x0[3])) + ((x1[0] * x1[0] + x1[1] * x1[1]) + (x1[2] * x1[2] + x1[3] * x1[3]));
                        const f32x4 y0 = x0 * gm[bj][0], y1 = x1 * gm[bj][1];
                        u32x4 w; w.x = pk_bf16(y0[0], y0[1]); w.y = pk_bf16(y0[2], y0[3]); w.z = pk_bf16(y1[0], y1[1]); w.w = pk_bf16(y1[2], y1[3]);
                        *(u32x4*)(XNo + ro + bj * 128) = w;
                    }
                }
                if (FUSE) { sq += shfl_xor_l(sq, 16, fr + 16 * fq); sq += shfl_xor_l(sq, 32, fr + 16 * fq); if (fq == 0) unsafeAtomicAdd(ssq + row, sq); }
            }
            asm volatile("" ::: "memory");
        }
    }
};
struct EpiResFinal {
    static constexpr bool PERM = true, AFTER_DRAIN = false;
    const bf16_t* xres; const float* gate; float* ssq; unsigned* cnt; const float* gfin; float* out;
    __device__ __forceinline__ void operator()(const AccT& acc_c, const Unit& u, int wr, int wc, int fr, int fq) const {
        AccT& acc = const_cast<AccT&>(acc_c);
        const int cv = u.pm < MC / 256 ? 8 : ((u.pm - MC / 256) >> 2);
        const int col0 = u.pn * 256 + wc * 32 + 8 * fq, row0 = u.pm * 256 + wr * 64 + fr, lane = fr + 16 * fq;
        f32x4 gv[2][2];
#pragma unroll
        for (int bj = 0; bj < 2; ++bj)
#pragma unroll
            for (int n = 0; n < 2; ++n) gv[bj][n] = *(const f32x4*)(gate + (size_t)cv * NMOD + col0 + bj * 128 + n * 4);
#pragma unroll
        for (int ai = 0; ai < 2; ++ai)
#pragma unroll
        for (int mp = 0; mp < 2; ++mp) {
            u32x4 xs[2][2];
#pragma unroll
            for (int mm = 0; mm < 2; ++mm)
#pragma unroll
                for (int bj = 0; bj < 2; ++bj) xs[mm][bj] = *(const u32x4*)(xres + (size_t)(row0 + ai * 128 + (2 * mp + mm) * 16) * D + col0 + bj * 128);
            asm volatile("" ::: "memory");
#pragma unroll
            for (int mm = 0; mm < 2; ++mm) {
                const int m = 2 * mp + mm;
                float sq = 0.f;
#pragma unroll
                for (int bj = 0; bj < 2; ++bj) {
                    const u32x4 w = xs[mm][bj];
                    const f32x4 x0 = (f32x4){bf_lo(w.x), bf_hi(w.x), bf_lo(w.y), bf_hi(w.y)} + gv[bj][0] * acc[ai][bj][m][0], x1 = (f32x4){bf_lo(w.z), bf_hi(w.z), bf_lo(w.w), bf_hi(w.w)} + gv[bj][1] * acc[ai][bj][m][1];
                    acc[ai][bj][m][0] = x0; acc[ai][bj][m][1] = x1;
                    sq += ((x0[0] * x0[0] + x0[1] * x0[1]) + (x0[2] * x0[2] + x0[3] * x0[3])) + ((x1[0] * x1[0] + x1[1] * x1[1]) + (x1[2] * x1[2] + x1[3] * x1[3]));
                }
                sq += shfl_xor_l(sq, 16, lane); sq += shfl_xor_l(sq, 32, lane);
                if (fq == 0) unsafeAtomicAdd(ssq + row0 + ai * 128 + m * 16, sq);
            }
        }
        asm volatile("s_waitcnt vmcnt(0)" ::: "memory");
        unsigned* c = cnt + 64 * u.pm;
        if (lane == 0) __hip_atomic_fetch_add(c, 1u, __ATOMIC_RELAXED, __HIP_MEMORY_SCOPE_AGENT);
        { unsigned sp = 0;
          while ((unsigned)__builtin_amdgcn_readfirstlane(__hip_atomic_load(c, __ATOMIC_RELAXED, __HIP_MEMORY_SCOPE_AGENT)) < 32u) { __builtin_amdgcn_s_sleep(2); if (++sp > (1u << 20)) break; } }
        float rs[2][4];
#pragma unroll
        for (int ai = 0; ai < 2; ++ai)
#pragma unroll
            for (int m = 0; m < 4; ++m) rs[ai][m] = __hip_atomic_load(ssq + row0 + ai * 128 + m * 16, __ATOMIC_RELAXED, __HIP_MEMORY_SCOPE_AGENT);
        f32x4 gf[2][2];
#pragma unroll
        for (int bj = 0; bj < 2; ++bj)
#pragma unroll
            for (int n = 0; n < 2; ++n) gf[bj][n] = *(const f32x4*)(gfin + col0 + bj * 128 + n * 4);
#pragma unroll
        for (int ai = 0; ai < 2; ++ai)
#pragma unroll
            for (int m = 0; m < 4; ++m) {
                const float rstd = __builtin_amdgcn_rsqf(rs[ai][m] * (1.f / D) + RMS_EPS);
                float* op = out + (size_t)(row0 + ai * 128 + m * 16) * D + col0;
#pragma unroll
                for (int bj = 0; bj < 2; ++bj) { *(f32x4*)(op + bj * 128) = acc[ai][bj][m][0] * rstd * gf[bj][0]; *(f32x4*)(op + bj * 128 + 4) = acc[ai][bj][m][1] * rstd * gf[bj][1]; }
            }
    }
};
struct EpiSwiglu {
    static constexpr bool PERM = true, AFTER_DRAIN = false;
    bf16_t* H; const float* ssq; const float* shw;
    __device__ __forceinline__ void operator()(const AccT& acc, const Unit& u, int wr, int wc, int fr, int fq) const {
        const int cv = u.pm < MC / 256 ? 8 : ((u.pm - MC / 256) >> 2);
        const int col0 = u.pn * 128 + wc * 32 + 8 * fq, row0 = u.pm * 256 + wr * 64 + fr;
        const float* sp = shw + (size_t)cv * 2 * FF + u.pn * 256 + wc * 32 + 8 * fq;
        const f32x4 sg0 = *(const f32x4*)(sp), sg1 = *(const f32x4*)(sp + 4), su0 = *(const f32x4*)(sp + 128), su1 = *(const f32x4*)(sp + 132);
        float rs[2][4];
#pragma unroll
        for (int ai = 0; ai < 2; ++ai)
#pragma unroll
            for (int m = 0; m < 4; ++m) rs[ai][m] = ssq[row0 + ai * 128 + m * 16];
        asm volatile("" ::: "memory");
#pragma unroll
        for (int ai = 0; ai < 2; ++ai)
#pragma unroll
            for (int m = 0; m < 4; ++m) rs[ai][m] = __builtin_amdgcn_rsqf(rs[ai][m] * (1.f / D) + RMS_EPS);
#pragma unroll
        for (int ai = 0; ai < 2; ++ai)
#pragma unroll
            for (int m = 0; m < 4; ++m) {
                const int row = row0 + ai * 128 + m * 16;
                const float rstd = rs[ai][m];
                float o[8];
#pragma unroll
                for (int n = 0; n < 2; ++n) {
                    const f32x4 gq = acc[ai][0][m][n] * rstd + (n ? sg1 : sg0), uq = acc[ai][1][m][n] * rstd + (n ? su1 : su0);
#pragma unroll
                    for (int j = 0; j < 4; ++j) o[n * 4 + j] = silu_f(gq[j]) * uq[j];
                }
                u32x4 w; w.x = pk_bf16(o[0], o[1]); w.y = pk_bf16(o[2], o[3]); w.z = pk_bf16(o[4], o[5]); w.w = pk_bf16(o[6], o[7]);
                *(u32x4*)(H + (size_t)row * FF + col0) = w;
            }
    }
};
struct EpiWin {
    static constexpr bool PERM = true, AFTER_DRAIN = false;
    bf16_t *G, *XR; const float* ssq; const float* shw;
    __device__ __forceinline__ void operator()(const AccT& acc, const Unit& u, int wr, int wc, int fr, int fq) const {
        const bool isg = u.pn < 4;
        const int cv = u.pm < MC / 256 ? 8 : ((u.pm - MC / 256) >> 2);
        bf16_t* base = isg ? G : XR;
        const int colt = (u.pn & 3) * 256 + wc * 32 + 8 * fq, row0 = u.pm * 256 + wr * 64 + fr;
        const float* sp = shw + (size_t)cv * 2 * D + u.pn * 256 + wc * 32 + 8 * fq;
        f32x4 sv[2][2];
#pragma unroll
        for (int bj = 0; bj < 2; ++bj) { sv[bj][0] = *(const f32x4*)(sp + bj * 128); sv[bj][1] = *(const f32x4*)(sp + bj * 128 + 4); }
        float rs[2][4];
#pragma unroll
        for (int ai = 0; ai < 2; ++ai)
#pragma unroll
            for (int m = 0; m < 4; ++m) rs[ai][m] = ssq[row0 + ai * 128 + m * 16];
        asm volatile("" ::: "memory");
#pragma unroll
        for (int ai = 0; ai < 2; ++ai)
#pragma unroll
            for (int m = 0; m < 4; ++m) rs[ai][m] = __builtin_amdgcn_rsqf(rs[ai][m] * (1.f / D) + RMS_EPS);
#pragma unroll
        for (int ai = 0; ai < 2; ++ai)
#pragma unroll
            for (int m = 0; m < 4; ++m) {
                const int row = row0 + ai * 128 + m * 16;
                const float rstd = rs[ai][m];
#pragma unroll
                for (int bj = 0; bj < 2; ++bj) {
                    f32x4 v0 = acc[ai][bj][m][0] * rstd + sv[bj][0], v1 = acc[ai][bj][m][1] * rstd + sv[bj][1];
                    if (isg) {
#pragma unroll
                        for (int j = 0; j < 4; ++j) { v0[j] = gelu_tanh_f(v0[j]); v1[j] = gelu_tanh_f(v1[j]); }
                    }
                    u32x4 w; w.x = pk_bf16(v0[0], v0[1]); w.y = pk_bf16(v0[2], v0[3]); w.z = pk_bf16(v1[0], v1[1]); w.w = pk_bf16(v1[2], v1[3]);
                    *(u32x4*)(base + (size_t)row * D + colt + bj * 128) = w;
                }
            }
    }
};
struct EpiLru {
    static constexpr bool PERM = true, AFTER_DRAIN = true;
    LAS const unsigned long long* ptab;
    const float* h0;
    int row_base, cb, dir, q;

    template <int AI>
    __device__ __forceinline__ void half(const AccT& acc, int wr, int wc, int fr, int fq, PG8_LAS unsigned char* lds, int tid,
                                         const u32x4 (&xall)[4], bf16_t* HL, bf16_t* PP) const {
#pragma unroll
        for (int m = 0; m < 4; ++m) {
            const int tl = wr * 64 + m * 16 + fr;
            const size_t row = (size_t)(row_base + AI * 128 + tl);
#pragma unroll
            for (int n = 0; n < 2; ++n) {
                asm volatile("" ::: "memory");
                const int chl = wc * 32 + 8 * fq + 4 * n;
                const PG8_LAS f32x4* cst = (const PG8_LAS f32x4*)(lds + CST_OFF + chl * 4);
                const f32x4 ba = cst[0], bi = cst[32], L2 = cst[64];
                u32x2 xw; xw.x = n ? xall[m].z : xall[m].x; xw.y = n ? xall[m].w : xall[m].y;
                const f32x4 xc = {bf_lo(xw.x), bf_hi(xw.x), bf_lo(xw.y), bf_hi(xw.y)};
                f32x4 av, bv;
#pragma unroll
                for (int j = 0; j < 4; ++j) {
                    const float za = acc[AI][0][m][n][j] + ba[j], zi = acc[AI][1][m][n][j] + bi[j];
                    const float r = sigmoid_f(za), ig = sigmoid_f(zi);
                    const float a = fast_exp2(r * L2[j]);
                    av[j] = a; bv[j] = __builtin_amdgcn_sqrtf(1.f - a * a) * (ig * xc[j]);
                }
                PG8_LAS f32x4* dst = (PG8_LAS f32x4*)(lds + tl * AB_PITCH + chl * 8);
                dst[0] = (f32x4){av[0], bv[0], av[1], bv[1]}; dst[1] = (f32x4){av[2], bv[2], av[3], bv[3]};
            }
        }
        __syncthreads();
        if (tid < 128) {
            PG8_LAS float* hst = (PG8_LAS float*)(lds + HST_OFF);
            float h = hst[tid], P = hst[128 + tid];
            PG8_LAS f32x2* col = (PG8_LAS f32x2*)(lds + tid * 8);
            if (dir == 0) {
#pragma unroll 8
                for (int t = 0; t < 128; ++t) { PG8_LAS f32x2* p = (PG8_LAS f32x2*)((PG8_LAS unsigned char*)col + t * AB_PITCH); const f32x2 ab = *p; h = ab.x * h + ab.y; P *= ab.x; *p = (f32x2){h, P}; }
            } else {
#pragma unroll 8
                for (int t = 127; t >= 0; --t) { PG8_LAS f32x2* p = (PG8_LAS f32x2*)((PG8_LAS unsigned char*)col + t * AB_PITCH); const f32x2 ab = *p; h = ab.x * h + ab.y; P *= ab.x; *p = (f32x2){h, P}; }
            }
            hst[tid] = h; hst[128 + tid] = P;
        }
        __syncthreads();
        const bool lat = row_base >= MC;
#pragma unroll
        for (int it = 0; it < 8; ++it) {
            const int idx = it * 512 + tid, tl = idx >> 5, c4 = (idx & 31) * 4;
            const PG8_LAS f32x4* src = (const PG8_LAS f32x4*)(lds + tl * AB_PITCH + c4 * 8);
            const f32x4 s0 = src[0], s1 = src[1];
            const size_t row = (size_t)(row_base + AI * 128 + tl);
            { u32x2 wh; wh.x = pk_bf16(s0[0], s0[2]); wh.y = pk_bf16(s1[0], s1[2]); *(u32x2*)(HL + row * D + cb + c4) = wh; }
            if (lat) { u32x2 w; w.x = pk_bf16(s0[1], s0[3]); w.y = pk_bf16(s1[1], s1[3]); *(u32x2*)(PP + (row - MC) * D + cb + c4) = w; }
        }
        __syncthreads();
    }
    __device__ __forceinline__ void fused(AccT& acc, const Unit&, int wr, int wc, int fr, int fq, PG8_LAS unsigned char* lds, int wid, int lane) const {
        const int tid = wid * 64 + lane;
        const PT pt{ptab};
        unsigned char* ws = pt.ws();
        PG8_LAS float* hst = (PG8_LAS float*)(lds + HST_OFF);
        PG8_LAS float* cst = (PG8_LAS float*)(lds + CST_OFF);
        if (tid < 128) {
            hst[tid] = h0 ? h0[cb + tid] : 0.f; hst[128 + tid] = 1.f;
            const int ch = dir * D + cb + tid;
            cst[tid] = pt.f(I_b_a)[ch]; cst[128 + tid] = pt.f(I_b_i)[ch];
            const float l = pt.f(I_lam)[ch];
            const float x = __expf(-l);
            const float sp = x < 0.03f ? x * (1.f - x * (0.5f - x * (0.33333334f - 0.25f * x))) : __logf(1.f + x);
            cst[256 + tid] = -8.0f * sp * LOG2E;
        }
        __syncthreads();
        const bf16_t* XC = (const bf16_t*)(ws + WS_XN);
        bf16_t* HL = (bf16_t*)(ws + (dir ? WS_HLB : WS_HLF));
        bf16_t* PP = (bf16_t*)(ws + (dir ? WS_PB : WS_PF));
        u32x4 xc0[4], xc1[4];
#pragma unroll
        for (int m = 0; m < 4; ++m) {
            xc0[m] = *(const u32x4*)(XC + (size_t)(row_base + wr * 64 + m * 16 + fr) * D + cb + wc * 32 + 8 * fq);
            xc1[m] = *(const u32x4*)(XC + (size_t)(row_base + 128 + wr * 64 + m * 16 + fr) * D + cb + wc * 32 + 8 * fq);
        }
        if (dir == 0) { half<0>(acc, wr, wc, fr, fq, lds, tid, xc0, HL, PP); half<1>(acc, wr, wc, fr, fq, lds, tid, xc1, HL, PP); }
        else          { half<1>(acc, wr, wc, fr, fq, lds, tid, xc1, HL, PP); half<0>(acc, wr, wc, fr, fq, lds, tid, xc0, HL, PP); }
        if (tid < 128) {
            const float h = hst[tid], P = hst[128 + tid];
            float* sumE = (float*)(ws + WS_SUME) + (size_t)dir * 48 * D; float* sumP = (float*)(ws + WS_SUMP) + (size_t)dir * 48 * D;
            sumE[(size_t)q * D + cb + tid] = h; sumP[(size_t)q * D + cb + tid] = P;
            if (row_base < MC) pt.out()[OUT_NH + (size_t)q * 2 * D + dir * D + cb + tid] = h;
        }
        __syncthreads();
    }
};
}
namespace att {
constexpr int KP = 144, VP = 136;
constexpr int K_OFF = 0, V_OFF = 2 * 64 * KP, F_OFF = V_OFF + 2 * 64 * KP, T_OFF = F_OFF + 8 * 32 * 4, A_END = T_OFF + 640 * 4;
typedef short v4i16_t __attribute__((ext_vector_type(4)));
#define MFMA32(a, b, c) __builtin_amdgcn_mfma_f32_32x32x16_bf16((a), (b), (c), 0, 0, 0)
__device__ __forceinline__ float max2f(float a, float b) { float r; asm("v_max_f32_e32 %0, %1, %2" : "=v"(r) : "v"(a), "v"(b)); return r; }
__device__ __forceinline__ float max3f(float a, float b, float c) { float r; asm("v_max3_f32 %0, %1, %2, %3" : "=v"(r) : "v"(a), "v"(b), "v"(c)); return r; }
__device__ __forceinline__ int crow(int r, int hi) { return (r & 3) + 8 * (r >> 2) + 4 * hi; }

template <bool NA>
__device__ __forceinline__ void unit(int wv, LAS unsigned char* lds, int b, int h, int g, const bf16_t* __restrict__ Qb, const bf16_t* __restrict__ Kb, const bf16_t* __restrict__ Vb,
                                     const float* __restrict__ CK, const float* __restrict__ CV, bf16_t* __restrict__ Ob, const float* __restrict__ rpb) {
    int wid_ = wv; asm volatile("" : "+s"(wid_));
    const int tid = tid_l(wid_), lane = tid & 63, wid = wid_, r32 = lane & 31, hi = lane >> 5;
    LAS float* fscr = (LAS float*)(lds + F_OFF) + wid * 32;
    LAS float* tab = (LAS float*)(lds + T_OFF);
    if (NA) { for (int i = tid; i < 15 * 31; i += 512) { const int dr = i / 31, dc = i % 31; tab[64 + dr * 32 + dc] = rpb[(h * 15 + dr) * 31 + dc] * LOG2E; } }
    int qrow, nlat, ntile, Rlo = 0, rq = 0, rs = 0;
    if (NA) {
        rq = 4 * g + (wid >> 1); rs = min(max(rq - 4, 0), 8);
        qrow = MC + b * 1024 + rq * 64 + 32 * (wid & 1) + r32;
        Rlo = min(max(4 * g - 4, 0), 8); const int Rhi = min(max(4 * g - 1, 0), 8) + 8;
        nlat = Rhi - Rlo; ntile = nlat + 8;
    } else { qrow = b * 256 + 32 * wid + r32; nlat = 4; ntile = 4; }
    const int qc = 32 * (wid & 1) + r32, cs = min(max(qc - 8, 0), 48);
    f32x16 pen0, pen1;
#pragma unroll
    for (int i = 0; i < 16; ++i) { const int kc = (i & 3) + 8 * (i >> 2) + 4 * hi - cs; pen0[i] = (NA && (unsigned)kc >= 16u) ? -1e30f : 0.f; pen1[i] = (NA && (unsigned)(kc + 32) >= 16u) ? -1e30f : 0.f; }
    bf16x8 qr[4];
#pragma unroll
    for (int s = 0; s < 4; ++s) qr[s] = *(const bf16x8*)(Qb + (size_t)qrow * D + h * 64 + 16 * s + 8 * hi);
    const int lkey = tid >> 3, lch = tid & 7;
    auto src_row = [&](int t) -> size_t {
        if (NA) return t < nlat ? (size_t)(MC + b * 1024 + (Rlo + t) * 64) : (size_t)(b * 512 + (t - nlat) * 64);
        return (size_t)(b * 256 + t * 64);
    };
    u32x4 kreg = {0u, 0u, 0u, 0u}, vreg = kreg, kreg2 = kreg, vreg2 = kreg;
    auto gload = [&](int t) {
        const bool cache = NA && t >= nlat;
        const size_t off = (src_row(t) + lkey) * D + h * 64 + 8 * lch;
        const unsigned char* kp = cache ? (const unsigned char*)CK + off * 4 : (const unsigned char*)Kb + off * 2;
        const unsigned char* vp = cache ? (const unsigned char*)CV + off * 4 : (const unsigned char*)Vb + off * 2;
        const size_t second = cache ? 16 : 0;
        kreg = *(const u32x4*)kp; kreg2 = *(const u32x4*)(kp + second);
        vreg = *(const u32x4*)vp; vreg2 = *(const u32x4*)(vp + second);
    };
    auto lstore = [&](int buf, int t) {
        LAS u32x4* kd = (LAS u32x4*)(lds + K_OFF + buf * 64 * KP + lkey * KP + lch * 16);
        LAS u32x4* vd = (LAS u32x4*)(lds + V_OFF + buf * 64 * KP + lkey * KP + lch * 16);
        if (NA && t >= nlat) {
            *kd = (u32x4){pk_bf16(__uint_as_float(kreg.x), __uint_as_float(kreg.y)), pk_bf16(__uint_as_float(kreg.z), __uint_as_float(kreg.w)),
                          pk_bf16(__uint_as_float(kreg2.x), __uint_as_float(kreg2.y)), pk_bf16(__uint_as_float(kreg2.z), __uint_as_float(kreg2.w))};
            *vd = (u32x4){pk_bf16(__uint_as_float(vreg.x), __uint_as_float(vreg.y)), pk_bf16(__uint_as_float(vreg.z), __uint_as_float(vreg.w)),
                          pk_bf16(__uint_as_float(vreg2.x), __uint_as_float(vreg2.y)), pk_bf16(__uint_as_float(vreg2.z), __uint_as_float(vreg2.w))};
        } else { *kd = kreg; *vd = vreg; }
    };
    float m_run = -1e30f, l_run = 0.f;
    f32x16 o0, o1;
#pragma unroll
    for (int i = 0; i < 16; ++i) { o0[i] = 0.f; o1[i] = 0.f; }
    gload(0); lstore(0, 0);
    asm volatile("" :: "v"(qr[0]), "v"(qr[1]), "v"(qr[2]), "v"(qr[3]));
    __syncthreads();
    for (int t = 0; t < ntile; ++t) {
        const int buf = t & 1;
        if (t + 1 < ntile) gload(t + 1);
        bool active = true, biased = false; int dr = 0;
        if (NA && t < nlat) { const int R = Rlo + t; active = (R >= rs) && (R < rs + 8); biased = true; dr = R - rq + 7; }
        if (active) {
            f32x16 p0, p1;
#pragma unroll
            for (int i = 0; i < 16; ++i) { p0[i] = 0.f; p1[i] = 0.f; }
            const LAS unsigned char* kb = lds + K_OFF + buf * 64 * KP + r32 * KP + 16 * hi;
#pragma unroll
            for (int s = 0; s < 4; ++s) {
                const bf16x8 k0 = *(const LAS bf16x8*)(kb + 32 * s), k1 = *(const LAS bf16x8*)(kb + 32 * KP + 32 * s);
                p0 = MFMA32(k0, qr[s], p0); p1 = MFMA32(k1, qr[s], p1);
            }
            if (biased) {
                const LAS float* tb = tab + 64 + dr * 32 + (4 * hi - qc + 15);
                f32x16 b0, b1;
#pragma unroll
                for (int i = 0; i < 16; ++i) { const int kc = (i & 3) + 8 * (i >> 2); b0[i] = tb[kc]; b1[i] = tb[kc + 32]; }
                p0 += b0; p1 += b1; p0 += pen0; p1 += pen1;
            }
            float mxa = max3f(p0[0], p0[1], p0[2]), mxb = max3f(p0[3], p0[4], p0[5]), mxc = max3f(p1[0], p1[1], p1[2]), mxd = max3f(p1[3], p1[4], p1[5]);
            mxa = max3f(mxa, p0[6], p0[7]); mxb = max3f(mxb, p0[8], p0[9]); mxc = max3f(mxc, p1[6], p1[7]); mxd = max3f(mxd, p1[8], p1[9]);
            mxa = max3f(mxa, p0[10], p0[11]); mxb = max3f(mxb, p0[12], p0[13]); mxc = max3f(mxc, p1[10], p1[11]); mxd = max3f(mxd, p1[12], p1[13]);
            mxa = max3f(mxa, p0[14], p0[15]); mxc = max3f(mxc, p1[14], p1[15]);
            float mx = max2f(max2f(mxa, mxb), max2f(mxc, mxd));
            mx = max2f(mx, shfl_xor_l(mx, 32, lane));
            const float mnew = max2f(m_run, mx);
            const float f = fast_exp2(m_run - mnew);
            m_run = mnew;
            p0 -= mnew; p1 -= mnew;
#pragma unroll
            for (int i = 0; i < 16; ++i) { p0[i] = fast_exp2(p0[i]); p1[i] = fast_exp2(p1[i]); }
            f32x4 ls4 = {0.f, 0.f, 0.f, 0.f};
#pragma unroll
            for (int i = 0; i < 16; i += 4) ls4 += (f32x4){p0[i], p0[i + 1], p0[i + 2], p0[i + 3]} + (f32x4){p1[i], p1[i + 1], p1[i + 2], p1[i + 3]};
            const float ls = (ls4[0] + ls4[1]) + (ls4[2] + ls4[3]);
            l_run = l_run * f + ls;
            if (__any(f != 1.f)) {
                if (hi == 0) fscr[r32] = f;
                asm volatile("s_waitcnt lgkmcnt(0)" ::: "memory");
#pragma unroll
                for (int i = 0; i < 16; ++i) { const float fi = fscr[crow(i, hi)]; o0[i] *= fi; o1[i] *= fi; }
                asm volatile("s_waitcnt lgkmcnt(0)" ::: "memory");
            }
            bf16x8 pa[2][2];
#pragma unroll
            for (int s = 0; s < 2; ++s) {
                u32x4 w0, w1;
                w0.x = pk_bf16(p0[8 * s + 0], p0[8 * s + 1]); w0.y = pk_bf16(p0[8 * s + 2], p0[8 * s + 3]); w0.z = pk_bf16(p0[8 * s + 4], p0[8 * s + 5]); w0.w = pk_bf16(p0[8 * s + 6], p0[8 * s + 7]);
                w1.x = pk_bf16(p1[8 * s + 0], p1[8 * s + 1]); w1.y = pk_bf16(p1[8 * s + 2], p1[8 * s + 3]); w1.z = pk_bf16(p1[8 * s + 4], p1[8 * s + 5]); w1.w = pk_bf16(p1[8 * s + 6], p1[8 * s + 7]);
                pa[0][s] = __builtin_bit_cast(bf16x8, w0); pa[1][s] = __builtin_bit_cast(bf16x8, w1);
            }
            const int i16 = lane & 15, g16 = (lane >> 4) & 1;
            const LAS unsigned char* vb = lds + V_OFF + buf * 64 * KP + (4 * hi + (i16 >> 2)) * KP + (16 * g16 + 4 * (i16 & 3)) * 2;
#pragma unroll
            for (int blk = 0; blk < 2; ++blk)
#pragma unroll
                for (int s = 0; s < 2; ++s) {
                    const int ko = (32 * blk + 16 * s) * KP;
                    const s16x4 a0 = __builtin_bit_cast(s16x4, __builtin_amdgcn_ds_read_tr16_b64_v4i16((LAS v4i16_t*)(vb + ko))), a1 = __builtin_bit_cast(s16x4, __builtin_amdgcn_ds_read_tr16_b64_v4i16((LAS v4i16_t*)(vb + ko + 8 * KP)));
                    const s16x4 c0 = __builtin_bit_cast(s16x4, __builtin_amdgcn_ds_read_tr16_b64_v4i16((LAS v4i16_t*)(vb + ko + 64))), c1 = __builtin_bit_cast(s16x4, __builtin_amdgcn_ds_read_tr16_b64_v4i16((LAS v4i16_t*)(vb + ko + 8 * KP + 64)));
                    const bf16x8 v0 = __builtin_shufflevector(a0, a1, 0, 1, 2, 3, 4, 5, 6, 7), v1 = __builtin_shufflevector(c0, c1, 0, 1, 2, 3, 4, 5, 6, 7);
                    o0 = MFMA32(pa[blk][s], v0, o0); o1 = MFMA32(pa[blk][s], v1, o1);
                }
        }
        if (t + 1 < ntile) lstore(buf ^ 1, t + 1);
        __syncthreads();
    }
    l_run += shfl_xor_l(l_run, 32, lane);
    if (hi == 0) fscr[r32] = fast_rcp(l_run);
    asm volatile("s_waitcnt lgkmcnt(0)" ::: "memory");
    const int qbase = qrow - r32;
    LAS unsigned char* stg = lds + K_OFF + wid * (32 * KP);
#pragma unroll
    for (int i = 0; i < 16; ++i) {
        const int qi = crow(i, hi); const float li = fscr[qi];
        LAS unsigned short* sp = (LAS unsigned short*)(stg + qi * KP + r32 * 2);
        sp[0] = (unsigned short)(pk_bf16(o0[i] * li, 0.f) & 0xffff); sp[32] = (unsigned short)(pk_bf16(o1[i] * li, 0.f) & 0xffff);
    }
    asm volatile("s_waitcnt lgkmcnt(0)" ::: "memory");
    {
        const int row = lane >> 1, half = lane & 1;
        bf16_t* op = Ob + (size_t)(qbase + row) * D + h * 64 + half * 32;
#pragma unroll
        for (int j = 0; j < 4; ++j) *(u32x4*)(op + 8 * j) = *(const LAS u32x4*)(stg + row * KP + half * 64 + 16 * j);
    }
    __syncthreads();
}
}
#ifndef REP_P4
#define REP_P4 1
#endif
#ifndef REP_ADA
#define REP_ADA 1
#endif
#ifndef REP_PRO
#define REP_PRO 1
#endif
#ifndef REP_FILL
#define REP_FILL 1
#endif
#ifndef REP_ATT
#define REP_ATT 1
#endif
#ifndef REP_GEMM
#define REP_GEMM 1
#endif
#ifndef REP_THIN
#define REP_THIN 1
#endif
#ifndef REP_LRU
#define REP_LRU 1
#endif
#ifndef REP_SYNC
#define REP_SYNC 1
#endif
struct Args {
    const float *x_prompt, *x_sample, *c, *cache_k, *cache_v, *state_h, *c_ctx, *norm_g, *w_mod, *b_mod, *w_qkv, *w_o, *rpb, *w_in, *conv_w, *conv_b,
                *w_a, *b_a, *w_i, *b_i, *lam, *w_out, *w_gu, *w_down, *final_g;
    float* out; unsigned char* ws;
};

__device__ __forceinline__ void tr_item(const float* __restrict__ W, int ldw, int k0, int n0, bf16_t* __restrict__ dst, int ldd, LAS float* scr, int lane) {
    float tv[32];
#pragma unroll
    for (int i = 0; i < 32; ++i) { const int kk = 2 * i + (lane >> 5); tv[i] = W[(size_t)(k0 + kk) * ldw + n0 + (lane & 31)]; }
#pragma unroll
    for (int i = 0; i < 32; ++i) { const int kk = 2 * i + (lane >> 5); scr[kk * 33 + (lane & 31)] = tv[i]; }
    asm volatile("s_waitcnt lgkmcnt(0)" ::: "memory");
    const int c = lane & 7;
#pragma unroll
    for (int j = 0; j < 4; ++j) {
        const int n = (lane >> 3) + 8 * j; const LAS float* s = scr + (8 * c) * 33 + n;
        u32x4 o; o.x = pk_bf16(s[0 * 33], s[1 * 33]); o.y = pk_bf16(s[2 * 33], s[3 * 33]); o.z = pk_bf16(s[4 * 33], s[5 * 33]); o.w = pk_bf16(s[6 * 33], s[7 * 33]);
        *(u32x4*)(dst + (size_t)n * ldd + k0 + 8 * c) = o;
    }
    asm volatile("s_waitcnt lgkmcnt(0)" ::: "memory");
}

__device__ __forceinline__ void tr_items(int wv, const PT pt, LAS unsigned char* lds, int it0, int it1, int gwr, int ngw) {
    const int lane = tid_l(wv) & 63;
    unsigned char* ws = pt.ws();
    {
        LAS float* scr = (LAS float*)(lds + wv * 8448);
        constexpr int I_QKV = 16 * 96, I_WO = 16 * 32, I_GU = 16 * 176, I_DN = 44 * 32, I_WIN = 16 * 64, I_WOUT = 16 * 32, I_G = 32 * 8;
        for (int it = it0 + gwr; it < it1; it += ngw) {
            int r = it;
            if (r < I_QKV) { const int kb = r / 96, nb = r % 96; tr_item(pt.f(I_w_qkv), NQKV, 64 * kb, 32 * nb, (bf16_t*)(ws + WS_WQKV) + (size_t)(32 * nb) * D, D, scr, lane); continue; } r -= I_QKV;
            if (r < I_WO) { const int kb = r / 32, nb = r % 32; tr_item(pt.f(I_w_o), D, 64 * kb, 32 * nb, (bf16_t*)(ws + WS_WO) + (size_t)(32 * nb) * D, D, scr, lane); continue; } r -= I_WO;
#pragma unroll 1
            for (int l = 0; l < 2; ++l) {
                if (r >= 0 && r < I_GU) { const int kb = r / 176, nb = r % 176; const int n0 = 32 * nb, half = n0 >= FF ? 1 : 0, c0 = n0 - half * FF;
                    const int drow = 256 * (c0 >> 7) + 128 * half + (c0 & 127);
                    tr_item(pt.f(I_w_gu) + (size_t)l * D * 2 * FF, 2 * FF, 64 * kb, n0, (bf16_t*)(ws + WS_WGU) + ((size_t)l * 2 * FF + drow) * D, D, scr, lane); r = -1; break; } r -= I_GU;
                if (r >= 0 && r < I_DN) { const int kb = r / 32, nb = r % 32;
                    tr_item(pt.f(I_w_down) + (size_t)l * FF * D, D, 64 * kb, 32 * nb, (bf16_t*)(ws + WS_WDN) + ((size_t)l * D + 32 * nb) * FF, FF, scr, lane); r = -1; break; } r -= I_DN;
            }
            if (r < 0) continue;
            if (r < I_WIN) { const int kb = r / 64, nb = r % 64; tr_item(pt.f(I_w_in), 2 * D, 64 * kb, 32 * nb, (bf16_t*)(ws + WS_WIN) + (size_t)(32 * nb) * D, D, scr, lane); continue; } r -= I_WIN;
            if (r < I_WOUT) { const int kb = r / 32, nb = r % 32; tr_item(pt.f(I_w_out), D, 64 * kb, 32 * nb, (bf16_t*)(ws + WS_WOUT) + (size_t)(32 * nb) * D, D, scr, lane); continue; } r -= I_WOUT;
            { const int mat = r >> 3, sub = r & 7, kb = sub >> 2, nb = sub & 3;
              const int gsel = mat >> 4, dir = (mat >> 3) & 1, blk = mat & 7;
              const float* src = (gsel ? pt.f(I_w_i) : pt.f(I_w_a)) + (size_t)(dir * 8 + blk) * 128 * 128;
              tr_item(src, 128, 64 * kb, 32 * nb, (bf16_t*)(ws + WS_WG) + ((size_t)((blk * 2 + dir) * 256 + gsel * 128 + 32 * nb)) * 128, 128, scr, lane); }
        }
    }
}

__device__ __forceinline__ void adaln_tasks(int wv, const PT pt, LAS unsigned char* lds, int l, int rank, int nb, int t0 = 0, int t1 = 256) {
    const int tid = tid_l(wv);
    LAS float* sl = (LAS float*)(lds + 70000);
    LAS float* red = (LAS float*)lds;
    float* mod = (float*)(pt.ws() + WS_MOD);
#pragma unroll 1
    for (int task = t0 + rank; task < t1; task += nb) {
        const int cg_ = task >> 3, kr = task & 7, col0 = cg_ * 192;
        __syncthreads();
        for (int i = tid; i < 9 * 128; i += 512) { const int cv = i >> 7, k = kr * 128 + (i & 127); const float v = cv < 8 ? pt.f(I_c)[cv * D + k] : pt.f(I_c_ctx)[k]; sl[i] = silu_f(v); }
        __syncthreads();
        if (tid < 384) {
            const int q = tid % 48, ks = tid / 48;
            float acc[9][4];
#pragma unroll
            for (int cv = 0; cv < 9; ++cv) { acc[cv][0] = 0.f; acc[cv][1] = 0.f; acc[cv][2] = 0.f; acc[cv][3] = 0.f; }
            const float* wp = pt.f(I_w_mod) + ((size_t)l * D + kr * 128 + ks * 16) * NMOD + col0 + 4 * q;
            f32x4 w[16];
#pragma unroll
            for (int k = 0; k < 16; ++k) w[k] = *(const f32x4*)(wp + (size_t)k * NMOD);
#pragma unroll
            for (int k = 0; k < 16; ++k) {
#pragma unroll
                for (int cv = 0; cv < 9; ++cv) { const float s = sl[cv * 128 + ks * 16 + k]; acc[cv][0] += s * w[k][0]; acc[cv][1] += s * w[k][1]; acc[cv][2] += s * w[k][2]; acc[cv][3] += s * w[k][3]; }
            }
#pragma unroll
            for (int cv = 0; cv < 9; ++cv) *(LAS f32x4*)(red + (ks * 9 + cv) * 192 + 4 * q) = (f32x4){acc[cv][0], acc[cv][1], acc[cv][2], acc[cv][3]};
        }
        __syncthreads();
        for (int i = tid; i < 9 * 192; i += 512) {
            const int cv = i / 192, cc = i % 192; float s = 0.f;
#pragma unroll
            for (int ks = 0; ks < 8; ++ks) s += red[(ks * 9 + cv) * 192 + cc];
            if (kr == 0) s += pt.f(I_b_mod)[l * NMOD + col0 + cc];
            unsafeAtomicAdd(mod + ((size_t)l * 9 + cv) * NMOD + col0 + cc, s);
        }
    }
    __syncthreads();
}

__device__ __forceinline__ void cache_conv(int wv, const PT pt, int rank, int nb) {
    const int tid = tid_l(wv);
    unsigned char* ws = pt.ws();
    const size_t n4 = (size_t)MC * D / 4;
#pragma unroll 8
    for (size_t i = (size_t)rank * 512 + tid; i < 2 * n4; i += (size_t)nb * 512) {
        const bool isv = i >= n4; const size_t j = isv ? i - n4 : i;
        const f32x4 v = *((const f32x4*)(isv ? pt.f(I_cache_v) : pt.f(I_cache_k)) + j);
        u32x2 w; w.x = pk_bf16(v[0], v[1]); w.y = pk_bf16(v[2], v[3]);
        *((u32x2*)(ws + (isv ? WS_CV : WS_CK)) + j) = w;
    }
}

__device__ __forceinline__ void p0_prologue(int wv, const PT pt, LAS unsigned char* lds) {
    const int tid = tid_l(wv), lane = tid & 63, wave = tid >> 6;
    const int G = gd_l(), bxl = bx_l(), gw = bxl * 8 + wave, NGW = G * 8;
    unsigned char* ws = pt.ws();
    adaln_tasks(wv, pt, lds, 0, bxl, G, 0, 88);
    for (int rp_ = 0; rp_ < REP_PRO; ++rp_) tr_items(wv, pt, lds, 0, 16 * 96, gw, NGW);
}

__device__ __forceinline__ void norm_phase(int wv, const float* xa, const float* xb, const float* g, const float* mod_l, int sh_chunk, bf16_t* XN) {
    const int tid = tid_l(wv), lane = tid & 63, gw = bx_l() * 8 + (tid >> 6), NGW = gd_l() * 8;
#pragma unroll 2
    for (int row = gw; row < MT; row += NGW) {
        const float* xr = row < MC ? xa + (size_t)row * D : xb + (size_t)(row - MC) * D;
        const int cv = row < MC ? 8 : ((row - MC) >> 10);
        const float* shp = mod_l + (size_t)cv * NMOD + sh_chunk * D; const float* scp = shp + D;
        f32x4 v[4], gg4[4], sc4[4], sh4[4]; float s = 0.f;
#pragma unroll
        for (int j = 0; j < 4; ++j) { const int c = 4 * lane + 256 * j; v[j] = *((const f32x4*)xr + lane + 64 * j); gg4[j] = *(const f32x4*)(g + c); sc4[j] = *(const f32x4*)(scp + c); sh4[j] = *(const f32x4*)(shp + c); }
#pragma unroll
        for (int j = 0; j < 4; ++j) s += (v[j][0] * v[j][0] + v[j][1] * v[j][1]) + (v[j][2] * v[j][2] + v[j][3] * v[j][3]);
        const float rstd = 1.f / sqrtf(wave_sum(s, lane) * (1.f / D) + RMS_EPS);
#pragma unroll
        for (int j = 0; j < 4; ++j) {
            const int c = 4 * lane + 256 * j;
            const f32x4 gg = gg4[j], sc = sc4[j], sh = sh4[j];
            const f32x4 y = v[j] * rstd * gg * (sc + 1.f) + sh;
            u32x2 w; w.x = pk_bf16(y[0], y[1]); w.y = pk_bf16(y[2], y[3]);
            *(u32x2*)(XN + (size_t)row * D + c) = w;
        }
    }
}
__device__ __forceinline__ void final_norm_phase(int wv, const bf16_t* XB, float* Y, const float* g) {
    const int tid = tid_l(wv), lane = tid & 63, gw = bx_l() * 8 + (tid >> 6), NGW = gd_l() * 8;
#pragma unroll 2
    for (int row = gw; row < MT; row += NGW) {
        const u32x4* xr = (const u32x4*)(XB + (size_t)row * D);
        f32x4 v[4], gg[4]; float s = 0.f;
#pragma unroll
        for (int j = 0; j < 2; ++j) {
            const u32x4 w = xr[lane + 64 * j];
            v[2 * j] = (f32x4){bf_lo(w.x), bf_hi(w.x), bf_lo(w.y), bf_hi(w.y)}; v[2 * j + 1] = (f32x4){bf_lo(w.z), bf_hi(w.z), bf_lo(w.w), bf_hi(w.w)};
            gg[2 * j] = *(const f32x4*)(g + 8 * lane + 512 * j); gg[2 * j + 1] = *(const f32x4*)(g + 8 * lane + 512 * j + 4);
        }
#pragma unroll
        for (int j = 0; j < 4; ++j) s += (v[j][0] * v[j][0] + v[j][1] * v[j][1]) + (v[j][2] * v[j][2] + v[j][3] * v[j][3]);
        const float rstd = 1.f / sqrtf(wave_sum(s, lane) * (1.f / D) + RMS_EPS);
        float* yr = Y + (size_t)row * D;
#pragma unroll
        for (int j = 0; j < 2; ++j) { *(f32x4*)(yr + 8 * lane + 512 * j) = v[2 * j] * rstd * gg[2 * j]; *(f32x4*)(yr + 8 * lane + 512 * j + 4) = v[2 * j + 1] * rstd * gg[2 * j + 1]; }
    }
}
__device__ __forceinline__ void conv_phase(int wv, const bf16_t* XR, const float* cw, const float* cb, bf16_t* XC) {
    const size_t n8 = (size_t)MT * D / 8;
#pragma unroll 2
    for (size_t i = (size_t)bx_l() * 512 + tid_l(wv), st_ = (size_t)gd_l() * 512; i < n8; i += st_) {
        const int row = (int)(i >> 7), c = (int)(i & 127) * 8;
        int pos, len; if (row < MC) { pos = row & 255; len = 256; } else { pos = (row - MC) & 1023; len = 1024; }
        float y[8];
#pragma unroll
        for (int e = 0; e < 8; ++e) y[e] = cb[c + e];
#pragma unroll
        for (int j = 0; j < 4; ++j) {
            const int p = pos + j - 2;
            if (p >= 0 && p < len) {
                const u32x4 xw = *(const u32x4*)(XR + (size_t)(row + j - 2) * D + c);
                const f32x4 w0 = *(const f32x4*)(cw + j * D + c), w1 = *(const f32x4*)(cw + j * D + c + 4);
                y[0] += w0[0] * bf_lo(xw.x); y[1] += w0[1] * bf_hi(xw.x); y[2] += w0[2] * bf_lo(xw.y); y[3] += w0[3] * bf_hi(xw.y);
                y[4] += w1[0] * bf_lo(xw.z); y[5] += w1[1] * bf_hi(xw.z); y[6] += w1[2] * bf_lo(xw.w); y[7] += w1[3] * bf_hi(xw.w);
            }
        }
        u32x4 o; o.x = pk_bf16(y[0], y[1]); o.y = pk_bf16(y[2], y[3]); o.z = pk_bf16(y[4], y[5]); o.w = pk_bf16(y[6], y[7]);
        *(u32x4*)(XC + (size_t)row * D + c) = o;
    }
}
__device__ __forceinline__ void conv_slab(int wv, const bf16_t* XR, const float* cw, const float* cb, bf16_t* XC, int q, int n) {
    const int tid = tid_l(wv), ch = n * 128 + (tid & 15) * 8, r0 = q * 256 + (tid >> 4) * 8;
    int pos0, len; if (r0 < MC) { pos0 = r0 & 255; len = 256; } else { pos0 = (r0 - MC) & 1023; len = 1024; }
    u32x4 x[11];
#pragma unroll
    for (int i = 0; i < 11; ++i) { const int p = pos0 + i - 2; x[i] = (p >= 0 && p < len) ? *(const u32x4*)(XR + (size_t)(r0 + i - 2) * D + ch) : (u32x4){0u, 0u, 0u, 0u}; }
    f32x4 w0[4], w1[4];
#pragma unroll
    for (int j = 0; j < 4; ++j) { w0[j] = *(const f32x4*)(cw + j * D + ch); w1[j] = *(const f32x4*)(cw + j * D + ch + 4); }
    const f32x4 b0 = *(const f32x4*)(cb + ch), b1 = *(const f32x4*)(cb + ch + 4);
#pragma unroll
    for (int r = 0; r < 8; ++r) {
        f32x4 y0 = b0, y1 = b1;
#pragma unroll
        for (int j = 0; j < 4; ++j) { const u32x4 xw = x[r + j];
            y0 += w0[j] * (f32x4){bf_lo(xw.x), bf_hi(xw.x), bf_lo(xw.y), bf_hi(xw.y)}; y1 += w1[j] * (f32x4){bf_lo(xw.z), bf_hi(xw.z), bf_lo(xw.w), bf_hi(xw.w)}; }
        u32x4 o; o.x = pk_bf16(y0[0], y0[1]); o.y = pk_bf16(y0[2], y0[3]); o.z = pk_bf16(y1[0], y1[1]); o.w = pk_bf16(y1[2], y1[3]);
        *(u32x4*)(XC + (size_t)(r0 + r) * D + ch) = o;
    }
    asm volatile("s_waitcnt vmcnt(0)" ::: "memory");
    __syncthreads();
}

__device__ __forceinline__ void lru_combine_phase(int wv, const unsigned char* ws, bf16_t* Y) {
    const bf16_t* HLF = (const bf16_t*)(ws + WS_HLF); const bf16_t* HLB = (const bf16_t*)(ws + WS_HLB);
    const bf16_t* PF = (const bf16_t*)(ws + WS_PF); const bf16_t* PB = (const bf16_t*)(ws + WS_PB); const bf16_t* GT = (const bf16_t*)(ws + WS_GATE);
    const float* sE = (const float*)(ws + WS_SUME); const float* sP = (const float*)(ws + WS_SUMP);
    const size_t n8 = (size_t)MT * D / 8;
#pragma unroll 2
    for (size_t i = (size_t)bx_l() * 512 + tid_l(wv), st_ = (size_t)gd_l() * 512; i < n8; i += st_) {
        const int row = (int)(i >> 7), c = (int)(i & 127) * 8;
        const size_t off = (size_t)row * D + c;
        const u32x4 hf = *(const u32x4*)(HLF + off), hb = *(const u32x4*)(HLB + off), gt = *(const u32x4*)(GT + off);
        float h[8] = {bf_lo(hf.x) + bf_lo(hb.x), bf_hi(hf.x) + bf_hi(hb.x), bf_lo(hf.y) + bf_lo(hb.y), bf_hi(hf.y) + bf_hi(hb.y),
                      bf_lo(hf.z) + bf_lo(hb.z), bf_hi(hf.z) + bf_hi(hb.z), bf_lo(hf.w) + bf_lo(hb.w), bf_hi(hf.w) + bf_hi(hb.w)};
        if (row >= MC) {
            const int q = row >> 8, ci = (q - 16) & 3, q0 = q - ci;
            const u32x4 pf = *(const u32x4*)(PF + off - (size_t)MC * D), pb = *(const u32x4*)(PB + off - (size_t)MC * D);
            f32x4 tf0 = {0.f, 0.f, 0.f, 0.f}, tf1 = tf0, tb0 = tf0, tb1 = tf0;
            for (int cc = 0; cc < ci; ++cc) { const float* e = sE + (size_t)(q0 + cc) * D + c; const float* p = sP + (size_t)(q0 + cc) * D + c;
                tf0 = *(const f32x4*)e + *(const f32x4*)p * tf0; tf1 = *(const f32x4*)(e + 4) + *(const f32x4*)(p + 4) * tf1; }
            for (int cc = 3; cc > ci; --cc) { const float* e = sE + (size_t)(48 + q0 + cc) * D + c; const float* p = sP + (size_t)(48 + q0 + cc) * D + c;
                tb0 = *(const f32x4*)e + *(const f32x4*)p * tb0; tb1 = *(const f32x4*)(e + 4) + *(const f32x4*)(p + 4) * tb1; }
            h[0] += bf_lo(pf.x) * tf0[0] + bf_lo(pb.x) * tb0[0]; h[1] += bf_hi(pf.x) * tf0[1] + bf_hi(pb.x) * tb0[1];
            h[2] += bf_lo(pf.y) * tf0[2] + bf_lo(pb.y) * tb0[2]; h[3] += bf_hi(pf.y) * tf0[3] + bf_hi(pb.y) * tb0[3];
            h[4] += bf_lo(pf.z) * tf1[0] + bf_lo(pb.z) * tb1[0]; h[5] += bf_hi(pf.z) * tf1[1] + bf_hi(pb.z) * tb1[1];
            h[6] += bf_lo(pf.w) * tf1[2] + bf_lo(pb.w) * tb1[2]; h[7] += bf_hi(pf.w) * tf1[3] + bf_hi(pb.w) * tb1[3];
        }
        u32x4 o;
        o.x = pk_bf16(h[0] * bf_lo(gt.x), h[1] * bf_hi(gt.x)); o.y = pk_bf16(h[2] * bf_lo(gt.y), h[3] * bf_hi(gt.y));
        o.z = pk_bf16(h[4] * bf_lo(gt.z), h[5] * bf_hi(gt.z)); o.w = pk_bf16(h[6] * bf_lo(gt.w), h[7] * bf_hi(gt.w));
        *(u32x4*)(Y + off) = o;
    }
}

#ifndef PG8_SP2
#define PG8_SP2 true
#endif
#ifndef PG8_ALIGN
#define PG8_ALIGN true
#endif

__device__ __forceinline__ void shw_phase(int wv, const PT pt, LAS unsigned char* lds, const int site, int bx, int G) {
    const int tid = tid_l(wv), lane = tid & 63;
    unsigned char* ws = pt.ws();
    const int lb = bx, nb = G;
    LAS float* sl = (LAS float*)lds;
    const float* mod = (const float*)(ws + WS_MOD);
    const int l = site ? 1 : 0, chunk = (site == 1) ? 0 : 3, N = (site == 1) ? 2 * D : 2 * FF;
    const bf16_t* Wt = site == 0 ? (const bf16_t*)(ws + WS_WGU) : (site == 1 ? (const bf16_t*)(ws + WS_WIN) : (const bf16_t*)(ws + WS_WGU) + (size_t)2 * FF * D);
    float* out = (float*)(ws + WS_SHW) + (site == 0 ? SHW_OFF0 : (site == 1 ? SHW_OFF1 : SHW_OFF2));
    __syncthreads();
#pragma unroll
    for (int r = 0; r < 3; ++r) {
        float v[6];
#pragma unroll
        for (int j = 0; j < 6; ++j) { const int i = tid + 512 * (6 * r + j); v[j] = mod[((size_t)l * 9 + (i >> 10)) * NMOD + chunk * D + (i & 1023)]; }
#pragma unroll
        for (int j = 0; j < 6; ++j) sl[tid + 512 * (6 * r + j)] = v[j];
    }
    __syncthreads();
    const int step = nb * 8;
    int n = lb * 8 + wv;
    u32x2 wa[4];
    if (n < N) {
#pragma unroll
        for (int j = 0; j < 4; ++j) wa[j] = *(const u32x2*)(Wt + (size_t)n * D + 4 * lane + 256 * j);
    }
    for (; n < N; n += step) {
        u32x2 wb[4];
        const int n2 = n + step;
        if (n2 < N) {
#pragma unroll
            for (int j = 0; j < 4; ++j) wb[j] = *(const u32x2*)(Wt + (size_t)n2 * D + 4 * lane + 256 * j);
        }
        float res = 0.f;
#pragma unroll
        for (int cv = 0; cv < 9; ++cv) {
            float s = 0.f;
#pragma unroll
            for (int j = 0; j < 4; ++j) { const f32x4 v = *(const LAS f32x4*)(sl + cv * D + 4 * lane + 256 * j); s += (v[0] * bf_lo(wa[j].x) + v[1] * bf_hi(wa[j].x)) + (v[2] * bf_lo(wa[j].y) + v[3] * bf_hi(wa[j].y)); }
            s = wave_sum(s, lane);
            if (lane == cv) res = s;
        }
        if (lane < 9) out[(size_t)lane * N + n] = res;
#pragma unroll
        for (int j = 0; j < 4; ++j) wa[j] = wb[j];
    }
    __syncthreads();
}

#ifndef PHMASK
#define PHMASK 0xffff
#endif
constexpr int PHM = PHMASK;
__global__ void __launch_bounds__(512, 2) fwd_megakernel(Args a) {
    extern __shared__ __attribute__((aligned(16))) unsigned char lds_raw[];
    LAS unsigned char* lds = (LAS unsigned char*)lds_raw;
    cg::grid_group grid = cg::this_grid();
    const int wv = __builtin_amdgcn_readfirstlane(threadIdx.x >> 6);
    {
        LAS unsigned long long* tw = (LAS unsigned long long*)(lds + PTAB_OFF);
        if (threadIdx.x == 0) {
            tw[0] = (unsigned long long)a.x_prompt; tw[1] = (unsigned long long)a.x_sample; tw[2] = (unsigned long long)a.c; tw[3] = (unsigned long long)a.cache_k; tw[4] = (unsigned long long)a.cache_v;
            tw[5] = (unsigned long long)a.state_h; tw[6] = (unsigned long long)a.c_ctx; tw[7] = (unsigned long long)a.norm_g; tw[8] = (unsigned long long)a.w_mod; tw[9] = (unsigned long long)a.b_mod;
            tw[10] = (unsigned long long)a.w_qkv; tw[11] = (unsigned long long)a.w_o; tw[12] = (unsigned long long)a.rpb; tw[13] = (unsigned long long)a.w_in; tw[14] = (unsigned long long)a.conv_w;
            tw[15] = (unsigned long long)a.conv_b; tw[16] = (unsigned long long)a.w_a; tw[17] = (unsigned long long)a.b_a; tw[18] = (unsigned long long)a.w_i; tw[19] = (unsigned long long)a.b_i;
            tw[20] = (unsigned long long)a.lam; tw[21] = (unsigned long long)a.w_out; tw[22] = (unsigned long long)a.w_gu; tw[23] = (unsigned long long)a.w_down; tw[24] = (unsigned long long)a.final_g;
            tw[25] = (unsigned long long)a.out; tw[26] = (unsigned long long)a.ws;
            LAS unsigned* st = (LAS unsigned*)(lds + BARST_OFF); st[0] = 0u; st[1] = 0u;
            (void)xb_add((unsigned*)(a.ws + WS_BAR) + XB_XCNT(xb_xcc_id()), 1u);
        }
        __syncthreads();
        if (a.out == nullptr) grid.sync();
    }
#define GSYNC() do { for (int rs_ = 0; rs_ < REP_SYNC; ++rs_) xcd_barrier(pt, lds, wv); } while (0)
    const PT pt{(LAS const unsigned long long*)(lds + PTAB_OFF)};
#define WSP(off) (pt.ws() + (off))
#define MODP ((float*)WSP(WS_MOD))
#define XNP ((bf16_t*)WSP(WS_XN))
#define XRES (pt.out() + OUT_Y)
#define XBP ((bf16_t*)WSP(WS_XB))
#define SSQP(i) ((float*)WSP(WS_SSQ) + (size_t)(i) * MT)

    if (PHM & 1) p0_prologue(wv, pt, lds);
    GSYNC();
    if (PHM & 2) for (int rep_ = 0; rep_ < REP_THIN; ++rep_) norm_phase(wv, pt.f(I_x_prompt), pt.f(I_x_sample), pt.f(I_norm_g), MODP, 0, XNP);
    GSYNC();
    if (PHM & 4) { pg8::Gemm g{XNP, (const bf16_t*)WSP(WS_WQKV), MT, NQKV, D, D, D, wv}; pg8::StaticOrder S; S.init(MT, NQKV, gd_l(), bx_l()); S.reps = REP_GEMM;
      pg8::EpiQKV E{(bf16_t*)WSP(WS_Q), pt.out() + OUT_NK, 0.125f * LOG2E};
      pg8::gemm_phase<pg8::EpiQKV, pg8::StaticOrder, PG8_ALIGN, PG8_SP2>(lds, g, S, E); }
    {
        const int G_ = gd_l(), c_ = bx_l(), nwg_ = (MT / 256) * (NQKV / 256), maxu_ = (nwg_ + G_ - 1) / G_, full_ = nwg_ - (maxu_ - 1) * G_;
        int rank_ = c_, n_ = G_;
        if (full_ < G_) { rank_ = c_ - full_; n_ = c_ >= full_ ? G_ - full_ : 0; }
        if (n_ > 0) { adaln_tasks(wv, pt, lds, 0, rank_, n_, 88, 256); tr_items(wv, pt, lds, 16 * 96, 16 * 96 + 16 * 32 + 16 * 176, rank_ * 8 + wv, n_ * 8); }
    }
    GSYNC();
    if (PHM & 8) for (int rep_ = 0; rep_ < REP_ATT; ++rep_) for (int vc = vcu_l(), G_ = gd_l(); vc < 256; vc += G_) {
        const int bh = vc >> 1;
#pragma unroll 1
        for (int gi = 0; gi < 2; ++gi)
            att::unit<true>(wv, lds, bh >> 4, bh & 15, 2 * (vc & 1) + gi, (const bf16_t*)WSP(WS_Q), (const bf16_t*)WSP(WS_K), (const bf16_t*)WSP(WS_V), pt.f(I_cache_k), pt.f(I_cache_v), XNP, pt.f(I_rpb));
        att::unit<false>(wv, lds, vc >> 4, vc & 15, 0, (const bf16_t*)WSP(WS_Q), (const bf16_t*)WSP(WS_K), (const bf16_t*)WSP(WS_V), nullptr, nullptr, XNP, nullptr);
    }
    GSYNC();
    if (PHM & 16)
#pragma unroll 1
    for (int rp_ = REP_P4 - 1; rp_ >= 0; --rp_) { pg8::Gemm g{XNP, (const bf16_t*)WSP(WS_WO), MT, D, D, D, D, wv}; pg8::StaticOrder S; S.init(MT, D, gd_l(), bx_l());
      pg8::EpiResT<true, true> E{pt.f(I_x_prompt), pt.f(I_x_sample), XBP, MODP + 2 * D, (bf16_t*)WSP(WS_XN2), pt.f(I_norm_g) + D, MODP + 4 * D, rp_ ? (float*)WSP(WS_HLF) : SSQP(0)};
      pg8::gemm_phase<pg8::EpiResT<true, true>, pg8::StaticOrder, false, PG8_SP2>(lds, g, S, E); }
    {
        const int G_ = gd_l(), c_ = bx_l(), nwg_ = (MT / 256) * (D / 256);
        int rank_ = c_, n_ = G_;
        if (nwg_ < G_) { rank_ = c_ - nwg_; n_ = c_ >= nwg_ ? G_ - nwg_ : 0; }
        if (n_ > 0) { shw_phase(wv, pt, lds, 0, rank_, n_); tr_items(wv, pt, lds, 16 * 96 + 16 * 32 + 16 * 176, 16 * 96 + 16 * 32 + 16 * 176 + 44 * 32, rank_ * 8 + wv, n_ * 8); }
    }
    GSYNC();
    if (PHM & 512) { pg8::Gemm g{(const bf16_t*)WSP(WS_XN2), (const bf16_t*)WSP(WS_WGU), MT, 2 * FF, D, D, D, wv}; pg8::StaticOrder S; S.init(MT, 2 * FF, gd_l(), bx_l()); S.reps = REP_GEMM;
      pg8::EpiSwiglu E{(bf16_t*)WSP(WS_H), SSQP(0), (const float*)WSP(WS_SHW) + SHW_OFF0};
      pg8::gemm_phase<pg8::EpiSwiglu, pg8::StaticOrder, PG8_ALIGN, PG8_SP2>(lds, g, S, E); }
    {
        const int G_ = gd_l(), c_ = bx_l(), nwg_ = (MT / 256) * (2 * FF / 256), maxu_ = (nwg_ + G_ - 1) / G_, full_ = nwg_ - (maxu_ - 1) * G_;
        int rank_ = c_, n_ = G_;
        if (full_ < G_) { rank_ = c_ - full_; n_ = c_ >= full_ ? G_ - full_ : 0; }
        if (n_ > 0) { adaln_tasks(wv, pt, lds, 1, rank_, n_); tr_items(wv, pt, lds, 16 * 96 + 16 * 32 + 2 * 16 * 176 + 44 * 32, 12288, rank_ * 8 + wv, n_ * 8); }
    }
    GSYNC();
    if (PHM & 16) { pg8::Gemm g{(const bf16_t*)WSP(WS_H), (const bf16_t*)WSP(WS_WDN), MT, D, FF, FF, FF, wv}; pg8::StaticOrder S; S.init(MT, D, gd_l(), bx_l());
      pg8::EpiResT<true, false> E{nullptr, nullptr, XBP, MODP + 5 * D, XNP, pt.f(I_norm_g) + 2 * D, MODP + (size_t)9 * NMOD + 1 * D, SSQP(1)};
      pg8::gemm_phase<pg8::EpiResT<true, false>, pg8::StaticOrder, false, PG8_SP2>(lds, g, S, E); }
    {
        const int G_ = gd_l(), c_ = bx_l(), nwg_ = (MT / 256) * (D / 256);
        int rank_ = c_, n_ = G_;
        if (nwg_ < G_) { rank_ = c_ - nwg_; n_ = c_ >= nwg_ ? G_ - nwg_ : 0; }
        if (n_ > 0) { shw_phase(wv, pt, lds, 1, rank_, n_); tr_items(wv, pt, lds, 16 * 96 + 16 * 32 + 16 * 176 + 44 * 32, 16 * 96 + 16 * 32 + 2 * 16 * 176 + 44 * 32, rank_ * 8 + wv, n_ * 8); }
    }
    GSYNC();
    if (PHM & 32) { pg8::Gemm g{XNP, (const bf16_t*)WSP(WS_WIN), MT, 2 * D, D, D, D, wv}; pg8::StaticOrder S; S.init(MT, 2 * D, gd_l(), bx_l()); S.reps = REP_GEMM;
      pg8::EpiWin E{(bf16_t*)WSP(WS_GATE), (bf16_t*)WSP(WS_XR), SSQP(1), (const float*)WSP(WS_SHW) + SHW_OFF1};
      pg8::gemm_phase<pg8::EpiWin, pg8::StaticOrder, PG8_ALIGN, PG8_SP2>(lds, g, S, E); }
    {
        const int G_ = gd_l(), c_ = bx_l(), nwg_ = (MT / 256) * (2 * D / 256), maxu_ = (nwg_ + G_ - 1) / G_, full_ = nwg_ - (maxu_ - 1) * G_;
        int rank_ = c_, n_ = G_;
        if (full_ < G_) { rank_ = c_ - full_; n_ = c_ >= full_ ? G_ - full_ : 0; }
        if (n_ > 0) shw_phase(wv, pt, lds, 2, rank_, n_);
    }
    GSYNC();
    if (PHM & 128)
#pragma unroll 1
    for (int uu = vcu_l(), G_ = gd_l(); uu < 768 * REP_LRU; uu += G_) {
        const int u = uu % 768;
        const int dir = u & 1, n = (u >> 1) & 7, q = u >> 4;
        const float* h0 = nullptr;
        if (q >= 16) { const int b = (q - 16) >> 2, ci = (q - 16) & 3; if ((dir == 0 && ci == 0) || (dir == 1 && ci == 3)) h0 = pt.f(I_state_h) + ((size_t)b * 2 + dir) * D; }
        conv_slab(wv, (const bf16_t*)WSP(WS_XR), pt.f(I_conv_w), pt.f(I_conv_b), XNP, q, n);
        pg8::Gemm g{XNP + (size_t)q * 256 * D + n * 128, (const bf16_t*)WSP(WS_WG) + (size_t)(n * 2 + dir) * 256 * 128, 256, 256, 128, D, 128, wv};
        pg8::OneUnit S;
        pg8::EpiLru E{pt.t, h0, q * 256, n * 128, dir, q};
        pg8::gemm_phase<pg8::EpiLru, pg8::OneUnit, false, false>(lds, g, S, E);
    }
    GSYNC();
    if (PHM & 256) for (int rep_ = 0; rep_ < REP_THIN; ++rep_) lru_combine_phase(wv, pt.ws(), (bf16_t*)WSP(WS_Y));
    GSYNC();
    if (PHM & 16) { pg8::Gemm g{(const bf16_t*)WSP(WS_Y), (const bf16_t*)WSP(WS_WOUT), MT, D, D, D, D, wv}; pg8::StaticOrder S; S.init(MT, D, gd_l(), bx_l());
      pg8::EpiResT<true, false> E{nullptr, nullptr, XBP, MODP + (size_t)9 * NMOD + 2 * D, XNP, pt.f(I_norm_g) + 3 * D, MODP + (size_t)9 * NMOD + 4 * D, SSQP(2)};
      pg8::gemm_phase<pg8::EpiResT<true, false>, pg8::StaticOrder, false, PG8_SP2>(lds, g, S, E); }
    GSYNC();
    if (PHM & 512) { pg8::Gemm g{XNP, (const bf16_t*)WSP(WS_WGU) + (size_t)2 * FF * D, MT, 2 * FF, D, D, D, wv}; pg8::StaticOrder S; S.init(MT, 2 * FF, gd_l(), bx_l()); S.reps = REP_GEMM;
      pg8::EpiSwiglu E{(bf16_t*)WSP(WS_H), SSQP(2), (const float*)WSP(WS_SHW) + SHW_OFF2};
      pg8::gemm_phase<pg8::EpiSwiglu, pg8::StaticOrder, PG8_ALIGN, PG8_SP2>(lds, g, S, E); }
    GSYNC();
    if (gd_l() >= (MT / 256) * (D / 256)) {
        pg8::Gemm g{(const bf16_t*)WSP(WS_H), (const bf16_t*)WSP(WS_WDN) + (size_t)D * FF, MT, D, FF, FF, FF, wv}; pg8::StaticOrder S; S.init(MT, D, gd_l(), bx_l());
        pg8::EpiResFinal E{XBP, MODP + (size_t)9 * NMOD + 5 * D, SSQP(3), (unsigned*)WSP(WS_FCNT), pt.f(I_final_g), XRES};
        pg8::gemm_phase<pg8::EpiResFinal, pg8::StaticOrder, true, PG8_SP2>(lds, g, S, E);
    } else {
        { pg8::Gemm g{(const bf16_t*)WSP(WS_H), (const bf16_t*)WSP(WS_WDN) + (size_t)D * FF, MT, D, FF, FF, FF, wv}; pg8::StaticOrder S; S.init(MT, D, gd_l(), bx_l());
          pg8::EpiResT<false, false> E{nullptr, nullptr, XBP, MODP + (size_t)9 * NMOD + 5 * D, nullptr, nullptr, nullptr, nullptr};
          pg8::gemm_phase<pg8::EpiResT<false, false>, pg8::StaticOrder, PG8_ALIGN, PG8_SP2>(lds, g, S, E); }
        GSYNC();
        final_norm_phase(wv, XBP, XRES, pt.f(I_final_g));
    }
}

extern "C" void kernel_launch(void* const* d_in, const int* in_sizes, int n_in, void* d_out, int out_size, void* d_ws, size_t ws_size, hipStream_t stream) {
    static int grid = 0;
    if (grid == 0) {
        int dev = 0, cus = 0, per_cu = 0;
        (void)hipGetDevice(&dev);
        (void)hipDeviceGetAttribute(&cus, hipDeviceAttributeMultiprocessorCount, dev);
        (void)hipFuncSetAttribute((const void*)fwd_megakernel, hipFuncAttributeMaxDynamicSharedMemorySize, LDS_BYTES);
        (void)hipOccupancyMaxActiveBlocksPerMultiprocessor(&per_cu, (const void*)fwd_megakernel, 512, LDS_BYTES);
        if (per_cu < 1) { fprintf(stderr, "kernel_launch: occupancy query says %d blocks per CU\n", per_cu); per_cu = 1; }
        grid = cus * per_cu;
        if (ws_size < WS_END) { fprintf(stderr, "kernel_launch: workspace too small (%zu < %zu)\n", ws_size, (size_t)WS_END); grid = -1; }
    }
    if (grid < 0) return;
    (void)hipMemsetAsync((char*)d_ws + WS_MOD, 0, 1024 * 1024, stream);
    Args a{};
    const float** ap = (const float**)&a;
    for (int i = 0; i < 25; ++i) ap[i] = (const float*)d_in[i];
    a.out = (float*)d_out; a.ws = (unsigned char*)d_ws;
    void* args[] = {&a};
    hipError_t e = hipLaunchCooperativeKernel((const void*)fwd_megakernel, dim3(grid), dim3(512), args, LDS_BYTES, stream);
    if (e != hipSuccess) fprintf(stderr, "cooperative launch failed: %s (grid %d)\n", hipGetErrorString(e), grid);
}
```

```cpp
#include <hip/hip_runtime.h>
#include <hip/hip_cooperative_groups.h>
#include <cstdio>
#include <cstdint>
namespace cg = cooperative_groups;

#define LAS __attribute__((address_space(3)))
typedef unsigned short bf16_t;
typedef short bf16x8 __attribute__((ext_vector_type(8)));
typedef short s16x4 __attribute__((ext_vector_type(4)));
typedef float f32x4 __attribute__((ext_vector_type(4)));
typedef float f32x2 __attribute__((ext_vector_type(2)));
typedef float f32x16 __attribute__((ext_vector_type(16)));
typedef unsigned u32x4 __attribute__((ext_vector_type(4)));
typedef unsigned u32x2 __attribute__((ext_vector_type(2)));
typedef __bf16 bf16x2_t __attribute__((ext_vector_type(2)));

constexpr int D = 1024, MC = 4096, ML = 8192, MT = MC + ML, FF = 2816, NQKV = 3072, NMOD = 6144;
constexpr float LOG2E = 1.4426950408889634f;
constexpr float RMS_EPS = 1e-6f;

constexpr size_t MiB = 1u << 20;
constexpr size_t WS_MOD = 0;
constexpr size_t WS_YCNT = 832 * 1024;
constexpr size_t WS_FCNT = 768 * 1024;
constexpr size_t WS_SSQ = 512 * 1024;
constexpr size_t WS_WQKV = 1 * MiB, WS_WO = 7 * MiB, WS_WGU = 9 * MiB, WS_WDN = 31 * MiB, WS_WIN = 42 * MiB, WS_WOUT = 46 * MiB, WS_WG = 48 * MiB;
constexpr size_t WS_CK = 49 * MiB, WS_CV = 57 * MiB;
constexpr size_t WS_PF = 49 * MiB;
constexpr size_t WS_XN = 65 * MiB;
constexpr size_t WS_Q = 89 * MiB, WS_K = 113 * MiB, WS_V = 137 * MiB;
constexpr size_t WS_H = 89 * MiB;
constexpr size_t WS_GATE = 89 * MiB, WS_XR = 113 * MiB, WS_Y = 113 * MiB;
constexpr size_t WS_XN2 = 161 * MiB;
constexpr size_t WS_PB = 137 * MiB;
constexpr size_t WS_XB = 185 * MiB;
constexpr size_t WS_HLF = 209 * MiB, WS_HLB = 161 * MiB;
constexpr size_t WS_SUMP = 250 * MiB;
constexpr size_t WS_SUME = 250 * MiB + 512 * 1024;
constexpr size_t WS_SHW = 252 * MiB;
constexpr int SHW_OFF0 = 0, SHW_OFF1 = 9 * 5632, SHW_OFF2 = 9 * 5632 + 9 * 2048;
constexpr size_t WS_END = 256 * MiB;

constexpr int LDS_BYTES = 143360;
constexpr int AB_PITCH = 1056;
constexpr int HST_OFF = 128 * AB_PITCH;

enum { I_x_prompt = 0, I_x_sample = 1, I_c = 2, I_cache_k = 3, I_cache_v = 4, I_state_h = 5, I_c_ctx = 6, I_norm_g = 7, I_w_mod = 8, I_b_mod = 9, I_w_qkv = 10, I_w_o = 11, I_rpb = 12, I_w_in = 13, I_conv_w = 14, I_conv_b = 15, I_w_a = 16, I_b_a = 17, I_w_i = 18, I_b_i = 19, I_lam = 20, I_w_out = 21, I_w_gu = 22, I_w_down = 23, I_final_g = 24, I_out = 25, I_ws = 26 };
constexpr int PTAB_OFF = LDS_BYTES - 256;
struct PT {
    LAS const unsigned long long* t;
    __device__ __forceinline__ unsigned long long raw(int i) const { const unsigned long long v = t[i]; const unsigned lo = __builtin_amdgcn_readfirstlane((unsigned)v), hi = __builtin_amdgcn_readfirstlane((unsigned)(v >> 32)); return ((unsigned long long)hi << 32) | lo; }
    __device__ __forceinline__ const float* f(int i) const { return (const float*)(const __attribute__((address_space(1))) float*)raw(i); }
    __device__ __forceinline__ float* out() const { return (float*)(__attribute__((address_space(1))) float*)raw(I_out); }
    __device__ __forceinline__ unsigned char* ws() const { return (unsigned char*)(__attribute__((address_space(1))) unsigned char*)raw(I_ws); }
};
constexpr size_t OUT_Y = 0, OUT_NK = (size_t)MT * D, OUT_NV = OUT_NK + (size_t)MC * D, OUT_NH = OUT_NV + (size_t)MC * D;
constexpr int CST_OFF = HST_OFF + 1024;
__device__ __forceinline__ int tid_l(int wv) { int l; asm volatile("v_mbcnt_lo_u32_b32 %0, -1, 0\n\tv_mbcnt_hi_u32_b32 %0, -1, %0" : "=v"(l)); return wv * 64 + l; }
__device__ __forceinline__ int bx_l() { int b = blockIdx.x; asm volatile("" : "+s"(b)); return b; }
__device__ __forceinline__ int gd_l() { int g = gridDim.x; asm volatile("" : "+s"(g)); return g; }
__device__ __forceinline__ int vcu_l() { const int b = bx_l(), g = gd_l(); return (g & 7) ? b : (b & 7) * (g >> 3) + (b >> 3); }

constexpr size_t WS_BAR = 448 * 1024;
constexpr int BARST_OFF = PTAB_OFF + 224;
#define XB_TMO      128
#define XB_XCNT(j)  (256  + 64 * (j))
#define XB_XSUB(j)  (1280 + 64 * (j))
#define XB_XGEN(j)  (2304 + 64 * (j))
#define XB_TOP      3328
#define XB_TOPGEN   3392
#define XCD_BAR_WORDS 3456
#define XB_SPIN_CAP (1u << 18)
__device__ __forceinline__ unsigned xb_ld(unsigned* p)              { return __hip_atomic_load(p, __ATOMIC_RELAXED, __HIP_MEMORY_SCOPE_AGENT); }
__device__ __forceinline__ unsigned xb_add(unsigned* p, unsigned v) { return __hip_atomic_fetch_add(p, v, __ATOMIC_RELAXED, __HIP_MEMORY_SCOPE_AGENT); }
__device__ __forceinline__ unsigned xb_xcc_id() { return (unsigned)__builtin_amdgcn_s_getreg((3 << 11) | 20) & 0xFu; }
#define XB_SPIN(cond, bar) do { unsigned _sp = 0; while (cond) { __builtin_amdgcn_s_sleep(1); \
    if ((++_sp & 255u) == 0u) { if (xb_ld(&(bar)[XB_TMO])) break; if (_sp > XB_SPIN_CAP) { atomicAdd(&(bar)[XB_TMO], 1u); break; } } } } while (0)
__device__ __forceinline__ void xcd_barrier_complete(unsigned* bar, unsigned x, unsigned& nloc, unsigned& nx) {
    const unsigned G = gridDim.x;
    unsigned sum, cnt, mine, sp = 0u;
    for (;;) {
        sum = 0u; cnt = 0u; mine = 0u;
#pragma unroll
        for (unsigned j = 0; j < 16; ++j) { const unsigned c = xb_ld(&bar[XB_XCNT(j)]); sum += c; cnt += (c > 0u) ? 1u : 0u; mine = (j == x) ? c : mine; }
        if (sum == G) break;
        __builtin_amdgcn_s_sleep(1);
        if ((++sp & 255u) == 0u) { if (xb_ld(&bar[XB_TMO])) break; if (sp > XB_SPIN_CAP) { atomicAdd(&bar[XB_TMO], 1u); break; } }
    }
    nloc = mine > 0u ? mine : 1u; nx = cnt > 0u ? cnt : 1u;
}
__device__ __forceinline__ void xcd_barrier(const PT pt, LAS unsigned char* lds, int wv) {
    asm volatile("s_waitcnt vmcnt(0)" ::: "memory");
    __syncthreads();
    if (tid_l(wv) == 0) {
        unsigned* bar = (unsigned*)(pt.ws() + WS_BAR);
        volatile LAS unsigned* st = (volatile LAS unsigned*)(lds + BARST_OFF);
        const unsigned x = xb_xcc_id();
        __builtin_amdgcn_s_waitcnt(0);
        unsigned nloc = st[0], nx = st[1];
        if (nloc == 0u) { xcd_barrier_complete(bar, x, nloc, nx); st[0] = nloc; st[1] = nx; }
        const unsigned old = xb_add(&bar[XB_XSUB(x)], 1u);
        const unsigned gen = old / nloc;
        if (old + 1u == (gen + 1u) * nloc) {
            __builtin_amdgcn_fence(__ATOMIC_RELEASE, "agent");
            asm volatile("s_waitcnt vmcnt(0)" ::: "memory");
            const unsigned og = xb_add(&bar[XB_TOP], 1u);
            const unsigned tg = og / nx;
            if (og + 1u == (tg + 1u) * nx) xb_add(&bar[XB_TOPGEN], 1u);
            else XB_SPIN(xb_ld(&bar[XB_TOPGEN]) == tg, bar);
            __builtin_amdgcn_fence(__ATOMIC_ACQUIRE, "agent");
            xb_add(&bar[XB_XGEN(x)], 1u);
            asm volatile("s_waitcnt vmcnt(0)" ::: "memory");
        } else {
            XB_SPIN(xb_ld(&bar[XB_XGEN(x)]) == gen, bar);
            __builtin_amdgcn_fence(__ATOMIC_ACQUIRE, "agent");
            asm volatile("s_waitcnt vmcnt(0)" ::: "memory");
        }
    }
    __syncthreads();
}
__device__ __forceinline__ unsigned pk_bf16(float lo, float hi) { f32x2 v = {lo, hi}; bf16x2_t b = __builtin_convertvector(v, bf16x2_t); return __builtin_bit_cast(unsigned, b); }
__device__ __forceinline__ float bf_lo(unsigned u) { return __uint_as_float(u << 16); }
__device__ __forceinline__ float bf_hi(unsigned u) { return __uint_as_float(u & 0xffff0000u); }
__device__ __forceinline__ float fast_rcp(float x) { return __builtin_amdgcn_rcpf(x); }
__device__ __forceinline__ float fast_exp2(float x) { return __builtin_amdgcn_exp2f(x); }
__device__ __forceinline__ float sigmoid_f(float x) { return fast_rcp(1.f + fast_exp2(-x * LOG2E)); }
__device__ __forceinline__ float silu_f(float x) { return x * sigmoid_f(x); }
__device__ __forceinline__ float gelu_tanh_f(float x) { const float u = 0.7978845608028654f * (x + 0.044715f * x * x * x); return x * sigmoid_f(2.f * u); }
__device__ __forceinline__ float shfl_xor_l(float v, int mask, int lane) { return __int_as_float(__builtin_amdgcn_ds_bpermute((lane ^ mask) << 2, __float_as_int(v))); }
__device__ __forceinline__ float wave_sum(float v, int lane) {
#pragma unroll
    for (int o = 1; o < 64; o <<= 1) v += shfl_xor_l(v, o, lane);
    return v;
}
namespace pg8 {
#define PG8_LAS __attribute__((address_space(3)))
constexpr int BM = 256, BK = 64, HALF = 128, HTB = HALF * BK * 2  , STAGE_BYTES = 8 * HTB, NXCD = 8, WGM = 4;

__host__ __device__ __forceinline__ int lds_byte(int r, int c) { const int st = (r >> 4) * 2 + (c >> 5), rr = r & 15, cc = c & 31, ob = rr * 64 + cc * 2; return st * 1024 + (ob ^ (((ob >> 9) & 1) << 5)); }
__host__ __device__ __forceinline__ void stage_rc(int b, int& R, int& C) { const int st = b / 1024, sb = b % 1024, swz = sb ^ (((sb >> 9) & 1) << 5); R = (st >> 1) * 16 + swz / 64; C = (st & 1) * 32 + (swz % 64) / 2; }
__host__ __device__ __forceinline__ int perm32(int rho) { const int n = rho >> 4, i = rho & 15; return 8 * (i >> 2) + 4 * n + (i & 3); }

struct Unit { int pm, pn; };
struct Gemm { const bf16_t* A; const bf16_t* Bt; int M, N, K, lda, ldb, wv; };

struct StaticOrder {
    int nM, nN, nwg, G, c;
    int reps = 1;
    __host__ __device__ __forceinline__ void init(int M, int N, int G_, int c_) { nM = M / BM; nN = N / BM; nwg = nM * nN; G = G_; c = c_; }
    __host__ __device__ __forceinline__ bool next(int i, Unit& u) const {
        const long L = (long)(i / reps) * G + c; if (L >= nwg) return false;
        int wgid = (int)L; { const int q = nwg / NXCD, r = nwg % NXCD, xcd = wgid % NXCD, off = wgid / NXCD; wgid = (xcd < r ? xcd * (q + 1) : r * (q + 1) + (xcd - r) * q) + off; }
        const int nig = WGM * nN, gid = wgid / nig, fm = gid * WGM, gsz = (nM - fm) < WGM ? (nM - fm) : WGM;
        u.pm = fm + ((wgid % nig) % gsz); u.pn = (wgid % nig) / gsz; return true;
    }
    __device__ __forceinline__ void a_ready(const Unit&) const {}
    __device__ __forceinline__ void done(const Unit&) const {}
};


template <class Epi, class Sched, bool ALIGN_EPI = false, bool SP2 = false>
__device__ __forceinline__ void gemm_phase(PG8_LAS unsigned char* lds, const Gemm g, const Sched& S, const Epi& E) {
    int wid_ = g.wv; asm volatile("" : "+s"(wid_));
    const int tid = tid_l(wid_), wid = wid_, lane = tid & 63, wr = wid >> 2, wc = wid & 3, fr = lane & 15, fq = lane >> 4;
    const int K = g.K, nt = K / BK;
    unsigned voffA[2], voffB[2];
#pragma unroll
    for (int i = 0; i < 2; ++i) { int R, C; stage_rc(tid * 16 + i * 8192, R, C); const int Rb = Epi::PERM ? ((R & ~31) + perm32(R & 31)) : R;
        voffA[i] = (unsigned)(R * g.lda + C) * 2u; voffB[i] = (unsigned)(Rb * g.ldb + C) * 2u; }
    const size_t kstep = (size_t)(BK * 2);
    const size_t hstepA = (size_t)HALF * g.lda * 2, hstepB = (size_t)HALF * g.ldb * 2;
    const size_t tstepA = 2 * hstepA, tstepB = 2 * hstepB;
    const unsigned ldsw = (unsigned)wid * 1024u;
    const int aoff = lds_byte(wr * 64 + fr, fq * 8), boff = lds_byte(wc * 32 + fr, fq * 8);
#define PG8_SA(b, h) (((b) * 2 + (h)) * HTB)
#define PG8_SB(b, h) ((4 + (b) * 2 + (h)) * HTB)
#define PG8_STAGE(bufoff, gbase, voff) do { _Pragma("unroll") for (int _i = 0; _i < 2; ++_i) \
        __builtin_amdgcn_global_load_lds((const unsigned*)((const char*)(gbase) + (voff)[_i]), (PG8_LAS unsigned*)(lds + (bufoff) + ldsw + _i * 8192), 16, 0, 0); } while (0)
#define PG8_LDA(dst, b, h) do { _Pragma("unroll") for (int m = 0; m < 4; ++m) _Pragma("unroll") for (int k = 0; k < 2; ++k) dst[m][k] = *(const PG8_LAS bf16x8*)(lds + PG8_SA(b, h) + aoff + m * 2048 + k * 1024); } while (0)
#define PG8_LDB(dst, b, h) do { _Pragma("unroll") for (int n = 0; n < 2; ++n) _Pragma("unroll") for (int k = 0; k < 2; ++k) dst[n][k] = *(const PG8_LAS bf16x8*)(lds + PG8_SB(b, h) + boff + n * 2048 + k * 1024); } while (0)
#define PG8_MMA(ai, bj, At, Bt) do { __builtin_amdgcn_s_setprio(1); _Pragma("unroll") for (int m = 0; m < 4; ++m) _Pragma("unroll") for (int n = 0; n < 2; ++n) _Pragma("unroll") for (int k = 0; k < 2; ++k) \
        acc[ai][bj][m][n] = __builtin_amdgcn_mfma_f32_16x16x32_bf16(Bt[n][k], At[m][k], acc[ai][bj][m][n], 0, 0, 0); __builtin_amdgcn_s_setprio(0); } while (0)
#define PG8_WAIT_V(n) asm volatile("s_waitcnt vmcnt(" #n ")" ::: "memory")
#define PG8_WAIT_L(n) asm volatile("s_waitcnt lgkmcnt(" #n ")" ::: "memory")
#define PG8_BAR __builtin_amdgcn_s_barrier()
#define PG8_SCHED __builtin_amdgcn_sched_barrier(0)
    Unit cur, nxt; int ui = 0;
    if (!S.next(0, cur)) return;
    f32x4 acc[2][2][4][2];
#pragma unroll
    for (int a = 0; a < 2; ++a)
#pragma unroll
        for (int b = 0; b < 2; ++b)
#pragma unroll
            for (int m = 0; m < 4; ++m)
#pragma unroll
                for (int n = 0; n < 2; ++n) acc[a][b][m][n] = (f32x4){0.f, 0.f, 0.f, 0.f};
    bf16x8 At[4][2], B0[2][2], B1[2][2];
    const char* cA = (const char*)g.A + (size_t)cur.pm * tstepA; const char* cB = (const char*)g.Bt + (size_t)cur.pn * tstepB;
    S.a_ready(cur);
    if constexpr (SP2) {
        PG8_STAGE(PG8_SB(0, 0), cB, voffB); PG8_STAGE(PG8_SB(0, 1), cB + hstepB, voffB); PG8_STAGE(PG8_SA(0, 0), cA, voffA); PG8_STAGE(PG8_SA(0, 1), cA + hstepA, voffA);
        if (wr == 1) PG8_BAR;
        PG8_WAIT_V(2); PG8_BAR;
        PG8_STAGE(PG8_SB(1, 0), cB + kstep, voffB); PG8_STAGE(PG8_SA(1, 0), cA + kstep, voffA); PG8_STAGE(PG8_SB(1, 1), cB + hstepB + kstep, voffB);
        PG8_WAIT_V(6); PG8_BAR;
    } else {
        PG8_STAGE(PG8_SB(0, 0), cB, voffB); PG8_STAGE(PG8_SA(0, 0), cA, voffA); PG8_STAGE(PG8_SB(0, 1), cB + hstepB, voffB); PG8_STAGE(PG8_SA(0, 1), cA + hstepA, voffA);
        if (wr == 1) PG8_BAR;
        PG8_WAIT_V(4); PG8_BAR;
        PG8_STAGE(PG8_SB(1, 0), cB + kstep, voffB); PG8_STAGE(PG8_SA(1, 0), cA + kstep, voffA); PG8_STAGE(PG8_SB(1, 1), cB + hstepB + kstep, voffB);
        PG8_WAIT_V(6); PG8_BAR;
    }
    for (;;) {
        const bool has_next = S.next(ui + 1, nxt);
        const char* nA = has_next ? (const char*)g.A + (size_t)nxt.pm * tstepA : cA; const char* nB = has_next ? (const char*)g.Bt + (size_t)nxt.pn * tstepB : cB;
        for (int t = 0; t < nt; t += 2) {
            const bool last = (t == nt - 2);
            const char* a1 = cA + (size_t)(t + 1) * kstep;
            const char* a2 = last ? nA : cA + (size_t)(t + 2) * kstep; const char* b2 = last ? nB : cB + (size_t)(t + 2) * kstep;
            const char* a3 = a2 + kstep; const char* b3 = b2 + kstep;
            if (last && has_next) S.a_ready(nxt);
            if constexpr (SP2) {
            PG8_LDB(B0, 0, 0); PG8_LDB(B1, 0, 1); PG8_SCHED; PG8_LDA(At, 0, 0); PG8_STAGE(PG8_SA(1, 1), a1 + hstepA, voffA);
            PG8_WAIT_V(8); PG8_WAIT_L(0); PG8_BAR; PG8_MMA(0, 0, At, B0); PG8_MMA(0, 1, At, B1); PG8_BAR; PG8_SCHED;
            PG8_LDA(At, 0, 1); PG8_STAGE(PG8_SB(0, 0), b2, voffB); PG8_STAGE(PG8_SB(0, 1), b2 + hstepB, voffB); PG8_STAGE(PG8_SA(0, 0), a2, voffA);
            PG8_WAIT_V(8); PG8_WAIT_L(0); PG8_BAR; PG8_MMA(1, 0, At, B0); PG8_MMA(1, 1, At, B1); PG8_BAR; PG8_SCHED;
            PG8_LDB(B0, 1, 0); PG8_LDB(B1, 1, 1); PG8_SCHED; PG8_LDA(At, 1, 0); PG8_STAGE(PG8_SA(0, 1), a2 + hstepA, voffA);
            PG8_WAIT_V(8); PG8_WAIT_L(0); PG8_BAR; PG8_MMA(0, 0, At, B0); PG8_MMA(0, 1, At, B1); PG8_BAR; PG8_SCHED;
            PG8_LDA(At, 1, 1); PG8_STAGE(PG8_SB(1, 0), b3, voffB); PG8_STAGE(PG8_SB(1, 1), b3 + hstepB, voffB); PG8_STAGE(PG8_SA(1, 0), a3, voffA);
            PG8_WAIT_V(8); PG8_WAIT_L(0); PG8_BAR; PG8_MMA(1, 0, At, B0); PG8_MMA(1, 1, At, B1); PG8_BAR; PG8_SCHED;
            } else {
            PG8_LDB(B0, 0, 0); PG8_SCHED; PG8_LDA(At, 0, 0); PG8_STAGE(PG8_SA(1, 1), a1 + hstepA, voffA);
            PG8_WAIT_L(8); PG8_BAR; PG8_WAIT_L(0); PG8_MMA(0, 0, At, B0); PG8_BAR; PG8_SCHED;
            PG8_LDB(B1, 0, 1); PG8_STAGE(PG8_SB(0, 0), b2, voffB);
            PG8_BAR; PG8_WAIT_L(0); PG8_MMA(0, 1, At, B1); PG8_BAR;
            PG8_LDA(At, 0, 1); PG8_STAGE(PG8_SA(0, 0), a2, voffA);
            PG8_BAR; PG8_WAIT_L(0); PG8_MMA(1, 0, At, B0); PG8_BAR; PG8_SCHED;
            PG8_STAGE(PG8_SB(0, 1), b2 + hstepB, voffB);
            PG8_WAIT_V(6); PG8_BAR; PG8_MMA(1, 1, At, B1); PG8_BAR;
            PG8_LDB(B0, 1, 0); PG8_SCHED; PG8_LDA(At, 1, 0); PG8_STAGE(PG8_SA(0, 1), a2 + hstepA, voffA);
            PG8_WAIT_L(8); PG8_BAR; PG8_WAIT_L(0); PG8_MMA(0, 0, At, B0); PG8_BAR; PG8_SCHED;
            PG8_LDB(B1, 1, 1); PG8_STAGE(PG8_SB(1, 0), b3, voffB);
            PG8_BAR; PG8_WAIT_L(0); PG8_MMA(0, 1, At, B1); PG8_BAR;
            PG8_LDA(At, 1, 1); PG8_STAGE(PG8_SA(1, 0), a3, voffA);
            PG8_BAR; PG8_WAIT_L(0); PG8_MMA(1, 0, At, B0); PG8_BAR; PG8_SCHED;
            PG8_STAGE(PG8_SB(1, 1), b3 + hstepB, voffB);
            PG8_WAIT_V(6); PG8_BAR; PG8_MMA(1, 1, At, B1); PG8_BAR;
            }
        }
        if constexpr (ALIGN_EPI) { if (wr == 0) PG8_BAR; }
        if constexpr (!Epi::AFTER_DRAIN) { E(acc, cur, wr, wc, fr, fq); S.done(cur); }
        if (!has_next) break;
#pragma unroll
        for (int a = 0; a < 2; ++a)
#pragma unroll
            for (int b = 0; b < 2; ++b)
#pragma unroll
                for (int m = 0; m < 4; ++m)
#pragma unroll
                    for (int n = 0; n < 2; ++n) acc[a][b][m][n] = (f32x4){0.f, 0.f, 0.f, 0.f};
        cur = nxt; cA = nA; cB = nB; ++ui;
        if constexpr (ALIGN_EPI) { if (wr == 1) PG8_BAR; }
    }
    PG8_WAIT_V(0);
    if constexpr (!ALIGN_EPI) { if (wr == 0) PG8_BAR; }
    PG8_BAR;
    if constexpr (Epi::AFTER_DRAIN) { E.fused(acc, cur, wr, wc, fr, fq, lds, wid, lane); S.done(cur); }
#undef PG8_SA
#undef PG8_SB
#undef PG8_STAGE
#undef PG8_LDA
#undef PG8_LDB
#undef PG8_MMA
#undef PG8_WAIT_V
#undef PG8_WAIT_L
#undef PG8_BAR
#undef PG8_SCHED
}
}

namespace pg8 {
struct OneUnit {
    __device__ __forceinline__ bool next(int i, Unit& u) const { if (i) return false; u.pm = 0; u.pn = 0; return true; }
    __device__ __forceinline__ void a_ready(const Unit&) const {}
    __device__ __forceinline__ void done(const Unit&) const {}
};
typedef f32x4 AccT[2][2][4][2];

struct EpiQKV {
    static constexpr bool PERM = true, AFTER_DRAIN = false;
    bf16_t* Q; float* newk; float qscale;
    __device__ __forceinline__ void operator()(const AccT& acc, const Unit& u, int wr, int wc, int fr, int fq) const {
        const int t = u.pn >> 2;
        bf16_t* base = Q + (size_t)t * MT * D;
        const float sc = t == 0 ? qscale : 1.f;
        float* fo = newk + (size_t)(t - 1) * MC * D;
        const bool wf = (t != 0) && (u.pm < MC / 256);
        const int colt = (u.pn & 3) * 256 + wc * 32 + 8 * fq, row0 = u.pm * 256 + wr * 64 + fr;
#pragma unroll
        for (int ai = 0; ai < 2; ++ai)
#pragma unroll
            for (int m = 0; m < 4; ++m) {
                const size_t ro = (size_t)(row0 + ai * 128 + m * 16) * D;
#pragma unroll
                for (int bj = 0; bj < 2; ++bj) {
                    const f32x4 v0 = acc[ai][bj][m][0] * sc, v1 = acc[ai][bj][m][1] * sc;
                    u32x4 w; w.x = pk_bf16(v0[0], v0[1]); w.y = pk_bf16(v0[2], v0[3]); w.z = pk_bf16(v1[0], v1[1]); w.w = pk_bf16(v1[2], v1[3]);
                    *(u32x4*)(base + ro + colt + bj * 128) = w;
                    if (wf) { *(f32x4*)(fo + ro + colt + bj * 128) = v0; *(f32x4*)(fo + ro + colt + bj * 128 + 4) = v1; }
                }
            }
    }
};
template <bool FUSE, bool SRCF32> struct EpiResT {
    static constexpr bool PERM = true, AFTER_DRAIN = false;
    const float *xa, *xb;
    bf16_t* xres;
    const float* gate;
    bf16_t* XNo; const float* gn; const float* scv; float* ssq;
    __device__ __forceinline__ void operator()(const AccT& acc, const Unit& u, int wr, int wc, int fr, int fq) const {
        const bool isc = u.pm < MC / 256;
        const int cv = isc ? 8 : ((u.pm - MC / 256) >> 2);
        const float* src = isc ? xa : xb - (size_t)MC * D;
        const int col0 = u.pn * 256 + wc * 32 + 8 * fq, row0 = u.pm * 256 + wr * 64 + fr;
        f32x4 gv[2][2], gm[2][2];
#pragma unroll
        for (int bj = 0; bj < 2; ++bj)
#pragma unroll
            for (int n = 0; n < 2; ++n) {
                const int c = col0 + bj * 128 + n * 4;
                gv[bj][n] = *(const f32x4*)(gate + (size_t)cv * NMOD + c);
                if (FUSE) gm[bj][n] = *(const f32x4*)(gn + c) * (*(const f32x4*)(scv + (size_t)cv * NMOD + c) + 1.f);
            }
#pragma unroll
        for (int ai = 0; ai < 2; ++ai)
#pragma unroll
        for (int mp = 0; mp < 2; ++mp) {
            f32x4 xs[2][2][2];
#pragma unroll
            for (int mm = 0; mm < 2; ++mm)
#pragma unroll
                for (int bj = 0; bj < 2; ++bj) {
                    const size_t o = (size_t)(row0 + ai * 128 + (2 * mp + mm) * 16) * D + col0 + bj * 128;
                    if (SRCF32) { xs[mm][bj][0] = *(const f32x4*)(src + o); xs[mm][bj][1] = *(const f32x4*)(src + o + 4); }
                    else { const u32x4 w = *(const u32x4*)(xres + o); xs[mm][bj][0] = (f32x4){bf_lo(w.x), bf_hi(w.x), bf_lo(w.y), bf_hi(w.y)}; xs[mm][bj][1] = (f32x4){bf_lo(w.z), bf_hi(w.z), bf_lo(w.w), bf_hi(w.w)}; }
                }
            asm volatile("" ::: "memory");
#pragma unroll
            for (int mm = 0; mm < 2; ++mm) {
                const int m = 2 * mp + mm;
                const int row = row0 + ai * 128 + m * 16;
                const size_t ro = (size_t)row * D + col0;
                float sq = 0.f;
#pragma unroll
                for (int bj = 0; bj < 2; ++bj) {
                    const f32x4 x0 = xs[mm][bj][0] + gv[bj][0] * acc[ai][bj][m][0], x1 = xs[mm][bj][1] + gv[bj][1] * acc[ai][bj][m][1];
                    { u32x4 w; w.x = pk_bf16(x0[0], x0[1]); w.y = pk_bf16(x0[2], x0[3]); w.z = pk_bf16(x1[0], x1[1]); w.w = pk_bf16(x1[2], x1[3]); *(u32x4*)(xres + ro + bj * 128) = w; }
                    if (FUSE) {
                        sq += ((x0[0] * x0[0] + x0[1] * x0[1]) + (x0[2] * x0[2] + x0[3] * x0[3])) + ((x1[0] * x1[0] + x1[1] * x1[1]) + (x1[2] * x1[2] + x1[3] * x1[3]));
                        const f32x4 y0 = x0 * gm[bj][0], y1 = x1 * gm[bj][1];
                        u32x4 w; w.x = pk_bf16(y0[0], y0[1]); w.y = pk_bf16(y0[2], y0[3]); w.z = pk_bf16(y1[0], y1[1]); w.w = pk_bf16(y1[2], y1[3]);
                        *(u32x4*)(XNo + ro + bj * 128) = w;
                    }
                }
                if (FUSE) { sq += shfl_xor_l(sq, 16, fr + 16 * fq); sq += shfl_xor_l(sq, 32, fr + 16 * fq); if (fq == 0) unsafeAtomicAdd(ssq + row, sq); }
            }
            asm volatile("" ::: "memory");
        }
    }
};
struct EpiResFinal {
    static constexpr bool PERM = true, AFTER_DRAIN = false;
    const bf16_t* xres; const float* gate; float* ssq; unsigned* cnt; const float* gfin; float* out;
    __device__ __forceinline__ void operator()(const AccT& acc_c, const Unit& u, int wr, int wc, int fr, int fq) const {
        AccT& acc = const_cast<AccT&>(acc_c);
        const int cv = u.pm < MC / 256 ? 8 : ((u.pm - MC / 256) >> 2);
        const int col0 = u.pn * 256 + wc * 32 + 8 * fq, row0 = u.pm * 256 + wr * 64 + fr, lane = fr + 16 * fq;
        f32x4 gv[2][2];
#pragma unroll
        for (int bj = 0; bj < 2; ++bj)
#pragma unroll
            for (int n = 0; n < 2; ++n) gv[bj][n] = *(const f32x4*)(gate + (size_t)cv * NMOD + col0 + bj * 128 + n * 4);
#pragma unroll
        for (int ai = 0; ai < 2; ++ai)
#pragma unroll
        for (int mp = 0; mp < 2; ++mp) {
            u32x4 xs[2][2];
#pragma unroll
            for (int mm = 0; mm < 2; ++mm)
#pragma unroll
                for (int bj = 0; bj < 2; ++bj) xs[mm][bj] = *(const u32x4*)(xres + (size_t)(row0 + ai * 128 + (2 * mp + mm) * 16) * D + col0 + bj * 128);
            asm volatile("" ::: "memory");
#pragma unroll
            for (int mm = 0; mm < 2; ++mm) {
                const int m = 2 * mp + mm;
                float sq = 0.f;
#pragma unroll
                for (int bj = 0; bj < 2; ++bj) {
                    const u32x4 w = xs[mm][bj];
                    const f32x4 x0 = (f32x4){bf_lo(w.x), bf_hi(w.x), bf_lo(w.y), bf_hi(w.y)} + gv[bj][0] * acc[ai][bj][m][0], x1 = (f32x4){bf_lo(w.z), bf_hi(w.z), bf_lo(w.w), bf_hi(w.w)} + gv[bj][1] * acc[ai][bj][m][1];
                    acc[ai][bj][m][0] = x0; acc[ai][bj][m][1] = x1;
                    sq += ((x0[0] * x0[0] + x0[1] * x0[1]) + (x0[2] * x0[2] + x0[3] * x0[3])) + ((x1[0] * x1[0] + x1[1] * x1[1]) + (x1[2] * x1[2] + x1[3] * x1[3]));
                }
                sq += shfl_xor_l(sq, 16, lane); sq += shfl_xor_l(sq, 32, lane);
                if (fq == 0) unsafeAtomicAdd(ssq + row0 + ai * 128 + m * 16, sq);
            }
        }
        asm volatile("s_waitcnt vmcnt(0)" ::: "memory");
        unsigned* c = cnt + 64 * u.pm;
        if (lane == 0) __hip_atomic_fetch_add(c, 1u, __ATOMIC_RELAXED, __HIP_MEMORY_SCOPE_AGENT);
        { unsigned sp = 0;
          while ((unsigned)__builtin_amdgcn_readfirstlane(__hip_atomic_load(c, __ATOMIC_RELAXED, __HIP_MEMORY_SCOPE_AGENT)) < 32u) { __builtin_amdgcn_s_sleep(2); if (++sp > (1u << 20)) break; } }
        float rs[2][4];
#pragma unroll
        for (int ai = 0; ai < 2; ++ai)
#pragma unroll
            for (int m = 0; m < 4; ++m) rs[ai][m] = __hip_atomic_load(ssq + row0 + ai * 128 + m * 16, __ATOMIC_RELAXED, __HIP_MEMORY_SCOPE_AGENT);
        f32x4 gf[2][2];
#pragma unroll
        for (int bj = 0; bj < 2; ++bj)
#pragma unroll
            for (int n = 0; n < 2; ++n) gf[bj][n] = *(const f32x4*)(gfin + col0 + bj * 128 + n * 4);
#pragma unroll
        for (int ai = 0; ai < 2; ++ai)
#pragma unroll
            for (int m = 0; m < 4; ++m) {
                const float rstd = __builtin_amdgcn_rsqf(rs[ai][m] * (1.f / D) + RMS_EPS);
                float* op = out + (size_t)(row0 + ai * 128 + m * 16) * D + col0;
#pragma unroll
                for (int bj = 0; bj < 2; ++bj) { *(f32x4*)(op + bj * 128) = acc[ai][bj][m][0] * rstd * gf[bj][0]; *(f32x4*)(op + bj * 128 + 4) = acc[ai][bj][m][1] * rstd * gf[bj][1]; }
            }
    }
};
struct EpiSwiglu {
    static constexpr bool PERM = true, AFTER_DRAIN = false;
    bf16_t* H; const float* ssq; const float* shw;
    __device__ __forceinline__ void operator()(const AccT& acc, const Unit& u, int wr, int wc, int fr, int fq) const {
        const int cv = u.pm < MC / 256 ? 8 : ((u.pm - MC / 256) >> 2);
        const int col0 = u.pn * 128 + wc * 32 + 8 * fq, row0 = u.pm * 256 + wr * 64 + fr;
        const float* sp = shw + (size_t)cv * 2 * FF + u.pn * 256 + wc * 32 + 8 * fq;
        const f32x4 sg0 = *(const f32x4*)(sp), sg1 = *(const f32x4*)(sp + 4), su0 = *(const f32x4*)(sp + 128), su1 = *(const f32x4*)(sp + 132);
        float rs[2][4];
#pragma unroll
        for (int ai = 0; ai < 2; ++ai)
#pragma unroll
            for (int m = 0; m < 4; ++m) rs[ai][m] = ssq[row0 + ai * 128 + m * 16];
        asm volatile("" ::: "memory");
#pragma unroll
        for (int ai = 0; ai < 2; ++ai)
#pragma unroll
            for (int m = 0; m < 4; ++m) rs[ai][m] = __builtin_amdgcn_rsqf(rs[ai][m] * (1.f / D) + RMS_EPS);
#pragma unroll
        for (int ai = 0; ai < 2; ++ai)
#pragma unroll
            for (int m = 0; m < 4; ++m) {
                const int row = row0 + ai * 128 + m * 16;
                const float rstd = rs[ai][m];
                float o[8];
#pragma unroll
                for (int n = 0; n < 2; ++n) {
                    const f32x4 gq = acc[ai][0][m][n] * rstd + (n ? sg1 : sg0), uq = acc[ai][1][m][n] * rstd + (n ? su1 : su0);
#pragma unroll
                    for (int j = 0; j < 4; ++j) o[n * 4 + j] = silu_f(gq[j]) * uq[j];
                }
                u32x4 w; w.x = pk_bf16(o[0], o[1]); w.y = pk_bf16(o[2], o[3]); w.z = pk_bf16(o[4], o[5]); w.w = pk_bf16(o[6], o[7]);
                *(u32x4*)(H + (size_t)row * FF + col0) = w;
            }
    }
};
struct EpiWin {
    static constexpr bool PERM = true, AFTER_DRAIN = false;
    bf16_t *G, *XR; const float* ssq; const float* shw;
    __device__ __forceinline__ void operator()(const AccT& acc, const Unit& u, int wr, int wc, int fr, int fq) const {
        const bool isg = u.pn < 4;
        const int cv = u.pm < MC / 256 ? 8 : ((u.pm - MC / 256) >> 2);
        bf16_t* base = isg ? G : XR;
        const int colt = (u.pn & 3) * 256 + wc * 32 + 8 * fq, row0 = u.pm * 256 + wr * 64 + fr;
        const float* sp = shw + (size_t)cv * 2 * D + u.pn * 256 + wc * 32 + 8 * fq;
        f32x4 sv[2][2];
#pragma unroll
        for (int bj = 0; bj < 2; ++bj) { sv[bj][0] = *(const f32x4*)(sp + bj * 128); sv[bj][1] = *(const f32x4*)(sp + bj * 128 + 4); }
        float rs[2][4];
#pragma unroll
        for (int ai = 0; ai < 2; ++ai)
#pragma unroll
            for (int m = 0; m < 4; ++m) rs[ai][m] = ssq[row0 + ai * 128 + m * 16];
        asm volatile("" ::: "memory");
#pragma unroll
        for (int ai = 0; ai < 2; ++ai)
#pragma unroll
            for (int m = 0; m < 4; ++m) rs[ai][m] = __builtin_amdgcn_rsqf(rs[ai][m] * (1.f / D) + RMS_EPS);
#pragma unroll
        for (int ai = 0; ai < 2; ++ai)
#pragma unroll
            for (int m = 0; m < 4; ++m) {
                const int row = row0 + ai * 128 + m * 16;
                const float rstd = rs[ai][m];
#pragma unroll
                for (int bj = 0; bj < 2; ++bj) {
                    f32x4 v0 = acc[ai][bj][m][0] * rstd + sv[bj][0], v1 = acc[ai][bj][m][1] * rstd + sv[bj][1];
                    if (isg) {
#pragma unroll
                        for (int j = 0; j < 4; ++j) { v0[j] = gelu_tanh_f(v0[j]); v1[j] = gelu_tanh_f(v1[j]); }
                    }
                    u32x4 w; w.x = pk_bf16(v0[0], v0[1]); w.y = pk_bf16(v0[2], v0[3]); w.z = pk_bf16(v1[0], v1[1]); w.w = pk_bf16(v1[2], v1[3]);
                    *(u32x4*)(base + (size_t)row * D + colt + bj * 128) = w;
                }
            }
    }
};
struct EpiLru {
    static constexpr bool PERM = true, AFTER_DRAIN = true;
    LAS const unsigned long long* ptab;
    const float* h0;
    int row_base, cb, dir, q;

    template <int AI>
    __device__ __forceinline__ void half(const AccT& acc, int wr, int wc, int fr, int fq, PG8_LAS unsigned char* lds, int tid,
                                         const u32x4 (&xall)[4], bf16_t* HL, bf16_t* PP) const {
#pragma unroll
        for (int m = 0; m < 4; ++m) {
            const int tl = wr * 64 + m * 16 + fr;
            const size_t row = (size_t)(row_base + AI * 128 + tl);
#pragma unroll
            for (int n = 0; n < 2; ++n) {
                asm volatile("" ::: "memory");
                const int chl = wc * 32 + 8 * fq + 4 * n;
                const PG8_LAS f32x4* cst = (const PG8_LAS f32x4*)(lds + CST_OFF + chl * 4);
                const f32x4 ba = cst[0], bi = cst[32], L2 = cst[64];
                u32x2 xw; xw.x = n ? xall[m].z : xall[m].x; xw.y = n ? xall[m].w : xall[m].y;
                const f32x4 xc = {bf_lo(xw.x), bf_hi(xw.x), bf_lo(xw.y), bf_hi(xw.y)};
                f32x4 av, bv;
#pragma unroll
                for (int j = 0; j < 4; ++j) {
                    const float za = acc[AI][0][m][n][j] + ba[j], zi = acc[AI][1][m][n][j] + bi[j];
                    const float r = sigmoid_f(za), ig = sigmoid_f(zi);
                    const float a = fast_exp2(r * L2[j]);
                    av[j] = a; bv[j] = __builtin_amdgcn_sqrtf(1.f - a * a) * (ig * xc[j]);
                }
                PG8_LAS f32x4* dst = (PG8_LAS f32x4*)(lds + tl * AB_PITCH + chl * 8);
                dst[0] = (f32x4){av[0], bv[0], av[1], bv[1]}; dst[1] = (f32x4){av[2], bv[2], av[3], bv[3]};
            }
        }
        __syncthreads();
        if (tid < 128) {
            PG8_LAS float* hst = (PG8_LAS float*)(lds + HST_OFF);
            float h = hst[tid], P = hst[128 + tid];
            PG8_LAS f32x2* col = (PG8_LAS f32x2*)(lds + tid * 8);
            if (dir == 0) {
#pragma unroll 8
                for (int t = 0; t < 128; ++t) { PG8_LAS f32x2* p = (PG8_LAS f32x2*)((PG8_LAS unsigned char*)col + t * AB_PITCH); const f32x2 ab = *p; h = ab.x * h + ab.y; P *= ab.x; *p = (f32x2){h, P}; }
            } else {
#pragma unroll 8
                for (int t = 127; t >= 0; --t) { PG8_LAS f32x2* p = (PG8_LAS f32x2*)((PG8_LAS unsigned char*)col + t * AB_PITCH); const f32x2 ab = *p; h = ab.x * h + ab.y; P *= ab.x; *p = (f32x2){h, P}; }
            }
            hst[tid] = h; hst[128 + tid] = P;
        }
        __syncthreads();
        const bool lat = row_base >= MC;
#pragma unroll
        for (int it = 0; it < 8; ++it) {
            const int idx = it * 512 + tid, tl = idx >> 5, c4 = (idx & 31) * 4;
            const PG8_LAS f32x4* src = (const PG8_LAS f32x4*)(lds + tl * AB_PITCH + c4 * 8);
            const f32x4 s0 = src[0], s1 = src[1];
            const size_t row = (size_t)(row_base + AI * 128 + tl);
            { u32x2 wh; wh.x = pk_bf16(s0[0], s0[2]); wh.y = pk_bf16(s1[0], s1[2]); *(u32x2*)(HL + row * D + cb + c4) = wh; }
            if (lat) { u32x2 w; w.x = pk_bf16(s0[1], s0[3]); w.y = pk_bf16(s1[1], s1[3]); *(u32x2*)(PP + (row - MC) * D + cb + c4) = w; }
        }
        __syncthreads();
    }
    __device__ __forceinline__ void fused(AccT& acc, const Unit&, int wr, int wc, int fr, int fq, PG8_LAS unsigned char* lds, int wid, int lane) const {
        const int tid = wid * 64 + lane;
        const PT pt{ptab};
        unsigned char* ws = pt.ws();
        PG8_LAS float* hst = (PG8_LAS float*)(lds + HST_OFF);
        PG8_LAS float* cst = (PG8_LAS float*)(lds + CST_OFF);
        if (tid < 128) {
            hst[tid] = h0 ? h0[cb + tid] : 0.f; hst[128 + tid] = 1.f;
            const int ch = dir * D + cb + tid;
            cst[tid] = pt.f(I_b_a)[ch]; cst[128 + tid] = pt.f(I_b_i)[ch];
            const float l = pt.f(I_lam)[ch];
            const float x = __expf(-l);
            const float sp = x < 0.03f ? x * (1.f - x * (0.5f - x * (0.33333334f - 0.25f * x))) : __logf(1.f + x);
            cst[256 + tid] = -8.0f * sp * LOG2E;
        }
        __syncthreads();
        const bf16_t* XC = (const bf16_t*)(ws + WS_XN);
        bf16_t* HL = (bf16_t*)(ws + (dir ? WS_HLB : WS_HLF));
        bf16_t* PP = (bf16_t*)(ws + (dir ? WS_PB : WS_PF));
        u32x4 xc0[4], xc1[4];
#pragma unroll
        for (int m = 0; m < 4; ++m) {
            xc0[m] = *(const u32x4*)(XC + (size_t)(row_base + wr * 64 + m * 16 + fr) * D + cb + wc * 32 + 8 * fq);
            xc1[m] = *(const u32x4*)(XC + (size_t)(row_base + 128 + wr * 64 + m * 16 + fr) * D + cb + wc * 32 + 8 * fq);
        }
        if (dir == 0) { half<0>(acc, wr, wc, fr, fq, lds, tid, xc0, HL, PP); half<1>(acc, wr, wc, fr, fq, lds, tid, xc1, HL, PP); }
        else          { half<1>(acc, wr, wc, fr, fq, lds, tid, xc1, HL, PP); half<0>(acc, wr, wc, fr, fq, lds, tid, xc0, HL, PP); }
        if (tid < 128) {
            const float h = hst[tid], P = hst[128 + tid];
            float* sumE = (float*)(ws + WS_SUME) + (size_t)dir * 48 * D; float* sumP = (float*)(ws + WS_SUMP) + (size_t)dir * 48 * D;
            sumE[(size_t)q * D + cb + tid] = h; sumP[(size_t)q * D + cb + tid] = P;
            if (row_base < MC) pt.out()[OUT_NH + (size_t)q * 2 * D + dir * D + cb + tid] = h;
        }
        __syncthreads();
    }
};
}
namespace att {
constexpr int KP = 144, VP = 136;
constexpr int K_OFF = 0, V_OFF = 2 * 64 * KP, F_OFF = V_OFF + 2 * 64 * KP, T_OFF = F_OFF + 8 * 32 * 4, A_END = T_OFF + 640 * 4;
typedef short v4i16_t __attribute__((ext_vector_type(4)));
#define MFMA32(a, b, c) __builtin_amdgcn_mfma_f32_32x32x16_bf16((a), (b), (c), 0, 0, 0)
__device__ __forceinline__ float max2f(float a, float b) { float r; asm("v_max_f32_e32 %0, %1, %2" : "=v"(r) : "v"(a), "v"(b)); return r; }
__device__ __forceinline__ float max3f(float a, float b, float c) { float r; asm("v_max3_f32 %0, %1, %2, %3" : "=v"(r) : "v"(a), "v"(b), "v"(c)); return r; }
__device__ __forceinline__ int crow(int r, int hi) { return (r & 3) + 8 * (r >> 2) + 4 * hi; }

template <bool NA>
__device__ __forceinline__ void unit(int wv, LAS unsigned char* lds, int b, int h, int g, const bf16_t* __restrict__ Qb, const bf16_t* __restrict__ Kb, const bf16_t* __restrict__ Vb,
                                     const float* __restrict__ CK, const float* __restrict__ CV, bf16_t* __restrict__ Ob, const float* __restrict__ rpb) {
    int wid_ = wv; asm volatile("" : "+s"(wid_));
    const int tid = tid_l(wid_), lane = tid & 63, wid = wid_, r32 = lane & 31, hi = lane >> 5;
    LAS float* fscr = (LAS float*)(lds + F_OFF) + wid * 32;
    LAS float* tab = (LAS float*)(lds + T_OFF);
    if (NA) { for (int i = tid; i < 15 * 31; i += 512) { const int dr = i / 31, dc = i % 31; tab[64 + dr * 32 + dc] = rpb[(h * 15 + dr) * 31 + dc] * LOG2E; } }
    int qrow, nlat, ntile, Rlo = 0, rq = 0, rs = 0;
    if (NA) {
        rq = 4 * g + (wid >> 1); rs = min(max(rq - 4, 0), 8);
        qrow = MC + b * 1024 + rq * 64 + 32 * (wid & 1) + r32;
        Rlo = min(max(4 * g - 4, 0), 8); const int Rhi = min(max(4 * g - 1, 0), 8) + 8;
        nlat = Rhi - Rlo; ntile = nlat + 8;
    } else { qrow = b * 256 + 32 * wid + r32; nlat = 4; ntile = 4; }
    const int qc = 32 * (wid & 1) + r32, cs = min(max(qc - 8, 0), 48);
    f32x16 pen0, pen1;
#pragma unroll
    for (int i = 0; i < 16; ++i) { const int kc = (i & 3) + 8 * (i >> 2) + 4 * hi - cs; pen0[i] = (NA && (unsigned)kc >= 16u) ? -1e30f : 0.f; pen1[i] = (NA && (unsigned)(kc + 32) >= 16u) ? -1e30f : 0.f; }
    bf16x8 qr[4];
#pragma unroll
    for (int s = 0; s < 4; ++s) qr[s] = *(const bf16x8*)(Qb + (size_t)qrow * D + h * 64 + 16 * s + 8 * hi);
    const int lkey = tid >> 3, lch = tid & 7;
    auto src_row = [&](int t) -> size_t {
        if (NA) return t < nlat ? (size_t)(MC + b * 1024 + (Rlo + t) * 64) : (size_t)(b * 512 + (t - nlat) * 64);
        return (size_t)(b * 256 + t * 64);
    };
    u32x4 kreg = {0u, 0u, 0u, 0u}, vreg = kreg, kreg2 = kreg, vreg2 = kreg;
    auto gload = [&](int t) {
        const bool cache = NA && t >= nlat;
        const size_t off = (src_row(t) + lkey) * D + h * 64 + 8 * lch;
        const unsigned char* kp = cache ? (const unsigned char*)CK + off * 4 : (const unsigned char*)Kb + off * 2;
        const unsigned char* vp = cache ? (const unsigned char*)CV + off * 4 : (const unsigned char*)Vb + off * 2;
        const size_t second = cache ? 16 : 0;
        kreg = *(const u32x4*)kp; kreg2 = *(const u32x4*)(kp + second);
        vreg = *(const u32x4*)vp; vreg2 = *(const u32x4*)(vp + second);
    };
    auto lstore = [&](int buf, int t) {
        LAS u32x4* kd = (LAS u32x4*)(lds + K_OFF + buf * 64 * KP + lkey * KP + lch * 16);
        LAS u32x4* vd = (LAS u32x4*)(lds + V_OFF + buf * 64 * KP + lkey * KP + lch * 16);
        if (NA && t >= nlat) {
            *kd = (u32x4){pk_bf16(__uint_as_float(kreg.x), __uint_as_float(kreg.y)), pk_bf16(__uint_as_float(kreg.z), __uint_as_float(kreg.w)),
                          pk_bf16(__uint_as_float(kreg2.x), __uint_as_float(kreg2.y)), pk_bf16(__uint_as_float(kreg2.z), __uint_as_float(kreg2.w))};
            *vd = (u32x4){pk_bf16(__uint_as_float(vreg.x), __uint_as_float(vreg.y)), pk_bf16(__uint_as_float(vreg.z), __uint_as_float(vreg.w)),
                          pk_bf16(__uint_as_float(vreg2.x), __uint_as_float(vreg2.y)), pk_bf16(__uint_as_float(vreg2.z), __uint_as_float(vreg2.w))};
        } else { *kd = kreg; *vd = vreg; }
    };
    float m_run = -1e30f, l_run = 0.f;
    f32x16 o0, o1;
#pragma unroll
    for (int i = 0; i < 16; ++i) { o0[i] = 0.f; o1[i] = 0.f; }
    gload(0); lstore(0, 0);
    asm volatile("" :: "v"(qr[0]), "v"(qr[1]), "v"(qr[2]), "v"(qr[3]));
    __syncthreads();
    for (int t = 0; t < ntile; ++t) {
        const int buf = t & 1;
        if (t + 1 < ntile) gload(t + 1);
        bool active = true, biased = false; int dr = 0;
        if (NA && t < nlat) { const int R = Rlo + t; active = (R >= rs) && (R < rs + 8); biased = true; dr = R - rq + 7; }
        if (active) {
            f32x16 p0, p1;
#pragma unroll
            for (int i = 0; i < 16; ++i) { p0[i] = 0.f; p1[i] = 0.f; }
            const LAS unsigned char* kb = lds + K_OFF + buf * 64 * KP + r32 * KP + 16 * hi;
#pragma unroll
            for (int s = 0; s < 4; ++s) {
                const bf16x8 k0 = *(const LAS bf16x8*)(kb + 32 * s), k1 = *(const LAS bf16x8*)(kb + 32 * KP + 32 * s);
                p0 = MFMA32(k0, qr[s], p0); p1 = MFMA32(k1, qr[s], p1);
            }
            if (biased) {
                const LAS float* tb = tab + 64 + dr * 32 + (4 * hi - qc + 15);
                f32x16 b0, b1;
#pragma unroll
                for (int i = 0; i < 16; ++i) { const int kc = (i & 3) + 8 * (i >> 2); b0[i] = tb[kc]; b1[i] = tb[kc + 32]; }
                p0 += b0; p1 += b1; p0 += pen0; p1 += pen1;
            }
            float mxa = max3f(p0[0], p0[1], p0[2]), mxb = max3f(p0[3], p0[4], p0[5]), mxc = max3f(p1[0], p1[1], p1[2]), mxd = max3f(p1[3], p1[4], p1[5]);
            mxa = max3f(mxa, p0[6], p0[7]); mxb = max3f(mxb, p0[8], p0[9]); mxc = max3f(mxc, p1[6], p1[7]); mxd = max3f(mxd, p1[8], p1[9]);
            mxa = max3f(mxa, p0[10], p0[11]); mxb = max3f(mxb, p0[12], p0[13]); mxc = max3f(mxc, p1[10], p1[11]); mxd = max3f(mxd, p1[12], p1[13]);
            mxa = max3f(mxa, p0[14], p0[15]); mxc = max3f(mxc, p1[14], p1[15]);
            float mx = max2f(max2f(mxa, mxb), max2f(mxc, mxd));
            mx = max2f(mx, shfl_xor_l(mx, 32, lane));
            const float mnew = max2f(m_run, mx);
            const float f = fast_exp2(m_run - mnew);
            m_run = mnew;
            p0 -= mnew; p1 -= mnew;
#pragma unroll
            for (int i = 0; i < 16; ++i) { p0[i] = fast_exp2(p0[i]); p1[i] = fast_exp2(p1[i]); }
            f32x4 ls4 = {0.f, 0.f, 0.f, 0.f};
#pragma unroll
            for (int i = 0; i < 16; i += 4) ls4 += (f32x4){p0[i], p0[i + 1], p0[i + 2], p0[i + 3]} + (f32x4){p1[i], p1[i + 1], p1[i + 2], p1[i + 3]};
            const float ls = (ls4[0] + ls4[1]) + (ls4[2] + ls4[3]);
            l_run = l_run * f + ls;
            if (__any(f != 1.f)) {
                if (hi == 0) fscr[r32] = f;
                asm volatile("s_waitcnt lgkmcnt(0)" ::: "memory");
#pragma unroll
                for (int i = 0; i < 16; ++i) { const float fi = fscr[crow(i, hi)]; o0[i] *= fi; o1[i] *= fi; }
                asm volatile("s_waitcnt lgkmcnt(0)" ::: "memory");
            }
            bf16x8 pa[2][2];
#pragma unroll
            for (int s = 0; s < 2; ++s) {
                u32x4 w0, w1;
                w0.x = pk_bf16(p0[8 * s + 0], p0[8 * s + 1]); w0.y = pk_bf16(p0[8 * s + 2], p0[8 * s + 3]); w0.z = pk_bf16(p0[8 * s + 4], p0[8 * s + 5]); w0.w = pk_bf16(p0[8 * s + 6], p0[8 * s + 7]);
                w1.x = pk_bf16(p1[8 * s + 0], p1[8 * s + 1]); w1.y = pk_bf16(p1[8 * s + 2], p1[8 * s + 3]); w1.z = pk_bf16(p1[8 * s + 4], p1[8 * s + 5]); w1.w = pk_bf16(p1[8 * s + 6], p1[8 * s + 7]);
                pa[0][s] = __builtin_bit_cast(bf16x8, w0); pa[1][s] = __builtin_bit_cast(bf16x8, w1);
            }
            const int i16 = lane & 15, g16 = (lane >> 4) & 1;
            const LAS unsigned char* vb = lds + V_OFF + buf * 64 * KP + (4 * hi + (i16 >> 2)) * KP + (16 * g16 + 4 * (i16 & 3)) * 2;
#pragma unroll
            for (int blk = 0; blk < 2; ++blk)
#pragma unroll
                for (int s = 0; s < 2; ++s) {
                    const int ko = (32 * blk + 16 * s) * KP;
                    const s16x4 a0 = __builtin_bit_cast(s16x4, __builtin_amdgcn_ds_read_tr16_b64_v4i16((LAS v4i16_t*)(vb + ko))), a1 = __builtin_bit_cast(s16x4, __builtin_amdgcn_ds_read_tr16_b64_v4i16((LAS v4i16_t*)(vb + ko + 8 * KP)));
                    const s16x4 c0 = __builtin_bit_cast(s16x4, __builtin_amdgcn_ds_read_tr16_b64_v4i16((LAS v4i16_t*)(vb + ko + 64))), c1 = __builtin_bit_cast(s16x4, __builtin_amdgcn_ds_read_tr16_b64_v4i16((LAS v4i16_t*)(vb + ko + 8 * KP + 64)));
                    const bf16x8 v0 = __builtin_shufflevector(a0, a1, 0, 1, 2, 3, 4, 5, 6, 7), v1 = __builtin_shufflevector(c0, c1, 0, 1, 2, 3, 4, 5, 6, 7);
                    o0 = MFMA32(pa[blk][s], v0, o0); o1 = MFMA32(pa[blk][s], v1, o1);
                }
        }
        if (t + 1 < ntile) lstore(buf ^ 1, t + 1);
        __syncthreads();
    }
    l_run += shfl_xor_l(l_run, 32, lane);
    if (hi == 0) fscr[r32] = fast_rcp(l_run);
    asm volatile("s_waitcnt lgkmcnt(0)" ::: "memory");
    const int qbase = qrow - r32;
    LAS unsigned char* stg = lds + K_OFF + wid * (32 * KP);
#pragma unroll
    for (int i = 0; i < 16; ++i) {
        const int qi = crow(i, hi); const float li = fscr[qi];
        LAS unsigned short* sp = (LAS unsigned short*)(stg + qi * KP + r32 * 2);
        sp[0] = (unsigned short)(pk_bf16(o0[i] * li, 0.f) & 0xffff); sp[32] = (unsigned short)(pk_bf16(o1[i] * li, 0.f) & 0xffff);
    }
    asm volatile("s_waitcnt lgkmcnt(0)" ::: "memory");
    {
        const int row = lane >> 1, half = lane & 1;
        bf16_t* op = Ob + (size_t)(qbase + row) * D + h * 64 + half * 32;
#pragma unroll
        for (int j = 0; j < 4; ++j) *(u32x4*)(op + 8 * j) = *(const LAS u32x4*)(stg + row * KP + half * 64 + 16 * j);
    }
    __syncthreads();
}
}
#ifndef REP_P4
#define REP_P4 1
#endif
#ifndef REP_ADA
#define REP_ADA 1
#endif
#ifndef REP_PRO
#define REP_PRO 1
#endif
#ifndef REP_FILL
#define REP_FILL 1
#endif
#ifndef REP_ATT
#define REP_ATT 1
#endif
#ifndef REP_GEMM
#define REP_GEMM 1
#endif
#ifndef REP_THIN
#define REP_THIN 1
#endif
#ifndef REP_LRU
#define REP_LRU 1
#endif
#ifndef REP_SYNC
#define REP_SYNC 1
#endif
struct Args {
    const float *x_prompt, *x_sample, *c, *cache_k, *cache_v, *state_h, *c_ctx, *norm_g, *w_mod, *b_mod, *w_qkv, *w_o, *rpb, *w_in, *conv_w, *conv_b,
                *w_a, *b_a, *w_i, *b_i, *lam, *w_out, *w_gu, *w_down, *final_g;
    float* out; unsigned char* ws;
};

__device__ __forceinline__ void tr_item(const float* __restrict__ W, int ldw, int k0, int n0, bf16_t* __restrict__ dst, int ldd, LAS float* scr, int lane) {
    float tv[32];
#pragma unroll
    for (int i = 0; i < 32; ++i) { const int kk = 2 * i + (lane >> 5); tv[i] = W[(size_t)(k0 + kk) * ldw + n0 + (lane & 31)]; }
#pragma unroll
    for (int i = 0; i < 32; ++i) { const int kk = 2 * i + (lane >> 5); scr[kk * 33 + (lane & 31)] = tv[i]; }
    asm volatile("s_waitcnt lgkmcnt(0)" ::: "memory");
    const int c = lane & 7;
#pragma unroll
    for (int j = 0; j < 4; ++j) {
        const int n = (lane >> 3) + 8 * j; const LAS float* s = scr + (8 * c) * 33 + n;
        u32x4 o; o.x = pk_bf16(s[0 * 33], s[1 * 33]); o.y = pk_bf16(s[2 * 33], s[3 * 33]); o.z = pk_bf16(s[4 * 33], s[5 * 33]); o.w = pk_bf16(s[6 * 33], s[7 * 33]);
        *(u32x4*)(dst + (size_t)n * ldd + k0 + 8 * c) = o;
    }
    asm volatile("s_waitcnt lgkmcnt(0)" ::: "memory");
}

__device__ __forceinline__ void tr_items(int wv, const PT pt, LAS unsigned char* lds, int it0, int it1, int gwr, int ngw) {
    const int lane = tid_l(wv) & 63;
    unsigned char* ws = pt.ws();
    {
        LAS float* scr = (LAS float*)(lds + wv * 8448);
        constexpr int I_QKV = 16 * 96, I_WO = 16 * 32, I_GU = 16 * 176, I_DN = 44 * 32, I_WIN = 16 * 64, I_WOUT = 16 * 32, I_G = 32 * 8;
        for (int it = it0 + gwr; it < it1; it += ngw) {
            int r = it;
            if (r < I_QKV) { const int kb = r / 96, nb = r % 96; tr_item(pt.f(I_w_qkv), NQKV, 64 * kb, 32 * nb, (bf16_t*)(ws + WS_WQKV) + (size_t)(32 * nb) * D, D, scr, lane); continue; } r -= I_QKV;
            if (r < I_WO) { const int kb = r / 32, nb = r % 32; tr_item(pt.f(I_w_o), D, 64 * kb, 32 * nb, (bf16_t*)(ws + WS_WO) + (size_t)(32 * nb) * D, D, scr, lane); continue; } r -= I_WO;
#pragma unroll 1
            for (int l = 0; l < 2; ++l) {
                if (r >= 0 && r < I_GU) { const int kb = r / 176, nb = r % 176; const int n0 = 32 * nb, half = n0 >= FF ? 1 : 0, c0 = n0 - half * FF;
                    const int drow = 256 * (c0 >> 7) + 128 * half + (c0 & 127);
                    tr_item(pt.f(I_w_gu) + (size_t)l * D * 2 * FF, 2 * FF, 64 * kb, n0, (bf16_t*)(ws + WS_WGU) + ((size_t)l * 2 * FF + drow) * D, D, scr, lane); r = -1; break; } r -= I_GU;
                if (r >= 0 && r < I_DN) { const int kb = r / 32, nb = r % 32;
                    tr_item(pt.f(I_w_down) + (size_t)l * FF * D, D, 64 * kb, 32 * nb, (bf16_t*)(ws + WS_WDN) + ((size_t)l * D + 32 * nb) * FF, FF, scr, lane); r = -1; break; } r -= I_DN;
            }
            if (r < 0) continue;
            if (r < I_WIN) { const int kb = r / 64, nb = r % 64; tr_item(pt.f(I_w_in), 2 * D, 64 * kb, 32 * nb, (bf16_t*)(ws + WS_WIN) + (size_t)(32 * nb) * D, D, scr, lane); continue; } r -= I_WIN;
            if (r < I_WOUT) { const int kb = r / 32, nb = r % 32; tr_item(pt.f(I_w_out), D, 64 * kb, 32 * nb, (bf16_t*)(ws + WS_WOUT) + (size_t)(32 * nb) * D, D, scr, lane); continue; } r -= I_WOUT;
            { const int mat = r >> 3, sub = r & 7, kb = sub >> 2, nb = sub & 3;
              const int gsel = mat >> 4, dir = (mat >> 3) & 1, blk = mat & 7;
              const float* src = (gsel ? pt.f(I_w_i) : pt.f(I_w_a)) + (size_t)(dir * 8 + blk) * 128 * 128;
              tr_item(src, 128, 64 * kb, 32 * nb, (bf16_t*)(ws + WS_WG) + ((size_t)((blk * 2 + dir) * 256 + gsel * 128 + 32 * nb)) * 128, 128, scr, lane); }
        }
    }
}

__device__ __forceinline__ void adaln_tasks(int wv, const PT pt, LAS unsigned char* lds, int l, int rank, int nb, int t0 = 0, int t1 = 256) {
    const int tid = tid_l(wv);
    LAS float* sl = (LAS float*)(lds + 70000);
    LAS float* red = (LAS float*)lds;
    float* mod = (float*)(pt.ws() + WS_MOD);
#pragma unroll 1
    for (int task = t0 + rank; task < t1; task += nb) {
        const int cg_ = task >> 3, kr = task & 7, col0 = cg_ * 192;
        __syncthreads();
        for (int i = tid; i < 9 * 128; i += 512) { const int cv = i >> 7, k = kr * 128 + (i & 127); const float v = cv < 8 ? pt.f(I_c)[cv * D + k] : pt.f(I_c_ctx)[k]; sl[i] = silu_f(v); }
        __syncthreads();
        if (tid < 384) {
            const int q = tid % 48, ks = tid / 48;
            float acc[9][4];
#pragma unroll
            for (int cv = 0; cv < 9; ++cv) { acc[cv][0] = 0.f; acc[cv][1] = 0.f; acc[cv][2] = 0.f; acc[cv][3] = 0.f; }
            const float* wp = pt.f(I_w_mod) + ((size_t)l * D + kr * 128 + ks * 16) * NMOD + col0 + 4 * q;
            f32x4 w[16];
#pragma unroll
            for (int k = 0; k < 16; ++k) w[k] = *(const f32x4*)(wp + (size_t)k * NMOD);
#pragma unroll
            for (int k = 0; k < 16; ++k) {
#pragma unroll
                for (int cv = 0; cv < 9; ++cv) { const float s = sl[cv * 128 + ks * 16 + k]; acc[cv][0] += s * w[k][0]; acc[cv][1] += s * w[k][1]; acc[cv][2] += s * w[k][2]; acc[cv][3] += s * w[k][3]; }
            }
#pragma unroll
            for (int cv = 0; cv < 9; ++cv) *(LAS f32x4*)(red + (ks * 9 + cv) * 192 + 4 * q) = (f32x4){acc[cv][0], acc[cv][1], acc[cv][2], acc[cv][3]};
        }
        __syncthreads();
        for (int i = tid; i < 9 * 192; i += 512) {
            const int cv = i / 192, cc = i % 192; float s = 0.f;
#pragma unroll
            for (int ks = 0; ks < 8; ++ks) s += red[(ks * 9 + cv) * 192 + cc];
            if (kr == 0) s += pt.f(I_b_mod)[l * NMOD + col0 + cc];
            unsafeAtomicAdd(mod + ((size_t)l * 9 + cv) * NMOD + col0 + cc, s);
        }
    }
    __syncthreads();
}

__device__ __forceinline__ void cache_conv(int wv, const PT pt, int rank, int nb) {
    const int tid = tid_l(wv);
    unsigned char* ws = pt.ws();
    const size_t n4 = (size_t)MC * D / 4;
#pragma unroll 8
    for (size_t i = (size_t)rank * 512 + tid; i < 2 * n4; i += (size_t)nb * 512) {
        const bool isv = i >= n4; const size_t j = isv ? i - n4 : i;
        const f32x4 v = *((const f32x4*)(isv ? pt.f(I_cache_v) : pt.f(I_cache_k)) + j);
        u32x2 w; w.x = pk_bf16(v[0], v[1]); w.y = pk_bf16(v[2], v[3]);
        *((u32x2*)(ws + (isv ? WS_CV : WS_CK)) + j) = w;
    }
}

__device__ __forceinline__ void p0_prologue(int wv, const PT pt, LAS unsigned char* lds) {
    const int tid = tid_l(wv), lane = tid & 63, wave = tid >> 6;
    const int G = gd_l(), bxl = bx_l(), gw = bxl * 8 + wave, NGW = G * 8;
    unsigned char* ws = pt.ws();
    adaln_tasks(wv, pt, lds, 0, bxl, G, 0, 88);
    if (G > 88 + 64) { if (bxl >= 88) tr_items(wv, pt, lds, 0, 16 * 96, (bxl - 88) * 8 + wave, (G - 88) * 8); }
    else tr_items(wv, pt, lds, 0, 16 * 96, gw, NGW);
}

__device__ __forceinline__ void norm_phase(int wv, const float* xa, const float* xb, const float* g, const float* mod_l, int sh_chunk, bf16_t* XN) {
    const int tid = tid_l(wv), lane = tid & 63, gw = bx_l() * 8 + (tid >> 6), NGW = gd_l() * 8;
#pragma unroll 2
    for (int row = gw; row < MT; row += NGW) {
        const float* xr = row < MC ? xa + (size_t)row * D : xb + (size_t)(row - MC) * D;
        const int cv = row < MC ? 8 : ((row - MC) >> 10);
        const float* shp = mod_l + (size_t)cv * NMOD + sh_chunk * D; const float* scp = shp + D;
        f32x4 v[4], gg4[4], sc4[4], sh4[4]; float s = 0.f;
#pragma unroll
        for (int j = 0; j < 4; ++j) { const int c = 4 * lane + 256 * j; v[j] = *((const f32x4*)xr + lane + 64 * j); gg4[j] = *(const f32x4*)(g + c); sc4[j] = *(const f32x4*)(scp + c); sh4[j] = *(const f32x4*)(shp + c); }
#pragma unroll
        for (int j = 0; j < 4; ++j) s += (v[j][0] * v[j][0] + v[j][1] * v[j][1]) + (v[j][2] * v[j][2] + v[j][3] * v[j][3]);
        const float rstd = 1.f / sqrtf(wave_sum(s, lane) * (1.f / D) + RMS_EPS);
#pragma unroll
        for (int j = 0; j < 4; ++j) {
            const int c = 4 * lane + 256 * j;
            const f32x4 gg = gg4[j], sc = sc4[j], sh = sh4[j];
            const f32x4 y = v[j] * rstd * gg * (sc + 1.f) + sh;
            u32x2 w; w.x = pk_bf16(y[0], y[1]); w.y = pk_bf16(y[2], y[3]);
            *(u32x2*)(XN + (size_t)row * D + c) = w;
        }
    }
}
__device__ __forceinline__ void final_norm_phase(int wv, const bf16_t* XB, float* Y, const float* g) {
    const int tid = tid_l(wv), lane = tid & 63, gw = bx_l() * 8 + (tid >> 6), NGW = gd_l() * 8;
#pragma unroll 2
    for (int row = gw; row < MT; row += NGW) {
        const u32x4* xr = (const u32x4*)(XB + (size_t)row * D);
        f32x4 v[4], gg[4]; float s = 0.f;
#pragma unroll
        for (int j = 0; j < 2; ++j) {
            const u32x4 w = xr[lane + 64 * j];
            v[2 * j] = (f32x4){bf_lo(w.x), bf_hi(w.x), bf_lo(w.y), bf_hi(w.y)}; v[2 * j + 1] = (f32x4){bf_lo(w.z), bf_hi(w.z), bf_lo(w.w), bf_hi(w.w)};
            gg[2 * j] = *(const f32x4*)(g + 8 * lane + 512 * j); gg[2 * j + 1] = *(const f32x4*)(g + 8 * lane + 512 * j + 4);
        }
#pragma unroll
        for (int j = 0; j < 4; ++j) s += (v[j][0] * v[j][0] + v[j][1] * v[j][1]) + (v[j][2] * v[j][2] + v[j][3] * v[j][3]);
        const float rstd = 1.f / sqrtf(wave_sum(s, lane) * (1.f / D) + RMS_EPS);
        float* yr = Y + (size_t)row * D;
#pragma unroll
        for (int j = 0; j < 2; ++j) { *(f32x4*)(yr + 8 * lane + 512 * j) = v[2 * j] * rstd * gg[2 * j]; *(f32x4*)(yr + 8 * lane + 512 * j + 4) = v[2 * j + 1] * rstd * gg[2 * j + 1]; }
    }
}
__device__ __forceinline__ void conv_phase(int wv, const bf16_t* XR, const float* cw, const float* cb, bf16_t* XC) {
    const size_t n8 = (size_t)MT * D / 8;
#pragma unroll 2
    for (size_t i = (size_t)bx_l() * 512 + tid_l(wv), st_ = (size_t)gd_l() * 512; i < n8; i += st_) {
        const int row = (int)(i >> 7), c = (int)(i & 127) * 8;
        int pos, len; if (row < MC) { pos = row & 255; len = 256; } else { pos = (row - MC) & 1023; len = 1024; }
        float y[8];
#pragma unroll
        for (int e = 0; e < 8; ++e) y[e] = cb[c + e];
#pragma unroll
        for (int j = 0; j < 4; ++j) {
            const int p = pos + j - 2;
            if (p >= 0 && p < len) {
                const u32x4 xw = *(const u32x4*)(XR + (size_t)(row + j - 2) * D + c);
                const f32x4 w0 = *(const f32x4*)(cw + j * D + c), w1 = *(const f32x4*)(cw + j * D + c + 4);
                y[0] += w0[0] * bf_lo(xw.x); y[1] += w0[1] * bf_hi(xw.x); y[2] += w0[2] * bf_lo(xw.y); y[3] += w0[3] * bf_hi(xw.y);
                y[4] += w1[0] * bf_lo(xw.z); y[5] += w1[1] * bf_hi(xw.z); y[6] += w1[2] * bf_lo(xw.w); y[7] += w1[3] * bf_hi(xw.w);
            }
        }
        u32x4 o; o.x = pk_bf16(y[0], y[1]); o.y = pk_bf16(y[2], y[3]); o.z = pk_bf16(y[4], y[5]); o.w = pk_bf16(y[6], y[7]);
        *(u32x4*)(XC + (size_t)row * D + c) = o;
    }
}
__device__ __forceinline__ void conv_slab(int wv, const bf16_t* XR, const float* cw, const float* cb, bf16_t* XC, int q, int n) {
    const int tid = tid_l(wv), ch = n * 128 + (tid & 15) * 8, r0 = q * 256 + (tid >> 4) * 8;
    int pos0, len; if (r0 < MC) { pos0 = r0 & 255; len = 256; } else { pos0 = (r0 - MC) & 1023; len = 1024; }
    u32x4 x[11];
#pragma unroll
    for (int i = 0; i < 11; ++i) { const int p = pos0 + i - 2; x[i] = (p >= 0 && p < len) ? *(const u32x4*)(XR + (size_t)(r0 + i - 2) * D + ch) : (u32x4){0u, 0u, 0u, 0u}; }
    f32x4 w0[4], w1[4];
#pragma unroll
    for (int j = 0; j < 4; ++j) { w0[j] = *(const f32x4*)(cw + j * D + ch); w1[j] = *(const f32x4*)(cw + j * D + ch + 4); }
    const f32x4 b0 = *(const f32x4*)(cb + ch), b1 = *(const f32x4*)(cb + ch + 4);
#pragma unroll
    for (int r = 0; r < 8; ++r) {
        f32x4 y0 = b0, y1 = b1;
#pragma unroll
        for (int j = 0; j < 4; ++j) { const u32x4 xw = x[r + j];
            y0 += w0[j] * (f32x4){bf_lo(xw.x), bf_hi(xw.x), bf_lo(xw.y), bf_hi(xw.y)}; y1 += w1[j] * (f32x4){bf_lo(xw.z), bf_hi(xw.z), bf_lo(xw.w), bf_hi(xw.w)}; }
        u32x4 o; o.x = pk_bf16(y0[0], y0[1]); o.y = pk_bf16(y0[2], y0[3]); o.z = pk_bf16(y1[0], y1[1]); o.w = pk_bf16(y1[2], y1[3]);
        *(u32x4*)(XC + (size_t)(r0 + r) * D + ch) = o;
    }
    asm volatile("s_waitcnt vmcnt(0)" ::: "memory");
    __syncthreads();
}

__device__ __forceinline__ void lru_combine_phase(int wv, const unsigned char* ws, bf16_t* Y) {
    const bf16_t* HLF = (const bf16_t*)(ws + WS_HLF); const bf16_t* HLB = (const bf16_t*)(ws + WS_HLB);
    const bf16_t* PF = (const bf16_t*)(ws + WS_PF); const bf16_t* PB = (const bf16_t*)(ws + WS_PB); const bf16_t* GT = (const bf16_t*)(ws + WS_GATE);
    const float* sE = (const float*)(ws + WS_SUME); const float* sP = (const float*)(ws + WS_SUMP);
    const size_t n8 = (size_t)MT * D / 8;
#pragma unroll 2
    for (size_t i = (size_t)bx_l() * 512 + tid_l(wv), st_ = (size_t)gd_l() * 512; i < n8; i += st_) {
        const int row = (int)(i >> 7), c = (int)(i & 127) * 8;
        const size_t off = (size_t)row * D + c;
        const u32x4 hf = *(const u32x4*)(HLF + off), hb = *(const u32x4*)(HLB + off), gt = *(const u32x4*)(GT + off);
        float h[8] = {bf_lo(hf.x) + bf_lo(hb.x), bf_hi(hf.x) + bf_hi(hb.x), bf_lo(hf.y) + bf_lo(hb.y), bf_hi(hf.y) + bf_hi(hb.y),
                      bf_lo(hf.z) + bf_lo(hb.z), bf_hi(hf.z) + bf_hi(hb.z), bf_lo(hf.w) + bf_lo(hb.w), bf_hi(hf.w) + bf_hi(hb.w)};
        if (row >= MC) {
            const int q = row >> 8, ci = (q - 16) & 3, q0 = q - ci;
            const u32x4 pf = *(const u32x4*)(PF + off - (size_t)MC * D), pb = *(const u32x4*)(PB + off - (size_t)MC * D);
            f32x4 tf0 = {0.f, 0.f, 0.f, 0.f}, tf1 = tf0, tb0 = tf0, tb1 = tf0;
            for (int cc = 0; cc < ci; ++cc) { const float* e = sE + (size_t)(q0 + cc) * D + c; const float* p = sP + (size_t)(q0 + cc) * D + c;
                tf0 = *(const f32x4*)e + *(const f32x4*)p * tf0; tf1 = *(const f32x4*)(e + 4) + *(const f32x4*)(p + 4) * tf1; }
            for (int cc = 3; cc > ci; --cc) { const float* e = sE + (size_t)(48 + q0 + cc) * D + c; const float* p = sP + (size_t)(48 + q0 + cc) * D + c;
                tb0 = *(const f32x4*)e + *(const f32x4*)p * tb0; tb1 = *(const f32x4*)(e + 4) + *(const f32x4*)(p + 4) * tb1; }
            h[0] += bf_lo(pf.x) * tf0[0] + bf_lo(pb.x) * tb0[0]; h[1] += bf_hi(pf.x) * tf0[1] + bf_hi(pb.x) * tb0[1];
            h[2] += bf_lo(pf.y) * tf0[2] + bf_lo(pb.y) * tb0[2]; h[3] += bf_hi(pf.y) * tf0[3] + bf_hi(pb.y) * tb0[3];
            h[4] += bf_lo(pf.z) * tf1[0] + bf_lo(pb.z) * tb1[0]; h[5] += bf_hi(pf.z) * tf1[1] + bf_hi(pb.z) * tb1[1];
            h[6] += bf_lo(pf.w) * tf1[2] + bf_lo(pb.w) * tb1[2]; h[7] += bf_hi(pf.w) * tf1[3] + bf_hi(pb.w) * tb1[3];
        }
        u32x4 o;
        o.x = pk_bf16(h[0] * bf_lo(gt.x), h[1] * bf_hi(gt.x)); o.y = pk_bf16(h[2] * bf_lo(gt.y), h[3] * bf_hi(gt.y));
        o.z = pk_bf16(h[4] * bf_lo(gt.z), h[5] * bf_hi(gt.z)); o.w = pk_bf16(h[6] * bf_lo(gt.w), h[7] * bf_hi(gt.w));
        *(u32x4*)(Y + off) = o;
    }
}

#ifndef PG8_SP2
#define PG8_SP2 true
#endif
#ifndef PG8_ALIGN
#define PG8_ALIGN true
#endif

__device__ __forceinline__ void shw_phase(int wv, const PT pt, LAS unsigned char* lds, const int site, int bx, int G) {
    const int tid = tid_l(wv), lane = tid & 63;
    unsigned char* ws = pt.ws();
    const int lb = bx, nb = G;
    LAS float* sl = (LAS float*)lds;
    const float* mod = (const float*)(ws + WS_MOD);
    const int l = site ? 1 : 0, chunk = (site == 1) ? 0 : 3, N = (site == 1) ? 2 * D : 2 * FF;
    const bf16_t* Wt = site == 0 ? (const bf16_t*)(ws + WS_WGU) : (site == 1 ? (const bf16_t*)(ws + WS_WIN) : (const bf16_t*)(ws + WS_WGU) + (size_t)2 * FF * D);
    float* out = (float*)(ws + WS_SHW) + (site == 0 ? SHW_OFF0 : (site == 1 ? SHW_OFF1 : SHW_OFF2));
    __syncthreads();
#pragma unroll
    for (int r = 0; r < 3; ++r) {
        float v[6];
#pragma unroll
        for (int j = 0; j < 6; ++j) { const int i = tid + 512 * (6 * r + j); v[j] = mod[((size_t)l * 9 + (i >> 10)) * NMOD + chunk * D + (i & 1023)]; }
#pragma unroll
        for (int j = 0; j < 6; ++j) sl[tid + 512 * (6 * r + j)] = v[j];
    }
    __syncthreads();
    const int step = nb * 8;
    int n = lb * 8 + wv;
    u32x2 wa[4];
    if (n < N) {
#pragma unroll
        for (int j = 0; j < 4; ++j) wa[j] = *(const u32x2*)(Wt + (size_t)n * D + 4 * lane + 256 * j);
    }
    for (; n < N; n += step) {
        u32x2 wb[4];
        const int n2 = n + step;
        if (n2 < N) {
#pragma unroll
            for (int j = 0; j < 4; ++j) wb[j] = *(const u32x2*)(Wt + (size_t)n2 * D + 4 * lane + 256 * j);
        }
        float res = 0.f;
#pragma unroll
        for (int cv = 0; cv < 9; ++cv) {
            float s = 0.f;
#pragma unroll
            for (int j = 0; j < 4; ++j) { const f32x4 v = *(const LAS f32x4*)(sl + cv * D + 4 * lane + 256 * j); s += (v[0] * bf_lo(wa[j].x) + v[1] * bf_hi(wa[j].x)) + (v[2] * bf_lo(wa[j].y) + v[3] * bf_hi(wa[j].y)); }
            s = wave_sum(s, lane);
            if (lane == cv) res = s;
        }
        if (lane < 9) out[(size_t)lane * N + n] = res;
#pragma unroll
        for (int j = 0; j < 4; ++j) wa[j] = wb[j];
    }
    __syncthreads();
}

#ifndef PHMASK
#define PHMASK 0xffff
#endif
constexpr int PHM = PHMASK;
__global__ void __launch_bounds__(512, 2) fwd_megakernel(Args a) {
    extern __shared__ __attribute__((aligned(16))) unsigned char lds_raw[];
    LAS unsigned char* lds = (LAS unsigned char*)lds_raw;
    cg::grid_group grid = cg::this_grid();
    const int wv = __builtin_amdgcn_readfirstlane(threadIdx.x >> 6);
    {
        LAS unsigned long long* tw = (LAS unsigned long long*)(lds + PTAB_OFF);
        if (threadIdx.x == 0) {
            tw[0] = (unsigned long long)a.x_prompt; tw[1] = (unsigned long long)a.x_sample; tw[2] = (unsigned long long)a.c; tw[3] = (unsigned long long)a.cache_k; tw[4] = (unsigned long long)a.cache_v;
            tw[5] = (unsigned long long)a.state_h; tw[6] = (unsigned long long)a.c_ctx; tw[7] = (unsigned long long)a.norm_g; tw[8] = (unsigned long long)a.w_mod; tw[9] = (unsigned long long)a.b_mod;
            tw[10] = (unsigned long long)a.w_qkv; tw[11] = (unsigned long long)a.w_o; tw[12] = (unsigned long long)a.rpb; tw[13] = (unsigned long long)a.w_in; tw[14] = (unsigned long long)a.conv_w;
            tw[15] = (unsigned long long)a.conv_b; tw[16] = (unsigned long long)a.w_a; tw[17] = (unsigned long long)a.b_a; tw[18] = (unsigned long long)a.w_i; tw[19] = (unsigned long long)a.b_i;
            tw[20] = (unsigned long long)a.lam; tw[21] = (unsigned long long)a.w_out; tw[22] = (unsigned long long)a.w_gu; tw[23] = (unsigned long long)a.w_down; tw[24] = (unsigned long long)a.final_g;
            tw[25] = (unsigned long long)a.out; tw[26] = (unsigned long long)a.ws;
            LAS unsigned* st = (LAS unsigned*)(lds + BARST_OFF); st[0] = 0u; st[1] = 0u;
            (void)xb_add((unsigned*)(a.ws + WS_BAR) + XB_XCNT(xb_xcc_id()), 1u);
        }
        __syncthreads();
        if (a.out == nullptr) grid.sync();
    }
#define GSYNC() do { for (int rs_ = 0; rs_ < REP_SYNC; ++rs_) xcd_barrier(pt, lds, wv); } while (0)
    const PT pt{(LAS const unsigned long long*)(lds + PTAB_OFF)};
#define WSP(off) (pt.ws() + (off))
#define MODP ((float*)WSP(WS_MOD))
#define XNP ((bf16_t*)WSP(WS_XN))
#define XRES (pt.out() + OUT_Y)
#define XBP ((bf16_t*)WSP(WS_XB))
#define SSQP(i) ((float*)WSP(WS_SSQ) + (size_t)(i) * MT)

    if (PHM & 1) p0_prologue(wv, pt, lds);
    GSYNC();
    if (PHM & 2) for (int rep_ = 0; rep_ < REP_THIN; ++rep_) norm_phase(wv, pt.f(I_x_prompt), pt.f(I_x_sample), pt.f(I_norm_g), MODP, 0, XNP);
    GSYNC();
    if (PHM & 4) { pg8::Gemm g{XNP, (const bf16_t*)WSP(WS_WQKV), MT, NQKV, D, D, D, wv}; pg8::StaticOrder S; S.init(MT, NQKV, gd_l(), bx_l()); S.reps = REP_GEMM;
      pg8::EpiQKV E{(bf16_t*)WSP(WS_Q), pt.out() + OUT_NK, 0.125f * LOG2E};
      pg8::gemm_phase<pg8::EpiQKV, pg8::StaticOrder, PG8_ALIGN, PG8_SP2>(lds, g, S, E); }
    {
        const int G_ = gd_l(), c_ = bx_l(), nwg_ = (MT / 256) * (NQKV / 256), maxu_ = (nwg_ + G_ - 1) / G_, full_ = nwg_ - (maxu_ - 1) * G_;
        int rank_ = c_, n_ = G_;
        if (full_ < G_) { rank_ = c_ - full_; n_ = c_ >= full_ ? G_ - full_ : 0; }
        if (n_ > 0) { adaln_tasks(wv, pt, lds, 0, rank_, n_, 88, 256); tr_items(wv, pt, lds, 16 * 96, 16 * 96 + 16 * 32 + 16 * 176, rank_ * 8 + wv, n_ * 8); }
    }
    GSYNC();
    if (PHM & 8) for (int rep_ = 0; rep_ < REP_ATT; ++rep_) for (int vc = vcu_l(), G_ = gd_l(); vc < 256; vc += G_) {
        const int bh = vc >> 1;
#pragma unroll 1
        for (int gi = 0; gi < 2; ++gi)
            att::unit<true>(wv, lds, bh >> 4, bh & 15, 2 * (vc & 1) + gi, (const bf16_t*)WSP(WS_Q), (const bf16_t*)WSP(WS_K), (const bf16_t*)WSP(WS_V), pt.f(I_cache_k), pt.f(I_cache_v), XNP, pt.f(I_rpb));
        att::unit<false>(wv, lds, vc >> 4, vc & 15, 0, (const bf16_t*)WSP(WS_Q), (const bf16_t*)WSP(WS_K), (const bf16_t*)WSP(WS_V), nullptr, nullptr, XNP, nullptr);
    }
    GSYNC();
    if (PHM & 16)
#pragma unroll 1
    for (int rp_ = REP_P4 - 1; rp_ >= 0; --rp_) { pg8::Gemm g{XNP, (const bf16_t*)WSP(WS_WO), MT, D, D, D, D, wv}; pg8::StaticOrder S; S.init(MT, D, gd_l(), bx_l());
      pg8::EpiResT<true, true> E{pt.f(I_x_prompt), pt.f(I_x_sample), XBP, MODP + 2 * D, (bf16_t*)WSP(WS_XN2), pt.f(I_norm_g) + D, MODP + 4 * D, rp_ ? (float*)WSP(WS_HLF) : SSQP(0)};
      pg8::gemm_phase<pg8::EpiResT<true, true>, pg8::StaticOrder, false, PG8_SP2>(lds, g, S, E); }
    {
        const int G_ = gd_l(), c_ = bx_l(), nwg_ = (MT / 256) * (D / 256);
        int rank_ = c_, n_ = G_;
        if (nwg_ < G_) { rank_ = c_ - nwg_; n_ = c_ >= nwg_ ? G_ - nwg_ : 0; }
        if (n_ > 0) { shw_phase(wv, pt, lds, 0, rank_, n_); tr_items(wv, pt, lds, 16 * 96 + 16 * 32 + 16 * 176, 16 * 96 + 16 * 32 + 16 * 176 + 44 * 32, rank_ * 8 + wv, n_ * 8); }
    }
    GSYNC();
    if (PHM & 512) { pg8::Gemm g{(const bf16_t*)WSP(WS_XN2), (const bf16_t*)WSP(WS_WGU), MT, 2 * FF, D, D, D, wv}; pg8::StaticOrder S; S.init(MT, 2 * FF, gd_l(), bx_l()); S.reps = REP_GEMM;
      pg8::EpiSwiglu E{(bf16_t*)WSP(WS_H), SSQP(0), (const float*)WSP(WS_SHW) + SHW_OFF0};
      pg8::gemm_phase<pg8::EpiSwiglu, pg8::StaticOrder, PG8_ALIGN, PG8_SP2>(lds, g, S, E); }
    {
        const int G_ = gd_l(), c_ = bx_l(), nwg_ = (MT / 256) * (2 * FF / 256), maxu_ = (nwg_ + G_ - 1) / G_, full_ = nwg_ - (maxu_ - 1) * G_;
        int rank_ = c_, n_ = G_;
        if (full_ < G_) { rank_ = c_ - full_; n_ = c_ >= full_ ? G_ - full_ : 0; }
        if (n_ > 0) { adaln_tasks(wv, pt, lds, 1, rank_, n_); tr_items(wv, pt, lds, 16 * 96 + 16 * 32 + 2 * 16 * 176 + 44 * 32, 12288, rank_ * 8 + wv, n_ * 8); }
    }
    GSYNC();
    if (PHM & 16) { pg8::Gemm g{(const bf16_t*)WSP(WS_H), (const bf16_t*)WSP(WS_WDN), MT, D, FF, FF, FF, wv}; pg8::StaticOrder S; S.init(MT, D, gd_l(), bx_l());
      pg8::EpiResT<true, false> E{nullptr, nullptr, XBP, MODP + 5 * D, XNP, pt.f(I_norm_g) + 2 * D, MODP + (size_t)9 * NMOD + 1 * D, SSQP(1)};
      pg8::gemm_phase<pg8::EpiResT<true, false>, pg8::StaticOrder, false, PG8_SP2>(lds, g, S, E); }
    {
        const int G_ = gd_l(), c_ = bx_l(), nwg_ = (MT / 256) * (D / 256);
        int rank_ = c_, n_ = G_;
        if (nwg_ < G_) { rank_ = c_ - nwg_; n_ = c_ >= nwg_ ? G_ - nwg_ : 0; }
        if (n_ > 0) { shw_phase(wv, pt, lds, 1, rank_, n_); tr_items(wv, pt, lds, 16 * 96 + 16 * 32 + 16 * 176 + 44 * 32, 16 * 96 + 16 * 32 + 2 * 16 * 176 + 44 * 32, rank_ * 8 + wv, n_ * 8); }
    }
    GSYNC();
    if (PHM & 32) { pg8::Gemm g{XNP, (const bf16_t*)WSP(WS_WIN), MT, 2 * D, D, D, D, wv}; pg8::StaticOrder S; S.init(MT, 2 * D, gd_l(), bx_l()); S.reps = REP_GEMM;
      pg8::EpiWin E{(bf16_t*)WSP(WS_GATE), (bf16_t*)WSP(WS_XR), SSQP(1), (const float*)WSP(WS_SHW) + SHW_OFF1};
      pg8::gemm_phase<pg8::EpiWin, pg8::StaticOrder, PG8_ALIGN, PG8_SP2>(lds, g, S, E); }
    {
        const int G_ = gd_l(), c_ = bx_l(), nwg_ = (MT / 256) * (2 * D / 256), maxu_ = (nwg_ + G_ - 1) / G_, full_ = nwg_ - (maxu_ - 1) * G_;
        int rank_ = c_, n_ = G_;
        if (full_ < G_) { rank_ = c_ - full_; n_ = c_ >= full_ ? G_ - full_ : 0; }
        if (n_ > 0) shw_phase(wv, pt, lds, 2, rank_, n_);
    }
    GSYNC();
    if (PHM & 128)
#pragma unroll 1
    for (int uu = vcu_l(), G_ = gd_l(); uu < 768 * REP_LRU; uu += G_) {
        const int u = uu % 768;
        const int dir = u & 1, n = (u >> 1) & 7, q = u >> 4;
        const float* h0 = nullptr;
        if (q >= 16) { const int b = (q - 16) >> 2, ci = (q - 16) & 3; if ((dir == 0 && ci == 0) || (dir == 1 && ci == 3)) h0 = pt.f(I_state_h) + ((size_t)b * 2 + dir) * D; }
        conv_slab(wv, (const bf16_t*)WSP(WS_XR), pt.f(I_conv_w), pt.f(I_conv_b), XNP, q, n);
        pg8::Gemm g{XNP + (size_t)q * 256 * D + n * 128, (const bf16_t*)WSP(WS_WG) + (size_t)(n * 2 + dir) * 256 * 128, 256, 256, 128, D, 128, wv};
        pg8::OneUnit S;
        pg8::EpiLru E{pt.t, h0, q * 256, n * 128, dir, q};
        pg8::gemm_phase<pg8::EpiLru, pg8::OneUnit, false, false>(lds, g, S, E);
    }
    GSYNC();
    if (PHM & 256) for (int rep_ = 0; rep_ < REP_THIN; ++rep_) lru_combine_phase(wv, pt.ws(), (bf16_t*)WSP(WS_Y));
    GSYNC();
    if (PHM & 16) { pg8::Gemm g{(const bf16_t*)WSP(WS_Y), (const bf16_t*)WSP(WS_WOUT), MT, D, D, D, D, wv}; pg8::StaticOrder S; S.init(MT, D, gd_l(), bx_l());
      pg8::EpiResT<true, false> E{nullptr, nullptr, XBP, MODP + (size_t)9 * NMOD + 2 * D, XNP, pt.f(I_norm_g) + 3 * D, MODP + (size_t)9 * NMOD + 4 * D, SSQP(2)};
      pg8::gemm_phase<pg8::EpiResT<true, false>, pg8::StaticOrder, false, PG8_SP2>(lds, g, S, E); }
    GSYNC();
    if (PHM & 512) { pg8::Gemm g{XNP, (const bf16_t*)WSP(WS_WGU) + (size_t)2 * FF * D, MT, 2 * FF, D, D, D, wv}; pg8::StaticOrder S; S.init(MT, 2 * FF, gd_l(), bx_l()); S.reps = REP_GEMM;
      pg8::EpiSwiglu E{(bf16_t*)WSP(WS_H), SSQP(2), (const float*)WSP(WS_SHW) + SHW_OFF2};
      pg8::gemm_phase<pg8::EpiSwiglu, pg8::StaticOrder, PG8_ALIGN, PG8_SP2>(lds, g, S, E); }
    GSYNC();
    if (gd_l() >= (MT / 256) * (D / 256)) {
        pg8::Gemm g{(const bf16_t*)WSP(WS_H), (const bf16_t*)WSP(WS_WDN) + (size_t)D * FF, MT, D, FF, FF, FF, wv}; pg8::StaticOrder S; S.init(MT, D, gd_l(), bx_l());
        pg8::EpiResFinal E{XBP, MODP + (size_t)9 * NMOD + 5 * D, SSQP(3), (unsigned*)WSP(WS_FCNT), pt.f(I_final_g), XRES};
        pg8::gemm_phase<pg8::EpiResFinal, pg8::StaticOrder, true, PG8_SP2>(lds, g, S, E);
    } else {
        { pg8::Gemm g{(const bf16_t*)WSP(WS_H), (const bf16_t*)WSP(WS_WDN) + (size_t)D * FF, MT, D, FF, FF, FF, wv}; pg8::StaticOrder S; S.init(MT, D, gd_l(), bx_l());
          pg8::EpiResT<false, false> E{nullptr, nullptr, XBP, MODP + (size_t)9 * NMOD + 5 * D, nullptr, nullptr, nullptr, nullptr};
          pg8::gemm_phase<pg8::EpiResT<false, false>, pg8::StaticOrder, PG8_ALIGN, PG8_SP2>(lds, g, S, E); }
        GSYNC();
        final_norm_phase(wv, XBP, XRES, pt.f(I_final_g));
    }
}

extern "C" void kernel_launch(void* const* d_in, const int* in_sizes, int n_in, void* d_out, int out_size, void* d_ws, size_t ws_size, hipStream_t stream) {
    static int grid = 0;
    if (grid == 0) {
        int dev = 0, cus = 0, per_cu = 0;
        (void)hipGetDevice(&dev);
        (void)hipDeviceGetAttribute(&cus, hipDeviceAttributeMultiprocessorCount, dev);
        (void)hipFuncSetAttribute((const void*)fwd_megakernel, hipFuncAttributeMaxDynamicSharedMemorySize, LDS_BYTES);
        (void)hipOccupancyMaxActiveBlocksPerMultiprocessor(&per_cu, (const void*)fwd_megakernel, 512, LDS_BYTES);
        if (per_cu < 1) { fprintf(stderr, "kernel_launch: occupancy query says %d blocks per CU\n", per_cu); per_cu = 1; }
        grid = cus * per_cu;
        if (ws_size < WS_END) { fprintf(stderr, "kernel_launch: workspace too small (%zu < %zu)\n", ws_size, (size_t)WS_END); grid = -1; }
    }
    if (grid < 0) return;
    (void)hipMemsetAsync((char*)d_ws + WS_MOD, 0, 1024 * 1024, stream);
    Args a{};
    const float** ap = (const float**)&a;
    for (int i = 0; i < 25; ++i) ap[i] = (const float*)d_in[i];
    a.out = (float*)d_out; a.ws = (unsigned char*)d_ws;
    void* args[] = {&a};
    hipError_t e = hipLaunchCooperativeKernel((const void*)fwd_megakernel, dim3(grid), dim3(512), args, LDS_BYTES, stream);
    if (e != hipSuccess) fprintf(stderr, "cooperative launch failed: %s (grid %d)\n", hipGetErrorString(e), grid);
}
```
